# Optimizing an MI355X kernel written in HIP

```python
import jax, jax.numpy as jnp
from jax import lax
import numpy as np

D_MODEL = 1024
BATCH = 16
SEQ = 4096
DEPTH = 2

N_MIXERS = 2
N_MEM = 256
MIX_WIDTH = D_MODEL
MEM_HEADS = 4
MEM_WIDTH = MIX_WIDTH // 4
MEM_HEAD_DIM = MEM_WIDTH // MEM_HEADS
MAIN_WIDTH = MIX_WIDTH - MEM_WIDTH
MLA_HEADS = 12
QK_NOPE = 64
QK_ROPE = 32
V_HEAD = MAIN_WIDTH // MLA_HEADS
Q_LORA = (3 * D_MODEL) // 8
KV_LORA = D_MODEL // 4
ROPE_THETA = 10000.0
Q_BLOCK = 128
FNET_GROUPS = 4
FNET_GROUP_DIM = MAIN_WIDTH // FNET_GROUPS
EPS = 1e-6

MLA_IN = Q_LORA + KV_LORA + QK_ROPE + MEM_WIDTH + MIX_WIDTH
FNET_IN = MAIN_WIDTH + MEM_WIDTH + MIX_WIDTH

kernel_name = "hybrid_mla_fnet_memory_encoder"


def rmsnorm(x, g):
    xf = x.astype(jnp.float32)
    y = xf * lax.rsqrt(jnp.mean(xf * xf, axis=-1, keepdims=True) + EPS)
    return (y * g.astype(jnp.float32)).astype(x.dtype)


def rope_tables(positions):
    inv_freq = 1.0 / (ROPE_THETA ** (jnp.arange(0, QK_ROPE, 2, dtype=jnp.float32) / QK_ROPE))
    ang = positions.astype(jnp.float32)[..., None] * inv_freq
    return jnp.cos(ang), jnp.sin(ang)


def apply_rope(t, cos, sin):
    tf = t.astype(jnp.float32)
    t1, t2 = tf[..., : QK_ROPE // 2], tf[..., QK_ROPE // 2:]
    return jnp.concatenate([t1 * cos - t2 * sin, t2 * cos + t1 * sin], axis=-1).astype(t.dtype)


def mla_attention(q_nope, q_rope, k_nope, k_rope, v):
    B, S, H, _ = q_nope.shape
    nb = S // Q_BLOCK
    scale = 1.0 / float(np.sqrt(QK_NOPE + QK_ROPE))

    def to_blocks(t):
        return jnp.moveaxis(t.reshape((B, nb, Q_BLOCK) + t.shape[2:]), 1, 0)

    def one_block(args):
        qn, qr = args
        s = (jnp.einsum('bqhd,bkhd->bhqk', qn, k_nope)
             + jnp.einsum('bqhr,bkr->bhqk', qr, k_rope)).astype(jnp.float32) * scale
        p = jax.nn.softmax(s, axis=-1).astype(v.dtype)
        return jnp.einsum('bhqk,bkhd->bqhd', p, v)

    out = lax.map(one_block, (to_blocks(q_nope), to_blocks(q_rope)))
    return jnp.moveaxis(out, 0, 1).reshape(B, S, H * V_HEAD)


def memory_cross_attention(q_mem, mem, mem_norm_g, w_mem_kv):
    B, S, _ = q_mem.shape
    q = q_mem.reshape(B, S, MEM_HEADS, MEM_HEAD_DIM)
    kv = (rmsnorm(mem, mem_norm_g) @ w_mem_kv).reshape(B, mem.shape[1], 2, MEM_HEADS, MEM_HEAD_DIM)
    k, v = kv[:, :, 0], kv[:, :, 1]
    s = jnp.einsum('bshd,bmhd->bhsm', q, k).astype(jnp.float32) * (1.0 / float(np.sqrt(MEM_HEAD_DIM)))
    p = jax.nn.softmax(s, axis=-1).astype(v.dtype)
    return jnp.einsum('bhsm,bmhd->bshd', p, v).reshape(B, S, MEM_WIDTH)


def mla_layer(x, mem, cos, sin, norm_g, w_in, q_norm_g, kv_norm_g, w_uq, w_ukv,
              mem_norm_g, w_mem_kv, w_out):
    B, S, _ = x.shape
    h = rmsnorm(x, norm_g)
    proj = h @ w_in
    o1 = Q_LORA
    o2 = o1 + KV_LORA
    o3 = o2 + QK_ROPE
    o4 = o3 + MEM_WIDTH
    c_q, c_kv, k_rope = proj[..., :o1], proj[..., o1:o2], proj[..., o2:o3]
    q_mem, gate = proj[..., o3:o4], proj[..., o4:]
    q = (rmsnorm(c_q, q_norm_g) @ w_uq).reshape(B, S, MLA_HEADS, QK_NOPE + QK_ROPE)
    kv = (rmsnorm(c_kv, kv_norm_g) @ w_ukv).reshape(B, S, MLA_HEADS, QK_NOPE + V_HEAD)
    q_nope = q[..., :QK_NOPE]
    q_rope = apply_rope(q[..., QK_NOPE:], cos[:, :, None, :], sin[:, :, None, :])
    k_nope, v = kv[..., :QK_NOPE], kv[..., QK_NOPE:]
    k_rope = apply_rope(k_rope, cos, sin)
    attn = mla_attention(q_nope, q_rope, k_nope, k_rope, v)
    mem_out = memory_cross_attention(q_mem, mem, mem_norm_g, w_mem_kv)
    branch = jnp.concatenate([attn, mem_out], axis=-1) * jax.nn.silu(gate)
    return x + branch @ w_out


def fnet_layer(x, mem, norm_g, w_in, w_fnet, mem_norm_g, w_mem_kv, w_out):
    B, S, _ = x.shape
    h = rmsnorm(x, norm_g)
    proj = h @ w_in
    f = proj[..., :MAIN_WIDTH].reshape(B, S, FNET_GROUPS, FNET_GROUP_DIM).astype(jnp.float32)
    q_mem = proj[..., MAIN_WIDTH:MAIN_WIDTH + MEM_WIDTH]
    gate = proj[..., MAIN_WIDTH + MEM_WIDTH:]
    spec = jnp.fft.fft2(f, axes=(1, 3), norm='ortho').real
    mixed = jnp.einsum('bsgc,gcd->bsgd', spec, w_fnet.astype(jnp.float32))
    mixed = mixed.reshape(B, S, MAIN_WIDTH).astype(x.dtype)
    mem_out = memory_cross_attention(q_mem, mem, mem_norm_g, w_mem_kv)
    branch = jnp.concatenate([mixed, mem_out], axis=-1) * jax.nn.silu(gate)
    return x + branch @ w_out


def setup_inputs(seed: int = 0) -> dict:
    key = jax.random.key(seed)
    ks = jax.random.split(key, 24)
    f32 = jnp.float32

    def w(k, shape, fan_in):
        return jax.random.normal(k, shape, f32) * (fan_in ** -0.5)

    def gain(k, n):
        return 1.0 + 0.02 * jax.random.normal(k, (n,), f32)

    x = jax.random.normal(ks[0], (BATCH, SEQ, D_MODEL), f32)
    mem = jax.random.normal(ks[1], (BATCH, N_MEM, D_MODEL), f32)
    offsets = jax.random.randint(ks[2], (BATCH, 1), 0, 1024, dtype=jnp.int32)
    positions = (jnp.arange(SEQ, dtype=jnp.int32)[None, :] + offsets).astype(jnp.int32)
    return {
        "x": x,
        "mem": mem,
        "positions": positions,
        "norm_g_l0": gain(ks[3], D_MODEL),
        "w_in_l0": w(ks[4], (D_MODEL, MLA_IN), D_MODEL),
        "q_norm_g_l0": gain(ks[5], Q_LORA),
        "kv_norm_g_l0": gain(ks[6], KV_LORA),
        "w_uq_l0": w(ks[7], (Q_LORA, MLA_HEADS * (QK_NOPE + QK_ROPE)), Q_LORA),
        "w_ukv_l0": w(ks[8], (KV_LORA, MLA_HEADS * (QK_NOPE + V_HEAD)), KV_LORA),
        "mem_norm_g_l0": gain(ks[9], D_MODEL),
        "w_mem_kv_l0": w(ks[10], (D_MODEL, 2 * MEM_WIDTH), D_MODEL),
        "w_out_l0": w(ks[11], (MIX_WIDTH, D_MODEL), MIX_WIDTH),
        "norm_g_l1": gain(ks[12], D_MODEL),
        "w_in_l1": w(ks[13], (D_MODEL, FNET_IN), D_MODEL),
        "w_fnet_l1": w(ks[14], (FNET_GROUPS, FNET_GROUP_DIM, FNET_GROUP_DIM), FNET_GROUP_DIM),
        "mem_norm_g_l1": gain(ks[15], D_MODEL),
        "w_mem_kv_l1": w(ks[16], (D_MODEL, 2 * MEM_WIDTH), D_MODEL),
        "w_out_l1": w(ks[17], (MIX_WIDTH, D_MODEL), MIX_WIDTH),
        "final_norm_g": gain(ks[18], D_MODEL),
    }


def reference(x, mem, positions,
              norm_g_l0, w_in_l0, q_norm_g_l0, kv_norm_g_l0, w_uq_l0, w_ukv_l0,
              mem_norm_g_l0, w_mem_kv_l0, w_out_l0,
              norm_g_l1, w_in_l1, w_fnet_l1, mem_norm_g_l1, w_mem_kv_l1, w_out_l1,
              final_norm_g):
    cos, sin = rope_tables(positions)
    for i in range(DEPTH):
        if i % N_MIXERS == 0:
            x = mla_layer(x, mem, cos, sin, norm_g_l0, w_in_l0, q_norm_g_l0, kv_norm_g_l0,
                          w_uq_l0, w_ukv_l0, mem_norm_g_l0, w_mem_kv_l0, w_out_l0)
        else:
            x = fnet_layer(x, mem, norm_g_l1, w_in_l1, w_fnet_l1,
                           mem_norm_g_l1, w_mem_kv_l1, w_out_l1)
    return rmsnorm(x, final_norm_g)
```

```cpp
#include <hip/hip_runtime.h>
#include <stdint.h>
#include <cstdio>

typedef unsigned short bf16_t;
constexpr int T = 65536, SEQ = 4096, NB = 16, DM = 1024;
constexpr float EPS = 1e-6f;
constexpr float LOG2E = 1.4426950408889634f;
constexpr float QS_MLA = 0.10206207261596575f * LOG2E;
constexpr float QS_MEM = 0.125f * LOG2E;

constexpr size_t MiB = 1u << 20;
constexpr size_t WS_CTL = 0;
constexpr size_t WS_WIN0 = 1 * MiB;
constexpr size_t WS_WUQ = 5 * MiB;
constexpr size_t WS_WUKV = 6 * MiB;
constexpr size_t WS_WMEM = 7 * MiB;
constexpr size_t WS_WOUT0 = 9 * MiB;
constexpr size_t WS_WOUT1 = 11 * MiB;
constexpr size_t WS_WIN1 = 13 * MiB;
constexpr size_t WS_AGBG = 19 * MiB;
constexpr size_t WS_ROPE = 21 * MiB;
constexpr size_t WS_MEMN = 29 * MiB;
constexpr size_t WS_MEMKV = 37 * MiB;
constexpr size_t WS_RSTD1 = 45 * MiB;
constexpr size_t WS_SSQ = 46 * MiB;
constexpr size_t WS_XN0 = 64 * MiB;
constexpr size_t WS_BR = 64 * MiB;
constexpr size_t WS_CQ = 192 * MiB;
constexpr size_t WS_CKV = 240 * MiB;
constexpr size_t WS_QMEM0 = 272 * MiB;
constexpr size_t WS_SG0 = 304 * MiB;
constexpr size_t WS_K = 432 * MiB;
constexpr size_t WS_Q = 576 * MiB;
constexpr size_t WS_V = 720 * MiB;
constexpr size_t WS_X1B = 192 * MiB;
constexpr size_t WS_PQ = 320 * MiB;
constexpr size_t WS_QMEM1 = 512 * MiB;
constexpr size_t WS_SG1 = 544 * MiB;
constexpr size_t WS_Y = 672 * MiB;
constexpr size_t WS_END = 864 * MiB;

__device__ __forceinline__ float bf2f(bf16_t h) { return __uint_as_float(((unsigned)h) << 16); }
__device__ __forceinline__ bf16_t f2bf(float f) { unsigned u = __float_as_uint(f); return (bf16_t)((u + 0x7fffu + ((u >> 16) & 1u)) >> 16); }
__device__ __forceinline__ unsigned pk2(float lo, float hi) { return (unsigned)f2bf(lo) | ((unsigned)f2bf(hi) << 16); }
__device__ __forceinline__ float silu_f(float v) { return v / (1.f + __expf(-v)); }
__device__ __forceinline__ float wave_sum(float v) {
#pragma unroll
    for (int o = 1; o < 64; o <<= 1) v += __shfl_xor(v, o);
    return v;
}
__host__ __device__ __forceinline__ int ropedim(int p) { return 4 * (p >> 3) + (p & 3) + 16 * ((p >> 2) & 1); }

enum { MODE_WIN0 = 0, MODE_WUQ = 1, MODE_WUKV = 2, MODE_PLAIN = 3 };
__device__ __forceinline__ int src_col(int mode, int n, int off) {
    if (mode == MODE_WIN0) {
        if (n < 640) return n;
        if (n < 896) return 672 + (n - 640);
        if (n < 928) return 640 + ropedim(n - 896);
        if (n < 1024) return -1;
        return 928 + (n - 1024);
    } else if (mode == MODE_WUQ) {
        if (n < 768) return (n >> 6) * 96 + (n & 63);
        if (n < 1152) { const int r = n - 768; return (r >> 5) * 96 + 64 + ropedim(r & 31); }
        return -1;
    } else if (mode == MODE_WUKV) {
        if (n < 768) return (n >> 6) * 128 + (n & 63);
        const int r = n - 768; return (r >> 6) * 128 + 64 + (r & 63);
    }
    return n + off;
}
__global__ __launch_bounds__(256) void prep_w(const float* __restrict__ W, int ldw, int K, bf16_t* __restrict__ out, int n0, int nrows, const float* __restrict__ scale, int mode, int off) {
    const int idx = blockIdx.x * 256 + threadIdx.x;
    const int n = idx % nrows, k8 = idx / nrows;
    if (k8 * 8 >= K) return;
    const int sc = src_col(mode, n, off);
    float v[8];
#pragma unroll
    for (int i = 0; i < 8; ++i) { const int k = k8 * 8 + i; float w = (sc >= 0) ? W[(size_t)k * ldw + sc] : 0.f; if (scale) w *= scale[k]; v[i] = w; }
    uint4 o; o.x = pk2(v[0], v[1]); o.y = pk2(v[2], v[3]); o.z = pk2(v[4], v[5]); o.w = pk2(v[6], v[7]);
    *(uint4*)(out + (size_t)(n0 + n) * K + k8 * 8) = o;
}

__global__ __launch_bounds__(256) void rmsnorm_rows(const float* __restrict__ X, const float* __restrict__ g, bf16_t* __restrict__ O, int nrows) {
    const int lane = threadIdx.x & 63, row = blockIdx.x * 4 + (threadIdx.x >> 6);
    if (row >= nrows) return;
    const float4* xr = (const float4*)(X + (size_t)row * DM) + lane;
    float4 v[4]; float s = 0.f;
#pragma unroll
    for (int j = 0; j < 4; ++j) { v[j] = xr[64 * j]; s += v[j].x * v[j].x + v[j].y * v[j].y + v[j].z * v[j].z + v[j].w * v[j].w; }
    const float rstd = rsqrtf(wave_sum(s) * (1.f / DM) + EPS);
    uint2* o = (uint2*)(O + (size_t)row * DM) + lane;
#pragma unroll
    for (int j = 0; j < 4; ++j) {
        float4 gv = g ? ((const float4*)g)[lane + 64 * j] : make_float4(1.f, 1.f, 1.f, 1.f);
        uint2 w; w.x = pk2(v[j].x * rstd * gv.x, v[j].y * rstd * gv.y); w.y = pk2(v[j].z * rstd * gv.z, v[j].w * rstd * gv.w);
        o[64 * j] = w;
    }
}
__global__ __launch_bounds__(256) void rope_table(const int* __restrict__ pos, float2* __restrict__ tab) {
    const int idx = blockIdx.x * 256 + threadIdx.x;
    const int t = idx >> 4, i = idx & 15;
    const float inv_freq = (float)(1.0 / pow(10000.0, (double)i / 16.0));
    const float ang = (float)pos[t] * inv_freq;
    tab[idx] = make_float2((float)cos((double)ang), (float)sin((double)ang));
}
__global__ __launch_bounds__(192) void fnet_fold1(const float* __restrict__ Wf, float* __restrict__ AG) {
    const int d = threadIdx.x, c = blockIdx.x, g = blockIdx.y, pq = blockIdx.z;
    float acc = 0.f;
    for (int m = 0; m < 192; ++m) {
        const float fr = 2.0f * (float)((m * c) % 192) / 192.0f;
        const float tr = pq ? sinpif(fr) : cospif(fr);
        acc += tr * Wf[((size_t)g * 192 + m) * 192 + d];
    }
    AG[(((size_t)pq * 4 + g) * 192 + c) * 192 + d] = acc * 0.07216878364870322f;
}
__global__ __launch_bounds__(192) void fnet_fold2(const float* __restrict__ Win1, const float* __restrict__ g1, const float* __restrict__ AG, bf16_t* __restrict__ out) {
    const int d = threadIdx.x, k = blockIdx.x, g = blockIdx.y, pq = blockIdx.z;
    const float* wr = Win1 + (size_t)k * 2048 + 192 * g;
    const float* ag = AG + (((size_t)pq * 4 + g) * 192) * 192 + d;
    float acc = 0.f;
    for (int c = 0; c < 192; ++c) acc += wr[c] * ag[(size_t)c * 192];
    out[(size_t)(pq * 768 + g * 192 + d) * 1024 + k] = f2bf(acc * g1[k]);
}

template <class Epi>
__global__ __launch_bounds__(256) void gemm_naive(const bf16_t* __restrict__ A, int lda, const bf16_t* __restrict__ Bt, int ldb, int K, Epi epi) {
    __shared__ float As[16][68];
    __shared__ __attribute__((aligned(16))) float Bs[16][128];
    const int tid = threadIdx.x, row = tid & 63, cg = tid >> 6;
    const int m0 = blockIdx.y * 64, n0 = blockIdx.x * 128;
    float acc[32];
#pragma unroll
    for (int j = 0; j < 32; ++j) acc[j] = 0.f;
    for (int k0 = 0; k0 < K; k0 += 16) {
        { const int r = tid >> 2, kq = (tid & 3) * 4; const uint2 v = *(const uint2*)(A + (size_t)(m0 + r) * lda + k0 + kq);
          As[kq + 0][r] = __uint_as_float(v.x << 16); As[kq + 1][r] = __uint_as_float(v.x & 0xffff0000u);
          As[kq + 2][r] = __uint_as_float(v.y << 16); As[kq + 3][r] = __uint_as_float(v.y & 0xffff0000u); }
        { const int n = tid >> 1, kh = (tid & 1) * 8; const uint4 v = *(const uint4*)(Bt + (size_t)(n0 + n) * ldb + k0 + kh);
          Bs[kh + 0][n] = __uint_as_float(v.x << 16); Bs[kh + 1][n] = __uint_as_float(v.x & 0xffff0000u);
          Bs[kh + 2][n] = __uint_as_float(v.y << 16); Bs[kh + 3][n] = __uint_as_float(v.y & 0xffff0000u);
          Bs[kh + 4][n] = __uint_as_float(v.z << 16); Bs[kh + 5][n] = __uint_as_float(v.z & 0xffff0000u);
          Bs[kh + 6][n] = __uint_as_float(v.w << 16); Bs[kh + 7][n] = __uint_as_float(v.w & 0xffff0000u); }
        __syncthreads();
#pragma unroll
        for (int k = 0; k < 16; ++k) {
            const float a = As[k][row]; const float4* b = (const float4*)&Bs[k][cg * 32];
#pragma unroll
            for (int j = 0; j < 8; ++j) { const float4 bv = b[j]; acc[4 * j] += a * bv.x; acc[4 * j + 1] += a * bv.y; acc[4 * j + 2] += a * bv.z; acc[4 * j + 3] += a * bv.w; }
        }
        __syncthreads();
    }
    epi(m0 + row, n0 + cg * 32, acc);
}
__device__ __forceinline__ void store32_bf16(bf16_t* p, const float (&v)[32], float s) {
#pragma unroll
    for (int j = 0; j < 4; ++j) { uint4 o; o.x = pk2(v[8 * j] * s, v[8 * j + 1] * s); o.y = pk2(v[8 * j + 2] * s, v[8 * j + 3] * s); o.z = pk2(v[8 * j + 4] * s, v[8 * j + 5] * s); o.w = pk2(v[8 * j + 6] * s, v[8 * j + 7] * s); ((uint4*)p)[j] = o; }
}
__device__ __forceinline__ void rope32(const float (&v)[32], const float2* cs  , float s, float (&o)[32]) {
#pragma unroll
    for (int fq = 0; fq < 4; ++fq)
#pragma unroll
        for (int j = 0; j < 4; ++j) { const int i = 4 * fq + j; const float t1 = v[8 * fq + j], t2 = v[8 * fq + 4 + j]; const float2 c = cs[i];
            o[i] = (t1 * c.x - t2 * c.y) * s; o[i + 16] = (t2 * c.x + t1 * c.y) * s; }
}
struct EpiIn0 {
    bf16_t *CQ, *CKV, *QMEM, *SG, *Kb; float* SSQ; const float2* rope;
    __device__ __forceinline__ void operator()(int row, int col0, float (&acc)[32]) const {
        if (col0 < 640) {
            float ss = 0.f;
#pragma unroll
            for (int j = 0; j < 32; ++j) ss += acc[j] * acc[j];
            if (col0 < 384) { store32_bf16(CQ + (size_t)row * 384 + col0, acc, 1.f); SSQ[(size_t)row * 20 + (col0 >> 5)] = ss; }
            else { store32_bf16(CKV + (size_t)row * 256 + (col0 - 384), acc, 1.f); SSQ[(size_t)row * 20 + 12 + ((col0 - 384) >> 5)] = ss; }
        } else if (col0 < 896) { store32_bf16(QMEM + (size_t)row * 256 + (col0 - 640), acc, QS_MEM); }
        else if (col0 == 896) {
            float o[32]; rope32(acc, rope + (size_t)row * 16, 1.f, o);
            for (int h = 0; h < 12; ++h) store32_bf16(Kb + (size_t)row * 1152 + h * 96 + 64, o, 1.f);
        } else if (col0 >= 1024) {
            float o[32];
#pragma unroll
            for (int j = 0; j < 32; ++j) o[j] = silu_f(acc[j]);
            store32_bf16(SG + (size_t)row * 1024 + (col0 - 1024), o, 1.f);
        }
    }
};
struct EpiPlain { bf16_t* O; int ldo; int pad;
    __device__ __forceinline__ void operator()(int row, int col0, float (&acc)[32]) const { store32_bf16(O + (size_t)row * ldo + col0, acc, 1.f); } };
struct EpiQup { bf16_t* Qb; const float* SSQ; const float2* rope;
    __device__ __forceinline__ void operator()(int row, int col0, float (&acc)[32]) const {
        if (col0 >= 1152) return;
        float ss = 0.f;
#pragma unroll
        for (int g = 0; g < 12; ++g) ss += SSQ[(size_t)row * 20 + g];
        const float s = rsqrtf(ss * (1.f / 384.f) + EPS) * QS_MLA;
        if (col0 < 768) { store32_bf16(Qb + (size_t)row * 1152 + (col0 >> 6) * 96 + (col0 & 63), acc, s); }
        else { float o[32]; rope32(acc, rope + (size_t)row * 16, s, o); store32_bf16(Qb + (size_t)row * 1152 + ((col0 - 768) >> 5) * 96 + 64, o, 1.f); }
    } };
struct EpiKVup { bf16_t *Kb, *Vb; const float* SSQ;
    __device__ __forceinline__ void operator()(int row, int col0, float (&acc)[32]) const {
        float ss = 0.f;
#pragma unroll
        for (int g = 0; g < 8; ++g) ss += SSQ[(size_t)row * 20 + 12 + g];
        const float s = rsqrtf(ss * (1.f / 256.f) + EPS);
        if (col0 < 768) store32_bf16(Kb + (size_t)row * 1152 + (col0 >> 6) * 96 + (col0 & 63), acc, s);
        else store32_bf16(Vb + (size_t)row * 768 + (col0 - 768), acc, s);
    } };
struct EpiOut0 { const float* X; float* X1; bf16_t* X1B;
    __device__ __forceinline__ void operator()(int row, int col0, float (&acc)[32]) const {
        const float4* xr = (const float4*)(X + (size_t)row * DM + col0); float4* o = (float4*)(X1 + (size_t)row * DM + col0); float v[32];
#pragma unroll
        for (int j = 0; j < 8; ++j) { float4 x = xr[j]; x.x += acc[4 * j]; x.y += acc[4 * j + 1]; x.z += acc[4 * j + 2]; x.w += acc[4 * j + 3]; o[j] = x; v[4 * j] = x.x; v[4 * j + 1] = x.y; v[4 * j + 2] = x.z; v[4 * j + 3] = x.w; }
        if (X1B) store32_bf16(X1B + (size_t)row * DM + col0, v, 1.f);
    } };
struct EpiIn1 { bf16_t *PQ, *QMEM, *SG; const float* RSTD;
    __device__ __forceinline__ void operator()(int row, int col0, float (&acc)[32]) const {
        const float r = RSTD[row];
        if (col0 < 1536) { const int pq = col0 / 768, d = col0 % 768, b = row >> 12, s = row & 4095, s1 = s >> 6, s2 = s & 63;
            store32_bf16(PQ + ((((size_t)b * 64 + s1) * 2 + pq) * 64 + s2) * 768 + d, acc, r); }
        else if (col0 < 1792) store32_bf16(QMEM + (size_t)row * 256 + (col0 - 1536), acc, r * QS_MEM);
        else { float o[32];
#pragma unroll
            for (int j = 0; j < 32; ++j) o[j] = silu_f(acc[j] * r);
            store32_bf16(SG + (size_t)row * 1024 + (col0 - 1792), o, 1.f); }
    } };

__global__ __launch_bounds__(256) void rstd_rows(const float* __restrict__ X, float* __restrict__ R) {
    const int lane = threadIdx.x & 63, row = blockIdx.x * 4 + (threadIdx.x >> 6);
    const float4* xr = (const float4*)(X + (size_t)row * DM) + lane; float s = 0.f;
#pragma unroll
    for (int j = 0; j < 4; ++j) { const float4 v = xr[64 * j]; s += v.x * v.x + v.y * v.y + v.z * v.z + v.w * v.w; }
    s = wave_sum(s);
    if (lane == 0) R[row] = rsqrtf(s * (1.f / DM) + EPS);
}
__global__ __launch_bounds__(256) void final_norm(float* __restrict__ X, const float* __restrict__ g) {
    const int lane = threadIdx.x & 63, row = blockIdx.x * 4 + (threadIdx.x >> 6);
    float4* xr = (float4*)(X + (size_t)row * DM) + lane; float4 v[4]; float s = 0.f;
#pragma unroll
    for (int j = 0; j < 4; ++j) { v[j] = xr[64 * j]; s += v[j].x * v[j].x + v[j].y * v[j].y + v[j].z * v[j].z + v[j].w * v[j].w; }
    const float rstd = rsqrtf(wave_sum(s) * (1.f / DM) + EPS);
#pragma unroll
    for (int j = 0; j < 4; ++j) { const float4 gv = ((const float4*)g)[lane + 64 * j]; v[j].x *= rstd * gv.x; v[j].y *= rstd * gv.y; v[j].z *= rstd * gv.z; v[j].w *= rstd * gv.w; xr[64 * j] = v[j]; }
}

template <int DQK>
__global__ __launch_bounds__(256) void attn_naive(const bf16_t* __restrict__ Q, int ldq, int qhs, const bf16_t* __restrict__ Kp, int ldk, int khs, const bf16_t* __restrict__ Vp, int ldv, int vhs,
                                                  int nkeys, bf16_t* __restrict__ O, const bf16_t* __restrict__ G, int ocol0) {
    __shared__ __attribute__((aligned(16))) float Ks[32][DQK];
    __shared__ __attribute__((aligned(16))) float Vs[32][64];
    const int tid = threadIdx.x, b = blockIdx.z, h = blockIdx.y;
    const size_t t = (size_t)b * SEQ + blockIdx.x * 256 + tid;
    float q[DQK], o[64], m = -1e30f, l = 0.f;
    { const bf16_t* qp = Q + t * ldq + h * qhs;
#pragma unroll
      for (int d = 0; d < DQK; d += 8) { const uint4 v = *(const uint4*)(qp + d);
          q[d] = __uint_as_float(v.x << 16); q[d + 1] = __uint_as_float(v.x & 0xffff0000u); q[d + 2] = __uint_as_float(v.y << 16); q[d + 3] = __uint_as_float(v.y & 0xffff0000u);
          q[d + 4] = __uint_as_float(v.z << 16); q[d + 5] = __uint_as_float(v.z & 0xffff0000u); q[d + 6] = __uint_as_float(v.w << 16); q[d + 7] = __uint_as_float(v.w & 0xffff0000u); } }
#pragma unroll
    for (int d = 0; d < 64; ++d) o[d] = 0.f;
    const bf16_t* Kb = Kp + (size_t)b * nkeys * ldk + h * khs; const bf16_t* Vb = Vp + (size_t)b * nkeys * ldv + h * vhs;
    for (int k0 = 0; k0 < nkeys; k0 += 32) {
        __syncthreads();
        for (int c = tid; c < 32 * DQK / 8; c += 256) { const int j = c / (DQK / 8), d = (c % (DQK / 8)) * 8; const uint4 v = *(const uint4*)(Kb + (size_t)(k0 + j) * ldk + d);
            float* p = &Ks[j][d]; p[0] = __uint_as_float(v.x << 16); p[1] = __uint_as_float(v.x & 0xffff0000u); p[2] = __uint_as_float(v.y << 16); p[3] = __uint_as_float(v.y & 0xffff0000u);
            p[4] = __uint_as_float(v.z << 16); p[5] = __uint_as_float(v.z & 0xffff0000u); p[6] = __uint_as_float(v.w << 16); p[7] = __uint_as_float(v.w & 0xffff0000u); }
        { const int j = tid >> 3, d = (tid & 7) * 8; const uint4 v = *(const uint4*)(Vb + (size_t)(k0 + j) * ldv + d);
            float* p = &Vs[j][d]; p[0] = __uint_as_float(v.x << 16); p[1] = __uint_as_float(v.x & 0xffff0000u); p[2] = __uint_as_float(v.y << 16); p[3] = __uint_as_float(v.y & 0xffff0000u);
            p[4] = __uint_as_float(v.z << 16); p[5] = __uint_as_float(v.z & 0xffff0000u); p[6] = __uint_as_float(v.w << 16); p[7] = __uint_as_float(v.w & 0xffff0000u); }
        __syncthreads();
        float sc[32]; float mx = m;
#pragma unroll
        for (int j = 0; j < 32; ++j) { float s = 0.f; const float4* kr = (const float4*)&Ks[j][0];
#pragma unroll
            for (int d = 0; d < DQK / 4; ++d) { const float4 kv = kr[d]; s += q[4 * d] * kv.x + q[4 * d + 1] * kv.y + q[4 * d + 2] * kv.z + q[4 * d + 3] * kv.w; }
            sc[j] = s; mx = fmaxf(mx, s); }
        const float alpha = __builtin_amdgcn_exp2f(m - mx); m = mx; l *= alpha;
#pragma unroll
        for (int d = 0; d < 64; ++d) o[d] *= alpha;
#pragma unroll
        for (int j = 0; j < 32; ++j) { const float p = __builtin_amdgcn_exp2f(sc[j] - mx); l += p; const float4* vr = (const float4*)&Vs[j][0];
#pragma unroll
            for (int d = 0; d < 16; ++d) { const float4 vv = vr[d]; o[4 * d] += p * vv.x; o[4 * d + 1] += p * vv.y; o[4 * d + 2] += p * vv.z; o[4 * d + 3] += p * vv.w; } }
    }
    const float rl = 1.f / l;
    const bf16_t* gp = G + t * 1024 + ocol0 + h * 64; bf16_t* op = O + t * 1024 + ocol0 + h * 64;
#pragma unroll
    for (int d = 0; d < 64; d += 8) { const uint4 gv = *(const uint4*)(gp + d); uint4 w;
        w.x = pk2(o[d] * rl * __uint_as_float(gv.x << 16), o[d + 1] * rl * __uint_as_float(gv.x & 0xffff0000u));
        w.y = pk2(o[d + 2] * rl * __uint_as_float(gv.y << 16), o[d + 3] * rl * __uint_as_float(gv.y & 0xffff0000u));
        w.z = pk2(o[d + 4] * rl * __uint_as_float(gv.z << 16), o[d + 5] * rl * __uint_as_float(gv.z & 0xffff0000u));
        w.w = pk2(o[d + 6] * rl * __uint_as_float(gv.w << 16), o[d + 7] * rl * __uint_as_float(gv.w & 0xffff0000u));
        *(uint4*)(op + d) = w; }
}

__global__ __launch_bounds__(256) void fft_a_naive(const bf16_t* __restrict__ PQ, bf16_t* __restrict__ Y) {
    __shared__ float2 tab[64];
    const int tid = threadIdx.x, k1 = blockIdx.y, b = blockIdx.z;
    if (tid < 64) tab[tid] = make_float2(cospif(2.f * tid / 64.f), sinpif(2.f * tid / 64.f));
    __syncthreads();
    const int idx = blockIdx.x * 256 + tid;
    float ar = 0.f, ai = 0.f;
    for (int s1 = 0; s1 < 64; ++s1) {
        const float2 w = tab[(k1 * s1) & 63];
        const size_t base = (((size_t)b * 64 + s1) * 2) * 49152 + idx;
        const float p = bf2f(PQ[base]), q = bf2f(PQ[base + 49152]);
        ar += w.x * p - w.y * q; ai += w.y * p + w.x * q;
    }
    ar *= 0.125f; ai *= 0.125f;
    const int s2 = idx / 768; const float fr = 2.f * (float)(k1 * s2) / 4096.f; const float tr = cospif(fr), ti = sinpif(fr);
    const size_t ob = (((size_t)b * 64 + k1) * 2) * 49152 + idx;
    Y[ob] = f2bf(tr * ar - ti * ai); Y[ob + 49152] = f2bf(ti * ar + tr * ai);
}
__global__ __launch_bounds__(256) void fft_b_naive(const bf16_t* __restrict__ Y, const bf16_t* __restrict__ SG, bf16_t* __restrict__ BR) {
    __shared__ float2 tab[64];
    const int tid = threadIdx.x, k2 = blockIdx.y, bk1 = blockIdx.z, b = bk1 >> 6, k1 = bk1 & 63;
    if (tid < 64) tab[tid] = make_float2(cospif(2.f * tid / 64.f), sinpif(2.f * tid / 64.f));
    __syncthreads();
    const int d = blockIdx.x * 256 + tid;
    float acc = 0.f;
    for (int s2 = 0; s2 < 64; ++s2) {
        const float2 w = tab[(k2 * s2) & 63];
        const size_t base = ((size_t)bk1 * 2) * 49152 + (size_t)s2 * 768 + d;
        acc += w.x * bf2f(Y[base]) - w.y * bf2f(Y[base + 49152]);
    }
    acc *= 0.125f;
    const size_t t = (size_t)b * SEQ + k1 + 64 * k2;
    BR[t * 1024 + d] = f2bf(acc * bf2f(SG[t * 1024 + d]));
}

extern "C" void kernel_launch(void* const* d_in, const int* in_sizes, int n_in, void* d_out, int out_size, void* d_ws, size_t ws_size, hipStream_t stream) {
    if (n_in != 19 || ws_size < WS_END) { fprintf(stderr, "kernel_launch: unexpected n_in %d / ws %zu\n", n_in, ws_size); return; }
    const float* x = (const float*)d_in[0]; const float* mem = (const float*)d_in[1]; const int* pos = (const int*)d_in[2];
    const float* g0 = (const float*)d_in[3]; const float* w_in0 = (const float*)d_in[4]; const float* gq = (const float*)d_in[5]; const float* gkv = (const float*)d_in[6];
    const float* w_uq = (const float*)d_in[7]; const float* w_ukv = (const float*)d_in[8]; const float* gm0 = (const float*)d_in[9]; const float* w_mkv0 = (const float*)d_in[10];
    const float* w_out0 = (const float*)d_in[11]; const float* g1 = (const float*)d_in[12]; const float* w_in1 = (const float*)d_in[13]; const float* w_fnet = (const float*)d_in[14];
    const float* gm1 = (const float*)d_in[15]; const float* w_mkv1 = (const float*)d_in[16]; const float* w_out1 = (const float*)d_in[17]; const float* gf = (const float*)d_in[18];
    char* ws = (char*)d_ws; float* out = (float*)d_out;
    bf16_t* WIN0 = (bf16_t*)(ws + WS_WIN0); bf16_t* WUQ = (bf16_t*)(ws + WS_WUQ); bf16_t* WUKV = (bf16_t*)(ws + WS_WUKV); bf16_t* WMEM = (bf16_t*)(ws + WS_WMEM);
    bf16_t* WOUT0 = (bf16_t*)(ws + WS_WOUT0); bf16_t* WOUT1 = (bf16_t*)(ws + WS_WOUT1); bf16_t* WIN1 = (bf16_t*)(ws + WS_WIN1); float* AGBG = (float*)(ws + WS_AGBG);
    float2* ROPE = (float2*)(ws + WS_ROPE); bf16_t* MEMN = (bf16_t*)(ws + WS_MEMN); bf16_t* MEMKV = (bf16_t*)(ws + WS_MEMKV); float* RSTD1 = (float*)(ws + WS_RSTD1); float* SSQ = (float*)(ws + WS_SSQ);
    bf16_t* XN0 = (bf16_t*)(ws + WS_XN0); bf16_t* BR = (bf16_t*)(ws + WS_BR); bf16_t* CQ = (bf16_t*)(ws + WS_CQ); bf16_t* CKV = (bf16_t*)(ws + WS_CKV); bf16_t* QMEM0 = (bf16_t*)(ws + WS_QMEM0);
    bf16_t* SG0 = (bf16_t*)(ws + WS_SG0); bf16_t* Kb = (bf16_t*)(ws + WS_K); bf16_t* Qb = (bf16_t*)(ws + WS_Q); bf16_t* Vb = (bf16_t*)(ws + WS_V); bf16_t* X1B = (bf16_t*)(ws + WS_X1B);
    bf16_t* PQ = (bf16_t*)(ws + WS_PQ); bf16_t* QMEM1 = (bf16_t*)(ws + WS_QMEM1); bf16_t* SG1 = (bf16_t*)(ws + WS_SG1); bf16_t* Y = (bf16_t*)(ws + WS_Y);
#define PREP(W, ldw, K, outp, n0, nrows, scale, mode, off) hipLaunchKernelGGL(prep_w, dim3(((nrows) * ((K) / 8) + 255) / 256), dim3(256), 0, stream, W, ldw, K, outp, n0, nrows, scale, mode, off)
    PREP(w_in0, 1952, 1024, WIN0, 0, 2048, (const float*)nullptr, MODE_WIN0, 0);
    PREP(w_uq, 1152, 384, WUQ, 0, 1280, gq, MODE_WUQ, 0);
    PREP(w_ukv, 1536, 256, WUKV, 0, 1536, gkv, MODE_WUKV, 0);
    PREP(w_mkv0, 512, 1024, WMEM, 0, 512, gm0, MODE_PLAIN, 0);
    PREP(w_mkv1, 512, 1024, WMEM, 512, 512, gm1, MODE_PLAIN, 0);
    PREP(w_out0, 1024, 1024, WOUT0, 0, 1024, (const float*)nullptr, MODE_PLAIN, 0);
    PREP(w_out1, 1024, 1024, WOUT1, 0, 1024, (const float*)nullptr, MODE_PLAIN, 0);
    PREP(w_in1, 2048, 1024, WIN1, 1536, 1280, g1, MODE_PLAIN, 768);
    hipLaunchKernelGGL(fnet_fold1, dim3(192, 4, 2), dim3(192), 0, stream, w_fnet, AGBG);
    hipLaunchKernelGGL(fnet_fold2, dim3(1024, 4, 2), dim3(192), 0, stream, w_in1, g1, AGBG, WIN1);
    hipLaunchKernelGGL(rope_table, dim3(T * 16 / 256), dim3(256), 0, stream, pos, ROPE);
    hipLaunchKernelGGL(rmsnorm_rows, dim3(T / 4), dim3(256), 0, stream, x, g0, XN0, T);
    hipLaunchKernelGGL(rmsnorm_rows, dim3(4096 / 4), dim3(256), 0, stream, mem, (const float*)nullptr, MEMN, 4096);
    hipLaunchKernelGGL(gemm_naive<EpiIn0>, dim3(2048 / 128, T / 64), dim3(256), 0, stream, XN0, 1024, WIN0, 1024, 1024, EpiIn0{CQ, CKV, QMEM0, SG0, Kb, SSQ, ROPE});
    hipLaunchKernelGGL(gemm_naive<EpiPlain>, dim3(1024 / 128, 4096 / 64), dim3(256), 0, stream, MEMN, 1024, WMEM, 1024, 1024, EpiPlain{MEMKV, 1024, 0});
    hipLaunchKernelGGL(gemm_naive<EpiQup>, dim3(1280 / 128, T / 64), dim3(256), 0, stream, CQ, 384, WUQ, 384, 384, EpiQup{Qb, SSQ, ROPE});
    hipLaunchKernelGGL(gemm_naive<EpiKVup>, dim3(1536 / 128, T / 64), dim3(256), 0, stream, CKV, 256, WUKV, 256, 256, EpiKVup{Kb, Vb, SSQ});
    hipLaunchKernelGGL(attn_naive<96>, dim3(SEQ / 256, 12, NB), dim3(256), 0, stream, Qb, 1152, 96, Kb, 1152, 96, Vb, 768, 64, SEQ, BR, SG0, 0);
    hipLaunchKernelGGL(attn_naive<64>, dim3(SEQ / 256, 4, NB), dim3(256), 0, stream, QMEM0, 256, 64, MEMKV, 1024, 64, MEMKV + 256, 1024, 64, 256, BR, SG0, 768);
    hipLaunchKernelGGL(gemm_naive<EpiOut0>, dim3(1024 / 128, T / 64), dim3(256), 0, stream, BR, 1024, WOUT0, 1024, 1024, EpiOut0{x, out, X1B});
    hipLaunchKernelGGL(rstd_rows, dim3(T / 4), dim3(256), 0, stream, out, RSTD1);
    hipLaunchKernelGGL(gemm_naive<EpiIn1>, dim3(2816 / 128, T / 64), dim3(256), 0, stream, X1B, 1024, WIN1, 1024, 1024, EpiIn1{PQ, QMEM1, SG1, RSTD1});
    hipLaunchKernelGGL(fft_a_naive, dim3(49152 / 256, 64, NB), dim3(256), 0, stream, PQ, Y);
    hipLaunchKernelGGL(attn_naive<64>, dim3(SEQ / 256, 4, NB), dim3(256), 0, stream, QMEM1, 256, 64, MEMKV + 512, 1024, 64, MEMKV + 768, 1024, 64, 256, BR, SG1, 768);
    hipLaunchKernelGGL(fft_b_naive, dim3(3, 64, NB * 64), dim3(256), 0, stream, Y, SG1, BR);
    hipLaunchKernelGGL(gemm_naive<EpiOut0>, dim3(1024 / 128, T / 64), dim3(256), 0, stream, BR, 1024, WOUT1, 1024, 1024, EpiOut0{out, out, (bf16_t*)nullptr});
    hipLaunchKernelGGL(final_norm, dim3(T / 4), dim3(256), 0, stream, out, gf);
}
```

```cpp
#include <hip/hip_runtime.h>
#include <stdint.h>
#include <cstdio>

typedef unsigned short bf16_t;
constexpr int T = 65536, SEQ = 4096, NB = 16, DM = 1024;
constexpr float EPS = 1e-6f;
constexpr float LOG2E = 1.4426950408889634f;
constexpr float QS_MLA = 0.10206207261596575f * LOG2E;
constexpr float QS_MEM = 0.125f * LOG2E;

constexpr size_t MiB = 1u << 20;
constexpr size_t WS_CTL = 0, CTL_ZERO_BYTES = 1 * MiB;
constexpr size_t WS_WIN0 = 1 * MiB;
constexpr size_t WS_WUQ = 5 * MiB;
constexpr size_t WS_WUKV = 6 * MiB;
constexpr size_t WS_WMEM = 7 * MiB;
constexpr size_t WS_WOUT0 = 9 * MiB;
constexpr size_t WS_WOUT1 = 11 * MiB;
constexpr size_t WS_WIN1 = 13 * MiB;
constexpr size_t WS_AGBG = 19 * MiB;
constexpr size_t WS_ROPE = 21 * MiB;
constexpr size_t WS_MEMN = 29 * MiB;
constexpr size_t WS_MEMKV = 37 * MiB;
constexpr size_t WS_RSTD1 = 45 * MiB;
constexpr size_t WS_SSQ = 46 * MiB;
constexpr size_t WS_XN0 = 64 * MiB;
constexpr size_t WS_BR = 64 * MiB;
constexpr size_t WS_CQ = 192 * MiB;
constexpr size_t WS_CKV = 240 * MiB;
constexpr size_t WS_QMEM0 = 272 * MiB;
constexpr size_t WS_SG0 = 304 * MiB;
constexpr size_t WS_K = 432 * MiB;
constexpr size_t WS_Q = 576 * MiB;
constexpr size_t WS_V = 720 * MiB;
constexpr size_t WS_X1B = 192 * MiB;
constexpr size_t WS_PQ = 320 * MiB;
constexpr size_t WS_QMEM1 = 512 * MiB;
constexpr size_t WS_SG1 = 544 * MiB;
constexpr size_t WS_Y = 672 * MiB;
constexpr size_t WS_END = 864 * MiB;

__device__ __forceinline__ float bf2f(bf16_t h) { return __uint_as_float(((unsigned)h) << 16); }
__device__ __forceinline__ bf16_t f2bf(float f) { unsigned u = __float_as_uint(f); return (bf16_t)((u + 0x7fffu + ((u >> 16) & 1u)) >> 16); }
__device__ __forceinline__ unsigned pk2(float lo, float hi) { return (unsigned)f2bf(lo) | ((unsigned)f2bf(hi) << 16); }
__device__ __forceinline__ float silu_f(float v) { return v * __builtin_amdgcn_rcpf(1.f + __expf(-v)); }
__device__ __forceinline__ float wave_sum(float v) {
#pragma unroll
    for (int o = 1; o < 64; o <<= 1) v += __shfl_xor(v, o);
    return v;
}
__host__ __device__ __forceinline__ int ropedim(int p) { return 4 * (p >> 3) + (p & 3) + 16 * ((p >> 2) & 1); }
enum { MODE_WIN0 = 0, MODE_WUQ = 1, MODE_WUKV = 2, MODE_PLAIN = 3 };
__device__ __forceinline__ int src_col(int mode, int n, int off) {
    if (mode == MODE_WIN0) {
        if (n < 640) return n;
        if (n < 896) return 672 + (n - 640);
        if (n < 928) return 640 + ropedim(n - 896);
        if (n < 1024) return -1;
        return 928 + (n - 1024);
    } else if (mode == MODE_WUQ) {
        if (n < 768) return (n >> 6) * 96 + (n & 63);
        if (n < 1152) { const int r = n - 768; return (r >> 5) * 96 + 64 + ropedim(r & 31); }
        return -1;
    } else if (mode == MODE_WUKV) {
        if (n < 768) return (n >> 6) * 128 + (n & 63);
        const int r = n - 768; return (r >> 6) * 128 + 64 + (r & 63);
    }
    return n + off;
}
namespace pg8 {
#define PG8_LAS __attribute__((address_space(3)))
typedef unsigned short bf16_t;
typedef short bf16x8 __attribute__((ext_vector_type(8)));
typedef float f32x4 __attribute__((ext_vector_type(4)));
typedef unsigned u32x4 __attribute__((ext_vector_type(4)));
constexpr int BM = 256, BK = 64, HALF = 128, HTB = HALF * BK * 2  , STAGE_BYTES = 8 * HTB, NXCD = 8, WGM = 8;

__host__ __device__ __forceinline__ int lds_byte(int r, int c) { const int st = (r >> 4) * 2 + (c >> 5), rr = r & 15, cc = c & 31, ob = rr * 64 + cc * 2; return st * 1024 + (ob ^ (((ob >> 9) & 1) << 5)); }
__host__ __device__ __forceinline__ void stage_rc(int b, int& R, int& C) { const int st = b / 1024, sb = b % 1024, swz = sb ^ (((sb >> 9) & 1) << 5); R = (st >> 1) * 16 + swz / 64; C = (st & 1) * 32 + (swz % 64) / 2; }
__host__ __device__ __forceinline__ int perm32(int rho) { const int n = rho >> 4, i = rho & 15; return 8 * (i >> 2) + 4 * n + (i & 3); }

struct Unit { int pm, pn; };
struct Gemm { const bf16_t* A; const bf16_t* Bt; int M, N, K; };

struct StaticOrder {
    int nM, nN, nwg, G, c;
    __host__ __device__ void init(int M, int N, int G_, int c_) { nM = M / BM; nN = N / BM; nwg = nM * nN; G = G_; c = c_; }
    __host__ __device__ bool next(int i, Unit& u) const {
        const long L = (long)i * G + c; if (L >= nwg) return false;
        int wgid = (int)L; { const int q = nwg / NXCD, r = nwg % NXCD, xcd = wgid % NXCD, off = wgid / NXCD; wgid = (xcd < r ? xcd * (q + 1) : r * (q + 1) + (xcd - r) * q) + off; }
        const int nig = WGM * nN, gid = wgid / nig, fm = gid * WGM, gsz = (nM - fm) < WGM ? (nM - fm) : WGM;
        u.pm = fm + ((wgid % nig) % gsz); u.pn = (wgid % nig) / gsz; return true;
    }
    __device__ __forceinline__ void a_ready(const Unit&) const {}
    __device__ __forceinline__ void done(const Unit&) const {}
};

__device__ __forceinline__ unsigned cvt_pk_bf16(float lo, float hi) { unsigned r; asm volatile("v_cvt_pk_bf16_f32 %0, %1, %2" : "=v"(r) : "v"(lo), "v"(hi)); return r; }
typedef float f32x2 __attribute__((ext_vector_type(2)));
__device__ __forceinline__ u32x4 pack8(const f32x4 a, const f32x4 b, float s) { u32x4 w; w.x = cvt_pk_bf16(a[0] * s, a[1] * s); w.y = cvt_pk_bf16(a[2] * s, a[3] * s); w.z = cvt_pk_bf16(b[0] * s, b[1] * s); w.w = cvt_pk_bf16(b[2] * s, b[3] * s); return w; }
__device__ __forceinline__ float ss8(const f32x4 a, const f32x4 b) { return (a[0] * a[0] + a[1] * a[1]) + (a[2] * a[2] + a[3] * a[3]) + (b[0] * b[0] + b[1] * b[1]) + (b[2] * b[2] + b[3] * b[3]); }
__device__ __forceinline__ float quad_sum(float v) { v += __shfl_xor(v, 16); v += __shfl_xor(v, 32); return v; }
__device__ __forceinline__ f32x4 silu4(const f32x4 v) { f32x4 o; o[0] = silu_f(v[0]); o[1] = silu_f(v[1]); o[2] = silu_f(v[2]); o[3] = silu_f(v[3]); return o; }
typedef unsigned u32x2 __attribute__((ext_vector_type(2)));
__device__ __forceinline__ void rope_pair(const f32x4 a, const f32x4 b, const float* cs  , float s, u32x2& o1, u32x2& o2) {
    const f32x4 c01 = *(const f32x4*)cs, c23 = *(const f32x4*)(cs + 4);
    const float r0 = (a[0] * c01[0] - b[0] * c01[1]) * s, r1 = (a[1] * c01[2] - b[1] * c01[3]) * s, r2 = (a[2] * c23[0] - b[2] * c23[1]) * s, r3 = (a[3] * c23[2] - b[3] * c23[3]) * s;
    const float q0 = (b[0] * c01[0] + a[0] * c01[1]) * s, q1 = (b[1] * c01[2] + a[1] * c01[3]) * s, q2 = (b[2] * c23[0] + a[2] * c23[1]) * s, q3 = (b[3] * c23[2] + a[3] * c23[3]) * s;
    o1.x = cvt_pk_bf16(r0, r1); o1.y = cvt_pk_bf16(r2, r3); o2.x = cvt_pk_bf16(q0, q1); o2.y = cvt_pk_bf16(q2, q3);
}
struct EpiIn0 {
    static constexpr bool PERM = true, AFTER_DRAIN = false;
    bf16_t *CQ, *CKV, *QMEM, *SG, *Kb; float* SSQ; const float* rope;
    __device__ __forceinline__ void operator()(const f32x4 (&acc)[2][2][4][2], const Unit& u, int wr, int wc, int fr, int fq) const {
#pragma unroll
        for (int ai = 0; ai < 2; ++ai)
#pragma unroll
            for (int m = 0; m < 4; ++m) { int rowi_ = u.pm * BM + ai * HALF + wr * 64 + m * 16 + fr; asm volatile("" : "+v"(rowi_)); const size_t row = (size_t)rowi_;
#pragma unroll
                for (int bj = 0; bj < 2; ++bj) { const int cb = u.pn * BM + bj * HALF + wc * 32, c = cb + 8 * fq; const f32x4 v0 = acc[ai][bj][m][0], v1 = acc[ai][bj][m][1];
                    if (cb < 640) { const float ss = quad_sum(ss8(v0, v1));
                        if (cb < 384) { *(u32x4*)(CQ + row * 384 + c) = pack8(v0, v1, 1.f); if (fq == 0) SSQ[row * 20 + (cb >> 5)] = ss; }
                        else { *(u32x4*)(CKV + row * 256 + (c - 384)) = pack8(v0, v1, 1.f); if (fq == 0) SSQ[row * 20 + 12 + ((cb - 384) >> 5)] = ss; } }
                    else if (cb < 896) { *(u32x4*)(QMEM + row * 256 + (c - 640)) = pack8(v0, v1, QS_MEM); }
                    else if (cb < 1024) { if (cb == 896) { u32x2 o1, o2; rope_pair(v0, v1, rope + row * 32 + 8 * fq, 1.f, o1, o2);
#pragma unroll
                            for (int h = 0; h < 12; ++h) { *(u32x2*)(Kb + row * 1152 + h * 96 + 64 + 4 * fq) = o1; *(u32x2*)(Kb + row * 1152 + h * 96 + 80 + 4 * fq) = o2; } } }
                    else { *(u32x4*)(SG + row * 1024 + (c - 1024)) = pack8(silu4(v0), silu4(v1), 1.f); } } }
    }
};
struct EpiPlainB {
    static constexpr bool PERM = true, AFTER_DRAIN = false;
    bf16_t* O; int ldo; int pad;
    __device__ __forceinline__ void operator()(const f32x4 (&acc)[2][2][4][2], const Unit& u, int wr, int wc, int fr, int fq) const {
#pragma unroll
        for (int ai = 0; ai < 2; ++ai)
#pragma unroll
            for (int m = 0; m < 4; ++m) { int rowi_ = u.pm * BM + ai * HALF + wr * 64 + m * 16 + fr; asm volatile("" : "+v"(rowi_)); const size_t row = (size_t)rowi_;
#pragma unroll
                for (int bj = 0; bj < 2; ++bj) { const int c = u.pn * BM + bj * HALF + wc * 32 + 8 * fq; *(u32x4*)(O + row * ldo + c) = pack8(acc[ai][bj][m][0], acc[ai][bj][m][1], 1.f); } }
    }
};
struct EpiQup {
    static constexpr bool PERM = true, AFTER_DRAIN = false;
    bf16_t* Qb; const float* SSQ; const float* rope;
    __device__ __forceinline__ void operator()(const f32x4 (&acc)[2][2][4][2], const Unit& u, int wr, int wc, int fr, int fq) const {
#pragma unroll
        for (int ai = 0; ai < 2; ++ai)
#pragma unroll
            for (int m = 0; m < 4; ++m) { int rowi_ = u.pm * BM + ai * HALF + wr * 64 + m * 16 + fr; asm volatile("" : "+v"(rowi_)); const size_t row = (size_t)rowi_;
                const f32x4 s0 = *(const f32x4*)(SSQ + row * 20), s1 = *(const f32x4*)(SSQ + row * 20 + 4), s2 = *(const f32x4*)(SSQ + row * 20 + 8);
                const float ss = ((s0[0] + s0[1]) + (s0[2] + s0[3])) + ((s1[0] + s1[1]) + (s1[2] + s1[3])) + ((s2[0] + s2[1]) + (s2[2] + s2[3]));
                const float s = rsqrtf(ss * (1.f / 384.f) + EPS) * QS_MLA;
#pragma unroll
                for (int bj = 0; bj < 2; ++bj) { const int cb = u.pn * BM + bj * HALF + wc * 32, c = cb + 8 * fq; const f32x4 v0 = acc[ai][bj][m][0], v1 = acc[ai][bj][m][1];
                    if (cb < 768) { *(u32x4*)(Qb + row * 1152 + (c >> 6) * 96 + (c & 63)) = pack8(v0, v1, s); }
                    else if (cb < 1152) { const int h = (cb - 768) >> 5; u32x2 o1, o2; rope_pair(v0, v1, rope + row * 32 + 8 * fq, s, o1, o2);
                        *(u32x2*)(Qb + row * 1152 + h * 96 + 64 + 4 * fq) = o1; *(u32x2*)(Qb + row * 1152 + h * 96 + 80 + 4 * fq) = o2; } }
                asm volatile("" ::: "memory"); }
    }
};
struct EpiKVup {
    static constexpr bool PERM = true, AFTER_DRAIN = false;
    bf16_t *Kb, *Vb; const float* SSQ;
    __device__ __forceinline__ void operator()(const f32x4 (&acc)[2][2][4][2], const Unit& u, int wr, int wc, int fr, int fq) const {
#pragma unroll
        for (int ai = 0; ai < 2; ++ai)
#pragma unroll
            for (int m = 0; m < 4; ++m) { int rowi_ = u.pm * BM + ai * HALF + wr * 64 + m * 16 + fr; asm volatile("" : "+v"(rowi_)); const size_t row = (size_t)rowi_;
                const f32x4 s0 = *(const f32x4*)(SSQ + row * 20 + 12), s1 = *(const f32x4*)(SSQ + row * 20 + 16);
                const float ss = ((s0[0] + s0[1]) + (s0[2] + s0[3])) + ((s1[0] + s1[1]) + (s1[2] + s1[3]));
                const float s = rsqrtf(ss * (1.f / 256.f) + EPS);
#pragma unroll
                for (int bj = 0; bj < 2; ++bj) { const int cb = u.pn * BM + bj * HALF + wc * 32, c = cb + 8 * fq; const f32x4 v0 = acc[ai][bj][m][0], v1 = acc[ai][bj][m][1];
                    if (cb < 768) *(u32x4*)(Kb + row * 1152 + (c >> 6) * 96 + (c & 63)) = pack8(v0, v1, s);
                    else *(u32x4*)(Vb + row * 768 + (c - 768)) = pack8(v0, v1, s); }
                asm volatile("" ::: "memory"); }
    }
};
struct EpiOut {
    static constexpr bool PERM = true, AFTER_DRAIN = false;
    const float* R; float* X1; bf16_t* X1B; PG8_LAS float* rs;
    __device__ __forceinline__ void operator()(const f32x4 (&acc)[2][2][4][2], const Unit& u, int wr, int wc, int fr, int fq) const {
#pragma unroll
        for (int ai = 0; ai < 2; ++ai)
#pragma unroll
            for (int m = 0; m < 4; ++m) { int rl = ai * HALF + wr * 64 + m * 16 + fr; asm volatile("" : "+v"(rl)); const size_t row = (size_t)(u.pm * BM + rl); float ssum = 0.f;
#pragma unroll
                for (int bj = 0; bj < 2; ++bj) { const int c = u.pn * BM + bj * HALF + wc * 32 + 8 * fq;
                    const f32x4 x0 = *(const f32x4*)(R + row * 1024 + c) + acc[ai][bj][m][0], x1 = *(const f32x4*)(R + row * 1024 + c + 4) + acc[ai][bj][m][1];
                    *(f32x4*)(X1 + row * 1024 + c) = x0; *(f32x4*)(X1 + row * 1024 + c + 4) = x1;
                    if (X1B) *(u32x4*)(X1B + row * 1024 + c) = pack8(x0, x1, 1.f);
                    ssum += ss8(x0, x1); }
                ssum = quad_sum(ssum); if (fq == 0) rs[rl * 4 + wc] += ssum; }
    }
};
struct EpiIn1 {
    static constexpr bool PERM = true, AFTER_DRAIN = false;
    bf16_t *PQ, *QMEM, *SG; const float* RSTD;
    __device__ __forceinline__ void operator()(const f32x4 (&acc)[2][2][4][2], const Unit& u, int wr, int wc, int fr, int fq) const {
#pragma unroll
        for (int ai = 0; ai < 2; ++ai)
#pragma unroll
            for (int m = 0; m < 4; ++m) { int rowi = u.pm * BM + ai * HALF + wr * 64 + m * 16 + fr; asm volatile("" : "+v"(rowi)); const size_t row = (size_t)rowi; const float r = RSTD[row];
                const int b = rowi >> 12, sq = rowi & 4095, s1 = sq >> 6, s2 = sq & 63; const size_t prow = ((size_t)(b * 64 + s1) * 2) * 64 + s2;
#pragma unroll
                for (int bj = 0; bj < 2; ++bj) { const int cb = u.pn * BM + bj * HALF + wc * 32, c = cb + 8 * fq; const f32x4 v0 = acc[ai][bj][m][0], v1 = acc[ai][bj][m][1];
                    if (cb < 1536) { const int pq = cb >= 768 ? 1 : 0; *(u32x4*)(PQ + (prow + pq * 64) * 768 + (c - pq * 768)) = pack8(v0, v1, r); }
                    else if (cb < 1792) *(u32x4*)(QMEM + row * 256 + (c - 1536)) = pack8(v0, v1, r * QS_MEM);
                    else *(u32x4*)(SG + row * 1024 + (c - 1792)) = pack8(silu4(v0 * r), silu4(v1 * r), 1.f); } }
    }
};
struct PanelOrder {
    int nM, G, c;
    __device__ void init(int M, int G_, int c_) { nM = M / BM; G = G_; c = c_; }
    __device__ bool next(int i, Unit& u) const { u.pm = c + G * (i >> 2); u.pn = i & 3; return u.pm < nM; }
    __device__ __forceinline__ void a_ready(const Unit&) const {}
    __device__ __forceinline__ void done(const Unit&) const {}
};
template <class Epi, class Sched, bool ALIGN_EPI = false, bool SP2 = false>
__device__ __forceinline__ void gemm_phase(PG8_LAS unsigned char* lds, const Gemm g, const Sched& S, const Epi& E) {
    const int tid = threadIdx.x, wid = __builtin_amdgcn_readfirstlane(tid >> 6), lane = tid & 63, wr = wid >> 2, wc = wid & 3, fr = lane & 15, fq = lane >> 4;
    const int K = g.K, nt = K / BK;
    unsigned voffA[2], voffB[2];
#pragma unroll
    for (int i = 0; i < 2; ++i) { int R, C; stage_rc(tid * 16 + i * 8192, R, C); const int Rb = Epi::PERM ? ((R & ~31) + perm32(R & 31)) : R;
        voffA[i] = (unsigned)(R * K + C) * 2u; voffB[i] = (unsigned)(Rb * K + C) * 2u; }
    const size_t kstep = (size_t)(BK * 2);
    const size_t hstep = (size_t)HALF * K * 2;
    const size_t tstep = 2 * hstep;
    const unsigned ldsw = (unsigned)wid * 1024u;
    const int aoff = lds_byte(wr * 64 + fr, fq * 8), boff = lds_byte(wc * 32 + fr, fq * 8);
#define PG8_SA(b, h) (((b) * 2 + (h)) * HTB)
#define PG8_SB(b, h) ((4 + (b) * 2 + (h)) * HTB)
#define PG8_STAGE(bufoff, gbase, voff) do { _Pragma("unroll") for (int _i = 0; _i < 2; ++_i) \
        __builtin_amdgcn_global_load_lds((const unsigned*)((const char*)(gbase) + (voff)[_i]), (PG8_LAS unsigned*)(lds + (bufoff) + ldsw + _i * 8192), 16, 0, 0); } while (0)
#define PG8_LDA(dst, b, h) do { _Pragma("unroll") for (int m = 0; m < 4; ++m) _Pragma("unroll") for (int k = 0; k < 2; ++k) dst[m][k] = *(const PG8_LAS bf16x8*)(lds + PG8_SA(b, h) + aoff + m * 2048 + k * 1024); } while (0)
#define PG8_LDB(dst, b, h) do { _Pragma("unroll") for (int n = 0; n < 2; ++n) _Pragma("unroll") for (int k = 0; k < 2; ++k) dst[n][k] = *(const PG8_LAS bf16x8*)(lds + PG8_SB(b, h) + boff + n * 2048 + k * 1024); } while (0)
#define PG8_MMA(ai, bj, At, Bt) do { __builtin_amdgcn_s_setprio(1); _Pragma("unroll") for (int m = 0; m < 4; ++m) _Pragma("unroll") for (int n = 0; n < 2; ++n) _Pragma("unroll") for (int k = 0; k < 2; ++k) \
        acc[ai][bj][m][n] = __builtin_amdgcn_mfma_f32_16x16x32_bf16(Bt[n][k], At[m][k], acc[ai][bj][m][n], 0, 0, 0); __builtin_amdgcn_s_setprio(0); } while (0)
#define PG8_WAIT_V(n) asm volatile("s_waitcnt vmcnt(" #n ")" ::: "memory")
#define PG8_WAIT_L(n) asm volatile("s_waitcnt lgkmcnt(" #n ")" ::: "memory")
#define PG8_BAR __builtin_amdgcn_s_barrier()
#define PG8_SCHED __builtin_amdgcn_sched_barrier(0)
    Unit cur, nxt; int ui = 0;
    if (!S.next(0, cur)) return;
    f32x4 acc[2][2][4][2];
#pragma unroll
    for (int a = 0; a < 2; ++a)
#pragma unroll
        for (int b = 0; b < 2; ++b)
#pragma unroll
            for (int m = 0; m < 4; ++m)
#pragma unroll
                for (int n = 0; n < 2; ++n) acc[a][b][m][n] = (f32x4){0.f, 0.f, 0.f, 0.f};
    bf16x8 At[4][2], B0[2][2], B1[2][2];
    const char* cA = (const char*)g.A + (size_t)cur.pm * tstep; const char* cB = (const char*)g.Bt + (size_t)cur.pn * tstep;
    S.a_ready(cur);
    if constexpr (SP2) {
        PG8_STAGE(PG8_SB(0, 0), cB, voffB); PG8_STAGE(PG8_SB(0, 1), cB + hstep, voffB); PG8_STAGE(PG8_SA(0, 0), cA, voffA); PG8_STAGE(PG8_SA(0, 1), cA + hstep, voffA);
        if (wr == 1) PG8_BAR;
        PG8_WAIT_V(2); PG8_BAR;
        PG8_STAGE(PG8_SB(1, 0), cB + kstep, voffB); PG8_STAGE(PG8_SA(1, 0), cA + kstep, voffA); PG8_STAGE(PG8_SB(1, 1), cB + hstep + kstep, voffB);
        PG8_WAIT_V(6); PG8_BAR;
    } else {
        PG8_STAGE(PG8_SB(0, 0), cB, voffB); PG8_STAGE(PG8_SA(0, 0), cA, voffA); PG8_STAGE(PG8_SB(0, 1), cB + hstep, voffB); PG8_STAGE(PG8_SA(0, 1), cA + hstep, voffA);
        if (wr == 1) PG8_BAR;
        PG8_WAIT_V(4); PG8_BAR;
        PG8_STAGE(PG8_SB(1, 0), cB + kstep, voffB); PG8_STAGE(PG8_SA(1, 0), cA + kstep, voffA); PG8_STAGE(PG8_SB(1, 1), cB + hstep + kstep, voffB);
        PG8_WAIT_V(6); PG8_BAR;
    }
    for (;;) {
        const bool has_next = S.next(ui + 1, nxt);
        const char* nA = has_next ? (const char*)g.A + (size_t)nxt.pm * tstep : cA; const char* nB = has_next ? (const char*)g.Bt + (size_t)nxt.pn * tstep : cB;
        for (int t = 0; t < nt; t += 2) {
            const bool last = (t == nt - 2);
            const char* a1 = cA + (size_t)(t + 1) * kstep;
            const char* a2 = last ? nA : cA + (size_t)(t + 2) * kstep; const char* b2 = last ? nB : cB + (size_t)(t + 2) * kstep;
            const char* a3 = a2 + kstep; const char* b3 = b2 + kstep;
            if (last && has_next) S.a_ready(nxt);
            if constexpr (SP2) {
            PG8_LDB(B0, 0, 0); PG8_LDB(B1, 0, 1); PG8_SCHED; PG8_LDA(At, 0, 0); PG8_STAGE(PG8_SA(1, 1), a1 + hstep, voffA);
            PG8_WAIT_V(8); PG8_WAIT_L(0); PG8_BAR; PG8_MMA(0, 0, At, B0); PG8_MMA(0, 1, At, B1); PG8_BAR; PG8_SCHED;
            PG8_LDA(At, 0, 1); PG8_STAGE(PG8_SB(0, 0), b2, voffB); PG8_STAGE(PG8_SB(0, 1), b2 + hstep, voffB); PG8_STAGE(PG8_SA(0, 0), a2, voffA);
            PG8_WAIT_V(8); PG8_WAIT_L(0); PG8_BAR; PG8_MMA(1, 0, At, B0); PG8_MMA(1, 1, At, B1); PG8_BAR; PG8_SCHED;
            PG8_LDB(B0, 1, 0); PG8_LDB(B1, 1, 1); PG8_SCHED; PG8_LDA(At, 1, 0); PG8_STAGE(PG8_SA(0, 1), a2 + hstep, voffA);
            PG8_WAIT_V(8); PG8_WAIT_L(0); PG8_BAR; PG8_MMA(0, 0, At, B0); PG8_MMA(0, 1, At, B1); PG8_BAR; PG8_SCHED;
            PG8_LDA(At, 1, 1); PG8_STAGE(PG8_SB(1, 0), b3, voffB); PG8_STAGE(PG8_SB(1, 1), b3 + hstep, voffB); PG8_STAGE(PG8_SA(1, 0), a3, voffA);
            PG8_WAIT_V(8); PG8_WAIT_L(0); PG8_BAR; PG8_MMA(1, 0, At, B0); PG8_MMA(1, 1, At, B1); PG8_BAR; PG8_SCHED;
            } else {
            PG8_LDB(B0, 0, 0); PG8_SCHED; PG8_LDA(At, 0, 0); PG8_STAGE(PG8_SA(1, 1), a1 + hstep, voffA);
            PG8_WAIT_L(8); PG8_BAR; PG8_WAIT_L(0); PG8_MMA(0, 0, At, B0); PG8_BAR; PG8_SCHED;
            PG8_LDB(B1, 0, 1); PG8_STAGE(PG8_SB(0, 0), b2, voffB);
            PG8_BAR; PG8_WAIT_L(0); PG8_MMA(0, 1, At, B1); PG8_BAR;
            PG8_LDA(At, 0, 1); PG8_STAGE(PG8_SA(0, 0), a2, voffA);
            PG8_BAR; PG8_WAIT_L(0); PG8_MMA(1, 0, At, B0); PG8_BAR; PG8_SCHED;
            PG8_STAGE(PG8_SB(0, 1), b2 + hstep, voffB);
            PG8_WAIT_V(6); PG8_BAR; PG8_MMA(1, 1, At, B1); PG8_BAR;
            PG8_LDB(B0, 1, 0); PG8_SCHED; PG8_LDA(At, 1, 0); PG8_STAGE(PG8_SA(0, 1), a2 + hstep, voffA);
            PG8_WAIT_L(8); PG8_BAR; PG8_WAIT_L(0); PG8_MMA(0, 0, At, B0); PG8_BAR; PG8_SCHED;
            PG8_LDB(B1, 1, 1); PG8_STAGE(PG8_SB(1, 0), b3, voffB);
            PG8_BAR; PG8_WAIT_L(0); PG8_MMA(0, 1, At, B1); PG8_BAR;
            PG8_LDA(At, 1, 1); PG8_STAGE(PG8_SA(1, 0), a3, voffA);
            PG8_BAR; PG8_WAIT_L(0); PG8_MMA(1, 0, At, B0); PG8_BAR; PG8_SCHED;
            PG8_STAGE(PG8_SB(1, 1), b3 + hstep, voffB);
            PG8_WAIT_V(6); PG8_BAR; PG8_MMA(1, 1, At, B1); PG8_BAR;
            }
        }
        if constexpr (ALIGN_EPI) { if (wr == 0) PG8_BAR; }
        if constexpr (!Epi::AFTER_DRAIN) { E(acc, cur, wr, wc, fr, fq); S.done(cur); }
        if (!has_next) break;
#pragma unroll
        for (int a = 0; a < 2; ++a)
#pragma unroll
            for (int b = 0; b < 2; ++b)
#pragma unroll
                for (int m = 0; m < 4; ++m)
#pragma unroll
                    for (int n = 0; n < 2; ++n) acc[a][b][m][n] = (f32x4){0.f, 0.f, 0.f, 0.f};
        cur = nxt; cA = nA; cB = nB; ++ui;
        if constexpr (ALIGN_EPI) { if (wr == 1) PG8_BAR; }
    }
    PG8_WAIT_V(0);
    if constexpr (!ALIGN_EPI) { if (wr == 0) PG8_BAR; }
    PG8_BAR;
    if constexpr (Epi::AFTER_DRAIN) { E.fused(acc, cur, wr, wc, fr, fq, lds, wid, lane); S.done(cur); }
#undef PG8_SA
#undef PG8_SB
#undef PG8_STAGE
#undef PG8_LDA
#undef PG8_LDB
#undef PG8_MMA
#undef PG8_WAIT_V
#undef PG8_WAIT_L
#undef PG8_BAR
#undef PG8_SCHED
}
}
#define GAS __attribute__((address_space(1)))
#define LAS __attribute__((address_space(3)))
typedef unsigned short bf16;
typedef unsigned v4u __attribute__((ext_vector_type(4)));
typedef float f32x4 __attribute__((ext_vector_type(4)));
typedef short bf16x8 __attribute__((ext_vector_type(8)));
typedef GAS unsigned gu32;
typedef GAS unsigned long long gu64;
#define RLX_AGENT __ATOMIC_RELAXED, __HIP_MEMORY_SCOPE_AGENT
#define LDS_WAIT() asm volatile("s_waitcnt lgkmcnt(0)" ::: "memory")
#define VM_WAIT() asm volatile("s_waitcnt vmcnt(0)" ::: "memory")
__device__ __forceinline__ unsigned long long rt() { return __builtin_amdgcn_s_memrealtime(); }
#define XB_TMO      128
#define XB_XCNT(j)  (256  + 64 * (j))
#define XB_XSUB(j)  (1280 + 64 * (j))
#define XB_XGEN(j)  (2304 + 64 * (j))
#define XB_TOP      3328
#define XB_TOPGEN   3392
#define XCD_BAR_WORDS 3456
#define XB_SPIN_CAP (1u << 18)

__device__ __forceinline__ unsigned xb_ld(unsigned* p)              { return __hip_atomic_load(p, __ATOMIC_RELAXED, __HIP_MEMORY_SCOPE_AGENT); }
__device__ __forceinline__ unsigned xb_add(unsigned* p, unsigned v) { return __hip_atomic_fetch_add(p, v, __ATOMIC_RELAXED, __HIP_MEMORY_SCOPE_AGENT); }
__device__ __forceinline__ unsigned xb_xcc_id() { return (unsigned)__builtin_amdgcn_s_getreg((3 << 11) | 20) & 0xFu; }
#define XB_SPIN(cond, bar) do { unsigned _sp = 0; while (cond) { __builtin_amdgcn_s_sleep(1); \
    if ((++_sp & 255u) == 0u) { if (xb_ld(&(bar)[XB_TMO])) break; if (_sp > XB_SPIN_CAP) { atomicAdd(&(bar)[XB_TMO], 1u); break; } } } } while (0)

struct XcdBarrier {
    unsigned* bar; unsigned x;
    volatile LAS unsigned* st;
};

__device__ __forceinline__ XcdBarrier xcd_barrier_post(unsigned* bar, volatile LAS unsigned* st) {
    XcdBarrier b; b.bar = bar; b.x = xb_xcc_id(); b.st = st;
    if (threadIdx.x == 0) (void)xb_add(&bar[XB_XCNT(b.x)], 1u);
    return b;
}
__device__ __forceinline__ void xcd_barrier_complete(unsigned* bar, unsigned x, unsigned& nloc, unsigned& nx) {
    const unsigned G = gridDim.x * gridDim.y * gridDim.z;
    unsigned sum, cnt, mine, sp = 0u;
    for (;;) {
        sum = 0u; cnt = 0u; mine = 0u;
#pragma unroll
        for (unsigned j = 0; j < 16; ++j) { const unsigned c = xb_ld(&bar[XB_XCNT(j)]); sum += c; cnt += (c > 0u) ? 1u : 0u; mine = (j == x) ? c : mine; }
        if (sum == G) break;
        __builtin_amdgcn_s_sleep(1);
        if ((++sp & 255u) == 0u) { if (xb_ld(&bar[XB_TMO])) break; if (sp > XB_SPIN_CAP) { atomicAdd(&bar[XB_TMO], 1u); break; } }
    }
    nloc = mine > 0u ? mine : 1u; nx = cnt > 0u ? cnt : 1u;
}

__device__ __forceinline__ void xcd_barrier(const XcdBarrier& b) {
    asm volatile("s_waitcnt vmcnt(0)" ::: "memory");
    __syncthreads();
    if (threadIdx.x == 0) {
        unsigned* bar = b.bar;
        __builtin_amdgcn_s_waitcnt(0);
        unsigned nloc = b.st[0], nx = b.st[1];
        if (nloc == 0u) { xcd_barrier_complete(bar, b.x, nloc, nx); b.st[0] = nloc; b.st[1] = nx; }
        const unsigned old = xb_add(&bar[XB_XSUB(b.x)], 1u);
        const unsigned gen = old / nloc;
        if (old + 1u == (gen + 1u) * nloc) {
            __builtin_amdgcn_fence(__ATOMIC_RELEASE, "agent");
            asm volatile("s_waitcnt vmcnt(0)" ::: "memory");
            const unsigned og = xb_add(&bar[XB_TOP], 1u);
            const unsigned tg = og / nx;
            if (og + 1u == (tg + 1u) * nx) xb_add(&bar[XB_TOPGEN], 1u);
            else XB_SPIN(xb_ld(&bar[XB_TOPGEN]) == tg, bar);
            __builtin_amdgcn_fence(__ATOMIC_ACQUIRE, "agent");
            xb_add(&bar[XB_XGEN(b.x)], 1u);
            asm volatile("s_waitcnt vmcnt(0)" ::: "memory");
        } else {
            XB_SPIN(xb_ld(&bar[XB_XGEN(b.x)]) == gen, bar);
            __builtin_amdgcn_fence(__ATOMIC_ACQUIRE, "agent");
            asm volatile("s_waitcnt vmcnt(0)" ::: "memory");
        }
    }
    __syncthreads();
}
constexpr int NWAVES = 8;
#ifndef MK_N_LAUNCHES
#define MK_N_LAUNCHES 1
#endif
constexpr int N_PHASES = 9;
constexpr int N_LAUNCHES = MK_N_LAUNCHES;
constexpr int CW_BAR = 4096;
constexpr int RING_OFF = 0, RING_BYTES = 131072;
constexpr int LDSCTL_OFF = RING_BYTES, MISC_OFF = LDSCTL_OFF + 320, RS_OFF = LDSCTL_OFF + 1024  ;
constexpr int LDS_BYTES = 147456;
static_assert(RS_OFF + 4096 <= LDS_BYTES, "LDS map");

struct Args { const void* in[19]; float* out; unsigned char* ws; int ph_lo, ph_hi, li, pad; };

__device__ __forceinline__ void prep_w_job(const float* __restrict__ W, int ldw, int K, bf16_t* __restrict__ out, int n0, int nrows, const float* __restrict__ scale, int mode, int off, int gt, int GT) {
    const int total = nrows * (K >> 3);
    for (int idx = gt; idx < total; idx += GT) {
        const int n = idx % nrows, k8 = idx / nrows; const int sc = src_col(mode, n, off);
        float v[8];
#pragma unroll
        for (int i = 0; i < 8; ++i) { const int k = k8 * 8 + i; float w = (sc >= 0) ? W[(size_t)k * ldw + sc] : 0.f; if (scale) w *= scale[k]; v[i] = w; }
        uint4 o; o.x = pk2(v[0], v[1]); o.y = pk2(v[2], v[3]); o.z = pk2(v[4], v[5]); o.w = pk2(v[6], v[7]);
        *(uint4*)(out + (size_t)(n0 + n) * K + k8 * 8) = o;
    }
}
__device__ __forceinline__ void rmsnorm_row(const float* __restrict__ xrow, const float* __restrict__ g, bf16_t* __restrict__ orow, int lane) {
    const float4* xr = (const float4*)xrow + lane; float4 v[4]; float s = 0.f;
#pragma unroll
    for (int j = 0; j < 4; ++j) { v[j] = xr[64 * j]; s += v[j].x * v[j].x + v[j].y * v[j].y + v[j].z * v[j].z + v[j].w * v[j].w; }
    const float rstd = rsqrtf(wave_sum(s) * (1.f / DM) + EPS);
    uint2* o = (uint2*)orow + lane;
#pragma unroll
    for (int j = 0; j < 4; ++j) { const float4 gv = g ? ((const float4*)g)[lane + 64 * j] : make_float4(1.f, 1.f, 1.f, 1.f);
        uint2 w; w.x = pk2(v[j].x * rstd * gv.x, v[j].y * rstd * gv.y); w.y = pk2(v[j].z * rstd * gv.z, v[j].w * rstd * gv.w); o[64 * j] = w; }
}

template <int DQK>
__device__ __forceinline__ void attn_naive_vb(float* Ks, float* Vs, int t256, const bf16_t* __restrict__ Q, int ldq, int qhs, const bf16_t* __restrict__ Kp, int ldk, int khs, const bf16_t* __restrict__ Vp, int ldv, int vhs,
                                              int nkeys, bf16_t* __restrict__ O, const bf16_t* __restrict__ G, int ocol0, int qblk, int h, int b) {
    constexpr int KT = 8;
    const size_t t = (size_t)b * SEQ + qblk * 256 + t256;
    unsigned qp2[DQK / 2]; float o[64], m = -1e30f, l = 0.f;
    { const bf16_t* qp = Q + t * ldq + h * qhs;
#pragma unroll
      for (int d = 0; d < DQK; d += 8) { const uint4 v = *(const uint4*)(qp + d); qp2[d / 2] = v.x; qp2[d / 2 + 1] = v.y; qp2[d / 2 + 2] = v.z; qp2[d / 2 + 3] = v.w; } }
#pragma unroll
    for (int d = 0; d < 64; ++d) o[d] = 0.f;
    const bf16_t* Kb = Kp + (size_t)b * nkeys * ldk + h * khs; const bf16_t* Vb = Vp + (size_t)b * nkeys * ldv + h * vhs;
    for (int k0 = 0; k0 < nkeys; k0 += KT) {
        __syncthreads();
        if (t256 < KT * DQK / 8) { const int j = t256 / (DQK / 8), d = (t256 % (DQK / 8)) * 8; const uint4 v = *(const uint4*)(Kb + (size_t)(k0 + j) * ldk + d);
            float* p = Ks + j * DQK + d; p[0] = __uint_as_float(v.x << 16); p[1] = __uint_as_float(v.x & 0xffff0000u); p[2] = __uint_as_float(v.y << 16); p[3] = __uint_as_float(v.y & 0xffff0000u);
            p[4] = __uint_as_float(v.z << 16); p[5] = __uint_as_float(v.z & 0xffff0000u); p[6] = __uint_as_float(v.w << 16); p[7] = __uint_as_float(v.w & 0xffff0000u); }
        if (t256 >= 128 && t256 < 128 + KT * 8) { const int tt = t256 - 128, j = tt >> 3, d = (tt & 7) * 8; const uint4 v = *(const uint4*)(Vb + (size_t)(k0 + j) * ldv + d);
            float* p = Vs + j * 64 + d; p[0] = __uint_as_float(v.x << 16); p[1] = __uint_as_float(v.x & 0xffff0000u); p[2] = __uint_as_float(v.y << 16); p[3] = __uint_as_float(v.y & 0xffff0000u);
            p[4] = __uint_as_float(v.z << 16); p[5] = __uint_as_float(v.z & 0xffff0000u); p[6] = __uint_as_float(v.w << 16); p[7] = __uint_as_float(v.w & 0xffff0000u); }
        __syncthreads();
#pragma unroll 1
        for (int j = 0; j < KT; ++j) { float s = 0.f; const float4* kr = (const float4*)(Ks + j * DQK);
#pragma unroll
            for (int d = 0; d < DQK / 4; ++d) { const float4 kv = kr[d]; const unsigned a = qp2[2 * d], c = qp2[2 * d + 1];
                s += __uint_as_float(a << 16) * kv.x + __uint_as_float(a & 0xffff0000u) * kv.y + __uint_as_float(c << 16) * kv.z + __uint_as_float(c & 0xffff0000u) * kv.w; }
            if (s > m) { const float alpha = __builtin_amdgcn_exp2f(m - s); m = s; l *= alpha;
#pragma unroll
                for (int d = 0; d < 64; ++d) o[d] *= alpha; }
            const float p = __builtin_amdgcn_exp2f(s - m); l += p; const float4* vr = (const float4*)(Vs + j * 64);
#pragma unroll
            for (int d = 0; d < 16; ++d) { const float4 vv = vr[d]; o[4 * d] += p * vv.x; o[4 * d + 1] += p * vv.y; o[4 * d + 2] += p * vv.z; o[4 * d + 3] += p * vv.w; } }
    }
    const float rl = 1.f / l;
    const bf16_t* gp = G + t * 1024 + ocol0 + h * 64; bf16_t* op = O + t * 1024 + ocol0 + h * 64;
#pragma unroll
    for (int d = 0; d < 64; d += 8) { const uint4 gv = *(const uint4*)(gp + d); uint4 w;
        w.x = pk2(o[d] * rl * __uint_as_float(gv.x << 16), o[d + 1] * rl * __uint_as_float(gv.x & 0xffff0000u));
        w.y = pk2(o[d + 2] * rl * __uint_as_float(gv.y << 16), o[d + 3] * rl * __uint_as_float(gv.y & 0xffff0000u));
        w.z = pk2(o[d + 4] * rl * __uint_as_float(gv.z << 16), o[d + 5] * rl * __uint_as_float(gv.z & 0xffff0000u));
        w.w = pk2(o[d + 6] * rl * __uint_as_float(gv.w << 16), o[d + 7] * rl * __uint_as_float(gv.w & 0xffff0000u));
        *(uint4*)(op + d) = w; }
}
template <int DQK>
__device__ __forceinline__ void attn_naive_phase(unsigned char* lds, int tid, const bf16_t* Q, int ldq, int qhs, const bf16_t* Kp, int ldk, int khs, const bf16_t* Vp, int ldv, int vhs, int nkeys, int nheads,
                                                 bf16_t* O, const bf16_t* G, int ocol0) {
    const int half = tid >> 8, t256 = tid & 255; float* Ks = (float*)(lds + half * 32768); float* Vs = Ks + 8 * DQK;
    const int total = 16 * nheads * NB, stride = (int)gridDim.x * 2;
    for (int vb = (int)blockIdx.x * 2 + half; vb < total; vb += stride) { const int qblk = vb & 15, h = (vb >> 4) % nheads, b = (vb >> 4) / nheads;
        attn_naive_vb<DQK>(Ks, Vs, t256, Q, ldq, qhs, Kp, ldk, khs, Vp, ldv, vhs, nkeys, O, G, ocol0, qblk, h, b); }
}

__global__ void __launch_bounds__(NWAVES * 64, 2) mk_fwd(Args args) {
    extern __shared__ __attribute__((aligned(16))) unsigned char lds[];
    LAS unsigned char* ldsl = (LAS unsigned char*)lds;
    volatile LAS unsigned* MISC = (volatile LAS unsigned*)(ldsl + MISC_OFF);
    const int tid = threadIdx.x, lane = tid & 63, wave = __builtin_amdgcn_readfirstlane(tid >> 6);
    const int G = gridDim.x, gt = (int)blockIdx.x * (NWAVES * 64) + tid, GT = G * NWAVES * 64, gw = (int)blockIdx.x * NWAVES + wave, NGW = G * NWAVES;
    unsigned char* ws = args.ws;
    gu32* ctl = (gu32*)(ws + WS_CTL);
    const float* x = (const float*)args.in[0]; const float* mem = (const float*)args.in[1]; const int* pos = (const int*)args.in[2];
    const float* g0 = (const float*)args.in[3]; const float* w_in0 = (const float*)args.in[4]; const float* gq = (const float*)args.in[5]; const float* gkv = (const float*)args.in[6];
    const float* w_uq = (const float*)args.in[7]; const float* w_ukv = (const float*)args.in[8]; const float* gm0 = (const float*)args.in[9]; const float* w_mkv0 = (const float*)args.in[10];
    const float* w_out0 = (const float*)args.in[11]; const float* g1 = (const float*)args.in[12]; const float* w_in1 = (const float*)args.in[13]; const float* w_fnet = (const float*)args.in[14];
    const float* gm1 = (const float*)args.in[15]; const float* w_mkv1 = (const float*)args.in[16]; const float* w_out1 = (const float*)args.in[17]; const float* gf = (const float*)args.in[18];
    float* out = args.out;
    bf16_t* WIN0 = (bf16_t*)(ws + WS_WIN0); bf16_t* WUQ = (bf16_t*)(ws + WS_WUQ); bf16_t* WUKV = (bf16_t*)(ws + WS_WUKV); bf16_t* WMEM = (bf16_t*)(ws + WS_WMEM);
    bf16_t* WOUT0 = (bf16_t*)(ws + WS_WOUT0); bf16_t* WOUT1 = (bf16_t*)(ws + WS_WOUT1); bf16_t* WIN1 = (bf16_t*)(ws + WS_WIN1); float* AGBG = (float*)(ws + WS_AGBG);
    float* ROPE = (float*)(ws + WS_ROPE); bf16_t* MEMN = (bf16_t*)(ws + WS_MEMN); bf16_t* MEMKV = (bf16_t*)(ws + WS_MEMKV); float* RSTD1 = (float*)(ws + WS_RSTD1); float* SSQ = (float*)(ws + WS_SSQ);
    bf16_t* XN0 = (bf16_t*)(ws + WS_XN0); bf16_t* BR = (bf16_t*)(ws + WS_BR); bf16_t* CQ = (bf16_t*)(ws + WS_CQ); bf16_t* CKV = (bf16_t*)(ws + WS_CKV); bf16_t* QMEM0 = (bf16_t*)(ws + WS_QMEM0);
    bf16_t* SG0 = (bf16_t*)(ws + WS_SG0); bf16_t* Kb = (bf16_t*)(ws + WS_K); bf16_t* Qb = (bf16_t*)(ws + WS_Q); bf16_t* Vb = (bf16_t*)(ws + WS_V); bf16_t* X1B = (bf16_t*)(ws + WS_X1B);
    bf16_t* PQ = (bf16_t*)(ws + WS_PQ); bf16_t* QMEM1 = (bf16_t*)(ws + WS_QMEM1); bf16_t* SG1 = (bf16_t*)(ws + WS_SG1); bf16_t* Y = (bf16_t*)(ws + WS_Y);

    for (int u = tid; u < (LDS_BYTES - LDSCTL_OFF) / 4; u += NWAVES * 64) ((LAS unsigned*)(ldsl + LDSCTL_OFF))[u] = 0u;
    __syncthreads();
    XcdBarrier bar; bar.bar = (unsigned*)(ctl + CW_BAR); bar.x = 0; bar.st = nullptr;
    if (N_LAUNCHES == 1) bar = xcd_barrier_post((unsigned*)(ctl + CW_BAR), MISC + 8);
#define GRID_BAR() do { if (N_LAUNCHES == 1) xcd_barrier(bar); } while (0)
    const int lo = args.ph_lo, hi = args.ph_hi;
#ifndef PH_MASK
#define PH_MASK 0x1ff
#endif
#define IN(k) (((PH_MASK >> (k)) & 1) && lo <= (k) && (k) < hi)
#define BOTH(k) (IN(k) && IN((k) + 1))
    LAS float* rs = (LAS float*)(ldsl + RS_OFF);

    if (IN(0)) {
        prep_w_job(w_in0, 1952, 1024, WIN0, 0, 2048, nullptr, MODE_WIN0, 0, gt, GT);
        prep_w_job(w_uq, 1152, 384, WUQ, 0, 1280, gq, MODE_WUQ, 0, gt, GT);
        prep_w_job(w_ukv, 1536, 256, WUKV, 0, 1536, gkv, MODE_WUKV, 0, gt, GT);
        prep_w_job(w_mkv0, 512, 1024, WMEM, 0, 512, gm0, MODE_PLAIN, 0, gt, GT);
        prep_w_job(w_mkv1, 512, 1024, WMEM, 512, 512, gm1, MODE_PLAIN, 0, gt, GT);
        prep_w_job(w_out0, 1024, 1024, WOUT0, 0, 1024, nullptr, MODE_PLAIN, 0, gt, GT);
        prep_w_job(w_out1, 1024, 1024, WOUT1, 0, 1024, nullptr, MODE_PLAIN, 0, gt, GT);
        prep_w_job(w_in1, 2048, 1024, WIN1, 1536, 1280, g1, MODE_PLAIN, 768, gt, GT);
        for (int idx = gt; idx < 2 * 4 * 192 * 192; idx += GT) { const int d = idx % 192, c = (idx / 192) % 192, g = (idx / 36864) & 3, pq = idx / 147456;
            float acc = 0.f;
            for (int m = 0; m < 192; ++m) { const float fr = 2.0f * (float)((m * c) % 192) / 192.0f; const float tr = pq ? sinpif(fr) : cospif(fr); acc += tr * w_fnet[((size_t)g * 192 + m) * 192 + d]; }
            AGBG[idx] = acc * 0.07216878364870322f; }
        for (int idx = gt; idx < T * 16; idx += GT) { const int t = idx >> 4, i = idx & 15;
            const float inv_freq = (float)(1.0 / pow(10000.0, (double)i / 16.0)); const float ang = (float)pos[t] * inv_freq;
            ROPE[2 * idx] = (float)cos((double)ang); ROPE[2 * idx + 1] = (float)sin((double)ang); }
        for (int m = gw; m < 4096; m += NGW) rmsnorm_row(mem + (size_t)m * DM, nullptr, MEMN + (size_t)m * DM, lane);
        for (int m = gw; m < T; m += NGW) rmsnorm_row(x + (size_t)m * DM, g0, XN0 + (size_t)m * DM, lane);
        if (BOTH(0)) GRID_BAR();
    }
    if (IN(1)) {
        for (int idx = gt; idx < 2 * 4 * 1024 * 192; idx += GT) { const int d = idx % 192, k = (idx / 192) & 1023, g = (idx / 196608) & 3, pq = idx / 786432;
            const float* wr = w_in1 + (size_t)k * 2048 + 192 * g; const float* ag = AGBG + (((size_t)pq * 4 + g) * 192) * 192 + d; float acc = 0.f;
            for (int c = 0; c < 192; ++c) acc += wr[c] * ag[(size_t)c * 192];
            WIN1[(size_t)(pq * 768 + g * 192 + d) * 1024 + k] = f2bf(acc * g1[k]); }
        { pg8::Gemm g{XN0, WIN0, T, 2048, 1024}; pg8::StaticOrder S; S.init(T, 2048, G, (int)blockIdx.x);
          pg8::EpiIn0 E{CQ, CKV, QMEM0, SG0, Kb, SSQ, ROPE};
          pg8::gemm_phase<pg8::EpiIn0, pg8::StaticOrder, true, true>(ldsl + RING_OFF, g, S, E); }
        { pg8::Gemm g{MEMN, WMEM, 4096, 1024, 1024}; pg8::StaticOrder S; S.init(4096, 1024, G, (int)blockIdx.x);
          pg8::EpiPlainB E{MEMKV, 1024, 0};
          pg8::gemm_phase<pg8::EpiPlainB, pg8::StaticOrder, true, true>(ldsl + RING_OFF, g, S, E); }
        if (BOTH(1)) GRID_BAR();
    }
    if (IN(2)) {
        { int kq_ = 384; asm volatile("" : "+s"(kq_)); pg8::Gemm g{CQ, WUQ, T, 1280, kq_}; pg8::StaticOrder S; S.init(T, 1280, G, (int)blockIdx.x);
          pg8::EpiQup E{Qb, SSQ, ROPE};
          pg8::gemm_phase<pg8::EpiQup, pg8::StaticOrder, true, true>(ldsl + RING_OFF, g, S, E); }
        { int kk_ = 256; asm volatile("" : "+s"(kk_)); pg8::Gemm g{CKV, WUKV, T, 1536, kk_}; pg8::StaticOrder S; S.init(T, 1536, G, (int)blockIdx.x);
          pg8::EpiKVup E{Kb, Vb, SSQ};
          pg8::gemm_phase<pg8::EpiKVup, pg8::StaticOrder, true, true>(ldsl + RING_OFF, g, S, E); }
        if (BOTH(2)) GRID_BAR();
    }
    if (IN(3)) {
#ifndef NO_ATTN
        attn_naive_phase<96>(lds, tid, Qb, 1152, 96, Kb, 1152, 96, Vb, 768, 64, SEQ, 12, BR, SG0, 0);
        attn_naive_phase<64>(lds, tid, QMEM0, 256, 64, MEMKV, 1024, 64, MEMKV + 256, 1024, 64, 256, 4, BR, SG0, 768);
#endif
        if (BOTH(3)) GRID_BAR();
    }
    if (IN(4)) {
        for (int i = tid; i < 1024; i += NWAVES * 64) rs[i] = 0.f;
        __syncthreads();
        { pg8::Gemm g{BR, WOUT0, T, 1024, 1024}; pg8::PanelOrder S; S.init(T, G, (int)blockIdx.x);
          pg8::EpiOut E{x, out, X1B, rs};
          pg8::gemm_phase<pg8::EpiOut, pg8::PanelOrder, true, true>(ldsl + RING_OFF, g, S, E); }
        __syncthreads();
        if (tid < 256) RSTD1[(size_t)blockIdx.x * 256 + tid] = rsqrtf(((rs[tid * 4] + rs[tid * 4 + 1]) + (rs[tid * 4 + 2] + rs[tid * 4 + 3])) * (1.f / DM) + EPS);
        if (BOTH(4)) GRID_BAR();
    }
    if (IN(5)) {
        { pg8::Gemm g{X1B, WIN1, T, 2816, 1024}; pg8::StaticOrder S; S.init(T, 2816, G, (int)blockIdx.x);
          pg8::EpiIn1 E{PQ, QMEM1, SG1, RSTD1};
          pg8::gemm_phase<pg8::EpiIn1, pg8::StaticOrder, true, true>(ldsl + RING_OFF, g, S, E); }
        if (BOTH(5)) GRID_BAR();
    }
    if (IN(6)) {
        LAS float* tab = (LAS float*)(ldsl + RING_OFF + 65536);
        if (tid < 64) { tab[2 * tid] = cospif(2.f * tid / 64.f); tab[2 * tid + 1] = sinpif(2.f * tid / 64.f); }
        __syncthreads();
        for (int idx = gt; idx < NB * 64 * 49152; idx += GT) { const int e = idx % 49152, k1 = (idx / 49152) & 63, b = idx / (49152 * 64);
            float ar = 0.f, ai = 0.f;
            for (int s1 = 0; s1 < 64; ++s1) { const int w = (k1 * s1) & 63; const float wx = tab[2 * w], wy = tab[2 * w + 1];
                const size_t base = (((size_t)b * 64 + s1) * 2) * 49152 + e; const float p = bf2f(PQ[base]), q = bf2f(PQ[base + 49152]);
                ar += wx * p - wy * q; ai += wy * p + wx * q; }
            ar *= 0.125f; ai *= 0.125f;
            const int s2 = e / 768; const float fr = 2.f * (float)(k1 * s2) / 4096.f; const float tr = cospif(fr), ti = sinpif(fr);
            const size_t ob = (((size_t)b * 64 + k1) * 2) * 49152 + e;
            Y[ob] = f2bf(tr * ar - ti * ai); Y[ob + 49152] = f2bf(ti * ar + tr * ai); }
        __syncthreads();
#ifndef NO_ATTN
        attn_naive_phase<64>(lds, tid, QMEM1, 256, 64, MEMKV + 512, 1024, 64, MEMKV + 768, 1024, 64, 256, 4, BR, SG1, 768);
#endif
        if (BOTH(6)) GRID_BAR();
    }
    if (IN(7)) {
        LAS float* tab = (LAS float*)(ldsl + RING_OFF + 65536);
        __syncthreads();
        if (tid < 64) { tab[2 * tid] = cospif(2.f * tid / 64.f); tab[2 * tid + 1] = sinpif(2.f * tid / 64.f); }
        __syncthreads();
        for (int idx = gt; idx < NB * 64 * 64 * 768; idx += GT) { const int d = idx % 768, k2 = (idx / 768) & 63, bk1 = idx / 49152, b = bk1 >> 6, k1 = bk1 & 63;
            float acc = 0.f;
            for (int s2 = 0; s2 < 64; ++s2) { const int w = (k2 * s2) & 63; const size_t base = ((size_t)bk1 * 2) * 49152 + (size_t)s2 * 768 + d;
                acc += tab[2 * w] * bf2f(Y[base]) - tab[2 * w + 1] * bf2f(Y[base + 49152]); }
            const size_t t = (size_t)b * SEQ + k1 + 64 * k2;
            BR[t * 1024 + d] = f2bf(acc * 0.125f * bf2f(SG1[t * 1024 + d])); }
        if (BOTH(7)) GRID_BAR();
    }
    if (IN(8)) {
        __syncthreads();
        for (int i = tid; i < 1024; i += NWAVES * 64) rs[i] = 0.f;
        __syncthreads();
        { pg8::Gemm g{BR, WOUT1, T, 1024, 1024}; pg8::PanelOrder S; S.init(T, G, (int)blockIdx.x);
          pg8::EpiOut E{out, out, nullptr, rs};
          pg8::gemm_phase<pg8::EpiOut, pg8::PanelOrder, true, true>(ldsl + RING_OFF, g, S, E); }
        asm volatile("s_waitcnt vmcnt(0)" ::: "memory");
        __syncthreads();
        for (int r = wave; r < 256; r += NWAVES) { const float rstd = rsqrtf(((rs[r * 4] + rs[r * 4 + 1]) + (rs[r * 4 + 2] + rs[r * 4 + 3])) * (1.f / DM) + EPS);
            float4* xr = (float4*)(out + ((size_t)blockIdx.x * 256 + r) * DM) + lane;
#pragma unroll
            for (int j = 0; j < 4; ++j) { float4 v = xr[64 * j]; const float4 gv = ((const float4*)gf)[lane + 64 * j]; v.x *= rstd * gv.x; v.y *= rstd * gv.y; v.z *= rstd * gv.z; v.w *= rstd * gv.w; xr[64 * j] = v; } }
    }
#undef IN
#undef BOTH
#undef GRID_BAR
}

extern "C" void kernel_launch(void* const* d_in, const int* in_sizes, int n_in, void* d_out, int out_size, void* d_ws, size_t ws_size, hipStream_t stream) {
    static int grid = 0;
    if (grid == 0) {
        if (n_in != 19 || ws_size < WS_END || out_size != T * DM) { fprintf(stderr, "kernel_launch: unexpected n_in %d / ws %zu / out %d\n", n_in, ws_size, out_size); grid = -1; return; }
        int dev = 0, cus = 0;
        if (hipGetDevice(&dev) != hipSuccess || hipDeviceGetAttribute(&cus, hipDeviceAttributeMultiprocessorCount, dev) != hipSuccess) { grid = -1; return; }
        if (hipFuncSetAttribute((const void*)mk_fwd, hipFuncAttributeMaxDynamicSharedMemorySize, LDS_BYTES) != hipSuccess) { fprintf(stderr, "kernel_launch: hipFuncSetAttribute failed\n"); grid = -1; return; }
        int per_cu = 0; (void)hipOccupancyMaxActiveBlocksPerMultiprocessor(&per_cu, (const void*)mk_fwd, NWAVES * 64, LDS_BYTES); (void)hipGetLastError();
        if (cus != 256 || per_cu < 1) fprintf(stderr, "kernel_launch: note: %d CUs, occupancy query %d (built for 256 CUs, one workgroup each)\n", cus, per_cu);
        grid = 256;
    }
    if (grid < 0) return;
    if (hipMemsetAsync((char*)d_ws + WS_CTL, 0, CTL_ZERO_BYTES, stream) != hipSuccess) { fprintf(stderr, "kernel_launch: memset failed\n"); return; }
    Args a{};
    for (int i = 0; i < 19; ++i) a.in[i] = d_in[i];
    a.out = (float*)d_out; a.ws = (unsigned char*)d_ws;
    for (int li = 0; li < N_LAUNCHES; ++li) {
        a.ph_lo = (N_LAUNCHES == 1) ? 0 : li; a.ph_hi = (N_LAUNCHES == 1) ? N_PHASES : li + 1; a.li = li; a.pad = 0;
        hipLaunchKernelGGL(mk_fwd, dim3(grid), dim3(NWAVES * 64), LDS_BYTES, stream, a);
        const hipError_t le = hipPeekAtLastError();
        if (le != hipSuccess) { fprintf(stderr, "kernel_launch: launch %d failed: %s\n", li, hipGetErrorName(le)); break; }
    }
}
```

```cpp
#include <hip/hip_runtime.h>
#include <stdint.h>
#include <cstdio>

typedef unsigned short bf16_t;
constexpr int T = 65536, SEQ = 4096, NB = 16, DM = 1024;
constexpr float EPS = 1e-6f;
constexpr float LOG2E = 1.4426950408889634f;
constexpr float QS_MLA = 0.10206207261596575f * LOG2E;
constexpr float QS_MEM = 0.125f * LOG2E;

constexpr size_t MiB = 1u << 20;
constexpr size_t WS_CTL = 0, CTL_ZERO_BYTES = 1 * MiB;
constexpr size_t WS_WIN0 = 1 * MiB;
constexpr size_t WS_WUQ = 5 * MiB;
constexpr size_t WS_WUKV = 6 * MiB;
constexpr size_t WS_WMEM = 7 * MiB;
constexpr size_t WS_WOUT0 = 9 * MiB;
constexpr size_t WS_WOUT1 = 11 * MiB;
constexpr size_t WS_WIN1 = 13 * MiB;
constexpr size_t WS_AGBG = 19 * MiB;
constexpr size_t WS_ROPE = 21 * MiB;
constexpr size_t WS_MEMN = 29 * MiB;
constexpr size_t WS_MEMKV = 37 * MiB;
constexpr size_t WS_RSTD1 = 45 * MiB;
constexpr size_t WS_SSQ = 46 * MiB;
constexpr size_t WS_XN0 = 64 * MiB;
constexpr size_t WS_BR = 64 * MiB;
constexpr size_t WS_CQ = 192 * MiB;
constexpr size_t WS_CKV = 240 * MiB;
constexpr size_t WS_QMEM0 = 272 * MiB;
constexpr size_t WS_SG0 = 304 * MiB;
constexpr size_t WS_K = 432 * MiB;
constexpr size_t WS_Q = 576 * MiB;
constexpr size_t WS_V = 720 * MiB;
constexpr size_t WS_X1B = 192 * MiB;
constexpr size_t WS_PQ = 320 * MiB;
constexpr size_t WS_QMEM1 = 512 * MiB;
constexpr size_t WS_SG1 = 544 * MiB;
constexpr size_t WS_Y = 672 * MiB;
constexpr size_t WS_END = 864 * MiB;

__device__ __forceinline__ float bf2f(bf16_t h) { return __uint_as_float(((unsigned)h) << 16); }
__device__ __forceinline__ bf16_t f2bf(float f) { unsigned u = __float_as_uint(f); return (bf16_t)((u + 0x7fffu + ((u >> 16) & 1u)) >> 16); }
__device__ __forceinline__ unsigned pk2(float lo, float hi) { return (unsigned)f2bf(lo) | ((unsigned)f2bf(hi) << 16); }
__device__ __forceinline__ float silu_f(float v) { return v * __builtin_amdgcn_rcpf(1.f + __expf(-v)); }
__device__ __forceinline__ float wave_sum(float v) {
#pragma unroll
    for (int o = 1; o < 64; o <<= 1) v += __shfl_xor(v, o);
    return v;
}
__host__ __device__ __forceinline__ int ropedim(int p) { return 4 * (p >> 3) + (p & 3) + 16 * ((p >> 2) & 1); }
enum { MODE_WIN0 = 0, MODE_WUQ = 1, MODE_WUKV = 2, MODE_PLAIN = 3 };
__device__ __forceinline__ int src_col(int mode, int n, int off) {
    if (mode == MODE_WIN0) {
        if (n < 640) return n;
        if (n < 896) return 672 + (n - 640);
        if (n < 928) return 640 + ropedim(n - 896);
        if (n < 1024) return -1;
        return 928 + (n - 1024);
    } else if (mode == MODE_WUQ) {
        if (n < 768) return (n >> 6) * 96 + (n & 63);
        if (n < 1152) { const int r = n - 768; return (r >> 5) * 96 + 64 + ropedim(r & 31); }
        return -1;
    } else if (mode == MODE_WUKV) {
        if (n < 768) return (n >> 6) * 128 + (n & 63);
        const int r = n - 768; return (r >> 6) * 128 + 64 + (r & 63);
    }
    return n + off;
}
namespace pg8 {
#define PG8_LAS __attribute__((address_space(3)))
typedef unsigned short bf16_t;
typedef short bf16x8 __attribute__((ext_vector_type(8)));
typedef float f32x4 __attribute__((ext_vector_type(4)));
typedef unsigned u32x4 __attribute__((ext_vector_type(4)));
constexpr int BM = 256, BK = 64, HALF = 128, HTB = HALF * BK * 2  , STAGE_BYTES = 8 * HTB, NXCD = 8, WGM = 8;

__host__ __device__ __forceinline__ int lds_byte(int r, int c) { const int st = (r >> 4) * 2 + (c >> 5), rr = r & 15, cc = c & 31, ob = rr * 64 + cc * 2; return st * 1024 + (ob ^ (((ob >> 9) & 1) << 5)); }
__host__ __device__ __forceinline__ void stage_rc(int b, int& R, int& C) { const int st = b / 1024, sb = b % 1024, swz = sb ^ (((sb >> 9) & 1) << 5); R = (st >> 1) * 16 + swz / 64; C = (st & 1) * 32 + (swz % 64) / 2; }
__host__ __device__ __forceinline__ int perm32(int rho) { const int n = rho >> 4, i = rho & 15; return 8 * (i >> 2) + 4 * n + (i & 3); }

struct Unit { int pm, pn; };
struct Gemm { const bf16_t* A; const bf16_t* Bt; int M, N, K; };

struct StaticOrder {
    int nM, nN, nwg, G, c;
    __host__ __device__ void init(int M, int N, int G_, int c_) { nM = M / BM; nN = N / BM; nwg = nM * nN; G = G_; c = c_; }
    __host__ __device__ bool next(int i, Unit& u) const {
        const long L = (long)i * G + c; if (L >= nwg) return false;
        int wgid = (int)L; { const int q = nwg / NXCD, r = nwg % NXCD, xcd = wgid % NXCD, off = wgid / NXCD; wgid = (xcd < r ? xcd * (q + 1) : r * (q + 1) + (xcd - r) * q) + off; }
        const int nig = WGM * nN, gid = wgid / nig, fm = gid * WGM, gsz = (nM - fm) < WGM ? (nM - fm) : WGM;
        u.pm = fm + ((wgid % nig) % gsz); u.pn = (wgid % nig) / gsz; return true;
    }
    __device__ __forceinline__ void a_ready(const Unit&) const {}
    __device__ __forceinline__ void done(const Unit&) const {}
};

__device__ __forceinline__ unsigned cvt_pk_bf16(float lo, float hi) { unsigned r; asm volatile("v_cvt_pk_bf16_f32 %0, %1, %2" : "=v"(r) : "v"(lo), "v"(hi)); return r; }
typedef float f32x2 __attribute__((ext_vector_type(2)));
__device__ __forceinline__ u32x4 pack8(const f32x4 a, const f32x4 b, float s) { u32x4 w; w.x = cvt_pk_bf16(a[0] * s, a[1] * s); w.y = cvt_pk_bf16(a[2] * s, a[3] * s); w.z = cvt_pk_bf16(b[0] * s, b[1] * s); w.w = cvt_pk_bf16(b[2] * s, b[3] * s); return w; }
__device__ __forceinline__ float ss8(const f32x4 a, const f32x4 b) { return (a[0] * a[0] + a[1] * a[1]) + (a[2] * a[2] + a[3] * a[3]) + (b[0] * b[0] + b[1] * b[1]) + (b[2] * b[2] + b[3] * b[3]); }
__device__ __forceinline__ float quad_sum(float v) { v += __shfl_xor(v, 16); v += __shfl_xor(v, 32); return v; }
__device__ __forceinline__ f32x4 silu4(const f32x4 v) { f32x4 o; o[0] = silu_f(v[0]); o[1] = silu_f(v[1]); o[2] = silu_f(v[2]); o[3] = silu_f(v[3]); return o; }
typedef unsigned u32x2 __attribute__((ext_vector_type(2)));
__device__ __forceinline__ void rope_pair(const f32x4 a, const f32x4 b, const float* cs  , float s, u32x2& o1, u32x2& o2) {
    const f32x4 c01 = *(const f32x4*)cs, c23 = *(const f32x4*)(cs + 4);
    const float r0 = (a[0] * c01[0] - b[0] * c01[1]) * s, r1 = (a[1] * c01[2] - b[1] * c01[3]) * s, r2 = (a[2] * c23[0] - b[2] * c23[1]) * s, r3 = (a[3] * c23[2] - b[3] * c23[3]) * s;
    const float q0 = (b[0] * c01[0] + a[0] * c01[1]) * s, q1 = (b[1] * c01[2] + a[1] * c01[3]) * s, q2 = (b[2] * c23[0] + a[2] * c23[1]) * s, q3 = (b[3] * c23[2] + a[3] * c23[3]) * s;
    o1.x = cvt_pk_bf16(r0, r1); o1.y = cvt_pk_bf16(r2, r3); o2.x = cvt_pk_bf16(q0, q1); o2.y = cvt_pk_bf16(q2, q3);
}
struct EpiIn0 {
    static constexpr bool PERM = true, AFTER_DRAIN = false;
    bf16_t *CQ, *CKV, *QMEM, *SG, *Kb; float* SSQ; const float* rope;
    __device__ __forceinline__ void operator()(const f32x4 (&acc)[2][2][4][2], const Unit& u, int wr, int wc, int fr, int fq) const {
#pragma unroll
        for (int ai = 0; ai < 2; ++ai)
#pragma unroll
            for (int m = 0; m < 4; ++m) { int rowi_ = u.pm * BM + ai * HALF + wr * 64 + m * 16 + fr; asm volatile("" : "+v"(rowi_)); const size_t row = (size_t)rowi_;
#pragma unroll
                for (int bj = 0; bj < 2; ++bj) { const int cb = u.pn * BM + bj * HALF + wc * 32, c = cb + 8 * fq; const f32x4 v0 = acc[ai][bj][m][0], v1 = acc[ai][bj][m][1];
                    if (cb < 640) { const float ss = quad_sum(ss8(v0, v1));
                        if (cb < 384) { *(u32x4*)(CQ + row * 384 + c) = pack8(v0, v1, 1.f); if (fq == 0) SSQ[row * 20 + (cb >> 5)] = ss; }
                        else { *(u32x4*)(CKV + row * 256 + (c - 384)) = pack8(v0, v1, 1.f); if (fq == 0) SSQ[row * 20 + 12 + ((cb - 384) >> 5)] = ss; } }
                    else if (cb < 896) { *(u32x4*)(QMEM + row * 256 + (c - 640)) = pack8(v0, v1, QS_MEM); }
                    else if (cb < 1024) { if (cb == 896) { u32x2 o1, o2; rope_pair(v0, v1, rope + row * 32 + 8 * fq, 1.f, o1, o2);
#pragma unroll
                            for (int h = 0; h < 12; ++h) { *(u32x2*)(Kb + row * 1152 + h * 96 + 64 + 4 * fq) = o1; *(u32x2*)(Kb + row * 1152 + h * 96 + 80 + 4 * fq) = o2; } } }
                    else { *(u32x4*)(SG + row * 1024 + (c - 1024)) = pack8(silu4(v0), silu4(v1), 1.f); } } }
    }
};
struct EpiPlainB {
    static constexpr bool PERM = true, AFTER_DRAIN = false;
    bf16_t* O; int ldo; int pad;
    __device__ __forceinline__ void operator()(const f32x4 (&acc)[2][2][4][2], const Unit& u, int wr, int wc, int fr, int fq) const {
#pragma unroll
        for (int ai = 0; ai < 2; ++ai)
#pragma unroll
            for (int m = 0; m < 4; ++m) { int rowi_ = u.pm * BM + ai * HALF + wr * 64 + m * 16 + fr; asm volatile("" : "+v"(rowi_)); const size_t row = (size_t)rowi_;
#pragma unroll
                for (int bj = 0; bj < 2; ++bj) { const int c = u.pn * BM + bj * HALF + wc * 32 + 8 * fq; *(u32x4*)(O + row * ldo + c) = pack8(acc[ai][bj][m][0], acc[ai][bj][m][1], 1.f); } }
    }
};
struct EpiQup {
    static constexpr bool PERM = true, AFTER_DRAIN = false;
    bf16_t* Qb; const float* SSQ; const float* rope;
    __device__ __forceinline__ void operator()(const f32x4 (&acc)[2][2][4][2], const Unit& u, int wr, int wc, int fr, int fq) const {
#pragma unroll
        for (int ai = 0; ai < 2; ++ai)
#pragma unroll
            for (int m = 0; m < 4; ++m) { int rowi_ = u.pm * BM + ai * HALF + wr * 64 + m * 16 + fr; asm volatile("" : "+v"(rowi_)); const size_t row = (size_t)rowi_;
                const f32x4 s0 = *(const f32x4*)(SSQ + row * 20), s1 = *(const f32x4*)(SSQ + row * 20 + 4), s2 = *(const f32x4*)(SSQ + row * 20 + 8);
                const float ss = ((s0[0] + s0[1]) + (s0[2] + s0[3])) + ((s1[0] + s1[1]) + (s1[2] + s1[3])) + ((s2[0] + s2[1]) + (s2[2] + s2[3]));
                const float s = rsqrtf(ss * (1.f / 384.f) + EPS) * QS_MLA;
#pragma unroll
                for (int bj = 0; bj < 2; ++bj) { const int cb = u.pn * BM + bj * HALF + wc * 32, c = cb + 8 * fq; const f32x4 v0 = acc[ai][bj][m][0], v1 = acc[ai][bj][m][1];
                    if (cb < 768) { *(u32x4*)(Qb + row * 1152 + (c >> 6) * 96 + (c & 63)) = pack8(v0, v1, s); }
                    else if (cb < 1152) { const int h = (cb - 768) >> 5; u32x2 o1, o2; rope_pair(v0, v1, rope + row * 32 + 8 * fq, s, o1, o2);
                        *(u32x2*)(Qb + row * 1152 + h * 96 + 64 + 4 * fq) = o1; *(u32x2*)(Qb + row * 1152 + h * 96 + 80 + 4 * fq) = o2; } }
                asm volatile("" ::: "memory"); }
    }
};
struct EpiKVup {
    static constexpr bool PERM = true, AFTER_DRAIN = false;
    bf16_t *Kb, *Vb; const float* SSQ;
    __device__ __forceinline__ void operator()(const f32x4 (&acc)[2][2][4][2], const Unit& u, int wr, int wc, int fr, int fq) const {
#pragma unroll
        for (int ai = 0; ai < 2; ++ai)
#pragma unroll
            for (int m = 0; m < 4; ++m) { int rowi_ = u.pm * BM + ai * HALF + wr * 64 + m * 16 + fr; asm volatile("" : "+v"(rowi_)); const size_t row = (size_t)rowi_;
                const f32x4 s0 = *(const f32x4*)(SSQ + row * 20 + 12), s1 = *(const f32x4*)(SSQ + row * 20 + 16);
                const float ss = ((s0[0] + s0[1]) + (s0[2] + s0[3])) + ((s1[0] + s1[1]) + (s1[2] + s1[3]));
                const float s = rsqrtf(ss * (1.f / 256.f) + EPS);
#pragma unroll
                for (int bj = 0; bj < 2; ++bj) { const int cb = u.pn * BM + bj * HALF + wc * 32, c = cb + 8 * fq; const f32x4 v0 = acc[ai][bj][m][0], v1 = acc[ai][bj][m][1];
                    if (cb < 768) *(u32x4*)(Kb + row * 1152 + (c >> 6) * 96 + (c & 63)) = pack8(v0, v1, s);
                    else *(u32x4*)(Vb + row * 768 + (c - 768)) = pack8(v0, v1, s); }
                asm volatile("" ::: "memory"); }
    }
};
struct EpiOut {
    static constexpr bool PERM = true, AFTER_DRAIN = false;
    const float* R; float* X1; bf16_t* X1B; PG8_LAS float* rs;
    __device__ __forceinline__ void operator()(const f32x4 (&acc)[2][2][4][2], const Unit& u, int wr, int wc, int fr, int fq) const {
#pragma unroll
        for (int ai = 0; ai < 2; ++ai)
#pragma unroll
            for (int m = 0; m < 4; ++m) { int rl = ai * HALF + wr * 64 + m * 16 + fr; asm volatile("" : "+v"(rl)); const size_t row = (size_t)(u.pm * BM + rl); float ssum = 0.f;
#pragma unroll
                for (int bj = 0; bj < 2; ++bj) { const int c = u.pn * BM + bj * HALF + wc * 32 + 8 * fq;
                    const f32x4 x0 = *(const f32x4*)(R + row * 1024 + c) + acc[ai][bj][m][0], x1 = *(const f32x4*)(R + row * 1024 + c + 4) + acc[ai][bj][m][1];
                    *(f32x4*)(X1 + row * 1024 + c) = x0; *(f32x4*)(X1 + row * 1024 + c + 4) = x1;
                    if (X1B) *(u32x4*)(X1B + row * 1024 + c) = pack8(x0, x1, 1.f);
                    ssum += ss8(x0, x1); }
                ssum = quad_sum(ssum); if (fq == 0) rs[rl * 4 + wc] += ssum; }
    }
};
struct EpiIn1 {
    static constexpr bool PERM = true, AFTER_DRAIN = false;
    bf16_t *PQ, *QMEM, *SG; const float* RSTD;
    __device__ __forceinline__ void operator()(const f32x4 (&acc)[2][2][4][2], const Unit& u, int wr, int wc, int fr, int fq) const {
#pragma unroll
        for (int ai = 0; ai < 2; ++ai)
#pragma unroll
            for (int m = 0; m < 4; ++m) { int rowi = u.pm * BM + ai * HALF + wr * 64 + m * 16 + fr; asm volatile("" : "+v"(rowi)); const size_t row = (size_t)rowi; const float r = RSTD[row];
                const int b = rowi >> 12, sq = rowi & 4095, s1 = sq >> 6, s2 = sq & 63; const size_t prow = ((size_t)(b * 64 + s1) * 2) * 64 + s2;
#pragma unroll
                for (int bj = 0; bj < 2; ++bj) { const int cb = u.pn * BM + bj * HALF + wc * 32, c = cb + 8 * fq; const f32x4 v0 = acc[ai][bj][m][0], v1 = acc[ai][bj][m][1];
                    if (cb < 1536) { const int pq = cb >= 768 ? 1 : 0; *(u32x4*)(PQ + (prow + pq * 64) * 768 + (c - pq * 768)) = pack8(v0, v1, r); }
                    else if (cb < 1792) *(u32x4*)(QMEM + row * 256 + (c - 1536)) = pack8(v0, v1, r * QS_MEM);
                    else *(u32x4*)(SG + row * 1024 + (c - 1792)) = pack8(silu4(v0 * r), silu4(v1 * r), 1.f); } }
    }
};
struct PanelOrder {
    int nM, G, c;
    __device__ void init(int M, int G_, int c_) { nM = M / BM; G = G_; c = c_; }
    __device__ bool next(int i, Unit& u) const { u.pm = c + G * (i >> 2); u.pn = i & 3; return u.pm < nM; }
    __device__ __forceinline__ void a_ready(const Unit&) const {}
    __device__ __forceinline__ void done(const Unit&) const {}
};
template <class Epi, class Sched, bool ALIGN_EPI = false, bool SP2 = false>
__device__ __forceinline__ void gemm_phase(PG8_LAS unsigned char* lds, const Gemm g, const Sched& S, const Epi& E) {
    const int tid = threadIdx.x, wid = __builtin_amdgcn_readfirstlane(tid >> 6), lane = tid & 63, wr = wid >> 2, wc = wid & 3, fr = lane & 15, fq = lane >> 4;
    const int K = g.K, nt = K / BK;
    unsigned voffA[2], voffB[2];
#pragma unroll
    for (int i = 0; i < 2; ++i) { int R, C; stage_rc(tid * 16 + i * 8192, R, C); const int Rb = Epi::PERM ? ((R & ~31) + perm32(R & 31)) : R;
        voffA[i] = (unsigned)(R * K + C) * 2u; voffB[i] = (unsigned)(Rb * K + C) * 2u; }
    const size_t kstep = (size_t)(BK * 2);
    const size_t hstep = (size_t)HALF * K * 2;
    const size_t tstep = 2 * hstep;
    const unsigned ldsw = (unsigned)wid * 1024u;
    const int aoff = lds_byte(wr * 64 + fr, fq * 8), boff = lds_byte(wc * 32 + fr, fq * 8);
#define PG8_SA(b, h) (((b) * 2 + (h)) * HTB)
#define PG8_SB(b, h) ((4 + (b) * 2 + (h)) * HTB)
#define PG8_STAGE(bufoff, gbase, voff) do { _Pragma("unroll") for (int _i = 0; _i < 2; ++_i) \
        __builtin_amdgcn_global_load_lds((const unsigned*)((const char*)(gbase) + (voff)[_i]), (PG8_LAS unsigned*)(lds + (bufoff) + ldsw + _i * 8192), 16, 0, 0); } while (0)
#define PG8_LDA(dst, b, h) do { _Pragma("unroll") for (int m = 0; m < 4; ++m) _Pragma("unroll") for (int k = 0; k < 2; ++k) dst[m][k] = *(const PG8_LAS bf16x8*)(lds + PG8_SA(b, h) + aoff + m * 2048 + k * 1024); } while (0)
#define PG8_LDB(dst, b, h) do { _Pragma("unroll") for (int n = 0; n < 2; ++n) _Pragma("unroll") for (int k = 0; k < 2; ++k) dst[n][k] = *(const PG8_LAS bf16x8*)(lds + PG8_SB(b, h) + boff + n * 2048 + k * 1024); } while (0)
#define PG8_MMA(ai, bj, At, Bt) do { __builtin_amdgcn_s_setprio(1); _Pragma("unroll") for (int m = 0; m < 4; ++m) _Pragma("unroll") for (int n = 0; n < 2; ++n) _Pragma("unroll") for (int k = 0; k < 2; ++k) \
        acc[ai][bj][m][n] = __builtin_amdgcn_mfma_f32_16x16x32_bf16(Bt[n][k], At[m][k], acc[ai][bj][m][n], 0, 0, 0); __builtin_amdgcn_s_setprio(0); } while (0)
#define PG8_WAIT_V(n) asm volatile("s_waitcnt vmcnt(" #n ")" ::: "memory")
#define PG8_WAIT_L(n) asm volatile("s_waitcnt lgkmcnt(" #n ")" ::: "memory")
#define PG8_BAR __builtin_amdgcn_s_barrier()
#define PG8_SCHED __builtin_amdgcn_sched_barrier(0)
    Unit cur, nxt; int ui = 0;
    if (!S.next(0, cur)) return;
    f32x4 acc[2][2][4][2];
#pragma unroll
    for (int a = 0; a < 2; ++a)
#pragma unroll
        for (int b = 0; b < 2; ++b)
#pragma unroll
            for (int m = 0; m < 4; ++m)
#pragma unroll
                for (int n = 0; n < 2; ++n) acc[a][b][m][n] = (f32x4){0.f, 0.f, 0.f, 0.f};
    bf16x8 At[4][2], B0[2][2], B1[2][2];
    const char* cA = (const char*)g.A + (size_t)cur.pm * tstep; const char* cB = (const char*)g.Bt + (size_t)cur.pn * tstep;
    S.a_ready(cur);
    if constexpr (SP2) {
        PG8_STAGE(PG8_SB(0, 0), cB, voffB); PG8_STAGE(PG8_SB(0, 1), cB + hstep, voffB); PG8_STAGE(PG8_SA(0, 0), cA, voffA); PG8_STAGE(PG8_SA(0, 1), cA + hstep, voffA);
        if (wr == 1) PG8_BAR;
        PG8_WAIT_V(2); PG8_BAR;
        PG8_STAGE(PG8_SB(1, 0), cB + kstep, voffB); PG8_STAGE(PG8_SA(1, 0), cA + kstep, voffA); PG8_STAGE(PG8_SB(1, 1), cB + hstep + kstep, voffB);
        PG8_WAIT_V(6); PG8_BAR;
    } else {
        PG8_STAGE(PG8_SB(0, 0), cB, voffB); PG8_STAGE(PG8_SA(0, 0), cA, voffA); PG8_STAGE(PG8_SB(0, 1), cB + hstep, voffB); PG8_STAGE(PG8_SA(0, 1), cA + hstep, voffA);
        if (wr == 1) PG8_BAR;
        PG8_WAIT_V(4); PG8_BAR;
        PG8_STAGE(PG8_SB(1, 0), cB + kstep, voffB); PG8_STAGE(PG8_SA(1, 0), cA + kstep, voffA); PG8_STAGE(PG8_SB(1, 1), cB + hstep + kstep, voffB);
        PG8_WAIT_V(6); PG8_BAR;
    }
    for (;;) {
        const bool has_next = S.next(ui + 1, nxt);
        const char* nA = has_next ? (const char*)g.A + (size_t)nxt.pm * tstep : cA; const char* nB = has_next ? (const char*)g.Bt + (size_t)nxt.pn * tstep : cB;
        for (int t = 0; t < nt; t += 2) {
            const bool last = (t == nt - 2);
            const char* a1 = cA + (size_t)(t + 1) * kstep;
            const char* a2 = last ? nA : cA + (size_t)(t + 2) * kstep; const char* b2 = last ? nB : cB + (size_t)(t + 2) * kstep;
            const char* a3 = a2 + kstep; const char* b3 = b2 + kstep;
            if (last && has_next) S.a_ready(nxt);
            if constexpr (SP2) {
            PG8_LDB(B0, 0, 0); PG8_LDB(B1, 0, 1); PG8_SCHED; PG8_LDA(At, 0, 0); PG8_STAGE(PG8_SA(1, 1), a1 + hstep, voffA);
            PG8_WAIT_V(8); PG8_WAIT_L(0); PG8_BAR; PG8_MMA(0, 0, At, B0); PG8_MMA(0, 1, At, B1); PG8_BAR; PG8_SCHED;
            PG8_LDA(At, 0, 1); PG8_STAGE(PG8_SB(0, 0), b2, voffB); PG8_STAGE(PG8_SB(0, 1), b2 + hstep, voffB); PG8_STAGE(PG8_SA(0, 0), a2, voffA);
            PG8_WAIT_V(8); PG8_WAIT_L(0); PG8_BAR; PG8_MMA(1, 0, At, B0); PG8_MMA(1, 1, At, B1); PG8_BAR; PG8_SCHED;
            PG8_LDB(B0, 1, 0); PG8_LDB(B1, 1, 1); PG8_SCHED; PG8_LDA(At, 1, 0); PG8_STAGE(PG8_SA(0, 1), a2 + hstep, voffA);
            PG8_WAIT_V(8); PG8_WAIT_L(0); PG8_BAR; PG8_MMA(0, 0, At, B0); PG8_MMA(0, 1, At, B1); PG8_BAR; PG8_SCHED;
            PG8_LDA(At, 1, 1); PG8_STAGE(PG8_SB(1, 0), b3, voffB); PG8_STAGE(PG8_SB(1, 1), b3 + hstep, voffB); PG8_STAGE(PG8_SA(1, 0), a3, voffA);
            PG8_WAIT_V(8); PG8_WAIT_L(0); PG8_BAR; PG8_MMA(1, 0, At, B0); PG8_MMA(1, 1, At, B1); PG8_BAR; PG8_SCHED;
            } else {
            PG8_LDB(B0, 0, 0); PG8_SCHED; PG8_LDA(At, 0, 0); PG8_STAGE(PG8_SA(1, 1), a1 + hstep, voffA);
            PG8_WAIT_L(8); PG8_BAR; PG8_WAIT_L(0); PG8_MMA(0, 0, At, B0); PG8_BAR; PG8_SCHED;
            PG8_LDB(B1, 0, 1); PG8_STAGE(PG8_SB(0, 0), b2, voffB);
            PG8_BAR; PG8_WAIT_L(0); PG8_MMA(0, 1, At, B1); PG8_BAR;
            PG8_LDA(At, 0, 1); PG8_STAGE(PG8_SA(0, 0), a2, voffA);
            PG8_BAR; PG8_WAIT_L(0); PG8_MMA(1, 0, At, B0); PG8_BAR; PG8_SCHED;
            PG8_STAGE(PG8_SB(0, 1), b2 + hstep, voffB);
            PG8_WAIT_V(6); PG8_BAR; PG8_MMA(1, 1, At, B1); PG8_BAR;
            PG8_LDB(B0, 1, 0); PG8_SCHED; PG8_LDA(At, 1, 0); PG8_STAGE(PG8_SA(0, 1), a2 + hstep, voffA);
            PG8_WAIT_L(8); PG8_BAR; PG8_WAIT_L(0); PG8_MMA(0, 0, At, B0); PG8_BAR; PG8_SCHED;
            PG8_LDB(B1, 1, 1); PG8_STAGE(PG8_SB(1, 0), b3, voffB);
            PG8_BAR; PG8_WAIT_L(0); PG8_MMA(0, 1, At, B1); PG8_BAR;
            PG8_LDA(At, 1, 1); PG8_STAGE(PG8_SA(1, 0), a3, voffA);
            PG8_BAR; PG8_WAIT_L(0); PG8_MMA(1, 0, At, B0); PG8_BAR; PG8_SCHED;
            PG8_STAGE(PG8_SB(1, 1), b3 + hstep, voffB);
            PG8_WAIT_V(6); PG8_BAR; PG8_MMA(1, 1, At, B1); PG8_BAR;
            }
        }
        if constexpr (ALIGN_EPI) { if (wr == 0) PG8_BAR; }
        if constexpr (!Epi::AFTER_DRAIN) { E(acc, cur, wr, wc, fr, fq); S.done(cur); }
        if (!has_next) break;
#pragma unroll
        for (int a = 0; a < 2; ++a)
#pragma unroll
            for (int b = 0; b < 2; ++b)
#pragma unroll
                for (int m = 0; m < 4; ++m)
#pragma unroll
                    for (int n = 0; n < 2; ++n) acc[a][b][m][n] = (f32x4){0.f, 0.f, 0.f, 0.f};
        cur = nxt; cA = nA; cB = nB; ++ui;
        if constexpr (ALIGN_EPI) { if (wr == 1) PG8_BAR; }
    }
    PG8_WAIT_V(0);
    if constexpr (!ALIGN_EPI) { if (wr == 0) PG8_BAR; }
    PG8_BAR;
    if constexpr (Epi::AFTER_DRAIN) { E.fused(acc, cur, wr, wc, fr, fq, lds, wid, lane); S.done(cur); }
#undef PG8_SA
#undef PG8_SB
#undef PG8_STAGE
#undef PG8_LDA
#undef PG8_LDB
#undef PG8_MMA
#undef PG8_WAIT_V
#undef PG8_WAIT_L
#undef PG8_BAR
#undef PG8_SCHED
}
}
#define GAS __attribute__((address_space(1)))
#define LAS __attribute__((address_space(3)))
typedef unsigned short bf16;
typedef unsigned v4u __attribute__((ext_vector_type(4)));
typedef float f32x4 __attribute__((ext_vector_type(4)));
typedef short bf16x8 __attribute__((ext_vector_type(8)));
typedef GAS unsigned gu32;
typedef GAS unsigned long long gu64;
#define RLX_AGENT __ATOMIC_RELAXED, __HIP_MEMORY_SCOPE_AGENT
#define LDS_WAIT() asm volatile("s_waitcnt lgkmcnt(0)" ::: "memory")
#define VM_WAIT() asm volatile("s_waitcnt vmcnt(0)" ::: "memory")
__device__ __forceinline__ unsigned long long rt() { return __builtin_amdgcn_s_memrealtime(); }
#define XB_TMO      128
#define XB_XCNT(j)  (256  + 64 * (j))
#define XB_XSUB(j)  (1280 + 64 * (j))
#define XB_XGEN(j)  (2304 + 64 * (j))
#define XB_TOP      3328
#define XB_TOPGEN   3392
#define XCD_BAR_WORDS 3456
#define XB_SPIN_CAP (1u << 18)

__device__ __forceinline__ unsigned xb_ld(unsigned* p)              { return __hip_atomic_load(p, __ATOMIC_RELAXED, __HIP_MEMORY_SCOPE_AGENT); }
__device__ __forceinline__ unsigned xb_add(unsigned* p, unsigned v) { return __hip_atomic_fetch_add(p, v, __ATOMIC_RELAXED, __HIP_MEMORY_SCOPE_AGENT); }
__device__ __forceinline__ unsigned xb_xcc_id() { return (unsigned)__builtin_amdgcn_s_getreg((3 << 11) | 20) & 0xFu; }
#define XB_SPIN(cond, bar) do { unsigned _sp = 0; while (cond) { __builtin_amdgcn_s_sleep(1); \
    if ((++_sp & 255u) == 0u) { if (xb_ld(&(bar)[XB_TMO])) break; if (_sp > XB_SPIN_CAP) { atomicAdd(&(bar)[XB_TMO], 1u); break; } } } } while (0)

struct XcdBarrier {
    unsigned* bar; unsigned x;
    volatile LAS unsigned* st;
};

__device__ __forceinline__ XcdBarrier xcd_barrier_post(unsigned* bar, volatile LAS unsigned* st) {
    XcdBarrier b; b.bar = bar; b.x = xb_xcc_id(); b.st = st;
    if (threadIdx.x == 0) (void)xb_add(&bar[XB_XCNT(b.x)], 1u);
    return b;
}
__device__ __forceinline__ void xcd_barrier_complete(unsigned* bar, unsigned x, unsigned& nloc, unsigned& nx) {
    const unsigned G = gridDim.x * gridDim.y * gridDim.z;
    unsigned sum, cnt, mine, sp = 0u;
    for (;;) {
        sum = 0u; cnt = 0u; mine = 0u;
#pragma unroll
        for (unsigned j = 0; j < 16; ++j) { const unsigned c = xb_ld(&bar[XB_XCNT(j)]); sum += c; cnt += (c > 0u) ? 1u : 0u; mine = (j == x) ? c : mine; }
        if (sum == G) break;
        __builtin_amdgcn_s_sleep(1);
        if ((++sp & 255u) == 0u) { if (xb_ld(&bar[XB_TMO])) break; if (sp > XB_SPIN_CAP) { atomicAdd(&bar[XB_TMO], 1u); break; } }
    }
    nloc = mine > 0u ? mine : 1u; nx = cnt > 0u ? cnt : 1u;
}

__device__ __forceinline__ void xcd_barrier(const XcdBarrier& b) {
    asm volatile("s_waitcnt vmcnt(0)" ::: "memory");
    __syncthreads();
    if (threadIdx.x == 0) {
        unsigned* bar = b.bar;
        __builtin_amdgcn_s_waitcnt(0);
        unsigned nloc = b.st[0], nx = b.st[1];
        if (nloc == 0u) { xcd_barrier_complete(bar, b.x, nloc, nx); b.st[0] = nloc; b.st[1] = nx; }
        const unsigned old = xb_add(&bar[XB_XSUB(b.x)], 1u);
        const unsigned gen = old / nloc;
        if (old + 1u == (gen + 1u) * nloc) {
            __builtin_amdgcn_fence(__ATOMIC_RELEASE, "agent");
            asm volatile("s_waitcnt vmcnt(0)" ::: "memory");
            const unsigned og = xb_add(&bar[XB_TOP], 1u);
            const unsigned tg = og / nx;
            if (og + 1u == (tg + 1u) * nx) xb_add(&bar[XB_TOPGEN], 1u);
            else XB_SPIN(xb_ld(&bar[XB_TOPGEN]) == tg, bar);
            __builtin_amdgcn_fence(__ATOMIC_ACQUIRE, "agent");
            xb_add(&bar[XB_XGEN(b.x)], 1u);
            asm volatile("s_waitcnt vmcnt(0)" ::: "memory");
        } else {
            XB_SPIN(xb_ld(&bar[XB_XGEN(b.x)]) == gen, bar);
            __builtin_amdgcn_fence(__ATOMIC_ACQUIRE, "agent");
            asm volatile("s_waitcnt vmcnt(0)" ::: "memory");
        }
    }
    __syncthreads();
}
namespace att {
using bf16x8 = __attribute__((ext_vector_type(8))) short;
using s16x4  = __attribute__((ext_vector_type(4))) short;
using f32x16 = __attribute__((ext_vector_type(16))) float;
using f32x4v = __attribute__((ext_vector_type(4))) float;
using u32x4  = __attribute__((ext_vector_type(4))) unsigned;
constexpr int NW = 8, QBLK = 32, KVBLK = 64;
constexpr float THRL = 6.f;
#define ASBAR() __builtin_amdgcn_sched_barrier(0)
__device__ __forceinline__ int crow(int r, int hi) { return (r & 3) + 8 * (r >> 2) + 4 * hi; }
__device__ __forceinline__ unsigned cvtpk(float lo, float hi) { unsigned r; asm volatile("v_cvt_pk_bf16_f32 %0, %1, %2" : "=v"(r) : "v"(lo), "v"(hi)); return r; }
template <int DQK> struct Cfg {
    static constexpr int KROW = DQK * 2 + 16;
    static constexpr int SHM_V = 8192, SHM_K = 64 * KROW;
    static constexpr int OFF_V = 0, OFF_K = 2 * SHM_V, OFF_WS = OFF_K + 2 * SHM_K, OFF_OST = OFF_WS + NW * 256, OSTW = 32 * 68 * 4, END = OFF_OST + NW * OSTW;
    static constexpr int KCH = DQK / 8;
};
__device__ __forceinline__ void partialSM(f32x16& p0, f32x16& p1, float& m_reg, float& mn, float& alpha) {
    float pmax = p0[0];
#pragma unroll
    for (int r = 1; r < 16; ++r) pmax = fmaxf(pmax, p0[r]);
#pragma unroll
    for (int r = 0; r < 16; ++r) pmax = fmaxf(pmax, p1[r]);
    { auto rr = __builtin_amdgcn_permlane32_swap(__float_as_uint(pmax), __float_as_uint(pmax), false, false); pmax = fmaxf(__uint_as_float(rr[0]), __uint_as_float(rr[1])); }
    if (__builtin_expect(__all(pmax - m_reg <= THRL), 1)) { mn = m_reg; alpha = 1.f; }
    else { mn = fmaxf(m_reg, pmax); alpha = __builtin_amdgcn_exp2f(m_reg - mn); m_reg = mn; }
#pragma unroll
    for (int r = 0; r < 16; ++r) p0[r] -= mn;
#pragma unroll
    for (int r = 0; r < 16; ++r) p1[r] -= mn;
#pragma unroll
    for (int r = 0; r < 16; ++r) p0[r] = __builtin_amdgcn_exp2f(p0[r]);
}
__device__ __forceinline__ void finishSM(f32x16& p0, f32x16& p1, float alpha, float& l_reg, bf16x8& pa0, bf16x8& pa1, bf16x8& pa2, bf16x8& pa3) {
#pragma unroll
    for (int r = 0; r < 16; ++r) p1[r] = __builtin_amdgcn_exp2f(p1[r]);
    float ps = 0;
#pragma unroll
    for (int r = 0; r < 16; ++r) ps += p0[r];
#pragma unroll
    for (int r = 0; r < 16; ++r) ps += p1[r];
    { auto rr = __builtin_amdgcn_permlane32_swap(__float_as_uint(ps), __float_as_uint(ps), false, false); ps = __uint_as_float(rr[0]) + __uint_as_float(rr[1]); }
    l_reg = l_reg * alpha + ps;
#define ATT_PK4(P, BASE, OUT) do { unsigned a0 = cvtpk(P[BASE + 0], P[BASE + 1]), a1 = cvtpk(P[BASE + 2], P[BASE + 3]);   \
    unsigned b0 = cvtpk(P[BASE + 4], P[BASE + 5]), b1 = cvtpk(P[BASE + 6], P[BASE + 7]);                              \
    auto r0 = __builtin_amdgcn_permlane32_swap(a0, b0, false, false); auto r1 = __builtin_amdgcn_permlane32_swap(a1, b1, false, false); \
    u32x4 w = {r0[0], r1[0], r0[1], r1[1]}; OUT = *reinterpret_cast<bf16x8*>(&w); } while (0)
    ATT_PK4(p0, 0, pa0); ATT_PK4(p0, 8, pa1); ATT_PK4(p1, 0, pa2); ATT_PK4(p1, 8, pa3);
#undef ATT_PK4
}
template <int DQK> __device__ __forceinline__ void qkt(f32x16& p0, f32x16& p1, const char* Ks, const bf16x8* qr, int r32, int hi) {
    constexpr int KROW = Cfg<DQK>::KROW;
    p0 = f32x16{}; p1 = f32x16{};
#pragma unroll
    for (int d0 = 0; d0 < DQK / 16; ++d0) { const int cb = (d0 * 16 + hi * 8) * 2;
        const bf16x8 b0 = *reinterpret_cast<const bf16x8*>(Ks + r32 * KROW + cb);
        const bf16x8 b1 = *reinterpret_cast<const bf16x8*>(Ks + (32 + r32) * KROW + cb);
        p0 = __builtin_amdgcn_mfma_f32_32x32x16_bf16(b0, qr[d0], p0, 0, 0, 0);
        p1 = __builtin_amdgcn_mfma_f32_32x32x16_bf16(b1, qr[d0], p1, 0, 0, 0); }
}
__device__ __forceinline__ int v_st(int k, int c) { const int kk = (k & ~0xC) | ((k & 4) << 1) | ((k & 8) >> 1); return ((kk >> 3) * 2 + (c >> 5)) * 512 + ((kk & 7) * 32 + (c & 31)) * 2; }
__device__ __forceinline__ int v_rd_base(int lane) { return ((lane & 3) << 3) | (((lane >> 2) & 3) << 6) | (((lane >> 4) & 1) << 5) | (((lane >> 5) & 1) << 8); }
constexpr int v_rd_off(int d0, int ks, int half) { return d0 * 512 + ks * 2048 + half * 1024; }
template <int OFF> __device__ __forceinline__ s16x4 tr_read(int vb) { s16x4 r; asm volatile("ds_read_b64_tr_b16 %0, %1 offset:%2" : "=&v"(r) : "v"(vb), "i"(OFF) : "memory"); return r; }
template <int D0> __device__ __forceinline__ void pv_one(f32x16& od, int vb, bf16x8 pa0, bf16x8 pa1, bf16x8 pa2, bf16x8 pa3) {
    const s16x4 l0 = tr_read<v_rd_off(D0, 0, 0)>(vb), h0 = tr_read<v_rd_off(D0, 0, 1)>(vb), l1 = tr_read<v_rd_off(D0, 1, 0)>(vb), h1 = tr_read<v_rd_off(D0, 1, 1)>(vb);
    const s16x4 l2 = tr_read<v_rd_off(D0, 2, 0)>(vb), h2 = tr_read<v_rd_off(D0, 2, 1)>(vb), l3 = tr_read<v_rd_off(D0, 3, 0)>(vb), h3 = tr_read<v_rd_off(D0, 3, 1)>(vb);
    asm volatile("s_waitcnt lgkmcnt(0)" ::: "memory"); ASBAR();
#define ATT_PK(L, H) (bf16x8){L[0], L[1], L[2], L[3], H[0], H[1], H[2], H[3]}
    od = __builtin_amdgcn_mfma_f32_32x32x16_bf16(pa0, ATT_PK(l0, h0), od, 0, 0, 0);
    od = __builtin_amdgcn_mfma_f32_32x32x16_bf16(pa1, ATT_PK(l1, h1), od, 0, 0, 0);
    od = __builtin_amdgcn_mfma_f32_32x32x16_bf16(pa2, ATT_PK(l2, h2), od, 0, 0, 0);
    od = __builtin_amdgcn_mfma_f32_32x32x16_bf16(pa3, ATT_PK(l3, h3), od, 0, 0, 0);
#undef ATT_PK
}
__device__ __forceinline__ void pv_d0(f32x16* o, int vb, bf16x8 pa0, bf16x8 pa1, bf16x8 pa2, bf16x8 pa3) { pv_one<0>(o[0], vb, pa0, pa1, pa2, pa3); pv_one<1>(o[1], vb, pa0, pa1, pa2, pa3); }

template <int DQK>
__device__ __forceinline__ void attn_unit(const bf16_t* __restrict__ Qb, int ldq, const bf16_t* __restrict__ Kh, int ldk, const bf16_t* __restrict__ Vh, int ldv, int seq,
                                          bf16_t* __restrict__ Ob, const bf16_t* __restrict__ Gb, char* lds) {
    using C = Cfg<DQK>;
    constexpr int KROW = C::KROW, KCH = C::KCH, SHM_V = C::SHM_V, SHM_K = C::SHM_K;
    const int tid = threadIdx.x, wid = tid >> 6, lane = tid & 63, r32 = lane & 31, hi = lane >> 5;
    char* V_lds = lds + C::OFF_V; char* K_lds = lds + C::OFF_K;
    float* ws = (float*)(lds + C::OFF_WS) + wid * 64; float* li_l = ws; float* al_l = ws + 32;
    float m_reg = -1e30f, l_reg = 0; f32x16 o[2] = {}; bf16x8 qr[DQK / 16];
    const bf16_t* Qw = Qb + (size_t)(wid * QBLK + r32) * ldq + hi * 8;
#pragma unroll
    for (int d0 = 0; d0 < DQK / 16; ++d0) qr[d0] = *reinterpret_cast<const bf16x8*>(Qw + d0 * 16);
    const int vk = tid >> 3, vc = (tid & 7) * 8, vst = v_st(vk, vc);
    const int kr0 = tid / KCH, kc0 = (tid % KCH) * 8, kr1 = (512 + tid) / KCH, kc1 = ((512 + tid) % KCH) * 8;
    const bool two = (KCH * 64 > 512) && (tid < KCH * 64 - 512);
    const int vb0 = (int)(uintptr_t)V_lds + v_rd_base(lane);
    struct { bf16x8 vs, ks0, ks1; } sr_[2];
#define ATT_SLOAD(i, k0) do { sr_[i].vs = *reinterpret_cast<const bf16x8*>(Vh + (size_t)((k0) + vk) * ldv + vc); \
    sr_[i].ks0 = *reinterpret_cast<const bf16x8*>(Kh + (size_t)((k0) + kr0) * ldk + kc0); \
    if (two) sr_[i].ks1 = *reinterpret_cast<const bf16x8*>(Kh + (size_t)((k0) + kr1) * ldk + kc1); } while (0)
#define ATT_SWRITE(b, i) do { *(bf16x8*)(V_lds + (b) * SHM_V + vst) = sr_[i].vs; *(bf16x8*)(K_lds + (b) * SHM_K + kr0 * KROW + kc0 * 2) = sr_[i].ks0; \
    if (two) *(bf16x8*)(K_lds + (b) * SHM_K + kr1 * KROW + kc1 * 2) = sr_[i].ks1; } while (0)
#define ATT_SWAIT() asm volatile("s_waitcnt vmcnt(3)" ::: "memory")
#define ATT_RESC(a) do { if (__any((a) < 1.f)) { if (hi == 0) al_l[r32] = (a); asm volatile("s_waitcnt lgkmcnt(0)" ::: "memory"); \
    _Pragma("unroll") for (int d = 0; d < 2; ++d) _Pragma("unroll") for (int r = 0; r < 16; ++r) o[d][r] *= al_l[crow(r, hi)]; } } while (0)
    f32x16 pA0, pA1, pB0, pB1; float mnA, mnB, alA, alB; bf16x8 pa0, pa1, pa2, pa3; const int NT = seq / KVBLK;
    constexpr int SE = 0, SO = 1;
    ATT_SLOAD(SE, 0); asm volatile("s_waitcnt vmcnt(0)" ::: "memory"); ATT_SWRITE(0, SE); __syncthreads();
    qkt<DQK>(pA0, pA1, K_lds, qr, r32, hi); partialSM(pA0, pA1, m_reg, mnA, alA);
    ATT_SLOAD(SO, KVBLK); if (2 < NT) ATT_SLOAD(SE, 2 * KVBLK);
    ATT_SWAIT(); ATT_SWRITE(1, SO); __syncthreads();
    for (int j = 1; j + 1 < NT; j += 2) {
        ASBAR(); qkt<DQK>(pB0, pB1, K_lds + SHM_K, qr, r32, hi);
        finishSM(pA0, pA1, alA, l_reg, pa0, pa1, pa2, pa3); ASBAR();
        ATT_SLOAD(SO, (j + 2) * KVBLK); ASBAR();
        pv_d0(o, vb0, pa0, pa1, pa2, pa3); partialSM(pB0, pB1, m_reg, mnB, alB);
        __syncthreads(); ATT_SWAIT(); ATT_SWRITE(0, SE);
        ATT_RESC(alB); __syncthreads();
        ASBAR(); qkt<DQK>(pA0, pA1, K_lds, qr, r32, hi);
        finishSM(pB0, pB1, alB, l_reg, pa0, pa1, pa2, pa3); ASBAR();
        if (j + 3 < NT) ATT_SLOAD(SE, (j + 3) * KVBLK); ASBAR();
        pv_d0(o, vb0 + SHM_V, pa0, pa1, pa2, pa3); partialSM(pA0, pA1, m_reg, mnA, alA);
        __syncthreads(); ATT_SWAIT(); ATT_SWRITE(1, SO);
        ATT_RESC(alA); __syncthreads();
    }
    ASBAR(); qkt<DQK>(pB0, pB1, K_lds + SHM_K, qr, r32, hi);
    finishSM(pA0, pA1, alA, l_reg, pa0, pa1, pa2, pa3); ASBAR();
    pv_d0(o, vb0, pa0, pa1, pa2, pa3); partialSM(pB0, pB1, m_reg, mnB, alB);
    __syncthreads(); ATT_RESC(alB);
    finishSM(pB0, pB1, alB, l_reg, pa0, pa1, pa2, pa3); ASBAR();
    pv_d0(o, vb0 + SHM_V, pa0, pa1, pa2, pa3);
    if (hi == 0) li_l[r32] = l_reg; asm volatile("s_waitcnt lgkmcnt(0)" ::: "memory");
    float* stg = (float*)(lds + C::OFF_OST + wid * C::OSTW);
#pragma unroll
    for (int r = 0; r < 16; ++r) { const int orow = crow(r, hi); const float rli = __builtin_amdgcn_rcpf(li_l[orow]);
        stg[orow * 68 + r32] = o[0][r] * rli; stg[orow * 68 + 32 + r32] = o[1][r] * rli; }
    asm volatile("s_waitcnt lgkmcnt(0)" ::: "memory");
#pragma unroll
    for (int i = 0; i < 4; ++i) { const int row = i * 8 + (lane >> 3), ch = (lane & 7) * 8;
        const f32x4v a = *(const f32x4v*)(stg + row * 68 + ch), b = *(const f32x4v*)(stg + row * 68 + ch + 4);
        const size_t off = (size_t)(wid * QBLK + row) * 1024 + ch; const u32x4 g = *(const u32x4*)(Gb + off); u32x4 w;
        w.x = cvtpk(a[0] * __uint_as_float(g.x << 16), a[1] * __uint_as_float(g.x & 0xffff0000u)); w.y = cvtpk(a[2] * __uint_as_float(g.y << 16), a[3] * __uint_as_float(g.y & 0xffff0000u));
        w.z = cvtpk(b[0] * __uint_as_float(g.z << 16), b[1] * __uint_as_float(g.z & 0xffff0000u)); w.w = cvtpk(b[2] * __uint_as_float(g.w << 16), b[3] * __uint_as_float(g.w & 0xffff0000u));
        *(u32x4*)(Ob + off) = w; }
    __syncthreads();
#undef ATT_SLOAD
#undef ATT_SWRITE
#undef ATT_SWAIT
#undef ATT_RESC
}
#undef ASBAR
}
constexpr int NWAVES = 8;
#ifndef MK_N_LAUNCHES
#define MK_N_LAUNCHES 1
#endif
constexpr int N_PHASES = 9;
constexpr int N_LAUNCHES = MK_N_LAUNCHES;
constexpr int CW_BAR = 4096;
constexpr int RING_OFF = 0, RING_BYTES = 131072;
constexpr int LDSCTL_OFF = RING_BYTES, MISC_OFF = LDSCTL_OFF + 320, RS_OFF = LDSCTL_OFF + 1024  ;
constexpr int LDS_BYTES = 147456;
static_assert(RS_OFF + 4096 <= LDS_BYTES, "LDS map");

struct Args { const void* in[19]; float* out; unsigned char* ws; int ph_lo, ph_hi, li, pad; };

__device__ __forceinline__ void prep_w_job(const float* __restrict__ W, int ldw, int K, bf16_t* __restrict__ out, int n0, int nrows, const float* __restrict__ scale, int mode, int off, int gt, int GT) {
    const int total = nrows * (K >> 3);
    for (int idx = gt; idx < total; idx += GT) {
        const int n = idx % nrows, k8 = idx / nrows; const int sc = src_col(mode, n, off);
        float v[8];
#pragma unroll
        for (int i = 0; i < 8; ++i) { const int k = k8 * 8 + i; float w = (sc >= 0) ? W[(size_t)k * ldw + sc] : 0.f; if (scale) w *= scale[k]; v[i] = w; }
        uint4 o; o.x = pk2(v[0], v[1]); o.y = pk2(v[2], v[3]); o.z = pk2(v[4], v[5]); o.w = pk2(v[6], v[7]);
        *(uint4*)(out + (size_t)(n0 + n) * K + k8 * 8) = o;
    }
}
__device__ __forceinline__ void rmsnorm_row(const float* __restrict__ xrow, const float* __restrict__ g, bf16_t* __restrict__ orow, int lane) {
    const float4* xr = (const float4*)xrow + lane; float4 v[4]; float s = 0.f;
#pragma unroll
    for (int j = 0; j < 4; ++j) { v[j] = xr[64 * j]; s += v[j].x * v[j].x + v[j].y * v[j].y + v[j].z * v[j].z + v[j].w * v[j].w; }
    const float rstd = rsqrtf(wave_sum(s) * (1.f / DM) + EPS);
    uint2* o = (uint2*)orow + lane;
#pragma unroll
    for (int j = 0; j < 4; ++j) { const float4 gv = g ? ((const float4*)g)[lane + 64 * j] : make_float4(1.f, 1.f, 1.f, 1.f);
        uint2 w; w.x = pk2(v[j].x * rstd * gv.x, v[j].y * rstd * gv.y); w.y = pk2(v[j].z * rstd * gv.z, v[j].w * rstd * gv.w); o[64 * j] = w; }
}

template <int DQK>
__device__ __forceinline__ void attn_naive_vb(float* Ks, float* Vs, int t256, const bf16_t* __restrict__ Q, int ldq, int qhs, const bf16_t* __restrict__ Kp, int ldk, int khs, const bf16_t* __restrict__ Vp, int ldv, int vhs,
                                              int nkeys, bf16_t* __restrict__ O, const bf16_t* __restrict__ G, int ocol0, int qblk, int h, int b) {
    constexpr int KT = 8;
    const size_t t = (size_t)b * SEQ + qblk * 256 + t256;
    unsigned qp2[DQK / 2]; float o[64], m = -1e30f, l = 0.f;
    { const bf16_t* qp = Q + t * ldq + h * qhs;
#pragma unroll
      for (int d = 0; d < DQK; d += 8) { const uint4 v = *(const uint4*)(qp + d); qp2[d / 2] = v.x; qp2[d / 2 + 1] = v.y; qp2[d / 2 + 2] = v.z; qp2[d / 2 + 3] = v.w; } }
#pragma unroll
    for (int d = 0; d < 64; ++d) o[d] = 0.f;
    const bf16_t* Kb = Kp + (size_t)b * nkeys * ldk + h * khs; const bf16_t* Vb = Vp + (size_t)b * nkeys * ldv + h * vhs;
    for (int k0 = 0; k0 < nkeys; k0 += KT) {
        __syncthreads();
        if (t256 < KT * DQK / 8) { const int j = t256 / (DQK / 8), d = (t256 % (DQK / 8)) * 8; const uint4 v = *(const uint4*)(Kb + (size_t)(k0 + j) * ldk + d);
            float* p = Ks + j * DQK + d; p[0] = __uint_as_float(v.x << 16); p[1] = __uint_as_float(v.x & 0xffff0000u); p[2] = __uint_as_float(v.y << 16); p[3] = __uint_as_float(v.y & 0xffff0000u);
            p[4] = __uint_as_float(v.z << 16); p[5] = __uint_as_float(v.z & 0xffff0000u); p[6] = __uint_as_float(v.w << 16); p[7] = __uint_as_float(v.w & 0xffff0000u); }
        if (t256 >= 128 && t256 < 128 + KT * 8) { const int tt = t256 - 128, j = tt >> 3, d = (tt & 7) * 8; const uint4 v = *(const uint4*)(Vb + (size_t)(k0 + j) * ldv + d);
            float* p = Vs + j * 64 + d; p[0] = __uint_as_float(v.x << 16); p[1] = __uint_as_float(v.x & 0xffff0000u); p[2] = __uint_as_float(v.y << 16); p[3] = __uint_as_float(v.y & 0xffff0000u);
            p[4] = __uint_as_float(v.z << 16); p[5] = __uint_as_float(v.z & 0xffff0000u); p[6] = __uint_as_float(v.w << 16); p[7] = __uint_as_float(v.w & 0xffff0000u); }
        __syncthreads();
#pragma unroll 1
        for (int j = 0; j < KT; ++j) { float s = 0.f; const float4* kr = (const float4*)(Ks + j * DQK);
#pragma unroll
            for (int d = 0; d < DQK / 4; ++d) { const float4 kv = kr[d]; const unsigned a = qp2[2 * d], c = qp2[2 * d + 1];
                s += __uint_as_float(a << 16) * kv.x + __uint_as_float(a & 0xffff0000u) * kv.y + __uint_as_float(c << 16) * kv.z + __uint_as_float(c & 0xffff0000u) * kv.w; }
            if (s > m) { const float alpha = __builtin_amdgcn_exp2f(m - s); m = s; l *= alpha;
#pragma unroll
                for (int d = 0; d < 64; ++d) o[d] *= alpha; }
            const float p = __builtin_amdgcn_exp2f(s - m); l += p; const float4* vr = (const float4*)(Vs + j * 64);
#pragma unroll
            for (int d = 0; d < 16; ++d) { const float4 vv = vr[d]; o[4 * d] += p * vv.x; o[4 * d + 1] += p * vv.y; o[4 * d + 2] += p * vv.z; o[4 * d + 3] += p * vv.w; } }
    }
    const float rl = 1.f / l;
    const bf16_t* gp = G + t * 1024 + ocol0 + h * 64; bf16_t* op = O + t * 1024 + ocol0 + h * 64;
#pragma unroll
    for (int d = 0; d < 64; d += 8) { const uint4 gv = *(const uint4*)(gp + d); uint4 w;
        w.x = pk2(o[d] * rl * __uint_as_float(gv.x << 16), o[d + 1] * rl * __uint_as_float(gv.x & 0xffff0000u));
        w.y = pk2(o[d + 2] * rl * __uint_as_float(gv.y << 16), o[d + 3] * rl * __uint_as_float(gv.y & 0xffff0000u));
        w.z = pk2(o[d + 4] * rl * __uint_as_float(gv.z << 16), o[d + 5] * rl * __uint_as_float(gv.z & 0xffff0000u));
        w.w = pk2(o[d + 6] * rl * __uint_as_float(gv.w << 16), o[d + 7] * rl * __uint_as_float(gv.w & 0xffff0000u));
        *(uint4*)(op + d) = w; }
}
template <int DQK>
__device__ __forceinline__ void attn_naive_phase(unsigned char* lds, int tid, const bf16_t* Q, int ldq, int qhs, const bf16_t* Kp, int ldk, int khs, const bf16_t* Vp, int ldv, int vhs, int nkeys, int nheads,
                                                 bf16_t* O, const bf16_t* G, int ocol0) {
    const int half = tid >> 8, t256 = tid & 255; float* Ks = (float*)(lds + half * 32768); float* Vs = Ks + 8 * DQK;
    const int total = 16 * nheads * NB, stride = (int)gridDim.x * 2;
    for (int vb = (int)blockIdx.x * 2 + half; vb < total; vb += stride) { const int qblk = vb & 15, h = (vb >> 4) % nheads, b = (vb >> 4) / nheads;
        attn_naive_vb<DQK>(Ks, Vs, t256, Q, ldq, qhs, Kp, ldk, khs, Vp, ldv, vhs, nkeys, O, G, ocol0, qblk, h, b); }
}

__global__ void __launch_bounds__(NWAVES * 64, 2) mk_fwd(Args args) {
    extern __shared__ __attribute__((aligned(16))) unsigned char lds[];
    LAS unsigned char* ldsl = (LAS unsigned char*)lds;
    volatile LAS unsigned* MISC = (volatile LAS unsigned*)(ldsl + MISC_OFF);
    const int tid0 = threadIdx.x;
#define PHASE_IDS() int tid = threadIdx.x; asm volatile("" : "+v"(tid)); const int lane = tid & 63, wave = __builtin_amdgcn_readfirstlane(tid >> 6); const int gt = (int)blockIdx.x * (NWAVES * 64) + tid, gw = (int)blockIdx.x * NWAVES + wave; (void)lane; (void)wave; (void)gt; (void)gw;
    const int vcu = (gridDim.x % 8 == 0) ? ((int)blockIdx.x % 8) * ((int)gridDim.x / 8) + (int)blockIdx.x / 8 : (int)blockIdx.x;
    const int G = gridDim.x, GT = G * NWAVES * 64, NGW = G * NWAVES;
    unsigned char* ws = args.ws;
    gu32* ctl = (gu32*)(ws + WS_CTL);
#define in_x ((const float*)args.in[0])
#define in_mem ((const float*)args.in[1])
#define in_pos ((const int*)args.in[2])
#define in_g0 ((const float*)args.in[3])
#define in_w_in0 ((const float*)args.in[4])
#define in_gq ((const float*)args.in[5])
#define in_gkv ((const float*)args.in[6])
#define in_w_uq ((const float*)args.in[7])
#define in_w_ukv ((const float*)args.in[8])
#define in_gm0 ((const float*)args.in[9])
#define in_w_mkv0 ((const float*)args.in[10])
#define in_w_out0 ((const float*)args.in[11])
#define in_g1 ((const float*)args.in[12])
#define in_w_in1 ((const float*)args.in[13])
#define in_w_fnet ((const float*)args.in[14])
#define in_gm1 ((const float*)args.in[15])
#define in_w_mkv1 ((const float*)args.in[16])
#define in_w_out1 ((const float*)args.in[17])
#define in_gf ((const float*)args.in[18])
#define in_out (args.out)
#define WIN0 ((bf16_t*)(ws + WS_WIN0))
#define WUQ ((bf16_t*)(ws + WS_WUQ))
#define WUKV ((bf16_t*)(ws + WS_WUKV))
#define WMEM ((bf16_t*)(ws + WS_WMEM))
#define WOUT0 ((bf16_t*)(ws + WS_WOUT0))
#define WOUT1 ((bf16_t*)(ws + WS_WOUT1))
#define WIN1 ((bf16_t*)(ws + WS_WIN1))
#define AGBG ((float*)(ws + WS_AGBG))
#define ROPE ((float*)(ws + WS_ROPE))
#define MEMN ((bf16_t*)(ws + WS_MEMN))
#define MEMKV ((bf16_t*)(ws + WS_MEMKV))
#define RSTD1 ((float*)(ws + WS_RSTD1))
#define SSQ ((float*)(ws + WS_SSQ))
#define XN0 ((bf16_t*)(ws + WS_XN0))
#define BR ((bf16_t*)(ws + WS_BR))
#define CQ ((bf16_t*)(ws + WS_CQ))
#define CKV ((bf16_t*)(ws + WS_CKV))
#define QMEM0 ((bf16_t*)(ws + WS_QMEM0))
#define SG0 ((bf16_t*)(ws + WS_SG0))
#define Kb ((bf16_t*)(ws + WS_K))
#define Qb ((bf16_t*)(ws + WS_Q))
#define Vb ((bf16_t*)(ws + WS_V))
#define X1B ((bf16_t*)(ws + WS_X1B))
#define PQ ((bf16_t*)(ws + WS_PQ))
#define QMEM1 ((bf16_t*)(ws + WS_QMEM1))
#define SG1 ((bf16_t*)(ws + WS_SG1))
#define Y ((bf16_t*)(ws + WS_Y))
    for (int u = tid0; u < (LDS_BYTES - LDSCTL_OFF) / 4; u += NWAVES * 64) ((LAS unsigned*)(ldsl + LDSCTL_OFF))[u] = 0u;
    __syncthreads();
    XcdBarrier bar; bar.bar = (unsigned*)(ctl + CW_BAR); bar.x = 0; bar.st = nullptr;
    if (N_LAUNCHES == 1) bar = xcd_barrier_post((unsigned*)(ctl + CW_BAR), MISC + 8);
#define GRID_BAR() do { if (N_LAUNCHES == 1) xcd_barrier(bar); } while (0)
    const int lo = args.ph_lo, hi = args.ph_hi;
#ifndef PH_MASK
#define PH_MASK 0x1ff
#endif
#define IN(k) (((PH_MASK >> (k)) & 1) && lo <= (k) && (k) < hi)
#define BOTH(k) (IN(k) && IN((k) + 1))
    LAS float* rs = (LAS float*)(ldsl + RS_OFF);

    if (IN(0)) { PHASE_IDS();
        prep_w_job(in_w_in0, 1952, 1024, WIN0, 0, 2048, nullptr, MODE_WIN0, 0, gt, GT);
        prep_w_job(in_w_uq, 1152, 384, WUQ, 0, 1280, in_gq, MODE_WUQ, 0, gt, GT);
        prep_w_job(in_w_ukv, 1536, 256, WUKV, 0, 1536, in_gkv, MODE_WUKV, 0, gt, GT);
        prep_w_job(in_w_mkv0, 512, 1024, WMEM, 0, 512, in_gm0, MODE_PLAIN, 0, gt, GT);
        prep_w_job(in_w_mkv1, 512, 1024, WMEM, 512, 512, in_gm1, MODE_PLAIN, 0, gt, GT);
        prep_w_job(in_w_out0, 1024, 1024, WOUT0, 0, 1024, nullptr, MODE_PLAIN, 0, gt, GT);
        prep_w_job(in_w_out1, 1024, 1024, WOUT1, 0, 1024, nullptr, MODE_PLAIN, 0, gt, GT);
        prep_w_job(in_w_in1, 2048, 1024, WIN1, 1536, 1280, in_g1, MODE_PLAIN, 768, gt, GT);
        for (int idx = gt; idx < 2 * 4 * 192 * 192; idx += GT) { const int d = idx % 192, c = (idx / 192) % 192, g = (idx / 36864) & 3, pq = idx / 147456;
            float acc = 0.f;
            for (int m = 0; m < 192; ++m) { const float fr = 2.0f * (float)((m * c) % 192) / 192.0f; const float tr = pq ? sinpif(fr) : cospif(fr); acc += tr * in_w_fnet[((size_t)g * 192 + m) * 192 + d]; }
            AGBG[idx] = acc * 0.07216878364870322f; }
        for (int idx = gt; idx < T * 16; idx += GT) { const int t = idx >> 4, i = idx & 15;
            const float inv_freq = (float)(1.0 / pow(10000.0, (double)i / 16.0)); const float ang = (float)in_pos[t] * inv_freq;
            ROPE[2 * idx] = (float)cos((double)ang); ROPE[2 * idx + 1] = (float)sin((double)ang); }
        for (int m = gw; m < 4096; m += NGW) rmsnorm_row(in_mem + (size_t)m * DM, nullptr, MEMN + (size_t)m * DM, lane);
        for (int m = gw; m < T; m += NGW) rmsnorm_row(in_x + (size_t)m * DM, in_g0, XN0 + (size_t)m * DM, lane);
        if (BOTH(0)) GRID_BAR();
    }
    if (IN(1)) { PHASE_IDS();
        for (int idx = gt; idx < 2 * 4 * 1024 * 192; idx += GT) { const int d = idx % 192, k = (idx / 192) & 1023, g = (idx / 196608) & 3, pq = idx / 786432;
            const float* wr = in_w_in1 + (size_t)k * 2048 + 192 * g; const float* ag = AGBG + (((size_t)pq * 4 + g) * 192) * 192 + d; float acc = 0.f;
            for (int c = 0; c < 192; ++c) acc += wr[c] * ag[(size_t)c * 192];
            WIN1[(size_t)(pq * 768 + g * 192 + d) * 1024 + k] = f2bf(acc * in_g1[k]); }
        { pg8::Gemm g{XN0, WIN0, T, 2048, 1024}; pg8::StaticOrder S; S.init(T, 2048, G, (int)blockIdx.x);
          pg8::EpiIn0 E{CQ, CKV, QMEM0, SG0, Kb, SSQ, ROPE};
          pg8::gemm_phase<pg8::EpiIn0, pg8::StaticOrder, true, true>(ldsl + RING_OFF, g, S, E); }
        { pg8::Gemm g{MEMN, WMEM, 4096, 1024, 1024}; pg8::StaticOrder S; S.init(4096, 1024, G, (int)blockIdx.x);
          pg8::EpiPlainB E{MEMKV, 1024, 0};
          pg8::gemm_phase<pg8::EpiPlainB, pg8::StaticOrder, true, true>(ldsl + RING_OFF, g, S, E); }
        if (BOTH(1)) GRID_BAR();
    }
    if (IN(2)) { PHASE_IDS();
        { int kq_ = 384; asm volatile("" : "+s"(kq_)); pg8::Gemm g{CQ, WUQ, T, 1280, kq_}; pg8::StaticOrder S; S.init(T, 1280, G, (int)blockIdx.x);
          pg8::EpiQup E{Qb, SSQ, ROPE};
          pg8::gemm_phase<pg8::EpiQup, pg8::StaticOrder, true, true>(ldsl + RING_OFF, g, S, E); }
        { int kk_ = 256; asm volatile("" : "+s"(kk_)); pg8::Gemm g{CKV, WUKV, T, 1536, kk_}; pg8::StaticOrder S; S.init(T, 1536, G, (int)blockIdx.x);
          pg8::EpiKVup E{Kb, Vb, SSQ};
          pg8::gemm_phase<pg8::EpiKVup, pg8::StaticOrder, true, true>(ldsl + RING_OFF, g, S, E); }
        if (BOTH(2)) GRID_BAR();
    }
    if (IN(3)) { PHASE_IDS();
#ifdef ATTN_NAIVE
        attn_naive_phase<96>(lds, tid, Qb, 1152, 96, Kb, 1152, 96, Vb, 768, 64, SEQ, 12, BR, SG0, 0);
        attn_naive_phase<64>(lds, tid, QMEM0, 256, 64, MEMKV, 1024, 64, MEMKV + 256, 1024, 64, 256, 4, BR, SG0, 768);
#else
        for (int u = vcu; u < 16 * 12 * NB; u += G) { const int qblk = u & 15, pair = u >> 4, b = pair / 12, h = pair % 12; const size_t t0 = (size_t)b * SEQ + qblk * 256;
            att::attn_unit<96>(Qb + t0 * 1152 + h * 96, 1152, Kb + (size_t)b * SEQ * 1152 + h * 96, 1152, Vb + (size_t)b * SEQ * 768 + h * 64, 768, SEQ, BR + t0 * 1024 + h * 64, SG0 + t0 * 1024 + h * 64, (char*)lds); }
        for (int u = vcu; u < 16 * 4 * NB; u += G) { const int qblk = u & 15, pair = u >> 4, b = pair >> 2, h = pair & 3; const size_t t0 = (size_t)b * SEQ + qblk * 256;
            att::attn_unit<64>(QMEM0 + t0 * 256 + h * 64, 256, MEMKV + (size_t)b * 256 * 1024 + h * 64, 1024, MEMKV + (size_t)b * 256 * 1024 + 256 + h * 64, 1024, 256, BR + t0 * 1024 + 768 + h * 64, SG0 + t0 * 1024 + 768 + h * 64, (char*)lds); }
#endif
        if (BOTH(3)) GRID_BAR();
    }
    if (IN(4)) { PHASE_IDS();
        for (int i = tid; i < 1024; i += NWAVES * 64) rs[i] = 0.f;
        __syncthreads();
        { pg8::Gemm g{BR, WOUT0, T, 1024, 1024}; pg8::PanelOrder S; S.init(T, G, (int)blockIdx.x);
          pg8::EpiOut E{in_x, in_out, X1B, rs};
          pg8::gemm_phase<pg8::EpiOut, pg8::PanelOrder, true, true>(ldsl + RING_OFF, g, S, E); }
        __syncthreads();
        if (tid < 256) RSTD1[(size_t)blockIdx.x * 256 + tid] = rsqrtf(((rs[tid * 4] + rs[tid * 4 + 1]) + (rs[tid * 4 + 2] + rs[tid * 4 + 3])) * (1.f / DM) + EPS);
        if (BOTH(4)) GRID_BAR();
    }
    if (IN(5)) { PHASE_IDS();
        { pg8::Gemm g{X1B, WIN1, T, 2816, 1024}; pg8::StaticOrder S; S.init(T, 2816, G, (int)blockIdx.x);
          pg8::EpiIn1 E{PQ, QMEM1, SG1, RSTD1};
          pg8::gemm_phase<pg8::EpiIn1, pg8::StaticOrder, true, true>(ldsl + RING_OFF, g, S, E); }
        if (BOTH(5)) GRID_BAR();
    }
    if (IN(6)) { PHASE_IDS();
        LAS float* tab = (LAS float*)(ldsl + RING_OFF + 65536);
        if (tid < 64) { tab[2 * tid] = cospif(2.f * tid / 64.f); tab[2 * tid + 1] = sinpif(2.f * tid / 64.f); }
        __syncthreads();
        for (int idx = gt; idx < NB * 64 * 49152; idx += GT) { const int e = idx % 49152, k1 = (idx / 49152) & 63, b = idx / (49152 * 64);
            float ar = 0.f, ai = 0.f;
            for (int s1 = 0; s1 < 64; ++s1) { const int w = (k1 * s1) & 63; const float wx = tab[2 * w], wy = tab[2 * w + 1];
                const size_t base = (((size_t)b * 64 + s1) * 2) * 49152 + e; const float p = bf2f(PQ[base]), q = bf2f(PQ[base + 49152]);
                ar += wx * p - wy * q; ai += wy * p + wx * q; }
            ar *= 0.125f; ai *= 0.125f;
            const int s2 = e / 768; const float fr = 2.f * (float)(k1 * s2) / 4096.f; const float tr = cospif(fr), ti = sinpif(fr);
            const size_t ob = (((size_t)b * 64 + k1) * 2) * 49152 + e;
            Y[ob] = f2bf(tr * ar - ti * ai); Y[ob + 49152] = f2bf(ti * ar + tr * ai); }
        __syncthreads();
#ifdef ATTN_NAIVE
        attn_naive_phase<64>(lds, tid, QMEM1, 256, 64, MEMKV + 512, 1024, 64, MEMKV + 768, 1024, 64, 256, 4, BR, SG1, 768);
#else
        for (int u = vcu; u < 16 * 4 * NB; u += G) { const int qblk = u & 15, pair = u >> 4, b = pair >> 2, h = pair & 3; const size_t t0 = (size_t)b * SEQ + qblk * 256;
            att::attn_unit<64>(QMEM1 + t0 * 256 + h * 64, 256, MEMKV + (size_t)b * 256 * 1024 + 512 + h * 64, 1024, MEMKV + (size_t)b * 256 * 1024 + 768 + h * 64, 1024, 256, BR + t0 * 1024 + 768 + h * 64, SG1 + t0 * 1024 + 768 + h * 64, (char*)lds); }
#endif
        if (BOTH(6)) GRID_BAR();
    }
    if (IN(7)) { PHASE_IDS();
        LAS float* tab = (LAS float*)(ldsl + RING_OFF + 65536);
        __syncthreads();
        if (tid < 64) { tab[2 * tid] = cospif(2.f * tid / 64.f); tab[2 * tid + 1] = sinpif(2.f * tid / 64.f); }
        __syncthreads();
        for (int idx = gt; idx < NB * 64 * 64 * 768; idx += GT) { const int d = idx % 768, k2 = (idx / 768) & 63, bk1 = idx / 49152, b = bk1 >> 6, k1 = bk1 & 63;
            float acc = 0.f;
            for (int s2 = 0; s2 < 64; ++s2) { const int w = (k2 * s2) & 63; const size_t base = ((size_t)bk1 * 2) * 49152 + (size_t)s2 * 768 + d;
                acc += tab[2 * w] * bf2f(Y[base]) - tab[2 * w + 1] * bf2f(Y[base + 49152]); }
            const size_t t = (size_t)b * SEQ + k1 + 64 * k2;
            BR[t * 1024 + d] = f2bf(acc * 0.125f * bf2f(SG1[t * 1024 + d])); }
        if (BOTH(7)) GRID_BAR();
    }
    if (IN(8)) { PHASE_IDS();
        __syncthreads();
        for (int i = tid; i < 1024; i += NWAVES * 64) rs[i] = 0.f;
        __syncthreads();
        { pg8::Gemm g{BR, WOUT1, T, 1024, 1024}; pg8::PanelOrder S; S.init(T, G, (int)blockIdx.x);
          pg8::EpiOut E{in_out, in_out, nullptr, rs};
          pg8::gemm_phase<pg8::EpiOut, pg8::PanelOrder, true, true>(ldsl + RING_OFF, g, S, E); }
        asm volatile("s_waitcnt vmcnt(0)" ::: "memory");
        __syncthreads();
        for (int r = wave; r < 256; r += NWAVES) { const float rstd = rsqrtf(((rs[r * 4] + rs[r * 4 + 1]) + (rs[r * 4 + 2] + rs[r * 4 + 3])) * (1.f / DM) + EPS);
            float4* xr = (float4*)(in_out + ((size_t)blockIdx.x * 256 + r) * DM) + lane;
#pragma unroll
            for (int j = 0; j < 4; ++j) { float4 v = xr[64 * j]; const float4 gv = ((const float4*)in_gf)[lane + 64 * j]; v.x *= rstd * gv.x; v.y *= rstd * gv.y; v.z *= rstd * gv.z; v.w *= rstd * gv.w; xr[64 * j] = v; } }
    }
#undef in_x
#undef in_mem
#undef in_pos
#undef in_g0
#undef in_w_in0
#undef in_gq
#undef in_gkv
#undef in_w_uq
#undef in_w_ukv
#undef in_gm0
#undef in_w_mkv0
#undef in_w_out0
#undef in_g1
#undef in_w_in1
#undef in_w_fnet
#undef in_gm1
#undef in_w_mkv1
#undef in_w_out1
#undef in_gf
#undef in_out
#undef WIN0
#undef WUQ
#undef WUKV
#undef WMEM
#undef WOUT0
#undef WOUT1
#undef WIN1
#undef AGBG
#undef ROPE
#undef MEMN
#undef MEMKV
#undef RSTD1
#undef SSQ
#undef XN0
#undef BR
#undef CQ
#undef CKV
#undef QMEM0
#undef SG0
#undef Kb
#undef Qb
#undef Vb
#undef X1B
#undef PQ
#undef QMEM1
#undef SG1
#undef Y
#undef PHASE_IDS
#undef IN
#undef BOTH
#undef GRID_BAR
}

extern "C" void kernel_launch(void* const* d_in, const int* in_sizes, int n_in, void* d_out, int out_size, void* d_ws, size_t ws_size, hipStream_t stream) {
    static int grid = 0;
    if (grid == 0) {
        if (n_in != 19 || ws_size < WS_END || out_size != T * DM) { fprintf(stderr, "kernel_launch: unexpected n_in %d / ws %zu / out %d\n", n_in, ws_size, out_size); grid = -1; return; }
        int dev = 0, cus = 0;
        if (hipGetDevice(&dev) != hipSuccess || hipDeviceGetAttribute(&cus, hipDeviceAttributeMultiprocessorCount, dev) != hipSuccess) { grid = -1; return; }
        if (hipFuncSetAttribute((const void*)mk_fwd, hipFuncAttributeMaxDynamicSharedMemorySize, LDS_BYTES) != hipSuccess) { fprintf(stderr, "kernel_launch: hipFuncSetAttribute failed\n"); grid = -1; return; }
        int per_cu = 0; (void)hipOccupancyMaxActiveBlocksPerMultiprocessor(&per_cu, (const void*)mk_fwd, NWAVES * 64, LDS_BYTES); (void)hipGetLastError();
        if (cus != 256 || per_cu < 1) fprintf(stderr, "kernel_launch: note: %d CUs, occupancy query %d (built for 256 CUs, one workgroup each)\n", cus, per_cu);
        grid = 256;
    }
    if (grid < 0) return;
    if (hipMemsetAsync((char*)d_ws + WS_CTL, 0, CTL_ZERO_BYTES, stream) != hipSuccess) { fprintf(stderr, "kernel_launch: memset failed\n"); return; }
    Args a{};
    for (int i = 0; i < 19; ++i) a.in[i] = d_in[i];
    a.out = (float*)d_out; a.ws = (unsigned char*)d_ws;
    for (int li = 0; li < N_LAUNCHES; ++li) {
        a.ph_lo = (N_LAUNCHES == 1) ? 0 : li; a.ph_hi = (N_LAUNCHES == 1) ? N_PHASES : li + 1; a.li = li; a.pad = 0;
        hipLaunchKernelGGL(mk_fwd, dim3(grid), dim3(NWAVES * 64), LDS_BYTES, stream, a);
        const hipError_t le = hipPeekAtLastError();
        if (le != hipSuccess) { fprintf(stderr, "kernel_launch: launch %d failed: %s\n", li, hipGetErrorName(le)); break; }
    }
}
```

```cpp
#include <hip/hip_runtime.h>
#include <stdint.h>
#include <cstdio>

typedef unsigned short bf16_t;
constexpr int T = 65536, SEQ = 4096, NB = 16, DM = 1024;
constexpr float EPS = 1e-6f;
constexpr float LOG2E = 1.4426950408889634f;
constexpr float QS_MLA = 0.10206207261596575f * LOG2E;
constexpr float QS_MEM = 0.125f * LOG2E;

constexpr size_t MiB = 1u << 20;
constexpr size_t WS_CTL = 0, CTL_ZERO_BYTES = 1 * MiB;
constexpr size_t WS_WIN0 = 1 * MiB;
constexpr size_t WS_WUQ = 5 * MiB;
constexpr size_t WS_WUKV = 6 * MiB;
constexpr size_t WS_WMEM = 7 * MiB;
constexpr size_t WS_WOUT0 = 9 * MiB;
constexpr size_t WS_WOUT1 = 11 * MiB;
constexpr size_t WS_WIN1 = 13 * MiB;
constexpr size_t WS_AGBG = 19 * MiB;
constexpr size_t WS_ROPE = 21 * MiB;
constexpr size_t WS_MEMN = 29 * MiB;
constexpr size_t WS_MEMKV = 37 * MiB;
constexpr size_t WS_RSTD1 = 45 * MiB;
constexpr size_t WS_SSQ = 46 * MiB;
constexpr size_t WS_XN0 = 64 * MiB;
constexpr size_t WS_BR = 64 * MiB;
constexpr size_t WS_CQ = 192 * MiB;
constexpr size_t WS_CKV = 240 * MiB;
constexpr size_t WS_QMEM0 = 272 * MiB;
constexpr size_t WS_SG0 = 304 * MiB;
constexpr size_t WS_K = 432 * MiB;
constexpr size_t WS_Q = 576 * MiB;
constexpr size_t WS_V = 720 * MiB;
constexpr size_t WS_X1B = 192 * MiB;
constexpr size_t WS_PQ = 320 * MiB;
constexpr size_t WS_QMEM1 = 512 * MiB;
constexpr size_t WS_SG1 = 544 * MiB;
constexpr size_t WS_Y = 672 * MiB;
constexpr size_t WS_END = 864 * MiB;

__device__ __forceinline__ float bf2f(bf16_t h) { return __uint_as_float(((unsigned)h) << 16); }
__device__ __forceinline__ bf16_t f2bf(float f) { unsigned u = __float_as_uint(f); return (bf16_t)((u + 0x7fffu + ((u >> 16) & 1u)) >> 16); }
__device__ __forceinline__ unsigned pk2(float lo, float hi) { return (unsigned)f2bf(lo) | ((unsigned)f2bf(hi) << 16); }
__device__ __forceinline__ float silu_f(float v) { return v * __builtin_amdgcn_rcpf(1.f + __expf(-v)); }
__device__ __forceinline__ float wave_sum(float v) {
#pragma unroll
    for (int o = 1; o < 64; o <<= 1) v += __shfl_xor(v, o);
    return v;
}
__host__ __device__ __forceinline__ int ropedim(int p) { return 4 * (p >> 3) + (p & 3) + 16 * ((p >> 2) & 1); }
enum { MODE_WIN0 = 0, MODE_WUQ = 1, MODE_WUKV = 2, MODE_PLAIN = 3 };
__device__ __forceinline__ int src_col(int mode, int n, int off) {
    if (mode == MODE_WIN0) {
        if (n < 640) return n;
        if (n < 896) return 672 + (n - 640);
        if (n < 928) return 640 + ropedim(n - 896);
        if (n < 1024) return -1;
        return 928 + (n - 1024);
    } else if (mode == MODE_WUQ) {
        if (n < 768) return (n >> 6) * 96 + (n & 63);
        if (n < 1152) { const int r = n - 768; return (r >> 5) * 96 + 64 + ropedim(r & 31); }
        return -1;
    } else if (mode == MODE_WUKV) {
        if (n < 768) return (n >> 6) * 128 + (n & 63);
        const int r = n - 768; return (r >> 6) * 128 + 64 + (r & 63);
    }
    return n + off;
}
namespace pg8 {
#define PG8_LAS __attribute__((address_space(3)))
typedef unsigned short bf16_t;
typedef short bf16x8 __attribute__((ext_vector_type(8)));
typedef float f32x4 __attribute__((ext_vector_type(4)));
typedef unsigned u32x4 __attribute__((ext_vector_type(4)));
constexpr int BM = 256, BK = 64, HALF = 128, HTB = HALF * BK * 2  , STAGE_BYTES = 8 * HTB, NXCD = 8, WGM = 8;

__host__ __device__ __forceinline__ int lds_byte(int r, int c) { const int st = (r >> 4) * 2 + (c >> 5), rr = r & 15, cc = c & 31, ob = rr * 64 + cc * 2; return st * 1024 + (ob ^ (((ob >> 9) & 1) << 5)); }
__host__ __device__ __forceinline__ void stage_rc(int b, int& R, int& C) { const int st = b / 1024, sb = b % 1024, swz = sb ^ (((sb >> 9) & 1) << 5); R = (st >> 1) * 16 + swz / 64; C = (st & 1) * 32 + (swz % 64) / 2; }
__host__ __device__ __forceinline__ int perm32(int rho) { const int n = rho >> 4, i = rho & 15; return 8 * (i >> 2) + 4 * n + (i & 3); }

struct Unit { int pm, pn; };
struct Gemm { const bf16_t* A; const bf16_t* Bt; int M, N, K; };

struct StaticOrder {
    int nM, nN, nwg, G, c;
    __host__ __device__ void init(int M, int N, int G_, int c_) { nM = M / BM; nN = N / BM; nwg = nM * nN; G = G_; c = c_; }
    __host__ __device__ bool next(int i, Unit& u) const {
        const long L = (long)i * G + c; if (L >= nwg) return false;
        int wgid = (int)L; { const int q = nwg / NXCD, r = nwg % NXCD, xcd = wgid % NXCD, off = wgid / NXCD; wgid = (xcd < r ? xcd * (q + 1) : r * (q + 1) + (xcd - r) * q) + off; }
        const int nig = WGM * nN, gid = wgid / nig, fm = gid * WGM, gsz = (nM - fm) < WGM ? (nM - fm) : WGM;
        u.pm = fm + ((wgid % nig) % gsz); u.pn = (wgid % nig) / gsz; return true;
    }
    __device__ __forceinline__ void a_ready(const Unit&) const {}
    __device__ __forceinline__ void done(const Unit&) const {}
};

__device__ __forceinline__ unsigned cvt_pk_bf16(float lo, float hi) { unsigned r; asm volatile("v_cvt_pk_bf16_f32 %0, %1, %2" : "=v"(r) : "v"(lo), "v"(hi)); return r; }
typedef float f32x2 __attribute__((ext_vector_type(2)));
__device__ __forceinline__ u32x4 pack8(const f32x4 a, const f32x4 b, float s) { u32x4 w; w.x = cvt_pk_bf16(a[0] * s, a[1] * s); w.y = cvt_pk_bf16(a[2] * s, a[3] * s); w.z = cvt_pk_bf16(b[0] * s, b[1] * s); w.w = cvt_pk_bf16(b[2] * s, b[3] * s); return w; }
__device__ __forceinline__ float ss8(const f32x4 a, const f32x4 b) { return (a[0] * a[0] + a[1] * a[1]) + (a[2] * a[2] + a[3] * a[3]) + (b[0] * b[0] + b[1] * b[1]) + (b[2] * b[2] + b[3] * b[3]); }
__device__ __forceinline__ float quad_sum(float v) { v += __shfl_xor(v, 16); v += __shfl_xor(v, 32); return v; }
__device__ __forceinline__ f32x4 silu4(const f32x4 v) { f32x4 o; o[0] = silu_f(v[0]); o[1] = silu_f(v[1]); o[2] = silu_f(v[2]); o[3] = silu_f(v[3]); return o; }
typedef unsigned u32x2 __attribute__((ext_vector_type(2)));
__device__ __forceinline__ void rope_pair(const f32x4 a, const f32x4 b, const float* cs  , float s, u32x2& o1, u32x2& o2) {
    const f32x4 c01 = *(const f32x4*)cs, c23 = *(const f32x4*)(cs + 4);
    const float r0 = (a[0] * c01[0] - b[0] * c01[1]) * s, r1 = (a[1] * c01[2] - b[1] * c01[3]) * s, r2 = (a[2] * c23[0] - b[2] * c23[1]) * s, r3 = (a[3] * c23[2] - b[3] * c23[3]) * s;
    const float q0 = (b[0] * c01[0] + a[0] * c01[1]) * s, q1 = (b[1] * c01[2] + a[1] * c01[3]) * s, q2 = (b[2] * c23[0] + a[2] * c23[1]) * s, q3 = (b[3] * c23[2] + a[3] * c23[3]) * s;
    o1.x = cvt_pk_bf16(r0, r1); o1.y = cvt_pk_bf16(r2, r3); o2.x = cvt_pk_bf16(q0, q1); o2.y = cvt_pk_bf16(q2, q3);
}
struct EpiIn0 {
    static constexpr bool PERM = true, AFTER_DRAIN = false;
    bf16_t *CQ, *CKV, *QMEM, *SG, *Kb; float* SSQ; const float* rope;
    __device__ __forceinline__ void operator()(const f32x4 (&acc)[2][2][4][2], const Unit& u, int wr, int wc, int fr, int fq) const {
#pragma unroll
        for (int ai = 0; ai < 2; ++ai)
#pragma unroll
            for (int m = 0; m < 4; ++m) { int rowi_ = u.pm * BM + ai * HALF + wr * 64 + m * 16 + fr; asm volatile("" : "+v"(rowi_)); const size_t row = (size_t)rowi_;
#pragma unroll
                for (int bj = 0; bj < 2; ++bj) { const int cb = u.pn * BM + bj * HALF + wc * 32, c = cb + 8 * fq; const f32x4 v0 = acc[ai][bj][m][0], v1 = acc[ai][bj][m][1];
                    if (cb < 640) { const float ss = quad_sum(ss8(v0, v1));
                        if (cb < 384) { *(u32x4*)(CQ + row * 384 + c) = pack8(v0, v1, 1.f); if (fq == 0) SSQ[row * 20 + (cb >> 5)] = ss; }
                        else { *(u32x4*)(CKV + row * 256 + (c - 384)) = pack8(v0, v1, 1.f); if (fq == 0) SSQ[row * 20 + 12 + ((cb - 384) >> 5)] = ss; } }
                    else if (cb < 896) { *(u32x4*)(QMEM + row * 256 + (c - 640)) = pack8(v0, v1, QS_MEM); }
                    else if (cb < 1024) { if (cb == 896) { u32x2 o1, o2; rope_pair(v0, v1, rope + row * 32 + 8 * fq, 1.f, o1, o2);
#pragma unroll
                            for (int h = 0; h < 12; ++h) { *(u32x2*)(Kb + row * 1152 + h * 96 + 64 + 4 * fq) = o1; *(u32x2*)(Kb + row * 1152 + h * 96 + 80 + 4 * fq) = o2; } } }
                    else { *(u32x4*)(SG + row * 1024 + (c - 1024)) = pack8(silu4(v0), silu4(v1), 1.f); } } }
    }
};
struct EpiPlainB {
    static constexpr bool PERM = true, AFTER_DRAIN = false;
    bf16_t* O; int ldo; int pad;
    __device__ __forceinline__ void operator()(const f32x4 (&acc)[2][2][4][2], const Unit& u, int wr, int wc, int fr, int fq) const {
#pragma unroll
        for (int ai = 0; ai < 2; ++ai)
#pragma unroll
            for (int m = 0; m < 4; ++m) { int rowi_ = u.pm * BM + ai * HALF + wr * 64 + m * 16 + fr; asm volatile("" : "+v"(rowi_)); const size_t row = (size_t)rowi_;
#pragma unroll
                for (int bj = 0; bj < 2; ++bj) { const int c = u.pn * BM + bj * HALF + wc * 32 + 8 * fq; *(u32x4*)(O + row * ldo + c) = pack8(acc[ai][bj][m][0], acc[ai][bj][m][1], 1.f); } }
    }
};
struct EpiQup {
    static constexpr bool PERM = true, AFTER_DRAIN = false;
    bf16_t* Qb; const float* SSQ; const float* rope;
    __device__ __forceinline__ void operator()(const f32x4 (&acc)[2][2][4][2], const Unit& u, int wr, int wc, int fr, int fq) const {
#pragma unroll
        for (int ai = 0; ai < 2; ++ai)
#pragma unroll
            for (int m = 0; m < 4; ++m) { int rowi_ = u.pm * BM + ai * HALF + wr * 64 + m * 16 + fr; asm volatile("" : "+v"(rowi_)); const size_t row = (size_t)rowi_;
                const f32x4 s0 = *(const f32x4*)(SSQ + row * 20), s1 = *(const f32x4*)(SSQ + row * 20 + 4), s2 = *(const f32x4*)(SSQ + row * 20 + 8);
                const float ss = ((s0[0] + s0[1]) + (s0[2] + s0[3])) + ((s1[0] + s1[1]) + (s1[2] + s1[3])) + ((s2[0] + s2[1]) + (s2[2] + s2[3]));
                const float s = rsqrtf(ss * (1.f / 384.f) + EPS) * QS_MLA;
#pragma unroll
                for (int bj = 0; bj < 2; ++bj) { const int cb = u.pn * BM + bj * HALF + wc * 32, c = cb + 8 * fq; const f32x4 v0 = acc[ai][bj][m][0], v1 = acc[ai][bj][m][1];
                    if (cb < 768) { *(u32x4*)(Qb + row * 1152 + (c >> 6) * 96 + (c & 63)) = pack8(v0, v1, s); }
                    else if (cb < 1152) { const int h = (cb - 768) >> 5; u32x2 o1, o2; rope_pair(v0, v1, rope + row * 32 + 8 * fq, s, o1, o2);
                        *(u32x2*)(Qb + row * 1152 + h * 96 + 64 + 4 * fq) = o1; *(u32x2*)(Qb + row * 1152 + h * 96 + 80 + 4 * fq) = o2; } }
                asm volatile("" ::: "memory"); }
    }
};
struct EpiKVup {
    static constexpr bool PERM = true, AFTER_DRAIN = false;
    bf16_t *Kb, *Vb; const float* SSQ;
    __device__ __forceinline__ void operator()(const f32x4 (&acc)[2][2][4][2], const Unit& u, int wr, int wc, int fr, int fq) const {
#pragma unroll
        for (int ai = 0; ai < 2; ++ai)
#pragma unroll
            for (int m = 0; m < 4; ++m) { int rowi_ = u.pm * BM + ai * HALF + wr * 64 + m * 16 + fr; asm volatile("" : "+v"(rowi_)); const size_t row = (size_t)rowi_;
                const f32x4 s0 = *(const f32x4*)(SSQ + row * 20 + 12), s1 = *(const f32x4*)(SSQ + row * 20 + 16);
                const float ss = ((s0[0] + s0[1]) + (s0[2] + s0[3])) + ((s1[0] + s1[1]) + (s1[2] + s1[3]));
                const float s = rsqrtf(ss * (1.f / 256.f) + EPS);
#pragma unroll
                for (int bj = 0; bj < 2; ++bj) { const int cb = u.pn * BM + bj * HALF + wc * 32, c = cb + 8 * fq; const f32x4 v0 = acc[ai][bj][m][0], v1 = acc[ai][bj][m][1];
                    if (cb < 768) *(u32x4*)(Kb + row * 1152 + (c >> 6) * 96 + (c & 63)) = pack8(v0, v1, s);
                    else *(u32x4*)(Vb + row * 768 + (c - 768)) = pack8(v0, v1, s); }
                asm volatile("" ::: "memory"); }
    }
};
struct EpiOut {
    static constexpr bool PERM = true, AFTER_DRAIN = false;
    const float* R; float* X1; bf16_t* X1B; PG8_LAS float* rs;
    __device__ __forceinline__ void operator()(const f32x4 (&acc)[2][2][4][2], const Unit& u, int wr, int wc, int fr, int fq) const {
#pragma unroll
        for (int ai = 0; ai < 2; ++ai)
#pragma unroll
            for (int m = 0; m < 4; ++m) { int rl = ai * HALF + wr * 64 + m * 16 + fr; asm volatile("" : "+v"(rl)); const size_t row = (size_t)(u.pm * BM + rl); float ssum = 0.f;
#pragma unroll
                for (int bj = 0; bj < 2; ++bj) { const int c = u.pn * BM + bj * HALF + wc * 32 + 8 * fq;
                    const f32x4 x0 = *(const f32x4*)(R + row * 1024 + c) + acc[ai][bj][m][0], x1 = *(const f32x4*)(R + row * 1024 + c + 4) + acc[ai][bj][m][1];
                    *(f32x4*)(X1 + row * 1024 + c) = x0; *(f32x4*)(X1 + row * 1024 + c + 4) = x1;
                    if (X1B) *(u32x4*)(X1B + row * 1024 + c) = pack8(x0, x1, 1.f);
                    ssum += ss8(x0, x1); }
                ssum = quad_sum(ssum); if (fq == 0) rs[rl * 4 + wc] += ssum; }
    }
};
struct EpiIn1 {
    static constexpr bool PERM = true, AFTER_DRAIN = false;
    bf16_t *PQ, *QMEM, *SG; const float* RSTD;
    __device__ __forceinline__ void operator()(const f32x4 (&acc)[2][2][4][2], const Unit& u, int wr, int wc, int fr, int fq) const {
#pragma unroll
        for (int ai = 0; ai < 2; ++ai)
#pragma unroll
            for (int m = 0; m < 4; ++m) { int rowi = u.pm * BM + ai * HALF + wr * 64 + m * 16 + fr; asm volatile("" : "+v"(rowi)); const size_t row = (size_t)rowi; const float r = RSTD[row];
                const int b = rowi >> 12, sq = rowi & 4095, s1 = sq >> 6, s2 = sq & 63; const size_t prow = ((size_t)(b * 64 + s1) * 2) * 64 + s2;
#pragma unroll
                for (int bj = 0; bj < 2; ++bj) { const int cb = u.pn * BM + bj * HALF + wc * 32, c = cb + 8 * fq; const f32x4 v0 = acc[ai][bj][m][0], v1 = acc[ai][bj][m][1];
                    if (cb < 1536) { const int pq = cb >= 768 ? 1 : 0; *(u32x4*)(PQ + (prow + pq * 64) * 768 + (c - pq * 768)) = pack8(v0, v1, r); }
                    else if (cb < 1792) *(u32x4*)(QMEM + row * 256 + (c - 1536)) = pack8(v0, v1, r * QS_MEM);
                    else *(u32x4*)(SG + row * 1024 + (c - 1792)) = pack8(silu4(v0 * r), silu4(v1 * r), 1.f); } }
    }
};
struct PanelOrder {
    int nM, G, c;
    __device__ void init(int M, int G_, int c_) { nM = M / BM; G = G_; c = c_; }
    __device__ bool next(int i, Unit& u) const { u.pm = c + G * (i >> 2); u.pn = i & 3; return u.pm < nM; }
    __device__ __forceinline__ void a_ready(const Unit&) const {}
    __device__ __forceinline__ void done(const Unit&) const {}
};
template <class Epi, class Sched, bool ALIGN_EPI = false, bool SP2 = false>
__device__ __forceinline__ void gemm_phase(PG8_LAS unsigned char* lds, const Gemm g, const Sched& S, const Epi& E) {
    const int tid = threadIdx.x, wid = __builtin_amdgcn_readfirstlane(tid >> 6), lane = tid & 63, wr = wid >> 2, wc = wid & 3, fr = lane & 15, fq = lane >> 4;
    const int K = g.K, nt = K / BK;
    unsigned voffA[2], voffB[2];
#pragma unroll
    for (int i = 0; i < 2; ++i) { int R, C; stage_rc(tid * 16 + i * 8192, R, C); const int Rb = Epi::PERM ? ((R & ~31) + perm32(R & 31)) : R;
        voffA[i] = (unsigned)(R * K + C) * 2u; voffB[i] = (unsigned)(Rb * K + C) * 2u; }
    const size_t kstep = (size_t)(BK * 2);
    const size_t hstep = (size_t)HALF * K * 2;
    const size_t tstep = 2 * hstep;
    const unsigned ldsw = (unsigned)wid * 1024u;
    const int aoff = lds_byte(wr * 64 + fr, fq * 8), boff = lds_byte(wc * 32 + fr, fq * 8);
#define PG8_SA(b, h) (((b) * 2 + (h)) * HTB)
#define PG8_SB(b, h) ((4 + (b) * 2 + (h)) * HTB)
#define PG8_STAGE(bufoff, gbase, voff) do { _Pragma("unroll") for (int _i = 0; _i < 2; ++_i) \
        __builtin_amdgcn_global_load_lds((const unsigned*)((const char*)(gbase) + (voff)[_i]), (PG8_LAS unsigned*)(lds + (bufoff) + ldsw + _i * 8192), 16, 0, 0); } while (0)
#define PG8_LDA(dst, b, h) do { _Pragma("unroll") for (int m = 0; m < 4; ++m) _Pragma("unroll") for (int k = 0; k < 2; ++k) dst[m][k] = *(const PG8_LAS bf16x8*)(lds + PG8_SA(b, h) + aoff + m * 2048 + k * 1024); } while (0)
#define PG8_LDB(dst, b, h) do { _Pragma("unroll") for (int n = 0; n < 2; ++n) _Pragma("unroll") for (int k = 0; k < 2; ++k) dst[n][k] = *(const PG8_LAS bf16x8*)(lds + PG8_SB(b, h) + boff + n * 2048 + k * 1024); } while (0)
#define PG8_MMA(ai, bj, At, Bt) do { __builtin_amdgcn_s_setprio(1); _Pragma("unroll") for (int m = 0; m < 4; ++m) _Pragma("unroll") for (int n = 0; n < 2; ++n) _Pragma("unroll") for (int k = 0; k < 2; ++k) \
        acc[ai][bj][m][n] = __builtin_amdgcn_mfma_f32_16x16x32_bf16(Bt[n][k], At[m][k], acc[ai][bj][m][n], 0, 0, 0); __builtin_amdgcn_s_setprio(0); } while (0)
#define PG8_WAIT_V(n) asm volatile("s_waitcnt vmcnt(" #n ")" ::: "memory")
#define PG8_WAIT_L(n) asm volatile("s_waitcnt lgkmcnt(" #n ")" ::: "memory")
#define PG8_BAR __builtin_amdgcn_s_barrier()
#define PG8_SCHED __builtin_amdgcn_sched_barrier(0)
    Unit cur, nxt; int ui = 0;
    if (!S.next(0, cur)) return;
    f32x4 acc[2][2][4][2];
#pragma unroll
    for (int a = 0; a < 2; ++a)
#pragma unroll
        for (int b = 0; b < 2; ++b)
#pragma unroll
            for (int m = 0; m < 4; ++m)
#pragma unroll
                for (int n = 0; n < 2; ++n) acc[a][b][m][n] = (f32x4){0.f, 0.f, 0.f, 0.f};
    bf16x8 At[4][2], B0[2][2], B1[2][2];
    const char* cA = (const char*)g.A + (size_t)cur.pm * tstep; const char* cB = (const char*)g.Bt + (size_t)cur.pn * tstep;
    S.a_ready(cur);
    if constexpr (SP2) {
        PG8_STAGE(PG8_SB(0, 0), cB, voffB); PG8_STAGE(PG8_SB(0, 1), cB + hstep, voffB); PG8_STAGE(PG8_SA(0, 0), cA, voffA); PG8_STAGE(PG8_SA(0, 1), cA + hstep, voffA);
        if (wr == 1) PG8_BAR;
        PG8_WAIT_V(2); PG8_BAR;
        PG8_STAGE(PG8_SB(1, 0), cB + kstep, voffB); PG8_STAGE(PG8_SA(1, 0), cA + kstep, voffA); PG8_STAGE(PG8_SB(1, 1), cB + hstep + kstep, voffB);
        PG8_WAIT_V(6); PG8_BAR;
    } else {
        PG8_STAGE(PG8_SB(0, 0), cB, voffB); PG8_STAGE(PG8_SA(0, 0), cA, voffA); PG8_STAGE(PG8_SB(0, 1), cB + hstep, voffB); PG8_STAGE(PG8_SA(0, 1), cA + hstep, voffA);
        if (wr == 1) PG8_BAR;
        PG8_WAIT_V(4); PG8_BAR;
        PG8_STAGE(PG8_SB(1, 0), cB + kstep, voffB); PG8_STAGE(PG8_SA(1, 0), cA + kstep, voffA); PG8_STAGE(PG8_SB(1, 1), cB + hstep + kstep, voffB);
        PG8_WAIT_V(6); PG8_BAR;
    }
    for (;;) {
        const bool has_next = S.next(ui + 1, nxt);
        const char* nA = has_next ? (const char*)g.A + (size_t)nxt.pm * tstep : cA; const char* nB = has_next ? (const char*)g.Bt + (size_t)nxt.pn * tstep : cB;
        for (int t = 0; t < nt; t += 2) {
            const bool last = (t == nt - 2);
            const char* a1 = cA + (size_t)(t + 1) * kstep;
            const char* a2 = last ? nA : cA + (size_t)(t + 2) * kstep; const char* b2 = last ? nB : cB + (size_t)(t + 2) * kstep;
            const char* a3 = a2 + kstep; const char* b3 = b2 + kstep;
            if (last && has_next) S.a_ready(nxt);
            if constexpr (SP2) {
            PG8_LDB(B0, 0, 0); PG8_LDB(B1, 0, 1); PG8_SCHED; PG8_LDA(At, 0, 0); PG8_STAGE(PG8_SA(1, 1), a1 + hstep, voffA);
            PG8_WAIT_V(8); PG8_WAIT_L(0); PG8_BAR; PG8_MMA(0, 0, At, B0); PG8_MMA(0, 1, At, B1); PG8_BAR; PG8_SCHED;
            PG8_LDA(At, 0, 1); PG8_STAGE(PG8_SB(0, 0), b2, voffB); PG8_STAGE(PG8_SB(0, 1), b2 + hstep, voffB); PG8_STAGE(PG8_SA(0, 0), a2, voffA);
            PG8_WAIT_V(8); PG8_WAIT_L(0); PG8_BAR; PG8_MMA(1, 0, At, B0); PG8_MMA(1, 1, At, B1); PG8_BAR; PG8_SCHED;
            PG8_LDB(B0, 1, 0); PG8_LDB(B1, 1, 1); PG8_SCHED; PG8_LDA(At, 1, 0); PG8_STAGE(PG8_SA(0, 1), a2 + hstep, voffA);
            PG8_WAIT_V(8); PG8_WAIT_L(0); PG8_BAR; PG8_MMA(0, 0, At, B0); PG8_MMA(0, 1, At, B1); PG8_BAR; PG8_SCHED;
            PG8_LDA(At, 1, 1); PG8_STAGE(PG8_SB(1, 0), b3, voffB); PG8_STAGE(PG8_SB(1, 1), b3 + hstep, voffB); PG8_STAGE(PG8_SA(1, 0), a3, voffA);
            PG8_WAIT_V(8); PG8_WAIT_L(0); PG8_BAR; PG8_MMA(1, 0, At, B0); PG8_MMA(1, 1, At, B1); PG8_BAR; PG8_SCHED;
            } else {
            PG8_LDB(B0, 0, 0); PG8_SCHED; PG8_LDA(At, 0, 0); PG8_STAGE(PG8_SA(1, 1), a1 + hstep, voffA);
            PG8_WAIT_L(8); PG8_BAR; PG8_WAIT_L(0); PG8_MMA(0, 0, At, B0); PG8_BAR; PG8_SCHED;
            PG8_LDB(B1, 0, 1); PG8_STAGE(PG8_SB(0, 0), b2, voffB);
            PG8_BAR; PG8_WAIT_L(0); PG8_MMA(0, 1, At, B1); PG8_BAR;
            PG8_LDA(At, 0, 1); PG8_STAGE(PG8_SA(0, 0), a2, voffA);
            PG8_BAR; PG8_WAIT_L(0); PG8_MMA(1, 0, At, B0); PG8_BAR; PG8_SCHED;
            PG8_STAGE(PG8_SB(0, 1), b2 + hstep, voffB);
            PG8_WAIT_V(6); PG8_BAR; PG8_MMA(1, 1, At, B1); PG8_BAR;
            PG8_LDB(B0, 1, 0); PG8_SCHED; PG8_LDA(At, 1, 0); PG8_STAGE(PG8_SA(0, 1), a2 + hstep, voffA);
            PG8_WAIT_L(8); PG8_BAR; PG8_WAIT_L(0); PG8_MMA(0, 0, At, B0); PG8_BAR; PG8_SCHED;
            PG8_LDB(B1, 1, 1); PG8_STAGE(PG8_SB(1, 0), b3, voffB);
            PG8_BAR; PG8_WAIT_L(0); PG8_MMA(0, 1, At, B1); PG8_BAR;
            PG8_LDA(At, 1, 1); PG8_STAGE(PG8_SA(1, 0), a3, voffA);
            PG8_BAR; PG8_WAIT_L(0); PG8_MMA(1, 0, At, B0); PG8_BAR; PG8_SCHED;
            PG8_STAGE(PG8_SB(1, 1), b3 + hstep, voffB);
            PG8_WAIT_V(6); PG8_BAR; PG8_MMA(1, 1, At, B1); PG8_BAR;
            }
        }
        if constexpr (ALIGN_EPI) { if (wr == 0) PG8_BAR; }
        if constexpr (!Epi::AFTER_DRAIN) { E(acc, cur, wr, wc, fr, fq); S.done(cur); }
        if (!has_next) break;
#pragma unroll
        for (int a = 0; a < 2; ++a)
#pragma unroll
            for (int b = 0; b < 2; ++b)
#pragma unroll
                for (int m = 0; m < 4; ++m)
#pragma unroll
                    for (int n = 0; n < 2; ++n) acc[a][b][m][n] = (f32x4){0.f, 0.f, 0.f, 0.f};
        cur = nxt; cA = nA; cB = nB; ++ui;
        if constexpr (ALIGN_EPI) { if (wr == 1) PG8_BAR; }
    }
    PG8_WAIT_V(0);
    if constexpr (!ALIGN_EPI) { if (wr == 0) PG8_BAR; }
    PG8_BAR;
    if constexpr (Epi::AFTER_DRAIN) { E.fused(acc, cur, wr, wc, fr, fq, lds, wid, lane); S.done(cur); }
#undef PG8_SA
#undef PG8_SB
#undef PG8_STAGE
#undef PG8_LDA
#undef PG8_LDB
#undef PG8_MMA
#undef PG8_WAIT_V
#undef PG8_WAIT_L
#undef PG8_BAR
#undef PG8_SCHED
}
}
#define GAS __attribute__((address_space(1)))
#define LAS __attribute__((address_space(3)))
typedef unsigned short bf16;
typedef unsigned v4u __attribute__((ext_vector_type(4)));
typedef float f32x4 __attribute__((ext_vector_type(4)));
typedef short bf16x8 __attribute__((ext_vector_type(8)));
typedef GAS unsigned gu32;
typedef GAS unsigned long long gu64;
#define RLX_AGENT __ATOMIC_RELAXED, __HIP_MEMORY_SCOPE_AGENT
#define LDS_WAIT() asm volatile("s_waitcnt lgkmcnt(0)" ::: "memory")
#define VM_WAIT() asm volatile("s_waitcnt vmcnt(0)" ::: "memory")
__device__ __forceinline__ unsigned long long rt() { return __builtin_amdgcn_s_memrealtime(); }
#define XB_TMO      128
#define XB_XCNT(j)  (256  + 64 * (j))
#define XB_XSUB(j)  (1280 + 64 * (j))
#define XB_XGEN(j)  (2304 + 64 * (j))
#define XB_TOP      3328
#define XB_TOPGEN   3392
#define XCD_BAR_WORDS 3456
#define XB_SPIN_CAP (1u << 18)

__device__ __forceinline__ unsigned xb_ld(unsigned* p)              { return __hip_atomic_load(p, __ATOMIC_RELAXED, __HIP_MEMORY_SCOPE_AGENT); }
__device__ __forceinline__ unsigned xb_add(unsigned* p, unsigned v) { return __hip_atomic_fetch_add(p, v, __ATOMIC_RELAXED, __HIP_MEMORY_SCOPE_AGENT); }
__device__ __forceinline__ unsigned xb_xcc_id() { return (unsigned)__builtin_amdgcn_s_getreg((3 << 11) | 20) & 0xFu; }
#define XB_SPIN(cond, bar) do { unsigned _sp = 0; while (cond) { __builtin_amdgcn_s_sleep(1); \
    if ((++_sp & 255u) == 0u) { if (xb_ld(&(bar)[XB_TMO])) break; if (_sp > XB_SPIN_CAP) { atomicAdd(&(bar)[XB_TMO], 1u); break; } } } } while (0)

struct XcdBarrier {
    unsigned* bar; unsigned x;
    volatile LAS unsigned* st;
};

__device__ __forceinline__ XcdBarrier xcd_barrier_post(unsigned* bar, volatile LAS unsigned* st) {
    XcdBarrier b; b.bar = bar; b.x = xb_xcc_id(); b.st = st;
    if (threadIdx.x == 0) (void)xb_add(&bar[XB_XCNT(b.x)], 1u);
    return b;
}
__device__ __forceinline__ void xcd_barrier_complete(unsigned* bar, unsigned x, unsigned& nloc, unsigned& nx) {
    const unsigned G = gridDim.x * gridDim.y * gridDim.z;
    unsigned sum, cnt, mine, sp = 0u;
    for (;;) {
        sum = 0u; cnt = 0u; mine = 0u;
#pragma unroll
        for (unsigned j = 0; j < 16; ++j) { const unsigned c = xb_ld(&bar[XB_XCNT(j)]); sum += c; cnt += (c > 0u) ? 1u : 0u; mine = (j == x) ? c : mine; }
        if (sum == G) break;
        __builtin_amdgcn_s_sleep(1);
        if ((++sp & 255u) == 0u) { if (xb_ld(&bar[XB_TMO])) break; if (sp > XB_SPIN_CAP) { atomicAdd(&bar[XB_TMO], 1u); break; } }
    }
    nloc = mine > 0u ? mine : 1u; nx = cnt > 0u ? cnt : 1u;
}

__device__ __forceinline__ void xcd_barrier(const XcdBarrier& b) {
    asm volatile("s_waitcnt vmcnt(0)" ::: "memory");
    __syncthreads();
    if (threadIdx.x == 0) {
        unsigned* bar = b.bar;
        __builtin_amdgcn_s_waitcnt(0);
        unsigned nloc = b.st[0], nx = b.st[1];
        if (nloc == 0u) { xcd_barrier_complete(bar, b.x, nloc, nx); b.st[0] = nloc; b.st[1] = nx; }
        const unsigned old = xb_add(&bar[XB_XSUB(b.x)], 1u);
        const unsigned gen = old / nloc;
        if (old + 1u == (gen + 1u) * nloc) {
            __builtin_amdgcn_fence(__ATOMIC_RELEASE, "agent");
            asm volatile("s_waitcnt vmcnt(0)" ::: "memory");
            const unsigned og = xb_add(&bar[XB_TOP], 1u);
            const unsigned tg = og / nx;
            if (og + 1u == (tg + 1u) * nx) xb_add(&bar[XB_TOPGEN], 1u);
            else XB_SPIN(xb_ld(&bar[XB_TOPGEN]) == tg, bar);
            __builtin_amdgcn_fence(__ATOMIC_ACQUIRE, "agent");
            xb_add(&bar[XB_XGEN(b.x)], 1u);
            asm volatile("s_waitcnt vmcnt(0)" ::: "memory");
        } else {
            XB_SPIN(xb_ld(&bar[XB_XGEN(b.x)]) == gen, bar);
            __builtin_amdgcn_fence(__ATOMIC_ACQUIRE, "agent");
            asm volatile("s_waitcnt vmcnt(0)" ::: "memory");
        }
    }
    __syncthreads();
}
namespace att {
using bf16x8 = __attribute__((ext_vector_type(8))) short;
using s16x4  = __attribute__((ext_vector_type(4))) short;
using f32x16 = __attribute__((ext_vector_type(16))) float;
using f32x4v = __attribute__((ext_vector_type(4))) float;
using u32x4  = __attribute__((ext_vector_type(4))) unsigned;
constexpr int NW = 8, QBLK = 32, KVBLK = 64;
constexpr float THRL = 6.f;
#define ASBAR() __builtin_amdgcn_sched_barrier(0)
__device__ __forceinline__ int crow(int r, int hi) { return (r & 3) + 8 * (r >> 2) + 4 * hi; }
__device__ __forceinline__ unsigned cvtpk(float lo, float hi) { unsigned r; asm volatile("v_cvt_pk_bf16_f32 %0, %1, %2" : "=v"(r) : "v"(lo), "v"(hi)); return r; }
template <int DQK> struct Cfg {
    static constexpr int KROW = DQK * 2 + 16;
    static constexpr int SHM_V = 8192, SHM_K = 64 * KROW;
    static constexpr int OFF_V = 0, OFF_K = 2 * SHM_V, OFF_WS = OFF_K + 2 * SHM_K, OFF_OST = OFF_WS + NW * 256, OSTW = 32 * 68 * 4, END = OFF_OST + NW * OSTW;
    static constexpr int KCH = DQK / 8;
};
__device__ __forceinline__ void partialSM(f32x16& p0, f32x16& p1, float& m_reg, float& mn, float& alpha) {
    float pmax = p0[0];
#pragma unroll
    for (int r = 1; r < 16; ++r) pmax = fmaxf(pmax, p0[r]);
#pragma unroll
    for (int r = 0; r < 16; ++r) pmax = fmaxf(pmax, p1[r]);
    { auto rr = __builtin_amdgcn_permlane32_swap(__float_as_uint(pmax), __float_as_uint(pmax), false, false); pmax = fmaxf(__uint_as_float(rr[0]), __uint_as_float(rr[1])); }
    if (__builtin_expect(__all(pmax - m_reg <= THRL), 1)) { mn = m_reg; alpha = 1.f; }
    else { mn = fmaxf(m_reg, pmax); alpha = __builtin_amdgcn_exp2f(m_reg - mn); m_reg = mn; }
#pragma unroll
    for (int r = 0; r < 16; ++r) p0[r] -= mn;
#pragma unroll
    for (int r = 0; r < 16; ++r) p1[r] -= mn;
#pragma unroll
    for (int r = 0; r < 16; ++r) p0[r] = __builtin_amdgcn_exp2f(p0[r]);
}
__device__ __forceinline__ void finishSM(f32x16& p0, f32x16& p1, float alpha, float& l_reg, bf16x8& pa0, bf16x8& pa1, bf16x8& pa2, bf16x8& pa3) {
#pragma unroll
    for (int r = 0; r < 16; ++r) p1[r] = __builtin_amdgcn_exp2f(p1[r]);
    float ps = 0;
#pragma unroll
    for (int r = 0; r < 16; ++r) ps += p0[r];
#pragma unroll
    for (int r = 0; r < 16; ++r) ps += p1[r];
    { auto rr = __builtin_amdgcn_permlane32_swap(__float_as_uint(ps), __float_as_uint(ps), false, false); ps = __uint_as_float(rr[0]) + __uint_as_float(rr[1]); }
    l_reg = l_reg * alpha + ps;
#define ATT_PK4(P, BASE, OUT) do { unsigned a0 = cvtpk(P[BASE + 0], P[BASE + 1]), a1 = cvtpk(P[BASE + 2], P[BASE + 3]);   \
    unsigned b0 = cvtpk(P[BASE + 4], P[BASE + 5]), b1 = cvtpk(P[BASE + 6], P[BASE + 7]);                              \
    auto r0 = __builtin_amdgcn_permlane32_swap(a0, b0, false, false); auto r1 = __builtin_amdgcn_permlane32_swap(a1, b1, false, false); \
    u32x4 w = {r0[0], r1[0], r0[1], r1[1]}; OUT = *reinterpret_cast<bf16x8*>(&w); } while (0)
    ATT_PK4(p0, 0, pa0); ATT_PK4(p0, 8, pa1); ATT_PK4(p1, 0, pa2); ATT_PK4(p1, 8, pa3);
#undef ATT_PK4
}
template <int DQK> __device__ __forceinline__ void qkt(f32x16& p0, f32x16& p1, const char* Ks, const bf16x8* qr, int r32, int hi) {
    constexpr int KROW = Cfg<DQK>::KROW;
    p0 = f32x16{}; p1 = f32x16{};
#pragma unroll
    for (int d0 = 0; d0 < DQK / 16; ++d0) { const int cb = (d0 * 16 + hi * 8) * 2;
        const bf16x8 b0 = *reinterpret_cast<const bf16x8*>(Ks + r32 * KROW + cb);
        const bf16x8 b1 = *reinterpret_cast<const bf16x8*>(Ks + (32 + r32) * KROW + cb);
        p0 = __builtin_amdgcn_mfma_f32_32x32x16_bf16(b0, qr[d0], p0, 0, 0, 0);
        p1 = __builtin_amdgcn_mfma_f32_32x32x16_bf16(b1, qr[d0], p1, 0, 0, 0); }
}
__device__ __forceinline__ int v_st(int k, int c) { const int kk = (k & ~0xC) | ((k & 4) << 1) | ((k & 8) >> 1); return ((kk >> 3) * 2 + (c >> 5)) * 512 + ((kk & 7) * 32 + (c & 31)) * 2; }
__device__ __forceinline__ int v_rd_base(int lane) { return ((lane & 3) << 3) | (((lane >> 2) & 3) << 6) | (((lane >> 4) & 1) << 5) | (((lane >> 5) & 1) << 8); }
constexpr int v_rd_off(int d0, int ks, int half) { return d0 * 512 + ks * 2048 + half * 1024; }
template <int OFF> __device__ __forceinline__ s16x4 tr_read(int vb) { s16x4 r; asm volatile("ds_read_b64_tr_b16 %0, %1 offset:%2" : "=&v"(r) : "v"(vb), "i"(OFF) : "memory"); return r; }
template <int D0> __device__ __forceinline__ void pv_one(f32x16& od, int vb, bf16x8 pa0, bf16x8 pa1, bf16x8 pa2, bf16x8 pa3) {
    const s16x4 l0 = tr_read<v_rd_off(D0, 0, 0)>(vb), h0 = tr_read<v_rd_off(D0, 0, 1)>(vb), l1 = tr_read<v_rd_off(D0, 1, 0)>(vb), h1 = tr_read<v_rd_off(D0, 1, 1)>(vb);
    const s16x4 l2 = tr_read<v_rd_off(D0, 2, 0)>(vb), h2 = tr_read<v_rd_off(D0, 2, 1)>(vb), l3 = tr_read<v_rd_off(D0, 3, 0)>(vb), h3 = tr_read<v_rd_off(D0, 3, 1)>(vb);
    asm volatile("s_waitcnt lgkmcnt(0)" ::: "memory"); ASBAR();
#define ATT_PK(L, H) (bf16x8){L[0], L[1], L[2], L[3], H[0], H[1], H[2], H[3]}
    od = __builtin_amdgcn_mfma_f32_32x32x16_bf16(pa0, ATT_PK(l0, h0), od, 0, 0, 0);
    od = __builtin_amdgcn_mfma_f32_32x32x16_bf16(pa1, ATT_PK(l1, h1), od, 0, 0, 0);
    od = __builtin_amdgcn_mfma_f32_32x32x16_bf16(pa2, ATT_PK(l2, h2), od, 0, 0, 0);
    od = __builtin_amdgcn_mfma_f32_32x32x16_bf16(pa3, ATT_PK(l3, h3), od, 0, 0, 0);
#undef ATT_PK
}
__device__ __forceinline__ void pv_d0(f32x16* o, int vb, bf16x8 pa0, bf16x8 pa1, bf16x8 pa2, bf16x8 pa3) { pv_one<0>(o[0], vb, pa0, pa1, pa2, pa3); pv_one<1>(o[1], vb, pa0, pa1, pa2, pa3); }

template <int DQK>
__device__ __forceinline__ void attn_unit(const bf16_t* __restrict__ Qb, int ldq, const bf16_t* __restrict__ Kh, int ldk, const bf16_t* __restrict__ Vh, int ldv, int seq,
                                          bf16_t* __restrict__ Ob, const bf16_t* __restrict__ Gb, char* lds) {
    using C = Cfg<DQK>;
    constexpr int KROW = C::KROW, KCH = C::KCH, SHM_V = C::SHM_V, SHM_K = C::SHM_K;
    const int tid = threadIdx.x, wid = tid >> 6, lane = tid & 63, r32 = lane & 31, hi = lane >> 5;
    char* V_lds = lds + C::OFF_V; char* K_lds = lds + C::OFF_K;
    float* ws = (float*)(lds + C::OFF_WS) + wid * 64; float* li_l = ws; float* al_l = ws + 32;
    float m_reg = -1e30f, l_reg = 0; f32x16 o[2] = {}; bf16x8 qr[DQK / 16];
    const bf16_t* Qw = Qb + (size_t)(wid * QBLK + r32) * ldq + hi * 8;
#pragma unroll
    for (int d0 = 0; d0 < DQK / 16; ++d0) qr[d0] = *reinterpret_cast<const bf16x8*>(Qw + d0 * 16);
    const int vk = tid >> 3, vc = (tid & 7) * 8, vst = v_st(vk, vc);
    const int kr0 = tid / KCH, kc0 = (tid % KCH) * 8, kr1 = (512 + tid) / KCH, kc1 = ((512 + tid) % KCH) * 8;
    const bool two = (KCH * 64 > 512) && (tid < KCH * 64 - 512);
    const int vb0 = (int)(uintptr_t)V_lds + v_rd_base(lane);
    constexpr int SDEPTH = (DQK > 64) ? 1 : 2;
    struct { bf16x8 vs, ks0, ks1; } sr_[SDEPTH];
#define ATT_SLOAD(i, k0) do { sr_[i].vs = *reinterpret_cast<const bf16x8*>(Vh + (size_t)((k0) + vk) * ldv + vc); \
    sr_[i].ks0 = *reinterpret_cast<const bf16x8*>(Kh + (size_t)((k0) + kr0) * ldk + kc0); \
    if (two) sr_[i].ks1 = *reinterpret_cast<const bf16x8*>(Kh + (size_t)((k0) + kr1) * ldk + kc1); } while (0)
#define ATT_SWRITE(b, i) do { *(bf16x8*)(V_lds + (b) * SHM_V + vst) = sr_[i].vs; *(bf16x8*)(K_lds + (b) * SHM_K + kr0 * KROW + kc0 * 2) = sr_[i].ks0; \
    if (two) *(bf16x8*)(K_lds + (b) * SHM_K + kr1 * KROW + kc1 * 2) = sr_[i].ks1; } while (0)
#define ATT_SWAIT() do { if constexpr (SDEPTH == 2) asm volatile("s_waitcnt vmcnt(2)" ::: "memory"); else asm volatile("s_waitcnt vmcnt(0)" ::: "memory"); } while (0)
#define ATT_RESC(a) do { if (__any((a) < 1.f)) { if (hi == 0) al_l[r32] = (a); asm volatile("s_waitcnt lgkmcnt(0)" ::: "memory"); \
    _Pragma("unroll") for (int d = 0; d < 2; ++d) _Pragma("unroll") for (int r = 0; r < 16; ++r) o[d][r] *= al_l[crow(r, hi)]; } } while (0)
    f32x16 pA0, pA1, pB0, pB1; float mnA, mnB, alA, alB; bf16x8 pa0, pa1, pa2, pa3; const int NT = seq / KVBLK;
    constexpr int SE = 0, SO = SDEPTH - 1;
    ATT_SLOAD(SE, 0); asm volatile("s_waitcnt vmcnt(0)" ::: "memory"); ATT_SWRITE(0, SE); __syncthreads();
    qkt<DQK>(pA0, pA1, K_lds, qr, r32, hi); partialSM(pA0, pA1, m_reg, mnA, alA);
    ATT_SLOAD(SO, KVBLK); if constexpr (SDEPTH == 2) { if (2 < NT) ATT_SLOAD(SE, 2 * KVBLK); }
    ATT_SWAIT(); ATT_SWRITE(1, SO); __syncthreads();
    for (int j = 1; j + 1 < NT; j += 2) {
        ASBAR(); qkt<DQK>(pB0, pB1, K_lds + SHM_K, qr, r32, hi);
        finishSM(pA0, pA1, alA, l_reg, pa0, pa1, pa2, pa3); ASBAR();
        ATT_SLOAD(SO, (j + SDEPTH) * KVBLK); ASBAR();
        pv_d0(o, vb0, pa0, pa1, pa2, pa3); partialSM(pB0, pB1, m_reg, mnB, alB);
        __syncthreads(); ATT_SWAIT(); ATT_SWRITE(0, SE);
        ATT_RESC(alB); __syncthreads();
        ASBAR(); qkt<DQK>(pA0, pA1, K_lds, qr, r32, hi);
        finishSM(pB0, pB1, alB, l_reg, pa0, pa1, pa2, pa3); ASBAR();
        if (SDEPTH == 1 || j + 3 < NT) ATT_SLOAD(SE, (j + 1 + SDEPTH) * KVBLK); ASBAR();
        pv_d0(o, vb0 + SHM_V, pa0, pa1, pa2, pa3); partialSM(pA0, pA1, m_reg, mnA, alA);
        __syncthreads(); ATT_SWAIT(); ATT_SWRITE(1, SO);
        ATT_RESC(alA); __syncthreads();
    }
    ASBAR(); qkt<DQK>(pB0, pB1, K_lds + SHM_K, qr, r32, hi);
    finishSM(pA0, pA1, alA, l_reg, pa0, pa1, pa2, pa3); ASBAR();
    pv_d0(o, vb0, pa0, pa1, pa2, pa3); partialSM(pB0, pB1, m_reg, mnB, alB);
    __syncthreads(); ATT_RESC(alB);
    finishSM(pB0, pB1, alB, l_reg, pa0, pa1, pa2, pa3); ASBAR();
    pv_d0(o, vb0 + SHM_V, pa0, pa1, pa2, pa3);
    if (hi == 0) li_l[r32] = l_reg; asm volatile("s_waitcnt lgkmcnt(0)" ::: "memory");
    float* stg = (float*)(lds + C::OFF_OST + wid * C::OSTW);
#pragma unroll
    for (int r = 0; r < 16; ++r) { const int orow = crow(r, hi); const float rli = __builtin_amdgcn_rcpf(li_l[orow]);
        stg[orow * 68 + r32] = o[0][r] * rli; stg[orow * 68 + 32 + r32] = o[1][r] * rli; }
    asm volatile("s_waitcnt lgkmcnt(0)" ::: "memory");
#pragma unroll
    for (int i = 0; i < 4; ++i) { const int row = i * 8 + (lane >> 3), ch = (lane & 7) * 8;
        const f32x4v a = *(const f32x4v*)(stg + row * 68 + ch), b = *(const f32x4v*)(stg + row * 68 + ch + 4);
        const size_t off = (size_t)(wid * QBLK + row) * 1024 + ch; const u32x4 g = *(const u32x4*)(Gb + off); u32x4 w;
        w.x = cvtpk(a[0] * __uint_as_float(g.x << 16), a[1] * __uint_as_float(g.x & 0xffff0000u)); w.y = cvtpk(a[2] * __uint_as_float(g.y << 16), a[3] * __uint_as_float(g.y & 0xffff0000u));
        w.z = cvtpk(b[0] * __uint_as_float(g.z << 16), b[1] * __uint_as_float(g.z & 0xffff0000u)); w.w = cvtpk(b[2] * __uint_as_float(g.w << 16), b[3] * __uint_as_float(g.w & 0xffff0000u));
        *(u32x4*)(Ob + off) = w; }
    __syncthreads();
#undef ATT_SLOAD
#undef ATT_SWRITE
#undef ATT_SWAIT
#undef ATT_RESC
}
#undef ASBAR
}
namespace fft {
using bf16x8 = __attribute__((ext_vector_type(8))) short;
using s16x4  = __attribute__((ext_vector_type(4))) short;
using f32x16 = __attribute__((ext_vector_type(16))) float;
using f32x4v = __attribute__((ext_vector_type(4))) float;
using u32x4  = __attribute__((ext_vector_type(4))) unsigned;
constexpr int OFF_X = 0, OFF_STG = 65536;
__device__ __forceinline__ int crow(int r, int hi) { return (r & 3) + 8 * (r >> 2) + 4 * hi; }
__device__ __forceinline__ unsigned cvtpk(float lo, float hi) { unsigned r; asm volatile("v_cvt_pk_bf16_f32 %0, %1, %2" : "=v"(r) : "v"(lo), "v"(hi)); return r; }
__device__ __forceinline__ int x_st(int kk, int c) { const int kp = (kk & ~0xC) | ((kk & 4) << 1) | ((kk & 8) >> 1); return ((kp >> 3) * 8 + (c >> 5)) * 512 + ((kp & 7) * 32 + (c & 31)) * 2; }
__device__ __forceinline__ int x_rd_base(int lane) { return ((lane & 3) << 3) | (((lane >> 2) & 3) << 6) | (((lane >> 4) & 1) << 5) | (((lane >> 5) & 1) << 8); }
constexpr int x_rd_off(int nb, int ks, int half) { return ks * 8192 + half * 4096 + nb * 512; }
template <int OFF> __device__ __forceinline__ s16x4 tr_read(int vb) { s16x4 r; asm volatile("ds_read_b64_tr_b16 %0, %1 offset:%2" : "=&v"(r) : "v"(vb), "i"(OFF) : "memory"); return r; }
template <int NB> __device__ __forceinline__ void mm_block(f32x16& acc, const bf16x8 (&afr)[8], int vb) {
#define FFT_PK(L, H) (bf16x8){L[0], L[1], L[2], L[3], H[0], H[1], H[2], H[3]}
    { const s16x4 l0 = tr_read<x_rd_off(NB, 0, 0)>(vb), h0 = tr_read<x_rd_off(NB, 0, 1)>(vb), l1 = tr_read<x_rd_off(NB, 1, 0)>(vb), h1 = tr_read<x_rd_off(NB, 1, 1)>(vb);
      const s16x4 l2 = tr_read<x_rd_off(NB, 2, 0)>(vb), h2 = tr_read<x_rd_off(NB, 2, 1)>(vb), l3 = tr_read<x_rd_off(NB, 3, 0)>(vb), h3 = tr_read<x_rd_off(NB, 3, 1)>(vb);
      asm volatile("s_waitcnt lgkmcnt(0)" ::: "memory"); __builtin_amdgcn_sched_barrier(0);
      acc = __builtin_amdgcn_mfma_f32_32x32x16_bf16(afr[0], FFT_PK(l0, h0), acc, 0, 0, 0); acc = __builtin_amdgcn_mfma_f32_32x32x16_bf16(afr[1], FFT_PK(l1, h1), acc, 0, 0, 0);
      acc = __builtin_amdgcn_mfma_f32_32x32x16_bf16(afr[2], FFT_PK(l2, h2), acc, 0, 0, 0); acc = __builtin_amdgcn_mfma_f32_32x32x16_bf16(afr[3], FFT_PK(l3, h3), acc, 0, 0, 0); }
    { const s16x4 l0 = tr_read<x_rd_off(NB, 4, 0)>(vb), h0 = tr_read<x_rd_off(NB, 4, 1)>(vb), l1 = tr_read<x_rd_off(NB, 5, 0)>(vb), h1 = tr_read<x_rd_off(NB, 5, 1)>(vb);
      const s16x4 l2 = tr_read<x_rd_off(NB, 6, 0)>(vb), h2 = tr_read<x_rd_off(NB, 6, 1)>(vb), l3 = tr_read<x_rd_off(NB, 7, 0)>(vb), h3 = tr_read<x_rd_off(NB, 7, 1)>(vb);
      asm volatile("s_waitcnt lgkmcnt(0)" ::: "memory"); __builtin_amdgcn_sched_barrier(0);
      acc = __builtin_amdgcn_mfma_f32_32x32x16_bf16(afr[4], FFT_PK(l0, h0), acc, 0, 0, 0); acc = __builtin_amdgcn_mfma_f32_32x32x16_bf16(afr[5], FFT_PK(l1, h1), acc, 0, 0, 0);
      acc = __builtin_amdgcn_mfma_f32_32x32x16_bf16(afr[6], FFT_PK(l2, h2), acc, 0, 0, 0); acc = __builtin_amdgcn_mfma_f32_32x32x16_bf16(afr[7], FFT_PK(l3, h3), acc, 0, 0, 0); }
#undef FFT_PK
}
struct TileRegs { bf16x8 v[8]; };
__device__ __forceinline__ void tile_load(TileRegs& t, const bf16_t* src  , size_t rowstride, int tid) {
    const bf16_t* p = src + (size_t)(tid >> 5) * rowstride + (tid & 31) * 8;
#pragma unroll
    for (int i = 0; i < 8; ++i) t.v[i] = *reinterpret_cast<const bf16x8*>(p + (size_t)(16 * i) * rowstride);
}
__device__ __forceinline__ void tile_write(const TileRegs& t, char* xl, int tid) {
    char* p = xl + x_st(tid >> 5, (tid & 31) * 8);
#pragma unroll
    for (int i = 0; i < 8; ++i) *reinterpret_cast<bf16x8*>(p + 8192 * i) = t.v[i];
}

__device__ __forceinline__ void stage_a(const bf16_t* __restrict__ PQ, bf16_t* __restrict__ Y, char* lds, int vcu, int G) {
    const int tid = threadIdx.x, wid = tid >> 6, lane = tid & 63, r32 = lane & 31, hi = lane >> 5, w = wid & 3, nh = wid >> 2;
    char* xl = lds + OFF_X; char* stg = lds + OFF_STG + wid * 8192;
    bf16x8 afr[8];
    { const int reim = r32 >> 4, k1 = 16 * w + (r32 & 15);
#pragma unroll
      for (int ks = 0; ks < 8; ++ks) { float v[8];
#pragma unroll
          for (int j = 0; j < 8; ++j) { const int kk = 16 * ks + 8 * hi + j, s1 = kk >> 1, pq = kk & 1; const float f = (float)((k1 * s1) & 63) * (1.f / 64.f);
              const float c = __builtin_amdgcn_cosf(f) * 0.125f, s = __builtin_amdgcn_sinf(f) * 0.125f; v[j] = reim == 0 ? (pq == 0 ? c : -s) : (pq == 0 ? s : c); }
          u32x4 p = {cvtpk(v[0], v[1]), cvtpk(v[2], v[3]), cvtpk(v[4], v[5]), cvtpk(v[6], v[7])}; afr[ks] = *reinterpret_cast<bf16x8*>(&p); } }
    const int vb = (int)(uintptr_t)xl + x_rd_base(lane) + nh * 4 * 512;
    constexpr int NU = NB * 192;
    TileRegs tr;
    int u = vcu;
    if (u < NU) tile_load(tr, PQ + (size_t)(u / 192) * 128 * 49152 + (u % 192) * 256, 49152, tid);
    for (; u < NU; u += G) {
        const int b = u / 192, j = u % 192;
        tile_write(tr, xl, tid);
        __syncthreads();
        { const int un = u + G; if (un < NU) tile_load(tr, PQ + (size_t)(un / 192) * 128 * 49152 + (un % 192) * 256, 49152, tid); }
        f32x16 acc[4] = {};
        mm_block<0>(acc[0], afr, vb); mm_block<1>(acc[1], afr, vb); mm_block<2>(acc[2], afr, vb); mm_block<3>(acc[3], afr, vb);
        const int s2 = j / 3;
#pragma unroll
        for (int r = 0; r < 8; ++r) { const int kl = crow(r, hi), k1 = 16 * w + kl; const float f = (float)(k1 * s2) * (1.f / 4096.f); const float tr_ = __builtin_amdgcn_cosf(f), ti_ = __builtin_amdgcn_sinf(f);
#pragma unroll
            for (int nb = 0; nb < 4; ++nb) { const float re = acc[nb][r], im = acc[nb][r + 8];
                *(bf16_t*)(stg + kl * 256 + (nb * 32 + r32) * 2) = f2bf(tr_ * re - ti_ * im);
                *(bf16_t*)(stg + (16 + kl) * 256 + (nb * 32 + r32) * 2) = f2bf(ti_ * re + tr_ * im); } }
        asm volatile("s_waitcnt lgkmcnt(0)" ::: "memory");
#pragma unroll
        for (int i = 0; i < 8; ++i) { const int rowl = i * 4 + (lane >> 4), c16 = lane & 15; const u32x4 v = *(const u32x4*)(stg + rowl * 256 + c16 * 16);
            const int reim = rowl >> 4, k1 = 16 * w + (rowl & 15);
            *(u32x4*)(Y + ((size_t)((b * 64 + k1) * 2 + reim)) * 49152 + j * 256 + nh * 128 + c16 * 8) = v; }
        __syncthreads();
    }
}
__device__ __forceinline__ void stage_b(const bf16_t* __restrict__ Y, const bf16_t* __restrict__ SG, bf16_t* __restrict__ BR, char* lds, int vcu, int G) {
    const int tid = threadIdx.x, wid = tid >> 6, lane = tid & 63, r32 = lane & 31, hi = lane >> 5, w = wid & 1, nq = wid >> 1;
    char* xl = lds + OFF_X; float* stg = (float*)(lds + OFF_STG + wid * 8192);
    bf16x8 afr[8];
    { const int k2 = 32 * w + r32;
#pragma unroll
      for (int ks = 0; ks < 8; ++ks) { float v[8];
#pragma unroll
          for (int j = 0; j < 8; ++j) { const int kk = 16 * ks + 8 * hi + j, reim = kk >> 6, s2 = kk & 63; const float f = (float)((k2 * s2) & 63) * (1.f / 64.f);
              v[j] = reim == 0 ? __builtin_amdgcn_cosf(f) * 0.125f : -__builtin_amdgcn_sinf(f) * 0.125f; }
          u32x4 p = {cvtpk(v[0], v[1]), cvtpk(v[2], v[3]), cvtpk(v[4], v[5]), cvtpk(v[6], v[7])}; afr[ks] = *reinterpret_cast<bf16x8*>(&p); } }
    const int vb = (int)(uintptr_t)xl + x_rd_base(lane) + nq * 2 * 512;
    constexpr int NU = NB * 64 * 3;
    TileRegs tr;
    int u = vcu;
    if (u < NU) tile_load(tr, Y + (size_t)(u / 3) * 2 * 49152 + (u % 3) * 256, 768, tid);
    for (; u < NU; u += G) {
        const int bk1 = u / 3, j = u % 3, b = bk1 >> 6, k1 = bk1 & 63;
        tile_write(tr, xl, tid);
        __syncthreads();
        { const int un = u + G; if (un < NU) tile_load(tr, Y + (size_t)(un / 3) * 2 * 49152 + (un % 3) * 256, 768, tid); }
        f32x16 acc[2] = {};
        mm_block<0>(acc[0], afr, vb); mm_block<1>(acc[1], afr, vb);
#pragma unroll
        for (int r = 0; r < 16; ++r) { const int rl = crow(r, hi); stg[rl * 64 + r32] = acc[0][r]; stg[rl * 64 + 32 + r32] = acc[1][r]; }
        asm volatile("s_waitcnt lgkmcnt(0)" ::: "memory");
#pragma unroll
        for (int i = 0; i < 4; ++i) { const int rowl = i * 8 + (lane >> 3), c8 = (lane & 7) * 8;
            const f32x4v a = *(const f32x4v*)(stg + rowl * 64 + c8), c = *(const f32x4v*)(stg + rowl * 64 + c8 + 4);
            const size_t off = ((size_t)b * SEQ + k1 + 64 * (32 * w + rowl)) * 1024 + j * 256 + nq * 64 + c8; const u32x4 g = *(const u32x4*)(SG + off); u32x4 o;
            o.x = cvtpk(a[0] * __uint_as_float(g.x << 16), a[1] * __uint_as_float(g.x & 0xffff0000u)); o.y = cvtpk(a[2] * __uint_as_float(g.y << 16), a[3] * __uint_as_float(g.y & 0xffff0000u));
            o.z = cvtpk(c[0] * __uint_as_float(g.z << 16), c[1] * __uint_as_float(g.z & 0xffff0000u)); o.w = cvtpk(c[2] * __uint_as_float(g.w << 16), c[3] * __uint_as_float(g.w & 0xffff0000u));
            *(u32x4*)(BR + off) = o; }
        __syncthreads();
    }
}
}
constexpr int NWAVES = 8;
#ifndef MK_N_LAUNCHES
#define MK_N_LAUNCHES 1
#endif
constexpr int N_PHASES = 9;
constexpr int N_LAUNCHES = MK_N_LAUNCHES;
constexpr int CW_BAR = 4096;
constexpr int RING_OFF = 0, RING_BYTES = 131072;
constexpr int LDSCTL_OFF = RING_BYTES, MISC_OFF = LDSCTL_OFF + 320, RS_OFF = LDSCTL_OFF + 1024  ;
constexpr int LDS_BYTES = 147456;
static_assert(RS_OFF + 4096 <= LDS_BYTES, "LDS map");

struct Args { const void* in[19]; float* out; unsigned char* ws; int ph_lo, ph_hi, li, pad; };

__device__ __forceinline__ void prep_w_job(const float* __restrict__ W, int ldw, int K, bf16_t* __restrict__ out, int n0, int nrows, const float* __restrict__ scale, int mode, int off, int gt, int GT) {
    const int total = nrows * (K >> 3);
    for (int idx = gt; idx < total; idx += GT) {
        const int n = idx % nrows, k8 = idx / nrows; const int sc = src_col(mode, n, off);
        float v[8];
#pragma unroll
        for (int i = 0; i < 8; ++i) { const int k = k8 * 8 + i; float w = (sc >= 0) ? W[(size_t)k * ldw + sc] : 0.f; if (scale) w *= scale[k]; v[i] = w; }
        uint4 o; o.x = pk2(v[0], v[1]); o.y = pk2(v[2], v[3]); o.z = pk2(v[4], v[5]); o.w = pk2(v[6], v[7]);
        *(uint4*)(out + (size_t)(n0 + n) * K + k8 * 8) = o;
    }
}
__device__ __forceinline__ void rmsnorm_row(const float* __restrict__ xrow, const float* __restrict__ g, bf16_t* __restrict__ orow, int lane) {
    const float4* xr = (const float4*)xrow + lane; float4 v[4]; float s = 0.f;
#pragma unroll
    for (int j = 0; j < 4; ++j) { v[j] = xr[64 * j]; s += v[j].x * v[j].x + v[j].y * v[j].y + v[j].z * v[j].z + v[j].w * v[j].w; }
    const float rstd = rsqrtf(wave_sum(s) * (1.f / DM) + EPS);
    uint2* o = (uint2*)orow + lane;
#pragma unroll
    for (int j = 0; j < 4; ++j) { const float4 gv = g ? ((const float4*)g)[lane + 64 * j] : make_float4(1.f, 1.f, 1.f, 1.f);
        uint2 w; w.x = pk2(v[j].x * rstd * gv.x, v[j].y * rstd * gv.y); w.y = pk2(v[j].z * rstd * gv.z, v[j].w * rstd * gv.w); o[64 * j] = w; }
}

template <int DQK>
__device__ __forceinline__ void attn_naive_vb(float* Ks, float* Vs, int t256, const bf16_t* __restrict__ Q, int ldq, int qhs, const bf16_t* __restrict__ Kp, int ldk, int khs, const bf16_t* __restrict__ Vp, int ldv, int vhs,
                                              int nkeys, bf16_t* __restrict__ O, const bf16_t* __restrict__ G, int ocol0, int qblk, int h, int b) {
    constexpr int KT = 8;
    const size_t t = (size_t)b * SEQ + qblk * 256 + t256;
    unsigned qp2[DQK / 2]; float o[64], m = -1e30f, l = 0.f;
    { const bf16_t* qp = Q + t * ldq + h * qhs;
#pragma unroll
      for (int d = 0; d < DQK; d += 8) { const uint4 v = *(const uint4*)(qp + d); qp2[d / 2] = v.x; qp2[d / 2 + 1] = v.y; qp2[d / 2 + 2] = v.z; qp2[d / 2 + 3] = v.w; } }
#pragma unroll
    for (int d = 0; d < 64; ++d) o[d] = 0.f;
    const bf16_t* Kb = Kp + (size_t)b * nkeys * ldk + h * khs; const bf16_t* Vb = Vp + (size_t)b * nkeys * ldv + h * vhs;
    for (int k0 = 0; k0 < nkeys; k0 += KT) {
        __syncthreads();
        if (t256 < KT * DQK / 8) { const int j = t256 / (DQK / 8), d = (t256 % (DQK / 8)) * 8; const uint4 v = *(const uint4*)(Kb + (size_t)(k0 + j) * ldk + d);
            float* p = Ks + j * DQK + d; p[0] = __uint_as_float(v.x << 16); p[1] = __uint_as_float(v.x & 0xffff0000u); p[2] = __uint_as_float(v.y << 16); p[3] = __uint_as_float(v.y & 0xffff0000u);
            p[4] = __uint_as_float(v.z << 16); p[5] = __uint_as_float(v.z & 0xffff0000u); p[6] = __uint_as_float(v.w << 16); p[7] = __uint_as_float(v.w & 0xffff0000u); }
        if (t256 >= 128 && t256 < 128 + KT * 8) { const int tt = t256 - 128, j = tt >> 3, d = (tt & 7) * 8; const uint4 v = *(const uint4*)(Vb + (size_t)(k0 + j) * ldv + d);
            float* p = Vs + j * 64 + d; p[0] = __uint_as_float(v.x << 16); p[1] = __uint_as_float(v.x & 0xffff0000u); p[2] = __uint_as_float(v.y << 16); p[3] = __uint_as_float(v.y & 0xffff0000u);
            p[4] = __uint_as_float(v.z << 16); p[5] = __uint_as_float(v.z & 0xffff0000u); p[6] = __uint_as_float(v.w << 16); p[7] = __uint_as_float(v.w & 0xffff0000u); }
        __syncthreads();
#pragma unroll 1
        for (int j = 0; j < KT; ++j) { float s = 0.f; const float4* kr = (const float4*)(Ks + j * DQK);
#pragma unroll
            for (int d = 0; d < DQK / 4; ++d) { const float4 kv = kr[d]; const unsigned a = qp2[2 * d], c = qp2[2 * d + 1];
                s += __uint_as_float(a << 16) * kv.x + __uint_as_float(a & 0xffff0000u) * kv.y + __uint_as_float(c << 16) * kv.z + __uint_as_float(c & 0xffff0000u) * kv.w; }
            if (s > m) { const float alpha = __builtin_amdgcn_exp2f(m - s); m = s; l *= alpha;
#pragma unroll
                for (int d = 0; d < 64; ++d) o[d] *= alpha; }
            const float p = __builtin_amdgcn_exp2f(s - m); l += p; const float4* vr = (const float4*)(Vs + j * 64);
#pragma unroll
            for (int d = 0; d < 16; ++d) { const float4 vv = vr[d]; o[4 * d] += p * vv.x; o[4 * d + 1] += p * vv.y; o[4 * d + 2] += p * vv.z; o[4 * d + 3] += p * vv.w; } }
    }
    const float rl = 1.f / l;
    const bf16_t* gp = G + t * 1024 + ocol0 + h * 64; bf16_t* op = O + t * 1024 + ocol0 + h * 64;
#pragma unroll
    for (int d = 0; d < 64; d += 8) { const uint4 gv = *(const uint4*)(gp + d); uint4 w;
        w.x = pk2(o[d] * rl * __uint_as_float(gv.x << 16), o[d + 1] * rl * __uint_as_float(gv.x & 0xffff0000u));
        w.y = pk2(o[d + 2] * rl * __uint_as_float(gv.y << 16), o[d + 3] * rl * __uint_as_float(gv.y & 0xffff0000u));
        w.z = pk2(o[d + 4] * rl * __uint_as_float(gv.z << 16), o[d + 5] * rl * __uint_as_float(gv.z & 0xffff0000u));
        w.w = pk2(o[d + 6] * rl * __uint_as_float(gv.w << 16), o[d + 7] * rl * __uint_as_float(gv.w & 0xffff0000u));
        *(uint4*)(op + d) = w; }
}
template <int DQK>
__device__ __forceinline__ void attn_naive_phase(unsigned char* lds, int tid, const bf16_t* Q, int ldq, int qhs, const bf16_t* Kp, int ldk, int khs, const bf16_t* Vp, int ldv, int vhs, int nkeys, int nheads,
                                                 bf16_t* O, const bf16_t* G, int ocol0) {
    const int half = tid >> 8, t256 = tid & 255; float* Ks = (float*)(lds + half * 32768); float* Vs = Ks + 8 * DQK;
    const int total = 16 * nheads * NB, stride = (int)gridDim.x * 2;
    for (int vb = (int)blockIdx.x * 2 + half; vb < total; vb += stride) { const int qblk = vb & 15, h = (vb >> 4) % nheads, b = (vb >> 4) / nheads;
        attn_naive_vb<DQK>(Ks, Vs, t256, Q, ldq, qhs, Kp, ldk, khs, Vp, ldv, vhs, nkeys, O, G, ocol0, qblk, h, b); }
}

__global__ void __launch_bounds__(NWAVES * 64, 2) mk_fwd(Args args) {
    extern __shared__ __attribute__((aligned(16))) unsigned char lds[];
    LAS unsigned char* ldsl = (LAS unsigned char*)lds;
    volatile LAS unsigned* MISC = (volatile LAS unsigned*)(ldsl + MISC_OFF);
    const int tid0 = threadIdx.x;
#define PHASE_IDS() int tid = threadIdx.x; asm volatile("" : "+v"(tid)); const int lane = tid & 63, wave = __builtin_amdgcn_readfirstlane(tid >> 6); const int gt = (int)blockIdx.x * (NWAVES * 64) + tid, gw = (int)blockIdx.x * NWAVES + wave; (void)lane; (void)wave; (void)gt; (void)gw;
    const int vcu = (gridDim.x % 8 == 0) ? ((int)blockIdx.x % 8) * ((int)gridDim.x / 8) + (int)blockIdx.x / 8 : (int)blockIdx.x;
    const int G = gridDim.x, GT = G * NWAVES * 64, NGW = G * NWAVES;
    unsigned char* ws = args.ws;
    gu32* ctl = (gu32*)(ws + WS_CTL);
#define in_x ((const float*)args.in[0])
#define in_mem ((const float*)args.in[1])
#define in_pos ((const int*)args.in[2])
#define in_g0 ((const float*)args.in[3])
#define in_w_in0 ((const float*)args.in[4])
#define in_gq ((const float*)args.in[5])
#define in_gkv ((const float*)args.in[6])
#define in_w_uq ((const float*)args.in[7])
#define in_w_ukv ((const float*)args.in[8])
#define in_gm0 ((const float*)args.in[9])
#define in_w_mkv0 ((const float*)args.in[10])
#define in_w_out0 ((const float*)args.in[11])
#define in_g1 ((const float*)args.in[12])
#define in_w_in1 ((const float*)args.in[13])
#define in_w_fnet ((const float*)args.in[14])
#define in_gm1 ((const float*)args.in[15])
#define in_w_mkv1 ((const float*)args.in[16])
#define in_w_out1 ((const float*)args.in[17])
#define in_gf ((const float*)args.in[18])
#define in_out (args.out)
#define WIN0 ((bf16_t*)(ws + WS_WIN0))
#define WUQ ((bf16_t*)(ws + WS_WUQ))
#define WUKV ((bf16_t*)(ws + WS_WUKV))
#define WMEM ((bf16_t*)(ws + WS_WMEM))
#define WOUT0 ((bf16_t*)(ws + WS_WOUT0))
#define WOUT1 ((bf16_t*)(ws + WS_WOUT1))
#define WIN1 ((bf16_t*)(ws + WS_WIN1))
#define AGBG ((float*)(ws + WS_AGBG))
#define ROPE ((float*)(ws + WS_ROPE))
#define MEMN ((bf16_t*)(ws + WS_MEMN))
#define MEMKV ((bf16_t*)(ws + WS_MEMKV))
#define RSTD1 ((float*)(ws + WS_RSTD1))
#define SSQ ((float*)(ws + WS_SSQ))
#define XN0 ((bf16_t*)(ws + WS_XN0))
#define BR ((bf16_t*)(ws + WS_BR))
#define CQ ((bf16_t*)(ws + WS_CQ))
#define CKV ((bf16_t*)(ws + WS_CKV))
#define QMEM0 ((bf16_t*)(ws + WS_QMEM0))
#define SG0 ((bf16_t*)(ws + WS_SG0))
#define Kb ((bf16_t*)(ws + WS_K))
#define Qb ((bf16_t*)(ws + WS_Q))
#define Vb ((bf16_t*)(ws + WS_V))
#define X1B ((bf16_t*)(ws + WS_X1B))
#define PQ ((bf16_t*)(ws + WS_PQ))
#define QMEM1 ((bf16_t*)(ws + WS_QMEM1))
#define SG1 ((bf16_t*)(ws + WS_SG1))
#define Y ((bf16_t*)(ws + WS_Y))
    for (int u = tid0; u < (LDS_BYTES - LDSCTL_OFF) / 4; u += NWAVES * 64) ((LAS unsigned*)(ldsl + LDSCTL_OFF))[u] = 0u;
    __syncthreads();
    XcdBarrier bar; bar.bar = (unsigned*)(ctl + CW_BAR); bar.x = 0; bar.st = nullptr;
    if (N_LAUNCHES == 1) bar = xcd_barrier_post((unsigned*)(ctl + CW_BAR), MISC + 8);
#define GRID_BAR() do { if (N_LAUNCHES == 1) xcd_barrier(bar); } while (0)
    const int lo = args.ph_lo, hi = args.ph_hi;
#ifndef PH_MASK
#define PH_MASK 0x1ff
#endif
#define IN(k) (((PH_MASK >> (k)) & 1) && lo <= (k) && (k) < hi)
#define BOTH(k) (IN(k) && IN((k) + 1))
    LAS float* rs = (LAS float*)(ldsl + RS_OFF);

    if (IN(0)) { PHASE_IDS();
        prep_w_job(in_w_in0, 1952, 1024, WIN0, 0, 2048, nullptr, MODE_WIN0, 0, gt, GT);
        prep_w_job(in_w_uq, 1152, 384, WUQ, 0, 1280, in_gq, MODE_WUQ, 0, gt, GT);
        prep_w_job(in_w_ukv, 1536, 256, WUKV, 0, 1536, in_gkv, MODE_WUKV, 0, gt, GT);
        prep_w_job(in_w_mkv0, 512, 1024, WMEM, 0, 512, in_gm0, MODE_PLAIN, 0, gt, GT);
        prep_w_job(in_w_mkv1, 512, 1024, WMEM, 512, 512, in_gm1, MODE_PLAIN, 0, gt, GT);
        prep_w_job(in_w_out0, 1024, 1024, WOUT0, 0, 1024, nullptr, MODE_PLAIN, 0, gt, GT);
        prep_w_job(in_w_out1, 1024, 1024, WOUT1, 0, 1024, nullptr, MODE_PLAIN, 0, gt, GT);
        prep_w_job(in_w_in1, 2048, 1024, WIN1, 1536, 1280, in_g1, MODE_PLAIN, 768, gt, GT);
        for (int idx = gt; idx < 2 * 4 * 192 * 192; idx += GT) { const int d = idx % 192, c = (idx / 192) % 192, g = (idx / 36864) & 3, pq = idx / 147456;
            float acc = 0.f;
            for (int m = 0; m < 192; ++m) { const float fr = 2.0f * (float)((m * c) % 192) / 192.0f; const float tr = pq ? sinpif(fr) : cospif(fr); acc += tr * in_w_fnet[((size_t)g * 192 + m) * 192 + d]; }
            AGBG[idx] = acc * 0.07216878364870322f; }
        for (int idx = gt; idx < T * 16; idx += GT) { const int t = idx >> 4, i = idx & 15;
            const float inv_freq = (float)(1.0 / pow(10000.0, (double)i / 16.0)); const float ang = (float)in_pos[t] * inv_freq;
            ROPE[2 * idx] = (float)cos((double)ang); ROPE[2 * idx + 1] = (float)sin((double)ang); }
        for (int m = gw; m < 4096; m += NGW) rmsnorm_row(in_mem + (size_t)m * DM, nullptr, MEMN + (size_t)m * DM, lane);
        for (int m = gw; m < T; m += NGW) rmsnorm_row(in_x + (size_t)m * DM, in_g0, XN0 + (size_t)m * DM, lane);
        if (BOTH(0)) GRID_BAR();
    }
    if (IN(1)) { PHASE_IDS();
        for (int idx = gt; idx < 2 * 4 * 1024 * 192; idx += GT) { const int d = idx % 192, k = (idx / 192) & 1023, g = (idx / 196608) & 3, pq = idx / 786432;
            const float* wr = in_w_in1 + (size_t)k * 2048 + 192 * g; const float* ag = AGBG + (((size_t)pq * 4 + g) * 192) * 192 + d; float acc = 0.f;
            for (int c = 0; c < 192; ++c) acc += wr[c] * ag[(size_t)c * 192];
            WIN1[(size_t)(pq * 768 + g * 192 + d) * 1024 + k] = f2bf(acc * in_g1[k]); }
        { pg8::Gemm g{XN0, WIN0, T, 2048, 1024}; pg8::StaticOrder S; S.init(T, 2048, G, (int)blockIdx.x);
          pg8::EpiIn0 E{CQ, CKV, QMEM0, SG0, Kb, SSQ, ROPE};
          pg8::gemm_phase<pg8::EpiIn0, pg8::StaticOrder, true, true>(ldsl + RING_OFF, g, S, E); }
        { pg8::Gemm g{MEMN, WMEM, 4096, 1024, 1024}; pg8::StaticOrder S; S.init(4096, 1024, G, (int)blockIdx.x);
          pg8::EpiPlainB E{MEMKV, 1024, 0};
          pg8::gemm_phase<pg8::EpiPlainB, pg8::StaticOrder, true, true>(ldsl + RING_OFF, g, S, E); }
        if (BOTH(1)) GRID_BAR();
    }
    if (IN(2)) { PHASE_IDS();
        { int kq_ = 384; asm volatile("" : "+s"(kq_)); pg8::Gemm g{CQ, WUQ, T, 1280, kq_}; pg8::StaticOrder S; S.init(T, 1280, G, (int)blockIdx.x);
          pg8::EpiQup E{Qb, SSQ, ROPE};
          pg8::gemm_phase<pg8::EpiQup, pg8::StaticOrder, true, true>(ldsl + RING_OFF, g, S, E); }
        { int kk_ = 256; asm volatile("" : "+s"(kk_)); pg8::Gemm g{CKV, WUKV, T, 1536, kk_}; pg8::StaticOrder S; S.init(T, 1536, G, (int)blockIdx.x);
          pg8::EpiKVup E{Kb, Vb, SSQ};
          pg8::gemm_phase<pg8::EpiKVup, pg8::StaticOrder, true, true>(ldsl + RING_OFF, g, S, E); }
        if (BOTH(2)) GRID_BAR();
    }
    if (IN(3)) { PHASE_IDS();
#ifdef ATTN_NAIVE
        attn_naive_phase<96>(lds, tid, Qb, 1152, 96, Kb, 1152, 96, Vb, 768, 64, SEQ, 12, BR, SG0, 0);
        attn_naive_phase<64>(lds, tid, QMEM0, 256, 64, MEMKV, 1024, 64, MEMKV + 256, 1024, 64, 256, 4, BR, SG0, 768);
#else
        for (int u = vcu; u < 16 * 12 * NB; u += G) { const int qblk = u & 15, pair = u >> 4, b = pair / 12, h = pair % 12; const size_t t0 = (size_t)b * SEQ + qblk * 256;
            att::attn_unit<96>(Qb + t0 * 1152 + h * 96, 1152, Kb + (size_t)b * SEQ * 1152 + h * 96, 1152, Vb + (size_t)b * SEQ * 768 + h * 64, 768, SEQ, BR + t0 * 1024 + h * 64, SG0 + t0 * 1024 + h * 64, (char*)lds); }
        for (int u = vcu; u < 16 * 4 * NB; u += G) { const int qblk = u & 15, pair = u >> 4, b = pair >> 2, h = pair & 3; const size_t t0 = (size_t)b * SEQ + qblk * 256;
            att::attn_unit<64>(QMEM0 + t0 * 256 + h * 64, 256, MEMKV + (size_t)b * 256 * 1024 + h * 64, 1024, MEMKV + (size_t)b * 256 * 1024 + 256 + h * 64, 1024, 256, BR + t0 * 1024 + 768 + h * 64, SG0 + t0 * 1024 + 768 + h * 64, (char*)lds); }
#endif
        if (BOTH(3)) GRID_BAR();
    }
    if (IN(4)) { PHASE_IDS();
        for (int i = tid; i < 1024; i += NWAVES * 64) rs[i] = 0.f;
        __syncthreads();
        { pg8::Gemm g{BR, WOUT0, T, 1024, 1024}; pg8::PanelOrder S; S.init(T, G, (int)blockIdx.x);
          pg8::EpiOut E{in_x, in_out, X1B, rs};
          pg8::gemm_phase<pg8::EpiOut, pg8::PanelOrder, true, true>(ldsl + RING_OFF, g, S, E); }
        __syncthreads();
        if (tid < 256) RSTD1[(size_t)blockIdx.x * 256 + tid] = rsqrtf(((rs[tid * 4] + rs[tid * 4 + 1]) + (rs[tid * 4 + 2] + rs[tid * 4 + 3])) * (1.f / DM) + EPS);
        if (BOTH(4)) GRID_BAR();
    }
    if (IN(5)) { PHASE_IDS();
        { pg8::Gemm g{X1B, WIN1, T, 2816, 1024}; pg8::StaticOrder S; S.init(T, 2816, G, (int)blockIdx.x);
          pg8::EpiIn1 E{PQ, QMEM1, SG1, RSTD1};
          pg8::gemm_phase<pg8::EpiIn1, pg8::StaticOrder, true, true>(ldsl + RING_OFF, g, S, E); }
        if (BOTH(5)) GRID_BAR();
    }
    if (IN(6)) { PHASE_IDS();
#ifdef FFT_NAIVE
        LAS float* tab = (LAS float*)(ldsl + RING_OFF + 65536);
        if (tid < 64) { tab[2 * tid] = cospif(2.f * tid / 64.f); tab[2 * tid + 1] = sinpif(2.f * tid / 64.f); }
        __syncthreads();
        for (int idx = gt; idx < NB * 64 * 49152; idx += GT) { const int e = idx % 49152, k1 = (idx / 49152) & 63, b = idx / (49152 * 64);
            float ar = 0.f, ai = 0.f;
            for (int s1 = 0; s1 < 64; ++s1) { const int w = (k1 * s1) & 63; const float wx = tab[2 * w], wy = tab[2 * w + 1];
                const size_t base = (((size_t)b * 64 + s1) * 2) * 49152 + e; const float p = bf2f(PQ[base]), q = bf2f(PQ[base + 49152]);
                ar += wx * p - wy * q; ai += wy * p + wx * q; }
            ar *= 0.125f; ai *= 0.125f;
            const int s2 = e / 768; const float fr = 2.f * (float)(k1 * s2) / 4096.f; const float tr = cospif(fr), ti = sinpif(fr);
            const size_t ob = (((size_t)b * 64 + k1) * 2) * 49152 + e;
            Y[ob] = f2bf(tr * ar - ti * ai); Y[ob + 49152] = f2bf(ti * ar + tr * ai); }
        __syncthreads();
#else
        fft::stage_a(PQ, Y, (char*)lds, vcu, G);
#endif
#ifdef ATTN_NAIVE
        attn_naive_phase<64>(lds, tid, QMEM1, 256, 64, MEMKV + 512, 1024, 64, MEMKV + 768, 1024, 64, 256, 4, BR, SG1, 768);
#else
        for (int u = vcu; u < 16 * 4 * NB; u += G) { const int qblk = u & 15, pair = u >> 4, b = pair >> 2, h = pair & 3; const size_t t0 = (size_t)b * SEQ + qblk * 256;
            att::attn_unit<64>(QMEM1 + t0 * 256 + h * 64, 256, MEMKV + (size_t)b * 256 * 1024 + 512 + h * 64, 1024, MEMKV + (size_t)b * 256 * 1024 + 768 + h * 64, 1024, 256, BR + t0 * 1024 + 768 + h * 64, SG1 + t0 * 1024 + 768 + h * 64, (char*)lds); }
#endif
        if (BOTH(6)) GRID_BAR();
    }
    if (IN(7)) { PHASE_IDS();
#ifdef FFT_NAIVE
        LAS float* tab = (LAS float*)(ldsl + RING_OFF + 65536);
        __syncthreads();
        if (tid < 64) { tab[2 * tid] = cospif(2.f * tid / 64.f); tab[2 * tid + 1] = sinpif(2.f * tid / 64.f); }
        __syncthreads();
        for (int idx = gt; idx < NB * 64 * 64 * 768; idx += GT) { const int d = idx % 768, k2 = (idx / 768) & 63, bk1 = idx / 49152, b = bk1 >> 6, k1 = bk1 & 63;
            float acc = 0.f;
            for (int s2 = 0; s2 < 64; ++s2) { const int w = (k2 * s2) & 63; const size_t base = ((size_t)bk1 * 2) * 49152 + (size_t)s2 * 768 + d;
                acc += tab[2 * w] * bf2f(Y[base]) - tab[2 * w + 1] * bf2f(Y[base + 49152]); }
            const size_t t = (size_t)b * SEQ + k1 + 64 * k2;
            BR[t * 1024 + d] = f2bf(acc * 0.125f * bf2f(SG1[t * 1024 + d])); }
#else
        fft::stage_b(Y, SG1, BR, (char*)lds, vcu, G);
#endif
        if (BOTH(7)) GRID_BAR();
    }
    if (IN(8)) { PHASE_IDS();
        __syncthreads();
        for (int i = tid; i < 1024; i += NWAVES * 64) rs[i] = 0.f;
        __syncthreads();
        { pg8::Gemm g{BR, WOUT1, T, 1024, 1024}; pg8::PanelOrder S; S.init(T, G, (int)blockIdx.x);
          pg8::EpiOut E{in_out, in_out, nullptr, rs};
          pg8::gemm_phase<pg8::EpiOut, pg8::PanelOrder, true, true>(ldsl + RING_OFF, g, S, E); }
        asm volatile("s_waitcnt vmcnt(0)" ::: "memory");
        __syncthreads();
        for (int r = wave; r < 256; r += NWAVES) { const float rstd = rsqrtf(((rs[r * 4] + rs[r * 4 + 1]) + (rs[r * 4 + 2] + rs[r * 4 + 3])) * (1.f / DM) + EPS);
            float4* xr = (float4*)(in_out + ((size_t)blockIdx.x * 256 + r) * DM) + lane;
#pragma unroll
            for (int j = 0; j < 4; ++j) { float4 v = xr[64 * j]; const float4 gv = ((const float4*)in_gf)[lane + 64 * j]; v.x *= rstd * gv.x; v.y *= rstd * gv.y; v.z *= rstd * gv.z; v.w *= rstd * gv.w; xr[64 * j] = v; } }
    }
#undef in_x
#undef in_mem
#undef in_pos
#undef in_g0
#undef in_w_in0
#undef in_gq
#undef in_gkv
#undef in_w_uq
#undef in_w_ukv
#undef in_gm0
#undef in_w_mkv0
#undef in_w_out0
#undef in_g1
#undef in_w_in1
#undef in_w_fnet
#undef in_gm1
#undef in_w_mkv1
#undef in_w_out1
#undef in_gf
#undef in_out
#undef WIN0
#undef WUQ
#undef WUKV
#undef WMEM
#undef WOUT0
#undef WOUT1
#undef WIN1
#undef AGBG
#undef ROPE
#undef MEMN
#undef MEMKV
#undef RSTD1
#undef SSQ
#undef XN0
#undef BR
#undef CQ
#undef CKV
#undef QMEM0
#undef SG0
#undef Kb
#undef Qb
#undef Vb
#undef X1B
#undef PQ
#undef QMEM1
#undef SG1
#undef Y
#undef PHASE_IDS
#undef IN
#undef BOTH
#undef GRID_BAR
}

extern "C" void kernel_launch(void* const* d_in, const int* in_sizes, int n_in, void* d_out, int out_size, void* d_ws, size_t ws_size, hipStream_t stream) {
    static int grid = 0;
    if (grid == 0) {
        if (n_in != 19 || ws_size < WS_END || out_size != T * DM) { fprintf(stderr, "kernel_launch: unexpected n_in %d / ws %zu / out %d\n", n_in, ws_size, out_size); grid = -1; return; }
        int dev = 0, cus = 0;
        if (hipGetDevice(&dev) != hipSuccess || hipDeviceGetAttribute(&cus, hipDeviceAttributeMultiprocessorCount, dev) != hipSuccess) { grid = -1; return; }
        if (hipFuncSetAttribute((const void*)mk_fwd, hipFuncAttributeMaxDynamicSharedMemorySize, LDS_BYTES) != hipSuccess) { fprintf(stderr, "kernel_launch: hipFuncSetAttribute failed\n"); grid = -1; return; }
        int per_cu = 0; (void)hipOccupancyMaxActiveBlocksPerMultiprocessor(&per_cu, (const void*)mk_fwd, NWAVES * 64, LDS_BYTES); (void)hipGetLastError();
        if (cus != 256 || per_cu < 1) fprintf(stderr, "kernel_launch: note: %d CUs, occupancy query %d (built for 256 CUs, one workgroup each)\n", cus, per_cu);
        grid = 256;
    }
    if (grid < 0) return;
    if (hipMemsetAsync((char*)d_ws + WS_CTL, 0, CTL_ZERO_BYTES, stream) != hipSuccess) { fprintf(stderr, "kernel_launch: memset failed\n"); return; }
    Args a{};
    for (int i = 0; i < 19; ++i) a.in[i] = d_in[i];
    a.out = (float*)d_out; a.ws = (unsigned char*)d_ws;
    for (int li = 0; li < N_LAUNCHES; ++li) {
        a.ph_lo = (N_LAUNCHES == 1) ? 0 : li; a.ph_hi = (N_LAUNCHES == 1) ? N_PHASES : li + 1; a.li = li; a.pad = 0;
        hipLaunchKernelGGL(mk_fwd, dim3(grid), dim3(NWAVES * 64), LDS_BYTES, stream, a);
        const hipError_t le = hipPeekAtLastError();
        if (le != hipSuccess) { fprintf(stderr, "kernel_launch: launch %d failed: %s\n", li, hipGetErrorName(le)); break; }
    }
}
```

```cpp
#include <hip/hip_runtime.h>
#include <stdint.h>
#include <cstdio>

typedef unsigned short bf16_t;
constexpr int T = 65536, SEQ = 4096, NB = 16, DM = 1024;
constexpr float EPS = 1e-6f;
constexpr float LOG2E = 1.4426950408889634f;
constexpr float QS_MLA = 0.10206207261596575f * LOG2E;
constexpr float QS_MEM = 0.125f * LOG2E;

constexpr size_t MiB = 1u << 20;
constexpr size_t WS_CTL = 0, CTL_ZERO_BYTES = 1 * MiB;
constexpr size_t WS_WIN0 = 1 * MiB;
constexpr size_t WS_WUQ = 5 * MiB;
constexpr size_t WS_WUKV = 6 * MiB;
constexpr size_t WS_WMEM = 7 * MiB;
constexpr size_t WS_WOUT0 = 9 * MiB;
constexpr size_t WS_WOUT1 = 11 * MiB;
constexpr size_t WS_WIN1 = 13 * MiB;
constexpr size_t WS_AGBG = 19 * MiB;
constexpr size_t WS_ROPE = 21 * MiB;
constexpr size_t WS_MEMN = 29 * MiB;
constexpr size_t WS_MEMKV = 37 * MiB;
constexpr size_t WS_RSTD1 = 45 * MiB;
constexpr size_t WS_SSQ = 46 * MiB;
constexpr size_t WS_XN0 = 64 * MiB;
constexpr size_t WS_BR = 64 * MiB;
constexpr size_t WS_CQ = 192 * MiB;
constexpr size_t WS_CKV = 240 * MiB;
constexpr size_t WS_QMEM0 = 272 * MiB;
constexpr size_t WS_SG0 = 304 * MiB;
constexpr size_t WS_K = 432 * MiB;
constexpr size_t WS_Q = 576 * MiB;
constexpr size_t WS_V = 720 * MiB;
constexpr size_t WS_X1B = 192 * MiB;
constexpr size_t WS_PQ = 320 * MiB;
constexpr size_t WS_QMEM1 = 512 * MiB;
constexpr size_t WS_SG1 = 544 * MiB;
constexpr size_t WS_Y = 672 * MiB;
constexpr size_t WS_END = 864 * MiB;

__device__ __forceinline__ float bf2f(bf16_t h) { return __uint_as_float(((unsigned)h) << 16); }
__device__ __forceinline__ bf16_t f2bf(float f) { unsigned u = __float_as_uint(f); return (bf16_t)((u + 0x7fffu + ((u >> 16) & 1u)) >> 16); }
__device__ __forceinline__ unsigned pk2(float lo, float hi) { return (unsigned)f2bf(lo) | ((unsigned)f2bf(hi) << 16); }
__device__ __forceinline__ float silu_f(float v) { return v * __builtin_amdgcn_rcpf(1.f + __expf(-v)); }
__device__ __forceinline__ float wave_sum(float v) {
#pragma unroll
    for (int o = 1; o < 64; o <<= 1) v += __shfl_xor(v, o);
    return v;
}
__host__ __device__ __forceinline__ int ropedim(int p) { return 4 * (p >> 3) + (p & 3) + 16 * ((p >> 2) & 1); }
enum { MODE_WIN0 = 0, MODE_WUQ = 1, MODE_WUKV = 2, MODE_PLAIN = 3 };
__device__ __forceinline__ int src_col(int mode, int n, int off) {
    if (mode == MODE_WIN0) {
        if (n < 640) return n;
        if (n < 896) return 672 + (n - 640);
        if (n < 928) return 640 + ropedim(n - 896);
        if (n < 1024) return -1;
        return 928 + (n - 1024);
    } else if (mode == MODE_WUQ) {
        if (n < 768) return (n >> 6) * 96 + (n & 63);
        if (n < 1152) { const int r = n - 768; return (r >> 5) * 96 + 64 + ropedim(r & 31); }
        return -1;
    } else if (mode == MODE_WUKV) {
        if (n < 768) return (n >> 6) * 128 + (n & 63);
        const int r = n - 768; return (r >> 6) * 128 + 64 + (r & 63);
    }
    return n + off;
}
namespace pg8 {
#define PG8_LAS __attribute__((address_space(3)))
typedef unsigned short bf16_t;
typedef short bf16x8 __attribute__((ext_vector_type(8)));
typedef float f32x4 __attribute__((ext_vector_type(4)));
typedef unsigned u32x4 __attribute__((ext_vector_type(4)));
constexpr int BM = 256, BK = 64, HALF = 128, HTB = HALF * BK * 2  , STAGE_BYTES = 8 * HTB, NXCD = 8, WGM = 8;

__host__ __device__ __forceinline__ int lds_byte(int r, int c) { const int st = (r >> 4) * 2 + (c >> 5), rr = r & 15, cc = c & 31, ob = rr * 64 + cc * 2; return st * 1024 + (ob ^ (((ob >> 9) & 1) << 5)); }
__host__ __device__ __forceinline__ void stage_rc(int b, int& R, int& C) { const int st = b / 1024, sb = b % 1024, swz = sb ^ (((sb >> 9) & 1) << 5); R = (st >> 1) * 16 + swz / 64; C = (st & 1) * 32 + (swz % 64) / 2; }
__host__ __device__ __forceinline__ int perm32(int rho) { const int n = rho >> 4, i = rho & 15; return 8 * (i >> 2) + 4 * n + (i & 3); }

struct Unit { int pm, pn; };
struct Gemm { const bf16_t* A; const bf16_t* Bt; int M, N, K; };

struct StaticOrder {
    int nM, nN, nwg, G, c;
    __host__ __device__ void init(int M, int N, int G_, int c_) { nM = M / BM; nN = N / BM; nwg = nM * nN; G = G_; c = c_; }
    __host__ __device__ bool next(int i, Unit& u) const {
        const long L = (long)i * G + c; if (L >= nwg) return false;
        int wgid = (int)L; { const int q = nwg / NXCD, r = nwg % NXCD, xcd = wgid % NXCD, off = wgid / NXCD; wgid = (xcd < r ? xcd * (q + 1) : r * (q + 1) + (xcd - r) * q) + off; }
        const int nig = WGM * nN, gid = wgid / nig, fm = gid * WGM, gsz = (nM - fm) < WGM ? (nM - fm) : WGM;
        u.pm = fm + ((wgid % nig) % gsz); u.pn = (wgid % nig) / gsz; return true;
    }
    __device__ __forceinline__ void a_ready(const Unit&) const {}
    __device__ __forceinline__ void done(const Unit&) const {}
};

__device__ __forceinline__ unsigned cvt_pk_bf16(float lo, float hi) { unsigned r; asm volatile("v_cvt_pk_bf16_f32 %0, %1, %2" : "=v"(r) : "v"(lo), "v"(hi)); return r; }
typedef float f32x2 __attribute__((ext_vector_type(2)));
__device__ __forceinline__ u32x4 pack8(const f32x4 a, const f32x4 b, float s) { u32x4 w; w.x = cvt_pk_bf16(a[0] * s, a[1] * s); w.y = cvt_pk_bf16(a[2] * s, a[3] * s); w.z = cvt_pk_bf16(b[0] * s, b[1] * s); w.w = cvt_pk_bf16(b[2] * s, b[3] * s); return w; }
__device__ __forceinline__ float ss8(const f32x4 a, const f32x4 b) { return (a[0] * a[0] + a[1] * a[1]) + (a[2] * a[2] + a[3] * a[3]) + (b[0] * b[0] + b[1] * b[1]) + (b[2] * b[2] + b[3] * b[3]); }
__device__ __forceinline__ float quad_sum(float v) { v += __shfl_xor(v, 16); v += __shfl_xor(v, 32); return v; }
__device__ __forceinline__ f32x4 silu4(const f32x4 v) { f32x4 o; o[0] = silu_f(v[0]); o[1] = silu_f(v[1]); o[2] = silu_f(v[2]); o[3] = silu_f(v[3]); return o; }
typedef unsigned u32x2 __attribute__((ext_vector_type(2)));
__device__ __forceinline__ void rope_pair(const f32x4 a, const f32x4 b, const float* cs  , float s, u32x2& o1, u32x2& o2) {
    const f32x4 c01 = *(const f32x4*)cs, c23 = *(const f32x4*)(cs + 4);
    const float r0 = (a[0] * c01[0] - b[0] * c01[1]) * s, r1 = (a[1] * c01[2] - b[1] * c01[3]) * s, r2 = (a[2] * c23[0] - b[2] * c23[1]) * s, r3 = (a[3] * c23[2] - b[3] * c23[3]) * s;
    const float q0 = (b[0] * c01[0] + a[0] * c01[1]) * s, q1 = (b[1] * c01[2] + a[1] * c01[3]) * s, q2 = (b[2] * c23[0] + a[2] * c23[1]) * s, q3 = (b[3] * c23[2] + a[3] * c23[3]) * s;
    o1.x = cvt_pk_bf16(r0, r1); o1.y = cvt_pk_bf16(r2, r3); o2.x = cvt_pk_bf16(q0, q1); o2.y = cvt_pk_bf16(q2, q3);
}
struct EpiIn0 {
    static constexpr bool PERM = true, AFTER_DRAIN = false;
    bf16_t *CQ, *CKV, *QMEM, *SG, *Kb; float* SSQ; const float* rope;
    __device__ __forceinline__ void operator()(const f32x4 (&acc)[2][2][4][2], const Unit& u, int wr, int wc, int fr, int fq) const {
#pragma unroll
        for (int ai = 0; ai < 2; ++ai)
#pragma unroll
            for (int m = 0; m < 4; ++m) { int rowi_ = u.pm * BM + ai * HALF + wr * 64 + m * 16 + fr; asm volatile("" : "+v"(rowi_)); const size_t row = (size_t)rowi_;
#pragma unroll
                for (int bj = 0; bj < 2; ++bj) { const int cb = u.pn * BM + bj * HALF + wc * 32, c = cb + 8 * fq; const f32x4 v0 = acc[ai][bj][m][0], v1 = acc[ai][bj][m][1];
                    if (cb < 640) { const float ss = quad_sum(ss8(v0, v1));
                        if (cb < 384) { *(u32x4*)(CQ + row * 384 + c) = pack8(v0, v1, 1.f); if (fq == 0) SSQ[row * 20 + (cb >> 5)] = ss; }
                        else { *(u32x4*)(CKV + row * 256 + (c - 384)) = pack8(v0, v1, 1.f); if (fq == 0) SSQ[row * 20 + 12 + ((cb - 384) >> 5)] = ss; } }
                    else if (cb < 896) { *(u32x4*)(QMEM + row * 256 + (c - 640)) = pack8(v0, v1, QS_MEM); }
                    else if (cb < 1024) { if (cb == 896) { u32x2 o1, o2; rope_pair(v0, v1, rope + row * 32 + 8 * fq, 1.f, o1, o2);
#pragma unroll
                            for (int h = 0; h < 12; ++h) { *(u32x2*)(Kb + row * 1152 + h * 96 + 64 + 4 * fq) = o1; *(u32x2*)(Kb + row * 1152 + h * 96 + 80 + 4 * fq) = o2; } } }
                    else { *(u32x4*)(SG + row * 1024 + (c - 1024)) = pack8(silu4(v0), silu4(v1), 1.f); } } }
    }
};
struct EpiPlainB {
    static constexpr bool PERM = true, AFTER_DRAIN = false;
    bf16_t* O; int ldo; int pad;
    __device__ __forceinline__ void operator()(const f32x4 (&acc)[2][2][4][2], const Unit& u, int wr, int wc, int fr, int fq) const {
#pragma unroll
        for (int ai = 0; ai < 2; ++ai)
#pragma unroll
            for (int m = 0; m < 4; ++m) { int rowi_ = u.pm * BM + ai * HALF + wr * 64 + m * 16 + fr; asm volatile("" : "+v"(rowi_)); const size_t row = (size_t)rowi_;
#pragma unroll
                for (int bj = 0; bj < 2; ++bj) { const int c = u.pn * BM + bj * HALF + wc * 32 + 8 * fq; *(u32x4*)(O + row * ldo + c) = pack8(acc[ai][bj][m][0], acc[ai][bj][m][1], 1.f); } }
    }
};
struct EpiQup {
    static constexpr bool PERM = true, AFTER_DRAIN = false;
    bf16_t* Qb; const float* SSQ; const float* rope;
    __device__ __forceinline__ void operator()(const f32x4 (&acc)[2][2][4][2], const Unit& u, int wr, int wc, int fr, int fq) const {
#pragma unroll
        for (int ai = 0; ai < 2; ++ai)
#pragma unroll
            for (int m = 0; m < 4; ++m) { int rowi_ = u.pm * BM + ai * HALF + wr * 64 + m * 16 + fr; asm volatile("" : "+v"(rowi_)); const size_t row = (size_t)rowi_;
                const f32x4 s0 = *(const f32x4*)(SSQ + row * 20), s1 = *(const f32x4*)(SSQ + row * 20 + 4), s2 = *(const f32x4*)(SSQ + row * 20 + 8);
                const float ss = ((s0[0] + s0[1]) + (s0[2] + s0[3])) + ((s1[0] + s1[1]) + (s1[2] + s1[3])) + ((s2[0] + s2[1]) + (s2[2] + s2[3]));
                const float s = rsqrtf(ss * (1.f / 384.f) + EPS) * QS_MLA;
#pragma unroll
                for (int bj = 0; bj < 2; ++bj) { const int cb = u.pn * BM + bj * HALF + wc * 32, c = cb + 8 * fq; const f32x4 v0 = acc[ai][bj][m][0], v1 = acc[ai][bj][m][1];
                    if (cb < 768) { *(u32x4*)(Qb + row * 1152 + (c >> 6) * 96 + (c & 63)) = pack8(v0, v1, s); }
                    else if (cb < 1152) { const int h = (cb - 768) >> 5; u32x2 o1, o2; rope_pair(v0, v1, rope + row * 32 + 8 * fq, s, o1, o2);
                        *(u32x2*)(Qb + row * 1152 + h * 96 + 64 + 4 * fq) = o1; *(u32x2*)(Qb + row * 1152 + h * 96 + 80 + 4 * fq) = o2; } }
                asm volatile("" ::: "memory"); }
    }
};
struct EpiKVup {
    static constexpr bool PERM = true, AFTER_DRAIN = false;
    bf16_t *Kb, *Vb; const float* SSQ;
    __device__ __forceinline__ void operator()(const f32x4 (&acc)[2][2][4][2], const Unit& u, int wr, int wc, int fr, int fq) const {
#pragma unroll
        for (int ai = 0; ai < 2; ++ai)
#pragma unroll
            for (int m = 0; m < 4; ++m) { int rowi_ = u.pm * BM + ai * HALF + wr * 64 + m * 16 + fr; asm volatile("" : "+v"(rowi_)); const size_t row = (size_t)rowi_;
                const f32x4 s0 = *(const f32x4*)(SSQ + row * 20 + 12), s1 = *(const f32x4*)(SSQ + row * 20 + 16);
                const float ss = ((s0[0] + s0[1]) + (s0[2] + s0[3])) + ((s1[0] + s1[1]) + (s1[2] + s1[3]));
                const float s = rsqrtf(ss * (1.f / 256.f) + EPS);
#pragma unroll
                for (int bj = 0; bj < 2; ++bj) { const int cb = u.pn * BM + bj * HALF + wc * 32, c = cb + 8 * fq; const f32x4 v0 = acc[ai][bj][m][0], v1 = acc[ai][bj][m][1];
                    if (cb < 768) *(u32x4*)(Kb + row * 1152 + (c >> 6) * 96 + (c & 63)) = pack8(v0, v1, s);
                    else *(u32x4*)(Vb + row * 768 + (c - 768)) = pack8(v0, v1, s); }
                asm volatile("" ::: "memory"); }
    }
};
struct EpiOut {
    static constexpr bool PERM = true, AFTER_DRAIN = false;
    const float* R; float* X1; bf16_t* X1B; PG8_LAS float* rs;
    __device__ __forceinline__ void operator()(const f32x4 (&acc)[2][2][4][2], const Unit& u, int wr, int wc, int fr, int fq) const {
#pragma unroll
        for (int ai = 0; ai < 2; ++ai)
#pragma unroll
            for (int m = 0; m < 4; ++m) { int rl = ai * HALF + wr * 64 + m * 16 + fr; asm volatile("" : "+v"(rl)); const size_t row = (size_t)(u.pm * BM + rl); float ssum = 0.f;
#pragma unroll
                for (int bj = 0; bj < 2; ++bj) { const int c = u.pn * BM + bj * HALF + wc * 32 + 8 * fq;
                    const f32x4 x0 = *(const f32x4*)(R + row * 1024 + c) + acc[ai][bj][m][0], x1 = *(const f32x4*)(R + row * 1024 + c + 4) + acc[ai][bj][m][1];
                    *(f32x4*)(X1 + row * 1024 + c) = x0; *(f32x4*)(X1 + row * 1024 + c + 4) = x1;
                    if (X1B) *(u32x4*)(X1B + row * 1024 + c) = pack8(x0, x1, 1.f);
                    ssum += ss8(x0, x1); }
                ssum = quad_sum(ssum); if (fq == 0) rs[rl * 4 + wc] += ssum; }
    }
};
struct EpiIn1 {
    static constexpr bool PERM = true, AFTER_DRAIN = false;
    bf16_t *PQ, *QMEM, *SG; const float* RSTD;
    __device__ __forceinline__ void operator()(const f32x4 (&acc)[2][2][4][2], const Unit& u, int wr, int wc, int fr, int fq) const {
#pragma unroll
        for (int ai = 0; ai < 2; ++ai)
#pragma unroll
            for (int m = 0; m < 4; ++m) { int rowi = u.pm * BM + ai * HALF + wr * 64 + m * 16 + fr; asm volatile("" : "+v"(rowi)); const size_t row = (size_t)rowi; const float r = RSTD[row];
                const int b = rowi >> 12, sq = rowi & 4095, s1 = sq >> 6, s2 = sq & 63; const size_t prow = ((size_t)(b * 64 + s1) * 2) * 64 + s2;
#pragma unroll
                for (int bj = 0; bj < 2; ++bj) { const int cb = u.pn * BM + bj * HALF + wc * 32, c = cb + 8 * fq; const f32x4 v0 = acc[ai][bj][m][0], v1 = acc[ai][bj][m][1];
                    if (cb < 1536) { const int pq = cb >= 768 ? 1 : 0; *(u32x4*)(PQ + (prow + pq * 64) * 768 + (c - pq * 768)) = pack8(v0, v1, r); }
                    else if (cb < 1792) *(u32x4*)(QMEM + row * 256 + (c - 1536)) = pack8(v0, v1, r * QS_MEM);
                    else *(u32x4*)(SG + row * 1024 + (c - 1792)) = pack8(silu4(v0 * r), silu4(v1 * r), 1.f); } }
    }
};
struct PanelOrder {
    int nM, G, c;
    __device__ void init(int M, int G_, int c_) { nM = M / BM; G = G_; c = c_; }
    __device__ bool next(int i, Unit& u) const { u.pm = c + G * (i >> 2); u.pn = i & 3; return u.pm < nM; }
    __device__ __forceinline__ void a_ready(const Unit&) const {}
    __device__ __forceinline__ void done(const Unit&) const {}
};
template <class Epi, class Sched, bool ALIGN_EPI = false, bool SP2 = false>
__device__ __forceinline__ void gemm_phase(PG8_LAS unsigned char* lds, const Gemm g, const Sched& S, const Epi& E) {
    const int tid = threadIdx.x, wid = __builtin_amdgcn_readfirstlane(tid >> 6), lane = tid & 63, wr = wid >> 2, wc = wid & 3, fr = lane & 15, fq = lane >> 4;
    const int K = g.K, nt = K / BK;
    unsigned voffA[2], voffB[2];
#pragma unroll
    for (int i = 0; i < 2; ++i) { int R, C; stage_rc(tid * 16 + i * 8192, R, C); const int Rb = Epi::PERM ? ((R & ~31) + perm32(R & 31)) : R;
        voffA[i] = (unsigned)(R * K + C) * 2u; voffB[i] = (unsigned)(Rb * K + C) * 2u; }
    const size_t kstep = (size_t)(BK * 2);
    const size_t hstep = (size_t)HALF * K * 2;
    const size_t tstep = 2 * hstep;
    const unsigned ldsw = (unsigned)wid * 1024u;
    const int aoff = lds_byte(wr * 64 + fr, fq * 8), boff = lds_byte(wc * 32 + fr, fq * 8);
#define PG8_SA(b, h) (((b) * 2 + (h)) * HTB)
#define PG8_SB(b, h) ((4 + (b) * 2 + (h)) * HTB)
#define PG8_STAGE(bufoff, gbase, voff) do { _Pragma("unroll") for (int _i = 0; _i < 2; ++_i) \
        __builtin_amdgcn_global_load_lds((const unsigned*)((const char*)(gbase) + (voff)[_i]), (PG8_LAS unsigned*)(lds + (bufoff) + ldsw + _i * 8192), 16, 0, 0); } while (0)
#define PG8_LDA(dst, b, h) do { _Pragma("unroll") for (int m = 0; m < 4; ++m) _Pragma("unroll") for (int k = 0; k < 2; ++k) dst[m][k] = *(const PG8_LAS bf16x8*)(lds + PG8_SA(b, h) + aoff + m * 2048 + k * 1024); } while (0)
#define PG8_LDB(dst, b, h) do { _Pragma("unroll") for (int n = 0; n < 2; ++n) _Pragma("unroll") for (int k = 0; k < 2; ++k) dst[n][k] = *(const PG8_LAS bf16x8*)(lds + PG8_SB(b, h) + boff + n * 2048 + k * 1024); } while (0)
#define PG8_MMA(ai, bj, At, Bt) do { __builtin_amdgcn_s_setprio(1); _Pragma("unroll") for (int m = 0; m < 4; ++m) _Pragma("unroll") for (int n = 0; n < 2; ++n) _Pragma("unroll") for (int k = 0; k < 2; ++k) \
        acc[ai][bj][m][n] = __builtin_amdgcn_mfma_f32_16x16x32_bf16(Bt[n][k], At[m][k], acc[ai][bj][m][n], 0, 0, 0); __builtin_amdgcn_s_setprio(0); } while (0)
#define PG8_WAIT_V(n) asm volatile("s_waitcnt vmcnt(" #n ")" ::: "memory")
#define PG8_WAIT_L(n) asm volatile("s_waitcnt lgkmcnt(" #n ")" ::: "memory")
#define PG8_BAR __builtin_amdgcn_s_barrier()
#define PG8_SCHED __builtin_amdgcn_sched_barrier(0)
    Unit cur, nxt; int ui = 0;
    if (!S.next(0, cur)) return;
    f32x4 acc[2][2][4][2];
#pragma unroll
    for (int a = 0; a < 2; ++a)
#pragma unroll
        for (int b = 0; b < 2; ++b)
#pragma unroll
            for (int m = 0; m < 4; ++m)
#pragma unroll
                for (int n = 0; n < 2; ++n) acc[a][b][m][n] = (f32x4){0.f, 0.f, 0.f, 0.f};
    bf16x8 At[4][2], B0[2][2], B1[2][2];
    const char* cA = (const char*)g.A + (size_t)cur.pm * tstep; const char* cB = (const char*)g.Bt + (size_t)cur.pn * tstep;
    S.a_ready(cur);
    if constexpr (SP2) {
        PG8_STAGE(PG8_SB(0, 0), cB, voffB); PG8_STAGE(PG8_SB(0, 1), cB + hstep, voffB); PG8_STAGE(PG8_SA(0, 0), cA, voffA); PG8_STAGE(PG8_SA(0, 1), cA + hstep, voffA);
        if (wr == 1) PG8_BAR;
        PG8_WAIT_V(2); PG8_BAR;
        PG8_STAGE(PG8_SB(1, 0), cB + kstep, voffB); PG8_STAGE(PG8_SA(1, 0), cA + kstep, voffA); PG8_STAGE(PG8_SB(1, 1), cB + hstep + kstep, voffB);
        PG8_WAIT_V(6); PG8_BAR;
    } else {
        PG8_STAGE(PG8_SB(0, 0), cB, voffB); PG8_STAGE(PG8_SA(0, 0), cA, voffA); PG8_STAGE(PG8_SB(0, 1), cB + hstep, voffB); PG8_STAGE(PG8_SA(0, 1), cA + hstep, voffA);
        if (wr == 1) PG8_BAR;
        PG8_WAIT_V(4); PG8_BAR;
        PG8_STAGE(PG8_SB(1, 0), cB + kstep, voffB); PG8_STAGE(PG8_SA(1, 0), cA + kstep, voffA); PG8_STAGE(PG8_SB(1, 1), cB + hstep + kstep, voffB);
        PG8_WAIT_V(6); PG8_BAR;
    }
    for (;;) {
        const bool has_next = S.next(ui + 1, nxt);
        const char* nA = has_next ? (const char*)g.A + (size_t)nxt.pm * tstep : cA; const char* nB = has_next ? (const char*)g.Bt + (size_t)nxt.pn * tstep : cB;
        for (int t = 0; t < nt; t += 2) {
            const bool last = (t == nt - 2);
            const char* a1 = cA + (size_t)(t + 1) * kstep;
            const char* a2 = last ? nA : cA + (size_t)(t + 2) * kstep; const char* b2 = last ? nB : cB + (size_t)(t + 2) * kstep;
            const char* a3 = a2 + kstep; const char* b3 = b2 + kstep;
            if (last && has_next) S.a_ready(nxt);
            if constexpr (SP2) {
            PG8_LDB(B0, 0, 0); PG8_LDB(B1, 0, 1); PG8_SCHED; PG8_LDA(At, 0, 0); PG8_STAGE(PG8_SA(1, 1), a1 + hstep, voffA);
            PG8_WAIT_V(8); PG8_WAIT_L(0); PG8_BAR; PG8_MMA(0, 0, At, B0); PG8_MMA(0, 1, At, B1); PG8_BAR; PG8_SCHED;
            PG8_LDA(At, 0, 1); PG8_STAGE(PG8_SB(0, 0), b2, voffB); PG8_STAGE(PG8_SB(0, 1), b2 + hstep, voffB); PG8_STAGE(PG8_SA(0, 0), a2, voffA);
            PG8_WAIT_V(8); PG8_WAIT_L(0); PG8_BAR; PG8_MMA(1, 0, At, B0); PG8_MMA(1, 1, At, B1); PG8_BAR; PG8_SCHED;
            PG8_LDB(B0, 1, 0); PG8_LDB(B1, 1, 1); PG8_SCHED; PG8_LDA(At, 1, 0); PG8_STAGE(PG8_SA(0, 1), a2 + hstep, voffA);
            PG8_WAIT_V(8); PG8_WAIT_L(0); PG8_BAR; PG8_MMA(0, 0, At, B0); PG8_MMA(0, 1, At, B1); PG8_BAR; PG8_SCHED;
            PG8_LDA(At, 1, 1); PG8_STAGE(PG8_SB(1, 0), b3, voffB); PG8_STAGE(PG8_SB(1, 1), b3 + hstep, voffB); PG8_STAGE(PG8_SA(1, 0), a3, voffA);
            PG8_WAIT_V(8); PG8_WAIT_L(0); PG8_BAR; PG8_MMA(1, 0, At, B0); PG8_MMA(1, 1, At, B1); PG8_BAR; PG8_SCHED;
            } else {
            PG8_LDB(B0, 0, 0); PG8_SCHED; PG8_LDA(At, 0, 0); PG8_STAGE(PG8_SA(1, 1), a1 + hstep, voffA);
            PG8_WAIT_L(8); PG8_BAR; PG8_WAIT_L(0); PG8_MMA(0, 0, At, B0); PG8_BAR; PG8_SCHED;
            PG8_LDB(B1, 0, 1); PG8_STAGE(PG8_SB(0, 0), b2, voffB);
            PG8_BAR; PG8_WAIT_L(0); PG8_MMA(0, 1, At, B1); PG8_BAR;
            PG8_LDA(At, 0, 1); PG8_STAGE(PG8_SA(0, 0), a2, voffA);
            PG8_BAR; PG8_WAIT_L(0); PG8_MMA(1, 0, At, B0); PG8_BAR; PG8_SCHED;
            PG8_STAGE(PG8_SB(0, 1), b2 + hstep, voffB);
            PG8_WAIT_V(6); PG8_BAR; PG8_MMA(1, 1, At, B1); PG8_BAR;
            PG8_LDB(B0, 1, 0); PG8_SCHED; PG8_LDA(At, 1, 0); PG8_STAGE(PG8_SA(0, 1), a2 + hstep, voffA);
            PG8_WAIT_L(8); PG8_BAR; PG8_WAIT_L(0); PG8_MMA(0, 0, At, B0); PG8_BAR; PG8_SCHED;
            PG8_LDB(B1, 1, 1); PG8_STAGE(PG8_SB(1, 0), b3, voffB);
            PG8_BAR; PG8_WAIT_L(0); PG8_MMA(0, 1, At, B1); PG8_BAR;
            PG8_LDA(At, 1, 1); PG8_STAGE(PG8_SA(1, 0), a3, voffA);
            PG8_BAR; PG8_WAIT_L(0); PG8_MMA(1, 0, At, B0); PG8_BAR; PG8_SCHED;
            PG8_STAGE(PG8_SB(1, 1), b3 + hstep, voffB);
            PG8_WAIT_V(6); PG8_BAR; PG8_MMA(1, 1, At, B1); PG8_BAR;
            }
        }
        if constexpr (ALIGN_EPI) { if (wr == 0) PG8_BAR; }
        if constexpr (!Epi::AFTER_DRAIN) { E(acc, cur, wr, wc, fr, fq); S.done(cur); }
        if (!has_next) break;
#pragma unroll
        for (int a = 0; a < 2; ++a)
#pragma unroll
            for (int b = 0; b < 2; ++b)
#pragma unroll
                for (int m = 0; m < 4; ++m)
#pragma unroll
                    for (int n = 0; n < 2; ++n) acc[a][b][m][n] = (f32x4){0.f, 0.f, 0.f, 0.f};
        cur = nxt; cA = nA; cB = nB; ++ui;
        if constexpr (ALIGN_EPI) { if (wr == 1) PG8_BAR; }
    }
    PG8_WAIT_V(0);
    if constexpr (!ALIGN_EPI) { if (wr == 0) PG8_BAR; }
    PG8_BAR;
    if constexpr (Epi::AFTER_DRAIN) { E.fused(acc, cur, wr, wc, fr, fq, lds, wid, lane); S.done(cur); }
#undef PG8_SA
#undef PG8_SB
#undef PG8_STAGE
#undef PG8_LDA
#undef PG8_LDB
#undef PG8_MMA
#undef PG8_WAIT_V
#undef PG8_WAIT_L
#undef PG8_BAR
#undef PG8_SCHED
}
}
#define GAS __attribute__((address_space(1)))
#define LAS __attribute__((address_space(3)))
typedef unsigned short bf16;
typedef unsigned v4u __attribute__((ext_vector_type(4)));
typedef float f32x4 __attribute__((ext_vector_type(4)));
typedef short bf16x8 __attribute__((ext_vector_type(8)));
typedef GAS unsigned gu32;
typedef GAS unsigned long long gu64;
#define RLX_AGENT __ATOMIC_RELAXED, __HIP_MEMORY_SCOPE_AGENT
#define LDS_WAIT() asm volatile("s_waitcnt lgkmcnt(0)" ::: "memory")
#define VM_WAIT() asm volatile("s_waitcnt vmcnt(0)" ::: "memory")
__device__ __forceinline__ unsigned long long rt() { return __builtin_amdgcn_s_memrealtime(); }
#define XB_TMO      128
#define XB_XCNT(j)  (256  + 64 * (j))
#define XB_XSUB(j)  (1280 + 64 * (j))
#define XB_XGEN(j)  (2304 + 64 * (j))
#define XB_TOP      3328
#define XB_TOPGEN   3392
#define XCD_BAR_WORDS 3456
#define XB_SPIN_CAP (1u << 18)

__device__ __forceinline__ unsigned xb_ld(unsigned* p)              { return __hip_atomic_load(p, __ATOMIC_RELAXED, __HIP_MEMORY_SCOPE_AGENT); }
__device__ __forceinline__ unsigned xb_add(unsigned* p, unsigned v) { return __hip_atomic_fetch_add(p, v, __ATOMIC_RELAXED, __HIP_MEMORY_SCOPE_AGENT); }
__device__ __forceinline__ unsigned xb_xcc_id() { return (unsigned)__builtin_amdgcn_s_getreg((3 << 11) | 20) & 0xFu; }
#define XB_SPIN(cond, bar) do { unsigned _sp = 0; while (cond) { __builtin_amdgcn_s_sleep(1); \
    if ((++_sp & 255u) == 0u) { if (xb_ld(&(bar)[XB_TMO])) break; if (_sp > XB_SPIN_CAP) { atomicAdd(&(bar)[XB_TMO], 1u); break; } } } } while (0)

struct XcdBarrier {
    unsigned* bar; unsigned x;
    volatile LAS unsigned* st;
};

__device__ __forceinline__ XcdBarrier xcd_barrier_post(unsigned* bar, volatile LAS unsigned* st) {
    XcdBarrier b; b.bar = bar; b.x = xb_xcc_id(); b.st = st;
    if (threadIdx.x == 0) (void)xb_add(&bar[XB_XCNT(b.x)], 1u);
    return b;
}
__device__ __forceinline__ void xcd_barrier_complete(unsigned* bar, unsigned x, unsigned& nloc, unsigned& nx) {
    const unsigned G = gridDim.x * gridDim.y * gridDim.z;
    unsigned sum, cnt, mine, sp = 0u;
    for (;;) {
        sum = 0u; cnt = 0u; mine = 0u;
#pragma unroll
        for (unsigned j = 0; j < 16; ++j) { const unsigned c = xb_ld(&bar[XB_XCNT(j)]); sum += c; cnt += (c > 0u) ? 1u : 0u; mine = (j == x) ? c : mine; }
        if (sum == G) break;
        __builtin_amdgcn_s_sleep(1);
        if ((++sp & 255u) == 0u) { if (xb_ld(&bar[XB_TMO])) break; if (sp > XB_SPIN_CAP) { atomicAdd(&bar[XB_TMO], 1u); break; } }
    }
    nloc = mine > 0u ? mine : 1u; nx = cnt > 0u ? cnt : 1u;
}

__device__ __forceinline__ void xcd_barrier(const XcdBarrier& b) {
    asm volatile("s_waitcnt vmcnt(0)" ::: "memory");
    __syncthreads();
    if (threadIdx.x == 0) {
        unsigned* bar = b.bar;
        __builtin_amdgcn_s_waitcnt(0);
        unsigned nloc = b.st[0], nx = b.st[1];
        if (nloc == 0u) { xcd_barrier_complete(bar, b.x, nloc, nx); b.st[0] = nloc; b.st[1] = nx; }
        const unsigned old = xb_add(&bar[XB_XSUB(b.x)], 1u);
        const unsigned gen = old / nloc;
        if (old + 1u == (gen + 1u) * nloc) {
            __builtin_amdgcn_fence(__ATOMIC_RELEASE, "agent");
            asm volatile("s_waitcnt vmcnt(0)" ::: "memory");
            const unsigned og = xb_add(&bar[XB_TOP], 1u);
            const unsigned tg = og / nx;
            if (og + 1u == (tg + 1u) * nx) xb_add(&bar[XB_TOPGEN], 1u);
            else XB_SPIN(xb_ld(&bar[XB_TOPGEN]) == tg, bar);
            __builtin_amdgcn_fence(__ATOMIC_ACQUIRE, "agent");
            xb_add(&bar[XB_XGEN(b.x)], 1u);
            asm volatile("s_waitcnt vmcnt(0)" ::: "memory");
        } else {
            XB_SPIN(xb_ld(&bar[XB_XGEN(b.x)]) == gen, bar);
            __builtin_amdgcn_fence(__ATOMIC_ACQUIRE, "agent");
            asm volatile("s_waitcnt vmcnt(0)" ::: "memory");
        }
    }
    __syncthreads();
}
namespace att {
using bf16x8 = __attribute__((ext_vector_type(8))) short;
using s16x4  = __attribute__((ext_vector_type(4))) short;
using f32x16 = __attribute__((ext_vector_type(16))) float;
using f32x4v = __attribute__((ext_vector_type(4))) float;
using u32x4  = __attribute__((ext_vector_type(4))) unsigned;
constexpr int NW = 8, QBLK = 32, KVBLK = 64;
constexpr float THRL = 6.f;
#define ASBAR() __builtin_amdgcn_sched_barrier(0)
__device__ __forceinline__ int crow(int r, int hi) { return (r & 3) + 8 * (r >> 2) + 4 * hi; }
__device__ __forceinline__ unsigned cvtpk(float lo, float hi) { unsigned r; asm volatile("v_cvt_pk_bf16_f32 %0, %1, %2" : "=v"(r) : "v"(lo), "v"(hi)); return r; }
template <int DQK> struct Cfg {
    static constexpr int KROW = DQK * 2 + 16;
    static constexpr int SHM_V = 8192, SHM_K = 64 * KROW;
    static constexpr int OFF_V = 0, OFF_K = 2 * SHM_V, OFF_WS = OFF_K + 2 * SHM_K, OFF_OST = OFF_WS + NW * 256, OSTW = 32 * 68 * 4, END = OFF_OST + NW * OSTW;
    static constexpr int KCH = DQK / 8;
};
__device__ __forceinline__ void partialSM(f32x16& p0, f32x16& p1, float& m_reg, float& mn, float& alpha) {
    float pmax = p0[0];
#pragma unroll
    for (int r = 1; r < 16; ++r) pmax = fmaxf(pmax, p0[r]);
#pragma unroll
    for (int r = 0; r < 16; ++r) pmax = fmaxf(pmax, p1[r]);
    { auto rr = __builtin_amdgcn_permlane32_swap(__float_as_uint(pmax), __float_as_uint(pmax), false, false); pmax = fmaxf(__uint_as_float(rr[0]), __uint_as_float(rr[1])); }
    if (__builtin_expect(__all(pmax - m_reg <= THRL), 1)) { mn = m_reg; alpha = 1.f; }
    else { mn = fmaxf(m_reg, pmax); alpha = __builtin_amdgcn_exp2f(m_reg - mn); m_reg = mn; }
#pragma unroll
    for (int r = 0; r < 16; ++r) p0[r] -= mn;
#pragma unroll
    for (int r = 0; r < 16; ++r) p1[r] -= mn;
#pragma unroll
    for (int r = 0; r < 16; ++r) p0[r] = __builtin_amdgcn_exp2f(p0[r]);
}
__device__ __forceinline__ void finishSM(f32x16& p0, f32x16& p1, float alpha, float& l_reg, bf16x8& pa0, bf16x8& pa1, bf16x8& pa2, bf16x8& pa3) {
#pragma unroll
    for (int r = 0; r < 16; ++r) p1[r] = __builtin_amdgcn_exp2f(p1[r]);
    float ps = 0;
#pragma unroll
    for (int r = 0; r < 16; ++r) ps += p0[r];
#pragma unroll
    for (int r = 0; r < 16; ++r) ps += p1[r];
    { auto rr = __builtin_amdgcn_permlane32_swap(__float_as_uint(ps), __float_as_uint(ps), false, false); ps = __uint_as_float(rr[0]) + __uint_as_float(rr[1]); }
    l_reg = l_reg * alpha + ps;
#define ATT_PK4(P, BASE, OUT) do { unsigned a0 = cvtpk(P[BASE + 0], P[BASE + 1]), a1 = cvtpk(P[BASE + 2], P[BASE + 3]);   \
    unsigned b0 = cvtpk(P[BASE + 4], P[BASE + 5]), b1 = cvtpk(P[BASE + 6], P[BASE + 7]);                              \
    auto r0 = __builtin_amdgcn_permlane32_swap(a0, b0, false, false); auto r1 = __builtin_amdgcn_permlane32_swap(a1, b1, false, false); \
    u32x4 w = {r0[0], r1[0], r0[1], r1[1]}; OUT = *reinterpret_cast<bf16x8*>(&w); } while (0)
    ATT_PK4(p0, 0, pa0); ATT_PK4(p0, 8, pa1); ATT_PK4(p1, 0, pa2); ATT_PK4(p1, 8, pa3);
#undef ATT_PK4
}
template <int DQK> __device__ __forceinline__ void qkt(f32x16& p0, f32x16& p1, const char* Ks, const bf16x8* qr, int r32, int hi) {
    constexpr int KROW = Cfg<DQK>::KROW;
    p0 = f32x16{}; p1 = f32x16{};
#pragma unroll
    for (int d0 = 0; d0 < DQK / 16; ++d0) { const int cb = (d0 * 16 + hi * 8) * 2;
        const bf16x8 b0 = *reinterpret_cast<const bf16x8*>(Ks + r32 * KROW + cb);
        const bf16x8 b1 = *reinterpret_cast<const bf16x8*>(Ks + (32 + r32) * KROW + cb);
        p0 = __builtin_amdgcn_mfma_f32_32x32x16_bf16(b0, qr[d0], p0, 0, 0, 0);
        p1 = __builtin_amdgcn_mfma_f32_32x32x16_bf16(b1, qr[d0], p1, 0, 0, 0); }
}
__device__ __forceinline__ int v_st(int k, int c) { const int kk = (k & ~0xC) | ((k & 4) << 1) | ((k & 8) >> 1); return ((kk >> 3) * 2 + (c >> 5)) * 512 + ((kk & 7) * 32 + (c & 31)) * 2; }
__device__ __forceinline__ int v_rd_base(int lane) { return ((lane & 3) << 3) | (((lane >> 2) & 3) << 6) | (((lane >> 4) & 1) << 5) | (((lane >> 5) & 1) << 8); }
constexpr int v_rd_off(int d0, int ks, int half) { return d0 * 512 + ks * 2048 + half * 1024; }
template <int OFF> __device__ __forceinline__ s16x4 tr_read(int vb) { s16x4 r; asm volatile("ds_read_b64_tr_b16 %0, %1 offset:%2" : "=&v"(r) : "v"(vb), "i"(OFF) : "memory"); return r; }
template <int D0> __device__ __forceinline__ void pv_one(f32x16& od, int vb, bf16x8 pa0, bf16x8 pa1, bf16x8 pa2, bf16x8 pa3) {
    const s16x4 l0 = tr_read<v_rd_off(D0, 0, 0)>(vb), h0 = tr_read<v_rd_off(D0, 0, 1)>(vb), l1 = tr_read<v_rd_off(D0, 1, 0)>(vb), h1 = tr_read<v_rd_off(D0, 1, 1)>(vb);
    const s16x4 l2 = tr_read<v_rd_off(D0, 2, 0)>(vb), h2 = tr_read<v_rd_off(D0, 2, 1)>(vb), l3 = tr_read<v_rd_off(D0, 3, 0)>(vb), h3 = tr_read<v_rd_off(D0, 3, 1)>(vb);
    asm volatile("s_waitcnt lgkmcnt(0)" ::: "memory"); ASBAR();
#define ATT_PK(L, H) (bf16x8){L[0], L[1], L[2], L[3], H[0], H[1], H[2], H[3]}
    od = __builtin_amdgcn_mfma_f32_32x32x16_bf16(pa0, ATT_PK(l0, h0), od, 0, 0, 0);
    od = __builtin_amdgcn_mfma_f32_32x32x16_bf16(pa1, ATT_PK(l1, h1), od, 0, 0, 0);
    od = __builtin_amdgcn_mfma_f32_32x32x16_bf16(pa2, ATT_PK(l2, h2), od, 0, 0, 0);
    od = __builtin_amdgcn_mfma_f32_32x32x16_bf16(pa3, ATT_PK(l3, h3), od, 0, 0, 0);
#undef ATT_PK
}
__device__ __forceinline__ void pv_d0(f32x16* o, int vb, bf16x8 pa0, bf16x8 pa1, bf16x8 pa2, bf16x8 pa3) { pv_one<0>(o[0], vb, pa0, pa1, pa2, pa3); pv_one<1>(o[1], vb, pa0, pa1, pa2, pa3); }

template <int DQK>
__device__ __forceinline__ void attn_unit(const bf16_t* __restrict__ Qb, int ldq, const bf16_t* __restrict__ Kh, int ldk, const bf16_t* __restrict__ Vh, int ldv, int seq,
                                          bf16_t* __restrict__ Ob, const bf16_t* __restrict__ Gb, char* lds) {
    using C = Cfg<DQK>;
    constexpr int KROW = C::KROW, KCH = C::KCH, SHM_V = C::SHM_V, SHM_K = C::SHM_K;
    const int tid = threadIdx.x, wid = tid >> 6, lane = tid & 63, r32 = lane & 31, hi = lane >> 5;
    char* V_lds = lds + C::OFF_V; char* K_lds = lds + C::OFF_K;
    float* ws = (float*)(lds + C::OFF_WS) + wid * 64; float* li_l = ws; float* al_l = ws + 32;
    float m_reg = -1e30f, l_reg = 0; f32x16 o[2] = {}; bf16x8 qr[DQK / 16];
    const bf16_t* Qw = Qb + (size_t)(wid * QBLK + r32) * ldq + hi * 8;
#pragma unroll
    for (int d0 = 0; d0 < DQK / 16; ++d0) qr[d0] = *reinterpret_cast<const bf16x8*>(Qw + d0 * 16);
    const int vk = tid >> 3, vc = (tid & 7) * 8, vst = v_st(vk, vc);
    const int kr0 = tid / KCH, kc0 = (tid % KCH) * 8, kr1 = (512 + tid) / KCH, kc1 = ((512 + tid) % KCH) * 8;
    const bool two = (KCH * 64 > 512) && (tid < KCH * 64 - 512);
    const int vb0 = (int)(uintptr_t)V_lds + v_rd_base(lane);
    constexpr int SDEPTH = (DQK > 64) ? 1 : 2;
    struct { bf16x8 vs, ks0, ks1; } sr_[SDEPTH];
#define ATT_SLOAD(i, k0) do { sr_[i].vs = *reinterpret_cast<const bf16x8*>(Vh + (size_t)((k0) + vk) * ldv + vc); \
    sr_[i].ks0 = *reinterpret_cast<const bf16x8*>(Kh + (size_t)((k0) + kr0) * ldk + kc0); \
    if (two) sr_[i].ks1 = *reinterpret_cast<const bf16x8*>(Kh + (size_t)((k0) + kr1) * ldk + kc1); } while (0)
#define ATT_SWRITE(b, i) do { *(bf16x8*)(V_lds + (b) * SHM_V + vst) = sr_[i].vs; *(bf16x8*)(K_lds + (b) * SHM_K + kr0 * KROW + kc0 * 2) = sr_[i].ks0; \
    if (two) *(bf16x8*)(K_lds + (b) * SHM_K + kr1 * KROW + kc1 * 2) = sr_[i].ks1; } while (0)
#define ATT_SWAIT() do { if constexpr (SDEPTH == 2) asm volatile("s_waitcnt vmcnt(2)" ::: "memory"); else asm volatile("s_waitcnt vmcnt(0)" ::: "memory"); } while (0)
#define ATT_RESC(a) do { if (__any((a) < 1.f)) { if (hi == 0) al_l[r32] = (a); asm volatile("s_waitcnt lgkmcnt(0)" ::: "memory"); \
    _Pragma("unroll") for (int d = 0; d < 2; ++d) _Pragma("unroll") for (int r = 0; r < 16; ++r) o[d][r] *= al_l[crow(r, hi)]; } } while (0)
    f32x16 pA0, pA1, pB0, pB1; float mnA, mnB, alA, alB; bf16x8 pa0, pa1, pa2, pa3; const int NT = seq / KVBLK;
    constexpr int SE = 0, SO = SDEPTH - 1;
    ATT_SLOAD(SE, 0); asm volatile("s_waitcnt vmcnt(0)" ::: "memory"); ATT_SWRITE(0, SE); __syncthreads();
    qkt<DQK>(pA0, pA1, K_lds, qr, r32, hi); partialSM(pA0, pA1, m_reg, mnA, alA);
    ATT_SLOAD(SO, KVBLK); if constexpr (SDEPTH == 2) { if (2 < NT) ATT_SLOAD(SE, 2 * KVBLK); }
    ATT_SWAIT(); ATT_SWRITE(1, SO); __syncthreads();
    for (int j = 1; j + 1 < NT; j += 2) {
        ASBAR(); qkt<DQK>(pB0, pB1, K_lds + SHM_K, qr, r32, hi);
        finishSM(pA0, pA1, alA, l_reg, pa0, pa1, pa2, pa3); ASBAR();
        ATT_SLOAD(SO, (j + SDEPTH) * KVBLK); ASBAR();
        pv_d0(o, vb0, pa0, pa1, pa2, pa3); partialSM(pB0, pB1, m_reg, mnB, alB);
        __syncthreads(); ATT_SWAIT(); ATT_SWRITE(0, SE);
        ATT_RESC(alB); __syncthreads();
        ASBAR(); qkt<DQK>(pA0, pA1, K_lds, qr, r32, hi);
        finishSM(pB0, pB1, alB, l_reg, pa0, pa1, pa2, pa3); ASBAR();
        if (SDEPTH == 1 || j + 3 < NT) ATT_SLOAD(SE, (j + 1 + SDEPTH) * KVBLK); ASBAR();
        pv_d0(o, vb0 + SHM_V, pa0, pa1, pa2, pa3); partialSM(pA0, pA1, m_reg, mnA, alA);
        __syncthreads(); ATT_SWAIT(); ATT_SWRITE(1, SO);
        ATT_RESC(alA); __syncthreads();
    }
    ASBAR(); qkt<DQK>(pB0, pB1, K_lds + SHM_K, qr, r32, hi);
    finishSM(pA0, pA1, alA, l_reg, pa0, pa1, pa2, pa3); ASBAR();
    pv_d0(o, vb0, pa0, pa1, pa2, pa3); partialSM(pB0, pB1, m_reg, mnB, alB);
    __syncthreads(); ATT_RESC(alB);
    finishSM(pB0, pB1, alB, l_reg, pa0, pa1, pa2, pa3); ASBAR();
    pv_d0(o, vb0 + SHM_V, pa0, pa1, pa2, pa3);
    if (hi == 0) li_l[r32] = l_reg; asm volatile("s_waitcnt lgkmcnt(0)" ::: "memory");
    float* stg = (float*)(lds + C::OFF_OST + wid * C::OSTW);
#pragma unroll
    for (int r = 0; r < 16; ++r) { const int orow = crow(r, hi); const float rli = __builtin_amdgcn_rcpf(li_l[orow]);
        stg[orow * 68 + r32] = o[0][r] * rli; stg[orow * 68 + 32 + r32] = o[1][r] * rli; }
    asm volatile("s_waitcnt lgkmcnt(0)" ::: "memory");
#pragma unroll
    for (int i = 0; i < 4; ++i) { const int row = i * 8 + (lane >> 3), ch = (lane & 7) * 8;
        const f32x4v a = *(const f32x4v*)(stg + row * 68 + ch), b = *(const f32x4v*)(stg + row * 68 + ch + 4);
        const size_t off = (size_t)(wid * QBLK + row) * 1024 + ch; const u32x4 g = *(const u32x4*)(Gb + off); u32x4 w;
        w.x = cvtpk(a[0] * __uint_as_float(g.x << 16), a[1] * __uint_as_float(g.x & 0xffff0000u)); w.y = cvtpk(a[2] * __uint_as_float(g.y << 16), a[3] * __uint_as_float(g.y & 0xffff0000u));
        w.z = cvtpk(b[0] * __uint_as_float(g.z << 16), b[1] * __uint_as_float(g.z & 0xffff0000u)); w.w = cvtpk(b[2] * __uint_as_float(g.w << 16), b[3] * __uint_as_float(g.w & 0xffff0000u));
        *(u32x4*)(Ob + off) = w; }
    __syncthreads();
#undef ATT_SLOAD
#undef ATT_SWRITE
#undef ATT_SWAIT
#undef ATT_RESC
}
#undef ASBAR
}
namespace fft {
using bf16x8 = __attribute__((ext_vector_type(8))) short;
using s16x4  = __attribute__((ext_vector_type(4))) short;
using f32x16 = __attribute__((ext_vector_type(16))) float;
using f32x4v = __attribute__((ext_vector_type(4))) float;
using u32x4  = __attribute__((ext_vector_type(4))) unsigned;
constexpr int OFF_X = 0, OFF_STG = 65536;
__device__ __forceinline__ int crow(int r, int hi) { return (r & 3) + 8 * (r >> 2) + 4 * hi; }
__device__ __forceinline__ unsigned cvtpk(float lo, float hi) { unsigned r; asm volatile("v_cvt_pk_bf16_f32 %0, %1, %2" : "=v"(r) : "v"(lo), "v"(hi)); return r; }
__device__ __forceinline__ int x_st(int kk, int c) { const int kp = (kk & ~0xC) | ((kk & 4) << 1) | ((kk & 8) >> 1); return ((kp >> 3) * 8 + (c >> 5)) * 512 + ((kp & 7) * 32 + (c & 31)) * 2; }
__device__ __forceinline__ int x_rd_base(int lane) { return ((lane & 3) << 3) | (((lane >> 2) & 3) << 6) | (((lane >> 4) & 1) << 5) | (((lane >> 5) & 1) << 8); }
constexpr int x_rd_off(int nb, int ks, int half) { return ks * 8192 + half * 4096 + nb * 512; }
template <int OFF> __device__ __forceinline__ s16x4 tr_read(int vb) { s16x4 r; asm volatile("ds_read_b64_tr_b16 %0, %1 offset:%2" : "=&v"(r) : "v"(vb), "i"(OFF) : "memory"); return r; }
template <int NB> __device__ __forceinline__ void mm_block(f32x16& acc, const bf16x8 (&afr)[8], int vb) {
#define FFT_PK(L, H) (bf16x8){L[0], L[1], L[2], L[3], H[0], H[1], H[2], H[3]}
    { const s16x4 l0 = tr_read<x_rd_off(NB, 0, 0)>(vb), h0 = tr_read<x_rd_off(NB, 0, 1)>(vb), l1 = tr_read<x_rd_off(NB, 1, 0)>(vb), h1 = tr_read<x_rd_off(NB, 1, 1)>(vb);
      const s16x4 l2 = tr_read<x_rd_off(NB, 2, 0)>(vb), h2 = tr_read<x_rd_off(NB, 2, 1)>(vb), l3 = tr_read<x_rd_off(NB, 3, 0)>(vb), h3 = tr_read<x_rd_off(NB, 3, 1)>(vb);
      asm volatile("s_waitcnt lgkmcnt(0)" ::: "memory"); __builtin_amdgcn_sched_barrier(0);
      acc = __builtin_amdgcn_mfma_f32_32x32x16_bf16(afr[0], FFT_PK(l0, h0), acc, 0, 0, 0); acc = __builtin_amdgcn_mfma_f32_32x32x16_bf16(afr[1], FFT_PK(l1, h1), acc, 0, 0, 0);
      acc = __builtin_amdgcn_mfma_f32_32x32x16_bf16(afr[2], FFT_PK(l2, h2), acc, 0, 0, 0); acc = __builtin_amdgcn_mfma_f32_32x32x16_bf16(afr[3], FFT_PK(l3, h3), acc, 0, 0, 0); }
    { const s16x4 l0 = tr_read<x_rd_off(NB, 4, 0)>(vb), h0 = tr_read<x_rd_off(NB, 4, 1)>(vb), l1 = tr_read<x_rd_off(NB, 5, 0)>(vb), h1 = tr_read<x_rd_off(NB, 5, 1)>(vb);
      const s16x4 l2 = tr_read<x_rd_off(NB, 6, 0)>(vb), h2 = tr_read<x_rd_off(NB, 6, 1)>(vb), l3 = tr_read<x_rd_off(NB, 7, 0)>(vb), h3 = tr_read<x_rd_off(NB, 7, 1)>(vb);
      asm volatile("s_waitcnt lgkmcnt(0)" ::: "memory"); __builtin_amdgcn_sched_barrier(0);
      acc = __builtin_amdgcn_mfma_f32_32x32x16_bf16(afr[4], FFT_PK(l0, h0), acc, 0, 0, 0); acc = __builtin_amdgcn_mfma_f32_32x32x16_bf16(afr[5], FFT_PK(l1, h1), acc, 0, 0, 0);
      acc = __builtin_amdgcn_mfma_f32_32x32x16_bf16(afr[6], FFT_PK(l2, h2), acc, 0, 0, 0); acc = __builtin_amdgcn_mfma_f32_32x32x16_bf16(afr[7], FFT_PK(l3, h3), acc, 0, 0, 0); }
#undef FFT_PK
}
struct TileRegs { bf16x8 v[8]; };
__device__ __forceinline__ void tile_load(TileRegs& t, const bf16_t* src  , size_t rowstride, int tid) {
    const bf16_t* p = src + (size_t)(tid >> 5) * rowstride + (tid & 31) * 8;
#pragma unroll
    for (int i = 0; i < 8; ++i) t.v[i] = *reinterpret_cast<const bf16x8*>(p + (size_t)(16 * i) * rowstride);
}
__device__ __forceinline__ void tile_write(const TileRegs& t, char* xl, int tid) {
    char* p = xl + x_st(tid >> 5, (tid & 31) * 8);
#pragma unroll
    for (int i = 0; i < 8; ++i) *reinterpret_cast<bf16x8*>(p + 8192 * i) = t.v[i];
}

__device__ __forceinline__ void stage_a(const bf16_t* __restrict__ PQ, bf16_t* __restrict__ Y, char* lds, int vcu, int G) {
    const int tid = threadIdx.x, wid = tid >> 6, lane = tid & 63, r32 = lane & 31, hi = lane >> 5, w = wid & 3, nh = wid >> 2;
    char* xl = lds + OFF_X; char* stg = lds + OFF_STG + wid * 8192;
    bf16x8 afr[8];
    { const int reim = r32 >> 4, k1 = 16 * w + (r32 & 15);
#pragma unroll
      for (int ks = 0; ks < 8; ++ks) { float v[8];
#pragma unroll
          for (int j = 0; j < 8; ++j) { const int kk = 16 * ks + 8 * hi + j, s1 = kk >> 1, pq = kk & 1; const float f = (float)((k1 * s1) & 63) * (1.f / 64.f);
              const float c = __builtin_amdgcn_cosf(f) * 0.125f, s = __builtin_amdgcn_sinf(f) * 0.125f; v[j] = reim == 0 ? (pq == 0 ? c : -s) : (pq == 0 ? s : c); }
          u32x4 p = {cvtpk(v[0], v[1]), cvtpk(v[2], v[3]), cvtpk(v[4], v[5]), cvtpk(v[6], v[7])}; afr[ks] = *reinterpret_cast<bf16x8*>(&p); } }
    const int vb = (int)(uintptr_t)xl + x_rd_base(lane) + nh * 4 * 512;
    constexpr int NU = NB * 192;
    TileRegs tr;
    int u = vcu;
    if (u < NU) tile_load(tr, PQ + (size_t)(u / 192) * 128 * 49152 + (u % 192) * 256, 49152, tid);
    for (; u < NU; u += G) {
        const int b = u / 192, j = u % 192;
        tile_write(tr, xl, tid);
        __syncthreads();
        { const int un = u + G; if (un < NU) tile_load(tr, PQ + (size_t)(un / 192) * 128 * 49152 + (un % 192) * 256, 49152, tid); }
        f32x16 acc[4] = {};
        mm_block<0>(acc[0], afr, vb); mm_block<1>(acc[1], afr, vb); mm_block<2>(acc[2], afr, vb); mm_block<3>(acc[3], afr, vb);
        const int s2 = j / 3;
#pragma unroll
        for (int r = 0; r < 8; ++r) { const int kl = crow(r, hi), k1 = 16 * w + kl; const float f = (float)(k1 * s2) * (1.f / 4096.f); const float tr_ = __builtin_amdgcn_cosf(f), ti_ = __builtin_amdgcn_sinf(f);
#pragma unroll
            for (int nb = 0; nb < 4; ++nb) { const float re = acc[nb][r], im = acc[nb][r + 8];
                *(bf16_t*)(stg + kl * 256 + (nb * 32 + r32) * 2) = f2bf(tr_ * re - ti_ * im);
                *(bf16_t*)(stg + (16 + kl) * 256 + (nb * 32 + r32) * 2) = f2bf(ti_ * re + tr_ * im); } }
        asm volatile("s_waitcnt lgkmcnt(0)" ::: "memory");
#pragma unroll
        for (int i = 0; i < 8; ++i) { const int rowl = i * 4 + (lane >> 4), c16 = lane & 15; const u32x4 v = *(const u32x4*)(stg + rowl * 256 + c16 * 16);
            const int reim = rowl >> 4, k1 = 16 * w + (rowl & 15);
            *(u32x4*)(Y + ((size_t)((b * 64 + k1) * 2 + reim)) * 49152 + j * 256 + nh * 128 + c16 * 8) = v; }
        __syncthreads();
    }
}
__device__ __forceinline__ void stage_b(const bf16_t* __restrict__ Y, const bf16_t* __restrict__ SG, bf16_t* __restrict__ BR, char* lds, int vcu, int G) {
    const int tid = threadIdx.x, wid = tid >> 6, lane = tid & 63, r32 = lane & 31, hi = lane >> 5, w = wid & 1, nq = wid >> 1;
    char* xl = lds + OFF_X; float* stg = (float*)(lds + OFF_STG + wid * 8192);
    bf16x8 afr[8];
    { const int k2 = 32 * w + r32;
#pragma unroll
      for (int ks = 0; ks < 8; ++ks) { float v[8];
#pragma unroll
          for (int j = 0; j < 8; ++j) { const int kk = 16 * ks + 8 * hi + j, reim = kk >> 6, s2 = kk & 63; const float f = (float)((k2 * s2) & 63) * (1.f / 64.f);
              v[j] = reim == 0 ? __builtin_amdgcn_cosf(f) * 0.125f : -__builtin_amdgcn_sinf(f) * 0.125f; }
          u32x4 p = {cvtpk(v[0], v[1]), cvtpk(v[2], v[3]), cvtpk(v[4], v[5]), cvtpk(v[6], v[7])}; afr[ks] = *reinterpret_cast<bf16x8*>(&p); } }
    const int vb = (int)(uintptr_t)xl + x_rd_base(lane) + nq * 2 * 512;
    constexpr int NU = NB * 64 * 3;
    TileRegs tr;
    int u = vcu;
    if (u < NU) tile_load(tr, Y + (size_t)(u / 3) * 2 * 49152 + (u % 3) * 256, 768, tid);
    for (; u < NU; u += G) {
        const int bk1 = u / 3, j = u % 3, b = bk1 >> 6, k1 = bk1 & 63;
        tile_write(tr, xl, tid);
        __syncthreads();
        { const int un = u + G; if (un < NU) tile_load(tr, Y + (size_t)(un / 3) * 2 * 49152 + (un % 3) * 256, 768, tid); }
        f32x16 acc[2] = {};
        mm_block<0>(acc[0], afr, vb); mm_block<1>(acc[1], afr, vb);
#pragma unroll
        for (int r = 0; r < 16; ++r) { const int rl = crow(r, hi); stg[rl * 64 + r32] = acc[0][r]; stg[rl * 64 + 32 + r32] = acc[1][r]; }
        asm volatile("s_waitcnt lgkmcnt(0)" ::: "memory");
#pragma unroll
        for (int i = 0; i < 4; ++i) { const int rowl = i * 8 + (lane >> 3), c8 = (lane & 7) * 8;
            const f32x4v a = *(const f32x4v*)(stg + rowl * 64 + c8), c = *(const f32x4v*)(stg + rowl * 64 + c8 + 4);
            const size_t off = ((size_t)b * SEQ + k1 + 64 * (32 * w + rowl)) * 1024 + j * 256 + nq * 64 + c8; const u32x4 g = *(const u32x4*)(SG + off); u32x4 o;
            o.x = cvtpk(a[0] * __uint_as_float(g.x << 16), a[1] * __uint_as_float(g.x & 0xffff0000u)); o.y = cvtpk(a[2] * __uint_as_float(g.y << 16), a[3] * __uint_as_float(g.y & 0xffff0000u));
            o.z = cvtpk(c[0] * __uint_as_float(g.z << 16), c[1] * __uint_as_float(g.z & 0xffff0000u)); o.w = cvtpk(c[2] * __uint_as_float(g.w << 16), c[3] * __uint_as_float(g.w & 0xffff0000u));
            *(u32x4*)(BR + off) = o; }
        __syncthreads();
    }
}
}
constexpr int NWAVES = 8;
constexpr int N_PHASES = 9;
constexpr int CW_BAR = 4096;
constexpr int RING_OFF = 0, RING_BYTES = 131072;
constexpr int LDSCTL_OFF = RING_BYTES, MISC_OFF = LDSCTL_OFF + 320, RS_OFF = LDSCTL_OFF + 1024  ;
constexpr int LDS_BYTES = 147456;
static_assert(RS_OFF + 4096 <= LDS_BYTES, "LDS map");

struct Args { const void* in[19]; float* out; unsigned char* ws; int ph_lo, ph_hi, li, pad; };

__device__ __forceinline__ void prep_w_job(const float* __restrict__ W, int ldw, int K, bf16_t* __restrict__ out, int n0, int nrows, const float* __restrict__ scale, int mode, int off, int gt, int GT) {
    const int total = nrows * (K >> 3);
    for (int idx = gt; idx < total; idx += GT) {
        const int n = idx % nrows, k8 = idx / nrows; const int sc = src_col(mode, n, off);
        float v[8];
#pragma unroll
        for (int i = 0; i < 8; ++i) { const int k = k8 * 8 + i; float w = (sc >= 0) ? W[(size_t)k * ldw + sc] : 0.f; if (scale) w *= scale[k]; v[i] = w; }
        uint4 o; o.x = pk2(v[0], v[1]); o.y = pk2(v[2], v[3]); o.z = pk2(v[4], v[5]); o.w = pk2(v[6], v[7]);
        *(uint4*)(out + (size_t)(n0 + n) * K + k8 * 8) = o;
    }
}
__device__ __forceinline__ void rmsnorm_row(const float* __restrict__ xrow, const float* __restrict__ g, bf16_t* __restrict__ orow, int lane) {
    const float4* xr = (const float4*)xrow + lane; float4 v[4]; float s = 0.f;
#pragma unroll
    for (int j = 0; j < 4; ++j) { v[j] = xr[64 * j]; s += v[j].x * v[j].x + v[j].y * v[j].y + v[j].z * v[j].z + v[j].w * v[j].w; }
    const float rstd = rsqrtf(wave_sum(s) * (1.f / DM) + EPS);
    uint2* o = (uint2*)orow + lane;
#pragma unroll
    for (int j = 0; j < 4; ++j) { const float4 gv = g ? ((const float4*)g)[lane + 64 * j] : make_float4(1.f, 1.f, 1.f, 1.f);
        uint2 w; w.x = pk2(v[j].x * rstd * gv.x, v[j].y * rstd * gv.y); w.y = pk2(v[j].z * rstd * gv.z, v[j].w * rstd * gv.w); o[64 * j] = w; }
}

typedef float f32x4m __attribute__((ext_vector_type(4)));
__device__ __forceinline__ void fold1_tiles(const float* __restrict__ Wf, float* __restrict__ AG, int gw, int NGW, int lane) {
    const int li = lane & 15, lk = lane >> 4;
    for (int tile = gw; tile < 2 * 4 * 12 * 12; tile += NGW) { const int di = tile % 12, ci = (tile / 12) % 12, g = (tile / 144) & 3, pq = tile / 576;
        const int c = ci * 16 + li; int p = (lk * c) % 192; const int step = (4 * c) % 192;
        const float* wp = Wf + ((size_t)g * 192 + lk) * 192 + di * 16 + li;
        f32x4m acc = {0.f, 0.f, 0.f, 0.f};
        for (int m0 = 0; m0 < 192; m0 += 4) { const float f = (float)p * (1.f / 192.f); const float a = pq ? __builtin_amdgcn_sinf(f) : __builtin_amdgcn_cosf(f);
            const float b = wp[(size_t)m0 * 192];
            acc = __builtin_amdgcn_mfma_f32_16x16x4f32(a, b, acc, 0, 0, 0);
            p += step; if (p >= 192) p -= 192; }
        float* op = AG + (((size_t)pq * 4 + g) * 192 + ci * 16 + 4 * lk) * 192 + di * 16 + li;
#pragma unroll
        for (int r = 0; r < 4; ++r) op[(size_t)r * 192] = acc[r] * 0.07216878364870322f; }
}
__device__ __forceinline__ void fold2_strips(const float* __restrict__ Win1, const float* __restrict__ g1, const float* __restrict__ AG, bf16_t* __restrict__ WIN1o, int gw, int NGW, int lane) {
    const int li = lane & 15, lk = lane >> 4;
    for (int s = gw; s < 64 * 8 * 3; s += NGW) { const int ki = s & 63, pg = (s >> 6) & 7, ds = s >> 9;
        const int g = pg & 3; const float* ap = Win1 + (size_t)(ki * 16 + li) * 2048 + 192 * g + lk; const float* bp = AG + ((size_t)pg * 192 + lk) * 192 + ds * 64 + li;
        f32x4m acc[4] = {{0.f, 0.f, 0.f, 0.f}, {0.f, 0.f, 0.f, 0.f}, {0.f, 0.f, 0.f, 0.f}, {0.f, 0.f, 0.f, 0.f}};
#pragma unroll 4
        for (int c0 = 0; c0 < 192; c0 += 4) { const float a = ap[c0]; const float* b = bp + (size_t)c0 * 192;
#pragma unroll
            for (int n = 0; n < 4; ++n) acc[n] = __builtin_amdgcn_mfma_f32_16x16x4f32(a, b[16 * n], acc[n], 0, 0, 0); }
        const int k0 = ki * 16 + 4 * lk; const float4 gv = *(const float4*)(g1 + k0);
#pragma unroll
        for (int n = 0; n < 4; ++n) { uint2 w; w.x = pk2(acc[n][0] * gv.x, acc[n][1] * gv.y); w.y = pk2(acc[n][2] * gv.z, acc[n][3] * gv.w);
            *(uint2*)(WIN1o + (size_t)((pg >> 2) * 768 + g * 192 + ds * 64 + n * 16 + li) * 1024 + k0) = w; } }
}
__device__ __forceinline__ void rmsnorm_rows2(const float* __restrict__ X, const float* __restrict__ g, bf16_t* __restrict__ O, int nrows, int gw, int NGW, int lane) {
    for (int m = 2 * gw; m < nrows; m += 2 * NGW) {
        const float4* x0 = (const float4*)(X + (size_t)m * DM) + lane; const float4* x1 = x0 + DM / 4; float4 v[8]; float s0 = 0.f, s1 = 0.f;
#pragma unroll
        for (int j = 0; j < 4; ++j) { v[j] = x0[64 * j]; v[4 + j] = x1[64 * j]; }
#pragma unroll
        for (int j = 0; j < 4; ++j) { s0 += v[j].x * v[j].x + v[j].y * v[j].y + v[j].z * v[j].z + v[j].w * v[j].w; s1 += v[4 + j].x * v[4 + j].x + v[4 + j].y * v[4 + j].y + v[4 + j].z * v[4 + j].z + v[4 + j].w * v[4 + j].w; }
        const float r0 = rsqrtf(wave_sum(s0) * (1.f / DM) + EPS), r1 = rsqrtf(wave_sum(s1) * (1.f / DM) + EPS);
        uint2* o0 = (uint2*)(O + (size_t)m * DM) + lane; uint2* o1 = o0 + DM / 4;
#pragma unroll
        for (int j = 0; j < 4; ++j) { const float4 gv = g ? ((const float4*)g)[lane + 64 * j] : make_float4(1.f, 1.f, 1.f, 1.f);
            uint2 w; w.x = pk2(v[j].x * r0 * gv.x, v[j].y * r0 * gv.y); w.y = pk2(v[j].z * r0 * gv.z, v[j].w * r0 * gv.w); o0[64 * j] = w;
            uint2 z; z.x = pk2(v[4 + j].x * r1 * gv.x, v[4 + j].y * r1 * gv.y); z.y = pk2(v[4 + j].z * r1 * gv.z, v[4 + j].w * r1 * gv.w); o1[64 * j] = z; } }
}
template <int DQK>
__device__ __forceinline__ void attn_naive_vb(float* Ks, float* Vs, int t256, const bf16_t* __restrict__ Q, int ldq, int qhs, const bf16_t* __restrict__ Kp, int ldk, int khs, const bf16_t* __restrict__ Vp, int ldv, int vhs,
                                              int nkeys, bf16_t* __restrict__ O, const bf16_t* __restrict__ G, int ocol0, int qblk, int h, int b) {
    constexpr int KT = 8;
    const size_t t = (size_t)b * SEQ + qblk * 256 + t256;
    unsigned qp2[DQK / 2]; float o[64], m = -1e30f, l = 0.f;
    { const bf16_t* qp = Q + t * ldq + h * qhs;
#pragma unroll
      for (int d = 0; d < DQK; d += 8) { const uint4 v = *(const uint4*)(qp + d); qp2[d / 2] = v.x; qp2[d / 2 + 1] = v.y; qp2[d / 2 + 2] = v.z; qp2[d / 2 + 3] = v.w; } }
#pragma unroll
    for (int d = 0; d < 64; ++d) o[d] = 0.f;
    const bf16_t* Kb = Kp + (size_t)b * nkeys * ldk + h * khs; const bf16_t* Vb = Vp + (size_t)b * nkeys * ldv + h * vhs;
    for (int k0 = 0; k0 < nkeys; k0 += KT) {
        __syncthreads();
        if (t256 < KT * DQK / 8) { const int j = t256 / (DQK / 8), d = (t256 % (DQK / 8)) * 8; const uint4 v = *(const uint4*)(Kb + (size_t)(k0 + j) * ldk + d);
            float* p = Ks + j * DQK + d; p[0] = __uint_as_float(v.x << 16); p[1] = __uint_as_float(v.x & 0xffff0000u); p[2] = __uint_as_float(v.y << 16); p[3] = __uint_as_float(v.y & 0xffff0000u);
            p[4] = __uint_as_float(v.z << 16); p[5] = __uint_as_float(v.z & 0xffff0000u); p[6] = __uint_as_float(v.w << 16); p[7] = __uint_as_float(v.w & 0xffff0000u); }
        if (t256 >= 128 && t256 < 128 + KT * 8) { const int tt = t256 - 128, j = tt >> 3, d = (tt & 7) * 8; const uint4 v = *(const uint4*)(Vb + (size_t)(k0 + j) * ldv + d);
            float* p = Vs + j * 64 + d; p[0] = __uint_as_float(v.x << 16); p[1] = __uint_as_float(v.x & 0xffff0000u); p[2] = __uint_as_float(v.y << 16); p[3] = __uint_as_float(v.y & 0xffff0000u);
            p[4] = __uint_as_float(v.z << 16); p[5] = __uint_as_float(v.z & 0xffff0000u); p[6] = __uint_as_float(v.w << 16); p[7] = __uint_as_float(v.w & 0xffff0000u); }
        __syncthreads();
#pragma unroll 1
        for (int j = 0; j < KT; ++j) { float s = 0.f; const float4* kr = (const float4*)(Ks + j * DQK);
#pragma unroll
            for (int d = 0; d < DQK / 4; ++d) { const float4 kv = kr[d]; const unsigned a = qp2[2 * d], c = qp2[2 * d + 1];
                s += __uint_as_float(a << 16) * kv.x + __uint_as_float(a & 0xffff0000u) * kv.y + __uint_as_float(c << 16) * kv.z + __uint_as_float(c & 0xffff0000u) * kv.w; }
            if (s > m) { const float alpha = __builtin_amdgcn_exp2f(m - s); m = s; l *= alpha;
#pragma unroll
                for (int d = 0; d < 64; ++d) o[d] *= alpha; }
            const float p = __builtin_amdgcn_exp2f(s - m); l += p; const float4* vr = (const float4*)(Vs + j * 64);
#pragma unroll
            for (int d = 0; d < 16; ++d) { const float4 vv = vr[d]; o[4 * d] += p * vv.x; o[4 * d + 1] += p * vv.y; o[4 * d + 2] += p * vv.z; o[4 * d + 3] += p * vv.w; } }
    }
    const float rl = 1.f / l;
    const bf16_t* gp = G + t * 1024 + ocol0 + h * 64; bf16_t* op = O + t * 1024 + ocol0 + h * 64;
#pragma unroll
    for (int d = 0; d < 64; d += 8) { const uint4 gv = *(const uint4*)(gp + d); uint4 w;
        w.x = pk2(o[d] * rl * __uint_as_float(gv.x << 16), o[d + 1] * rl * __uint_as_float(gv.x & 0xffff0000u));
        w.y = pk2(o[d + 2] * rl * __uint_as_float(gv.y << 16), o[d + 3] * rl * __uint_as_float(gv.y & 0xffff0000u));
        w.z = pk2(o[d + 4] * rl * __uint_as_float(gv.z << 16), o[d + 5] * rl * __uint_as_float(gv.z & 0xffff0000u));
        w.w = pk2(o[d + 6] * rl * __uint_as_float(gv.w << 16), o[d + 7] * rl * __uint_as_float(gv.w & 0xffff0000u));
        *(uint4*)(op + d) = w; }
}
template <int DQK>
__device__ __forceinline__ void attn_naive_phase(unsigned char* lds, int tid, const bf16_t* Q, int ldq, int qhs, const bf16_t* Kp, int ldk, int khs, const bf16_t* Vp, int ldv, int vhs, int nkeys, int nheads,
                                                 bf16_t* O, const bf16_t* G, int ocol0) {
    const int half = tid >> 8, t256 = tid & 255; float* Ks = (float*)(lds + half * 32768); float* Vs = Ks + 8 * DQK;
    const int total = 16 * nheads * NB, stride = (int)gridDim.x * 2;
    for (int vb = (int)blockIdx.x * 2 + half; vb < total; vb += stride) { const int qblk = vb & 15, h = (vb >> 4) % nheads, b = (vb >> 4) / nheads;
        attn_naive_vb<DQK>(Ks, Vs, t256, Q, ldq, qhs, Kp, ldk, khs, Vp, ldv, vhs, nkeys, O, G, ocol0, qblk, h, b); }
}

__global__ void __launch_bounds__(NWAVES * 64, 2) mk_fwd(Args args) {
    extern __shared__ __attribute__((aligned(16))) unsigned char lds[];
    LAS unsigned char* ldsl = (LAS unsigned char*)lds;
    volatile LAS unsigned* MISC = (volatile LAS unsigned*)(ldsl + MISC_OFF);
    const int tid0 = threadIdx.x;
#define PHASE_IDS() int tid = threadIdx.x; asm volatile("" : "+v"(tid)); const int lane = tid & 63, wave = __builtin_amdgcn_readfirstlane(tid >> 6); const int gt = (int)blockIdx.x * (NWAVES * 64) + tid, gw = (int)blockIdx.x * NWAVES + wave; (void)lane; (void)wave; (void)gt; (void)gw;
    const int vcu = (gridDim.x % 8 == 0) ? ((int)blockIdx.x % 8) * ((int)gridDim.x / 8) + (int)blockIdx.x / 8 : (int)blockIdx.x;
    const int G = gridDim.x, GT = G * NWAVES * 64, NGW = G * NWAVES;
    unsigned char* ws = args.ws;
    gu32* ctl = (gu32*)(ws + WS_CTL);
#define in_x ((const float*)args.in[0])
#define in_mem ((const float*)args.in[1])
#define in_pos ((const int*)args.in[2])
#define in_g0 ((const float*)args.in[3])
#define in_w_in0 ((const float*)args.in[4])
#define in_gq ((const float*)args.in[5])
#define in_gkv ((const float*)args.in[6])
#define in_w_uq ((const float*)args.in[7])
#define in_w_ukv ((const float*)args.in[8])
#define in_gm0 ((const float*)args.in[9])
#define in_w_mkv0 ((const float*)args.in[10])
#define in_w_out0 ((const float*)args.in[11])
#define in_g1 ((const float*)args.in[12])
#define in_w_in1 ((const float*)args.in[13])
#define in_w_fnet ((const float*)args.in[14])
#define in_gm1 ((const float*)args.in[15])
#define in_w_mkv1 ((const float*)args.in[16])
#define in_w_out1 ((const float*)args.in[17])
#define in_gf ((const float*)args.in[18])
#define in_out (args.out)
#define WIN0 ((bf16_t*)(ws + WS_WIN0))
#define WUQ ((bf16_t*)(ws + WS_WUQ))
#define WUKV ((bf16_t*)(ws + WS_WUKV))
#define WMEM ((bf16_t*)(ws + WS_WMEM))
#define WOUT0 ((bf16_t*)(ws + WS_WOUT0))
#define WOUT1 ((bf16_t*)(ws + WS_WOUT1))
#define WIN1 ((bf16_t*)(ws + WS_WIN1))
#define AGBG ((float*)(ws + WS_AGBG))
#define ROPE ((float*)(ws + WS_ROPE))
#define MEMN ((bf16_t*)(ws + WS_MEMN))
#define MEMKV ((bf16_t*)(ws + WS_MEMKV))
#define RSTD1 ((float*)(ws + WS_RSTD1))
#define SSQ ((float*)(ws + WS_SSQ))
#define XN0 ((bf16_t*)(ws + WS_XN0))
#define BR ((bf16_t*)(ws + WS_BR))
#define CQ ((bf16_t*)(ws + WS_CQ))
#define CKV ((bf16_t*)(ws + WS_CKV))
#define QMEM0 ((bf16_t*)(ws + WS_QMEM0))
#define SG0 ((bf16_t*)(ws + WS_SG0))
#define Kb ((bf16_t*)(ws + WS_K))
#define Qb ((bf16_t*)(ws + WS_Q))
#define Vb ((bf16_t*)(ws + WS_V))
#define X1B ((bf16_t*)(ws + WS_X1B))
#define PQ ((bf16_t*)(ws + WS_PQ))
#define QMEM1 ((bf16_t*)(ws + WS_QMEM1))
#define SG1 ((bf16_t*)(ws + WS_SG1))
#define Y ((bf16_t*)(ws + WS_Y))
    for (int u = tid0; u < (LDS_BYTES - LDSCTL_OFF) / 4; u += NWAVES * 64) ((LAS unsigned*)(ldsl + LDSCTL_OFF))[u] = 0u;
    __syncthreads();
    const XcdBarrier bar = xcd_barrier_post((unsigned*)(ctl + CW_BAR) + args.li * XCD_BAR_WORDS, MISC + 8);
#define GRID_BAR() xcd_barrier(bar)
    const int lo = args.ph_lo, hi = args.ph_hi;
#ifndef PH_MASK
#define PH_MASK 0x1ff
#endif
#define IN(k) (((PH_MASK >> (k)) & 1) && lo <= (k) && (k) < hi)
#define BOTH(k) (IN(k) && IN((k) + 1))
    LAS float* rs = (LAS float*)(ldsl + RS_OFF);

    if (IN(0)) { PHASE_IDS();
        prep_w_job(in_w_in0, 1952, 1024, WIN0, 0, 2048, nullptr, MODE_WIN0, 0, gt, GT);
        prep_w_job(in_w_uq, 1152, 384, WUQ, 0, 1280, in_gq, MODE_WUQ, 0, gt, GT);
        prep_w_job(in_w_ukv, 1536, 256, WUKV, 0, 1536, in_gkv, MODE_WUKV, 0, gt, GT);
        prep_w_job(in_w_mkv0, 512, 1024, WMEM, 0, 512, in_gm0, MODE_PLAIN, 0, gt, GT);
        prep_w_job(in_w_mkv1, 512, 1024, WMEM, 512, 512, in_gm1, MODE_PLAIN, 0, gt, GT);
        prep_w_job(in_w_out0, 1024, 1024, WOUT0, 0, 1024, nullptr, MODE_PLAIN, 0, gt, GT);
        prep_w_job(in_w_out1, 1024, 1024, WOUT1, 0, 1024, nullptr, MODE_PLAIN, 0, gt, GT);
        prep_w_job(in_w_in1, 2048, 1024, WIN1, 1536, 1280, in_g1, MODE_PLAIN, 768, gt, GT);
        fold1_tiles(in_w_fnet, AGBG, gw, NGW, lane);
        for (int idx = gt; idx < T * 16; idx += GT) { const int t = idx >> 4, i = idx & 15;
            const float inv_freq = __builtin_amdgcn_exp2f((float)i * -0.83048202372184058696f);
            const float ang = (float)in_pos[t] * inv_freq; double fd = (double)ang * 0.31830988618379067154; fd -= 2.0 * floor(fd * 0.5);
            float sn, cs; sincospif((float)fd, &sn, &cs); ROPE[2 * idx] = cs; ROPE[2 * idx + 1] = sn; }
        rmsnorm_rows2(in_mem, nullptr, MEMN, 4096, gw, NGW, lane);
        rmsnorm_rows2(in_x, in_g0, XN0, T, gw, NGW, lane);
        if (BOTH(0)) GRID_BAR();
    }
    if (IN(1)) { PHASE_IDS();
        fold2_strips(in_w_in1, in_g1, AGBG, WIN1, gw, NGW, lane);
        { pg8::Gemm g{XN0, WIN0, T, 2048, 1024}; pg8::StaticOrder S; S.init(T, 2048, G, (int)blockIdx.x);
          pg8::EpiIn0 E{CQ, CKV, QMEM0, SG0, Kb, SSQ, ROPE};
          pg8::gemm_phase<pg8::EpiIn0, pg8::StaticOrder, true, true>(ldsl + RING_OFF, g, S, E); }
        { pg8::Gemm g{MEMN, WMEM, 4096, 1024, 1024}; pg8::StaticOrder S; S.init(4096, 1024, G, (int)blockIdx.x);
          pg8::EpiPlainB E{MEMKV, 1024, 0};
          pg8::gemm_phase<pg8::EpiPlainB, pg8::StaticOrder, true, true>(ldsl + RING_OFF, g, S, E); }
        if (BOTH(1)) GRID_BAR();
    }
    if (IN(2)) { PHASE_IDS();
        { int kq_ = 384; asm volatile("" : "+s"(kq_)); pg8::Gemm g{CQ, WUQ, T, 1280, kq_}; pg8::StaticOrder S; S.init(T, 1280, G, (int)blockIdx.x);
          pg8::EpiQup E{Qb, SSQ, ROPE};
          pg8::gemm_phase<pg8::EpiQup, pg8::StaticOrder, true, true>(ldsl + RING_OFF, g, S, E); }
        { int kk_ = 256; asm volatile("" : "+s"(kk_)); pg8::Gemm g{CKV, WUKV, T, 1536, kk_}; pg8::StaticOrder S; S.init(T, 1536, G, (int)blockIdx.x);
          pg8::EpiKVup E{Kb, Vb, SSQ};
          pg8::gemm_phase<pg8::EpiKVup, pg8::StaticOrder, true, true>(ldsl + RING_OFF, g, S, E); }
        if (BOTH(2)) GRID_BAR();
    }
    if (IN(3)) { PHASE_IDS();
#ifdef ATTN_NAIVE
        attn_naive_phase<96>(lds, tid, Qb, 1152, 96, Kb, 1152, 96, Vb, 768, 64, SEQ, 12, BR, SG0, 0);
        attn_naive_phase<64>(lds, tid, QMEM0, 256, 64, MEMKV, 1024, 64, MEMKV + 256, 1024, 64, 256, 4, BR, SG0, 768);
#else
        for (int u = vcu; u < 16 * 12 * NB; u += G) { const int qblk = u & 15, pair = u >> 4, b = pair / 12, h = pair % 12; const size_t t0 = (size_t)b * SEQ + qblk * 256;
            att::attn_unit<96>(Qb + t0 * 1152 + h * 96, 1152, Kb + (size_t)b * SEQ * 1152 + h * 96, 1152, Vb + (size_t)b * SEQ * 768 + h * 64, 768, SEQ, BR + t0 * 1024 + h * 64, SG0 + t0 * 1024 + h * 64, (char*)lds); }
        for (int u = vcu; u < 16 * 4 * NB; u += G) { const int qblk = u & 15, pair = u >> 4, b = pair >> 2, h = pair & 3; const size_t t0 = (size_t)b * SEQ + qblk * 256;
            att::attn_unit<64>(QMEM0 + t0 * 256 + h * 64, 256, MEMKV + (size_t)b * 256 * 1024 + h * 64, 1024, MEMKV + (size_t)b * 256 * 1024 + 256 + h * 64, 1024, 256, BR + t0 * 1024 + 768 + h * 64, SG0 + t0 * 1024 + 768 + h * 64, (char*)lds); }
#endif
        if (BOTH(3)) GRID_BAR();
    }
    if (IN(4)) { PHASE_IDS();
        for (int i = tid; i < 1024; i += NWAVES * 64) rs[i] = 0.f;
        __syncthreads();
        { pg8::Gemm g{BR, WOUT0, T, 1024, 1024}; pg8::PanelOrder S; S.init(T, G, (int)blockIdx.x);
          pg8::EpiOut E{in_x, in_out, X1B, rs};
          pg8::gemm_phase<pg8::EpiOut, pg8::PanelOrder, true, true>(ldsl + RING_OFF, g, S, E); }
        __syncthreads();
        if (tid < 256) RSTD1[(size_t)blockIdx.x * 256 + tid] = rsqrtf(((rs[tid * 4] + rs[tid * 4 + 1]) + (rs[tid * 4 + 2] + rs[tid * 4 + 3])) * (1.f / DM) + EPS);
        if (BOTH(4)) GRID_BAR();
    }
    if (IN(5)) { PHASE_IDS();
        { pg8::Gemm g{X1B, WIN1, T, 2816, 1024}; pg8::StaticOrder S; S.init(T, 2816, G, (int)blockIdx.x);
          pg8::EpiIn1 E{PQ, QMEM1, SG1, RSTD1};
          pg8::gemm_phase<pg8::EpiIn1, pg8::StaticOrder, true, true>(ldsl + RING_OFF, g, S, E); }
        if (BOTH(5)) GRID_BAR();
    }
    if (IN(6)) { PHASE_IDS();
#ifdef FFT_NAIVE
        LAS float* tab = (LAS float*)(ldsl + RING_OFF + 65536);
        if (tid < 64) { tab[2 * tid] = cospif(2.f * tid / 64.f); tab[2 * tid + 1] = sinpif(2.f * tid / 64.f); }
        __syncthreads();
        for (int idx = gt; idx < NB * 64 * 49152; idx += GT) { const int e = idx % 49152, k1 = (idx / 49152) & 63, b = idx / (49152 * 64);
            float ar = 0.f, ai = 0.f;
            for (int s1 = 0; s1 < 64; ++s1) { const int w = (k1 * s1) & 63; const float wx = tab[2 * w], wy = tab[2 * w + 1];
                const size_t base = (((size_t)b * 64 + s1) * 2) * 49152 + e; const float p = bf2f(PQ[base]), q = bf2f(PQ[base + 49152]);
                ar += wx * p - wy * q; ai += wy * p + wx * q; }
            ar *= 0.125f; ai *= 0.125f;
            const int s2 = e / 768; const float fr = 2.f * (float)(k1 * s2) / 4096.f; const float tr = cospif(fr), ti = sinpif(fr);
            const size_t ob = (((size_t)b * 64 + k1) * 2) * 49152 + e;
            Y[ob] = f2bf(tr * ar - ti * ai); Y[ob + 49152] = f2bf(ti * ar + tr * ai); }
        __syncthreads();
#else
        fft::stage_a(PQ, Y, (char*)lds, vcu, G);
#endif
#ifdef ATTN_NAIVE
        attn_naive_phase<64>(lds, tid, QMEM1, 256, 64, MEMKV + 512, 1024, 64, MEMKV + 768, 1024, 64, 256, 4, BR, SG1, 768);
#else
        for (int u = vcu; u < 16 * 4 * NB; u += G) { const int qblk = u & 15, pair = u >> 4, b = pair >> 2, h = pair & 3; const size_t t0 = (size_t)b * SEQ + qblk * 256;
            att::attn_unit<64>(QMEM1 + t0 * 256 + h * 64, 256, MEMKV + (size_t)b * 256 * 1024 + 512 + h * 64, 1024, MEMKV + (size_t)b * 256 * 1024 + 768 + h * 64, 1024, 256, BR + t0 * 1024 + 768 + h * 64, SG1 + t0 * 1024 + 768 + h * 64, (char*)lds); }
#endif
        if (BOTH(6)) GRID_BAR();
    }
    if (IN(7)) { PHASE_IDS();
#ifdef FFT_NAIVE
        LAS float* tab = (LAS float*)(ldsl + RING_OFF + 65536);
        __syncthreads();
        if (tid < 64) { tab[2 * tid] = cospif(2.f * tid / 64.f); tab[2 * tid + 1] = sinpif(2.f * tid / 64.f); }
        __syncthreads();
        for (int idx = gt; idx < NB * 64 * 64 * 768; idx += GT) { const int d = idx % 768, k2 = (idx / 768) & 63, bk1 = idx / 49152, b = bk1 >> 6, k1 = bk1 & 63;
            float acc = 0.f;
            for (int s2 = 0; s2 < 64; ++s2) { const int w = (k2 * s2) & 63; const size_t base = ((size_t)bk1 * 2) * 49152 + (size_t)s2 * 768 + d;
                acc += tab[2 * w] * bf2f(Y[base]) - tab[2 * w + 1] * bf2f(Y[base + 49152]); }
            const size_t t = (size_t)b * SEQ + k1 + 64 * k2;
            BR[t * 1024 + d] = f2bf(acc * 0.125f * bf2f(SG1[t * 1024 + d])); }
#else
        fft::stage_b(Y, SG1, BR, (char*)lds, vcu, G);
#endif
        if (BOTH(7)) GRID_BAR();
    }
    if (IN(8)) { PHASE_IDS();
        __syncthreads();
        for (int i = tid; i < 1024; i += NWAVES * 64) rs[i] = 0.f;
        __syncthreads();
        { pg8::Gemm g{BR, WOUT1, T, 1024, 1024}; pg8::PanelOrder S; S.init(T, G, (int)blockIdx.x);
          pg8::EpiOut E{in_out, in_out, nullptr, rs};
          pg8::gemm_phase<pg8::EpiOut, pg8::PanelOrder, true, true>(ldsl + RING_OFF, g, S, E); }
        asm volatile("s_waitcnt vmcnt(0)" ::: "memory");
        __syncthreads();
        for (int r = wave; r < 256; r += NWAVES) { const float rstd = rsqrtf(((rs[r * 4] + rs[r * 4 + 1]) + (rs[r * 4 + 2] + rs[r * 4 + 3])) * (1.f / DM) + EPS);
            float4* xr = (float4*)(in_out + ((size_t)blockIdx.x * 256 + r) * DM) + lane;
#pragma unroll
            for (int j = 0; j < 4; ++j) { float4 v = xr[64 * j]; const float4 gv = ((const float4*)in_gf)[lane + 64 * j]; v.x *= rstd * gv.x; v.y *= rstd * gv.y; v.z *= rstd * gv.z; v.w *= rstd * gv.w; xr[64 * j] = v; } }
    }
#undef in_x
#undef in_mem
#undef in_pos
#undef in_g0
#undef in_w_in0
#undef in_gq
#undef in_gkv
#undef in_w_uq
#undef in_w_ukv
#undef in_gm0
#undef in_w_mkv0
#undef in_w_out0
#undef in_g1
#undef in_w_in1
#undef in_w_fnet
#undef in_gm1
#undef in_w_mkv1
#undef in_w_out1
#undef in_gf
#undef in_out
#undef WIN0
#undef WUQ
#undef WUKV
#undef WMEM
#undef WOUT0
#undef WOUT1
#undef WIN1
#undef AGBG
#undef ROPE
#undef MEMN
#undef MEMKV
#undef RSTD1
#undef SSQ
#undef XN0
#undef BR
#undef CQ
#undef CKV
#undef QMEM0
#undef SG0
#undef Kb
#undef Qb
#undef Vb
#undef X1B
#undef PQ
#undef QMEM1
#undef SG1
#undef Y
#undef PHASE_IDS
#undef IN
#undef BOTH
#undef GRID_BAR
}

extern "C" void kernel_launch(void* const* d_in, const int* in_sizes, int n_in, void* d_out, int out_size, void* d_ws, size_t ws_size, hipStream_t stream) {
    static int grid = 0;
    if (grid == 0) {
        if (n_in != 19 || ws_size < WS_END || out_size != T * DM) { fprintf(stderr, "kernel_launch: unexpected n_in %d / ws %zu / out %d\n", n_in, ws_size, out_size); grid = -1; return; }
        int dev = 0, cus = 0;
        if (hipGetDevice(&dev) != hipSuccess || hipDeviceGetAttribute(&cus, hipDeviceAttributeMultiprocessorCount, dev) != hipSuccess) { grid = -1; return; }
        if (hipFuncSetAttribute((const void*)mk_fwd, hipFuncAttributeMaxDynamicSharedMemorySize, LDS_BYTES) != hipSuccess) { fprintf(stderr, "kernel_launch: hipFuncSetAttribute failed\n"); grid = -1; return; }
        int per_cu = 0; (void)hipOccupancyMaxActiveBlocksPerMultiprocessor(&per_cu, (const void*)mk_fwd, NWAVES * 64, LDS_BYTES); (void)hipGetLastError();
        if (cus != 256 || per_cu < 1) fprintf(stderr, "kernel_launch: note: %d CUs, occupancy query %d (built for 256 CUs, one workgroup each)\n", cus, per_cu);
        grid = 256;
    }
    if (grid < 0) return;
    if (hipMemsetAsync((char*)d_ws + WS_CTL, 0, CTL_ZERO_BYTES, stream) != hipSuccess) { fprintf(stderr, "kernel_launch: memset failed\n"); return; }
    Args a{};
    for (int i = 0; i < 19; ++i) a.in[i] = d_in[i];
    a.out = (float*)d_out; a.ws = (unsigned char*)d_ws;
#ifndef PROBE_PHASE
    const int nl = 1; const int rlo[1] = {0}, rhi[1] = {N_PHASES};
#else
    const int nl = 3; const int rlo[3] = {0, PROBE_PHASE, PROBE_PHASE}, rhi[3] = {PROBE_PHASE + 1, PROBE_PHASE + 1, N_PHASES};
#endif
    for (int li = 0; li < nl; ++li) {
        a.ph_lo = rlo[li]; a.ph_hi = rhi[li]; a.li = li; a.pad = 0;
        hipLaunchKernelGGL(mk_fwd, dim3(grid), dim3(NWAVES * 64), LDS_BYTES, stream, a);
        const hipError_t le = hipPeekAtLastError();
        if (le != hipSuccess) { fprintf(stderr, "kernel_launch: launch %d failed: %s\n", li, hipGetErrorName(le)); break; }
    }
}
```

```cpp
#include <hip/hip_runtime.h>
#include <stdint.h>
#include <cstdio>

typedef unsigned short bf16_t;
constexpr int T = 65536, SEQ = 4096, NB = 16, DM = 1024;
constexpr float EPS = 1e-6f;
constexpr float LOG2E = 1.4426950408889634f;
constexpr float QS_MLA = 0.10206207261596575f * LOG2E;
constexpr float QS_MEM = 0.125f * LOG2E;

constexpr size_t MiB = 1u << 20;
constexpr size_t WS_CTL = 0, CTL_ZERO_BYTES = 1 * MiB;
constexpr size_t WS_WIN0 = 1 * MiB;
constexpr size_t WS_WUQ = 5 * MiB;
constexpr size_t WS_WUKV = 6 * MiB;
constexpr size_t WS_WMEM = 7 * MiB;
constexpr size_t WS_WOUT0 = 9 * MiB;
constexpr size_t WS_WOUT1 = 11 * MiB;
constexpr size_t WS_WIN1 = 13 * MiB;
constexpr size_t WS_AGBG = 19 * MiB;
constexpr size_t WS_ROPE = 21 * MiB;
constexpr size_t WS_MEMN = 29 * MiB;
constexpr size_t WS_MEMKV = 37 * MiB;
constexpr size_t WS_RSTD1 = 45 * MiB;
constexpr size_t WS_SSQ = 46 * MiB;
constexpr size_t WS_XN0 = 64 * MiB;
constexpr size_t WS_BR = 64 * MiB;
constexpr size_t WS_CQ = 192 * MiB;
constexpr size_t WS_CKV = 240 * MiB;
constexpr size_t WS_QMEM0 = 272 * MiB;
constexpr size_t WS_SG0 = 304 * MiB;
constexpr size_t WS_K = 432 * MiB;
constexpr size_t WS_Q = 576 * MiB;
constexpr size_t WS_V = 720 * MiB;
constexpr size_t WS_X1B = 192 * MiB;
constexpr size_t WS_PQ = 320 * MiB;
constexpr size_t WS_QMEM1 = 512 * MiB;
constexpr size_t WS_SG1 = 544 * MiB;
constexpr size_t WS_Y = 672 * MiB;
constexpr size_t WS_END = 864 * MiB;

__device__ __forceinline__ float bf2f(bf16_t h) { return __uint_as_float(((unsigned)h) << 16); }
__device__ __forceinline__ bf16_t f2bf(float f) { unsigned u = __float_as_uint(f); return (bf16_t)((u + 0x7fffu + ((u >> 16) & 1u)) >> 16); }
__device__ __forceinline__ unsigned pk2(float lo, float hi) { return (unsigned)f2bf(lo) | ((unsigned)f2bf(hi) << 16); }
__device__ __forceinline__ float silu_f(float v) { return v * __builtin_amdgcn_rcpf(1.f + __expf(-v)); }
__device__ __forceinline__ float wave_sum(float v) {
#pragma unroll
    for (int o = 1; o < 64; o <<= 1) v += __shfl_xor(v, o);
    return v;
}
__host__ __device__ __forceinline__ int ropedim(int p) { return 4 * (p >> 3) + (p & 3) + 16 * ((p >> 2) & 1); }
enum { MODE_WIN0 = 0, MODE_WUQ = 1, MODE_WUKV = 2, MODE_PLAIN = 3 };
__device__ __forceinline__ int src_col(int mode, int n, int off) {
    if (mode == MODE_WIN0) {
        if (n < 640) return n;
        if (n < 896) return 672 + (n - 640);
        if (n < 928) return 640 + ropedim(n - 896);
        if (n < 1024) return -1;
        return 928 + (n - 1024);
    } else if (mode == MODE_WUQ) {
        if (n < 768) return (n >> 6) * 96 + (n & 63);
        if (n < 1152) { const int r = n - 768; return (r >> 5) * 96 + 64 + ropedim(r & 31); }
        return -1;
    } else if (mode == MODE_WUKV) {
        if (n < 768) return (n >> 6) * 128 + (n & 63);
        const int r = n - 768; return (r >> 6) * 128 + 64 + (r & 63);
    }
    return n + off;
}
namespace pg8 {
#define PG8_LAS __attribute__((address_space(3)))
typedef unsigned short bf16_t;
typedef short bf16x8 __attribute__((ext_vector_type(8)));
typedef float f32x4 __attribute__((ext_vector_type(4)));
typedef unsigned u32x4 __attribute__((ext_vector_type(4)));
constexpr int BM = 256, BK = 64, HALF = 128, HTB = HALF * BK * 2  , STAGE_BYTES = 8 * HTB, NXCD = 8, WGM = 8;

__host__ __device__ __forceinline__ int lds_byte(int r, int c) { const int st = (r >> 4) * 2 + (c >> 5), rr = r & 15, cc = c & 31, ob = rr * 64 + cc * 2; return st * 1024 + (ob ^ (((ob >> 9) & 1) << 5)); }
__host__ __device__ __forceinline__ void stage_rc(int b, int& R, int& C) { const int st = b / 1024, sb = b % 1024, swz = sb ^ (((sb >> 9) & 1) << 5); R = (st >> 1) * 16 + swz / 64; C = (st & 1) * 32 + (swz % 64) / 2; }
__host__ __device__ __forceinline__ int perm32(int rho) { const int n = rho >> 4, i = rho & 15; return 8 * (i >> 2) + 4 * n + (i & 3); }

struct Unit { int pm, pn; };
struct Gemm { const bf16_t* A; const bf16_t* Bt; int M, N, K; };

struct StaticOrder {
    int nM, nN, nwg, G, c;
    __host__ __device__ void init(int M, int N, int G_, int c_) { nM = M / BM; nN = N / BM; nwg = nM * nN; G = G_; c = c_; }
    __host__ __device__ bool next(int i, Unit& u) const {
        const long L = (long)i * G + c; if (L >= nwg) return false;
        int wgid = (int)L; { const int q = nwg / NXCD, r = nwg % NXCD, xcd = wgid % NXCD, off = wgid / NXCD; wgid = (xcd < r ? xcd * (q + 1) : r * (q + 1) + (xcd - r) * q) + off; }
        const int nig = WGM * nN, gid = wgid / nig, fm = gid * WGM, gsz = (nM - fm) < WGM ? (nM - fm) : WGM;
        u.pm = fm + ((wgid % nig) % gsz); u.pn = (wgid % nig) / gsz; return true;
    }
    __device__ __forceinline__ void a_ready(const Unit&) const {}
    __device__ __forceinline__ void done(const Unit&) const {}
};

__device__ __forceinline__ unsigned cvt_pk_bf16(float lo, float hi) { unsigned r; asm volatile("v_cvt_pk_bf16_f32 %0, %1, %2" : "=v"(r) : "v"(lo), "v"(hi)); return r; }
typedef float f32x2 __attribute__((ext_vector_type(2)));
__device__ __forceinline__ u32x4 pack8(const f32x4 a, const f32x4 b, float s) { u32x4 w; w.x = cvt_pk_bf16(a[0] * s, a[1] * s); w.y = cvt_pk_bf16(a[2] * s, a[3] * s); w.z = cvt_pk_bf16(b[0] * s, b[1] * s); w.w = cvt_pk_bf16(b[2] * s, b[3] * s); return w; }
__device__ __forceinline__ float ss8(const f32x4 a, const f32x4 b) { return (a[0] * a[0] + a[1] * a[1]) + (a[2] * a[2] + a[3] * a[3]) + (b[0] * b[0] + b[1] * b[1]) + (b[2] * b[2] + b[3] * b[3]); }
__device__ __forceinline__ float quad_sum(float v) { v += __shfl_xor(v, 16); v += __shfl_xor(v, 32); return v; }
__device__ __forceinline__ f32x4 silu4(const f32x4 v) { f32x4 o; o[0] = silu_f(v[0]); o[1] = silu_f(v[1]); o[2] = silu_f(v[2]); o[3] = silu_f(v[3]); return o; }
typedef unsigned u32x2 __attribute__((ext_vector_type(2)));
__device__ __forceinline__ void rope_pair(const f32x4 a, const f32x4 b, const float* cs  , float s, u32x2& o1, u32x2& o2) {
    const f32x4 c01 = *(const f32x4*)cs, c23 = *(const f32x4*)(cs + 4);
    const float r0 = (a[0] * c01[0] - b[0] * c01[1]) * s, r1 = (a[1] * c01[2] - b[1] * c01[3]) * s, r2 = (a[2] * c23[0] - b[2] * c23[1]) * s, r3 = (a[3] * c23[2] - b[3] * c23[3]) * s;
    const float q0 = (b[0] * c01[0] + a[0] * c01[1]) * s, q1 = (b[1] * c01[2] + a[1] * c01[3]) * s, q2 = (b[2] * c23[0] + a[2] * c23[1]) * s, q3 = (b[3] * c23[2] + a[3] * c23[3]) * s;
    o1.x = cvt_pk_bf16(r0, r1); o1.y = cvt_pk_bf16(r2, r3); o2.x = cvt_pk_bf16(q0, q1); o2.y = cvt_pk_bf16(q2, q3);
}
struct EpiIn0 {
    static constexpr bool PERM = true, AFTER_DRAIN = false;
    bf16_t *CQ, *CKV, *QMEM, *SG, *Kb; float* SSQ; const float* rope;
    __device__ __forceinline__ void operator()(const f32x4 (&acc)[2][2][4][2], const Unit& u, int wr, int wc, int fr, int fq) const {
#pragma unroll
        for (int ai = 0; ai < 2; ++ai)
#pragma unroll
            for (int m = 0; m < 4; ++m) { int rowi_ = u.pm * BM + ai * HALF + wr * 64 + m * 16 + fr; asm volatile("" : "+v"(rowi_)); const size_t row = (size_t)rowi_;
#pragma unroll
                for (int bj = 0; bj < 2; ++bj) { const int cb = u.pn * BM + bj * HALF + wc * 32, c = cb + 8 * fq; const f32x4 v0 = acc[ai][bj][m][0], v1 = acc[ai][bj][m][1];
                    if (cb < 640) { const float ss = quad_sum(ss8(v0, v1));
                        if (cb < 384) { *(u32x4*)(CQ + row * 384 + c) = pack8(v0, v1, 1.f); if (fq == 0) SSQ[row * 20 + (cb >> 5)] = ss; }
                        else { *(u32x4*)(CKV + row * 256 + (c - 384)) = pack8(v0, v1, 1.f); if (fq == 0) SSQ[row * 20 + 12 + ((cb - 384) >> 5)] = ss; } }
                    else if (cb < 896) { *(u32x4*)(QMEM + row * 256 + (c - 640)) = pack8(v0, v1, QS_MEM); }
                    else if (cb < 1024) { if (cb == 896) { u32x2 o1, o2; rope_pair(v0, v1, rope + row * 32 + 8 * fq, 1.f, o1, o2);
#pragma unroll
                            for (int h = 0; h < 12; ++h) { *(u32x2*)(Kb + row * 1152 + h * 96 + 64 + 4 * fq) = o1; *(u32x2*)(Kb + row * 1152 + h * 96 + 80 + 4 * fq) = o2; } } }
                    else { *(u32x4*)(SG + row * 1024 + (c - 1024)) = pack8(silu4(v0), silu4(v1), 1.f); } } }
    }
};
struct EpiPlainB {
    static constexpr bool PERM = true, AFTER_DRAIN = false;
    bf16_t* O; int ldo; int pad;
    __device__ __forceinline__ void operator()(const f32x4 (&acc)[2][2][4][2], const Unit& u, int wr, int wc, int fr, int fq) const {
#pragma unroll
        for (int ai = 0; ai < 2; ++ai)
#pragma unroll
            for (int m = 0; m < 4; ++m) { int rowi_ = u.pm * BM + ai * HALF + wr * 64 + m * 16 + fr; asm volatile("" : "+v"(rowi_)); const size_t row = (size_t)rowi_;
#pragma unroll
                for (int bj = 0; bj < 2; ++bj) { const int c = u.pn * BM + bj * HALF + wc * 32 + 8 * fq; *(u32x4*)(O + row * ldo + c) = pack8(acc[ai][bj][m][0], acc[ai][bj][m][1], 1.f); } }
    }
};
struct EpiQup {
    static constexpr bool PERM = true, AFTER_DRAIN = false;
    bf16_t* Qb; const float* SSQ; const float* rope;
    __device__ __forceinline__ void operator()(const f32x4 (&acc)[2][2][4][2], const Unit& u, int wr, int wc, int fr, int fq) const {
#pragma unroll
        for (int ai = 0; ai < 2; ++ai)
#pragma unroll
            for (int m = 0; m < 4; ++m) { int rowi_ = u.pm * BM + ai * HALF + wr * 64 + m * 16 + fr; asm volatile("" : "+v"(rowi_)); const size_t row = (size_t)rowi_;
                const f32x4 s0 = *(const f32x4*)(SSQ + row * 20), s1 = *(const f32x4*)(SSQ + row * 20 + 4), s2 = *(const f32x4*)(SSQ + row * 20 + 8);
                const float ss = ((s0[0] + s0[1]) + (s0[2] + s0[3])) + ((s1[0] + s1[1]) + (s1[2] + s1[3])) + ((s2[0] + s2[1]) + (s2[2] + s2[3]));
                const float s = rsqrtf(ss * (1.f / 384.f) + EPS) * QS_MLA;
#pragma unroll
                for (int bj = 0; bj < 2; ++bj) { const int cb = u.pn * BM + bj * HALF + wc * 32, c = cb + 8 * fq; const f32x4 v0 = acc[ai][bj][m][0], v1 = acc[ai][bj][m][1];
                    if (cb < 768) { *(u32x4*)(Qb + row * 1152 + (c >> 6) * 96 + (c & 63)) = pack8(v0, v1, s); }
                    else if (cb < 1152) { const int h = (cb - 768) >> 5; u32x2 o1, o2; rope_pair(v0, v1, rope + row * 32 + 8 * fq, s, o1, o2);
                        *(u32x2*)(Qb + row * 1152 + h * 96 + 64 + 4 * fq) = o1; *(u32x2*)(Qb + row * 1152 + h * 96 + 80 + 4 * fq) = o2; } }
                asm volatile("" ::: "memory"); }
    }
};
struct EpiKVup {
    static constexpr bool PERM = true, AFTER_DRAIN = false;
    bf16_t *Kb, *Vb; const float* SSQ;
    __device__ __forceinline__ void operator()(const f32x4 (&acc)[2][2][4][2], const Unit& u, int wr, int wc, int fr, int fq) const {
#pragma unroll
        for (int ai = 0; ai < 2; ++ai)
#pragma unroll
            for (int m = 0; m < 4; ++m) { int rowi_ = u.pm * BM + ai * HALF + wr * 64 + m * 16 + fr; asm volatile("" : "+v"(rowi_)); const size_t row = (size_t)rowi_;
                const f32x4 s0 = *(const f32x4*)(SSQ + row * 20 + 12), s1 = *(const f32x4*)(SSQ + row * 20 + 16);
                const float ss = ((s0[0] + s0[1]) + (s0[2] + s0[3])) + ((s1[0] + s1[1]) + (s1[2] + s1[3]));
                const float s = rsqrtf(ss * (1.f / 256.f) + EPS);
#pragma unroll
                for (int bj = 0; bj < 2; ++bj) { const int cb = u.pn * BM + bj * HALF + wc * 32, c = cb + 8 * fq; const f32x4 v0 = acc[ai][bj][m][0], v1 = acc[ai][bj][m][1];
                    if (cb < 768) *(u32x4*)(Kb + row * 1152 + (c >> 6) * 96 + (c & 63)) = pack8(v0, v1, s);
                    else *(u32x4*)(Vb + row * 768 + (c - 768)) = pack8(v0, v1, s); }
                asm volatile("" ::: "memory"); }
    }
};
struct EpiOut {
    static constexpr bool PERM = true, AFTER_DRAIN = false;
    const float* R; float* X1; bf16_t* X1B; PG8_LAS float* rs;
    __device__ __forceinline__ void operator()(const f32x4 (&acc)[2][2][4][2], const Unit& u, int wr, int wc, int fr, int fq) const {
#pragma unroll
        for (int ai = 0; ai < 2; ++ai)
#pragma unroll
            for (int m = 0; m < 4; ++m) { int rl = ai * HALF + wr * 64 + m * 16 + fr; asm volatile("" : "+v"(rl)); const size_t row = (size_t)(u.pm * BM + rl); float ssum = 0.f;
#pragma unroll
                for (int bj = 0; bj < 2; ++bj) { const int c = u.pn * BM + bj * HALF + wc * 32 + 8 * fq;
                    const f32x4 x0 = *(const f32x4*)(R + row * 1024 + c) + acc[ai][bj][m][0], x1 = *(const f32x4*)(R + row * 1024 + c + 4) + acc[ai][bj][m][1];
                    *(f32x4*)(X1 + row * 1024 + c) = x0; *(f32x4*)(X1 + row * 1024 + c + 4) = x1;
                    if (X1B) *(u32x4*)(X1B + row * 1024 + c) = pack8(x0, x1, 1.f);
                    ssum += ss8(x0, x1); }
                ssum = quad_sum(ssum); if (fq == 0) rs[rl * 4 + wc] += ssum; }
    }
};
struct EpiIn1 {
    static constexpr bool PERM = true, AFTER_DRAIN = false;
    bf16_t *PQ, *QMEM, *SG; const float* RSTD;
    __device__ __forceinline__ void operator()(const f32x4 (&acc)[2][2][4][2], const Unit& u, int wr, int wc, int fr, int fq) const {
#pragma unroll
        for (int ai = 0; ai < 2; ++ai)
#pragma unroll
            for (int m = 0; m < 4; ++m) { int rowi = u.pm * BM + ai * HALF + wr * 64 + m * 16 + fr; asm volatile("" : "+v"(rowi)); const size_t row = (size_t)rowi; const float r = RSTD[row];
                const int b = rowi >> 12, sq = rowi & 4095, s1 = sq >> 6, s2 = sq & 63; const size_t prow = ((size_t)(b * 64 + s1) * 2) * 64 + s2;
#pragma unroll
                for (int bj = 0; bj < 2; ++bj) { const int cb = u.pn * BM + bj * HALF + wc * 32, c = cb + 8 * fq; const f32x4 v0 = acc[ai][bj][m][0], v1 = acc[ai][bj][m][1];
                    if (cb < 1536) { const int pq = cb >= 768 ? 1 : 0; *(u32x4*)(PQ + (prow + pq * 64) * 768 + (c - pq * 768)) = pack8(v0, v1, r); }
                    else if (cb < 1792) *(u32x4*)(QMEM + row * 256 + (c - 1536)) = pack8(v0, v1, r * QS_MEM);
                    else *(u32x4*)(SG + row * 1024 + (c - 1792)) = pack8(silu4(v0 * r), silu4(v1 * r), 1.f); } }
    }
};
struct PanelOrder {
    int nM, G, c;
    __device__ void init(int M, int G_, int c_) { nM = M / BM; G = G_; c = c_; }
    __device__ bool next(int i, Unit& u) const { u.pm = c + G * (i >> 2); u.pn = i & 3; return u.pm < nM; }
    __device__ __forceinline__ void a_ready(const Unit&) const {}
    __device__ __forceinline__ void done(const Unit&) const {}
};
template <class Epi, class Sched, bool ALIGN_EPI = false, bool SP2 = false>
__device__ __forceinline__ void gemm_phase(PG8_LAS unsigned char* lds, const Gemm g, const Sched& S, const Epi& E) {
    const int tid = threadIdx.x, wid = __builtin_amdgcn_readfirstlane(tid >> 6), lane = tid & 63, wr = wid >> 2, wc = wid & 3, fr = lane & 15, fq = lane >> 4;
    const int K = g.K, nt = K / BK;
    unsigned voffA[2], voffB[2];
#pragma unroll
    for (int i = 0; i < 2; ++i) { int R, C; stage_rc(tid * 16 + i * 8192, R, C); const int Rb = Epi::PERM ? ((R & ~31) + perm32(R & 31)) : R;
        voffA[i] = (unsigned)(R * K + C) * 2u; voffB[i] = (unsigned)(Rb * K + C) * 2u; }
    const size_t kstep = (size_t)(BK * 2);
    const size_t hstep = (size_t)HALF * K * 2;
    const size_t tstep = 2 * hstep;
    const unsigned ldsw = (unsigned)wid * 1024u;
    const int aoff = lds_byte(wr * 64 + fr, fq * 8), boff = lds_byte(wc * 32 + fr, fq * 8);
#define PG8_SA(b, h) (((b) * 2 + (h)) * HTB)
#define PG8_SB(b, h) ((4 + (b) * 2 + (h)) * HTB)
#define PG8_STAGE(bufoff, gbase, voff) do { _Pragma("unroll") for (int _i = 0; _i < 2; ++_i) \
        __builtin_amdgcn_global_load_lds((const unsigned*)((const char*)(gbase) + (voff)[_i]), (PG8_LAS unsigned*)(lds + (bufoff) + ldsw + _i * 8192), 16, 0, 0); } while (0)
#define PG8_LDA(dst, b, h) do { _Pragma("unroll") for (int m = 0; m < 4; ++m) _Pragma("unroll") for (int k = 0; k < 2; ++k) dst[m][k] = *(const PG8_LAS bf16x8*)(lds + PG8_SA(b, h) + aoff + m * 2048 + k * 1024); } while (0)
#define PG8_LDB(dst, b, h) do { _Pragma("unroll") for (int n = 0; n < 2; ++n) _Pragma("unroll") for (int k = 0; k < 2; ++k) dst[n][k] = *(const PG8_LAS bf16x8*)(lds + PG8_SB(b, h) + boff + n * 2048 + k * 1024); } while (0)
#define PG8_MMA(ai, bj, At, Bt) do { __builtin_amdgcn_s_setprio(1); _Pragma("unroll") for (int m = 0; m < 4; ++m) _Pragma("unroll") for (int n = 0; n < 2; ++n) _Pragma("unroll") for (int k = 0; k < 2; ++k) \
        acc[ai][bj][m][n] = __builtin_amdgcn_mfma_f32_16x16x32_bf16(Bt[n][k], At[m][k], acc[ai][bj][m][n], 0, 0, 0); __builtin_amdgcn_s_setprio(0); } while (0)
#define PG8_WAIT_V(n) asm volatile("s_waitcnt vmcnt(" #n ")" ::: "memory")
#define PG8_WAIT_L(n) asm volatile("s_waitcnt lgkmcnt(" #n ")" ::: "memory")
#define PG8_BAR __builtin_amdgcn_s_barrier()
#define PG8_SCHED __builtin_amdgcn_sched_barrier(0)
    Unit cur, nxt; int ui = 0;
    if (!S.next(0, cur)) return;
    f32x4 acc[2][2][4][2];
#pragma unroll
    for (int a = 0; a < 2; ++a)
#pragma unroll
        for (int b = 0; b < 2; ++b)
#pragma unroll
            for (int m = 0; m < 4; ++m)
#pragma unroll
                for (int n = 0; n < 2; ++n) acc[a][b][m][n] = (f32x4){0.f, 0.f, 0.f, 0.f};
    bf16x8 At[4][2], B0[2][2], B1[2][2];
    const char* cA = (const char*)g.A + (size_t)cur.pm * tstep; const char* cB = (const char*)g.Bt + (size_t)cur.pn * tstep;
    S.a_ready(cur);
    if constexpr (SP2) {
        PG8_STAGE(PG8_SB(0, 0), cB, voffB); PG8_STAGE(PG8_SB(0, 1), cB + hstep, voffB); PG8_STAGE(PG8_SA(0, 0), cA, voffA); PG8_STAGE(PG8_SA(0, 1), cA + hstep, voffA);
        if (wr == 1) PG8_BAR;
        PG8_WAIT_V(2); PG8_BAR;
        PG8_STAGE(PG8_SB(1, 0), cB + kstep, voffB); PG8_STAGE(PG8_SA(1, 0), cA + kstep, voffA); PG8_STAGE(PG8_SB(1, 1), cB + hstep + kstep, voffB);
        PG8_WAIT_V(6); PG8_BAR;
    } else {
        PG8_STAGE(PG8_SB(0, 0), cB, voffB); PG8_STAGE(PG8_SA(0, 0), cA, voffA); PG8_STAGE(PG8_SB(0, 1), cB + hstep, voffB); PG8_STAGE(PG8_SA(0, 1), cA + hstep, voffA);
        if (wr == 1) PG8_BAR;
        PG8_WAIT_V(4); PG8_BAR;
        PG8_STAGE(PG8_SB(1, 0), cB + kstep, voffB); PG8_STAGE(PG8_SA(1, 0), cA + kstep, voffA); PG8_STAGE(PG8_SB(1, 1), cB + hstep + kstep, voffB);
        PG8_WAIT_V(6); PG8_BAR;
    }
    for (;;) {
        const bool has_next = S.next(ui + 1, nxt);
        const char* nA = has_next ? (const char*)g.A + (size_t)nxt.pm * tstep : cA; const char* nB = has_next ? (const char*)g.Bt + (size_t)nxt.pn * tstep : cB;
        for (int t = 0; t < nt; t += 2) {
            const bool last = (t == nt - 2);
            const char* a1 = cA + (size_t)(t + 1) * kstep;
            const char* a2 = last ? nA : cA + (size_t)(t + 2) * kstep; const char* b2 = last ? nB : cB + (size_t)(t + 2) * kstep;
            const char* a3 = a2 + kstep; const char* b3 = b2 + kstep;
            if (last && has_next) S.a_ready(nxt);
            if constexpr (SP2) {
            PG8_LDB(B0, 0, 0); PG8_LDB(B1, 0, 1); PG8_SCHED; PG8_LDA(At, 0, 0); PG8_STAGE(PG8_SA(1, 1), a1 + hstep, voffA);
            PG8_WAIT_V(8); PG8_WAIT_L(0); PG8_BAR; PG8_MMA(0, 0, At, B0); PG8_MMA(0, 1, At, B1); PG8_BAR; PG8_SCHED;
            PG8_LDA(At, 0, 1); PG8_STAGE(PG8_SB(0, 0), b2, voffB); PG8_STAGE(PG8_SB(0, 1), b2 + hstep, voffB); PG8_STAGE(PG8_SA(0, 0), a2, voffA);
            PG8_WAIT_V(8); PG8_WAIT_L(0); PG8_BAR; PG8_MMA(1, 0, At, B0); PG8_MMA(1, 1, At, B1); PG8_BAR; PG8_SCHED;
            PG8_LDB(B0, 1, 0); PG8_LDB(B1, 1, 1); PG8_SCHED; PG8_LDA(At, 1, 0); PG8_STAGE(PG8_SA(0, 1), a2 + hstep, voffA);
            PG8_WAIT_V(8); PG8_WAIT_L(0); PG8_BAR; PG8_MMA(0, 0, At, B0); PG8_MMA(0, 1, At, B1); PG8_BAR; PG8_SCHED;
            PG8_LDA(At, 1, 1); PG8_STAGE(PG8_SB(1, 0), b3, voffB); PG8_STAGE(PG8_SB(1, 1), b3 + hstep, voffB); PG8_STAGE(PG8_SA(1, 0), a3, voffA);
            PG8_WAIT_V(8); PG8_WAIT_L(0); PG8_BAR; PG8_MMA(1, 0, At, B0); PG8_MMA(1, 1, At, B1); PG8_BAR; PG8_SCHED;
            } else {
            PG8_LDB(B0, 0, 0); PG8_SCHED; PG8_LDA(At, 0, 0); PG8_STAGE(PG8_SA(1, 1), a1 + hstep, voffA);
            PG8_WAIT_L(8); PG8_BAR; PG8_WAIT_L(0); PG8_MMA(0, 0, At, B0); PG8_BAR; PG8_SCHED;
            PG8_LDB(B1, 0, 1); PG8_STAGE(PG8_SB(0, 0), b2, voffB);
            PG8_BAR; PG8_WAIT_L(0); PG8_MMA(0, 1, At, B1); PG8_BAR;
            PG8_LDA(At, 0, 1); PG8_STAGE(PG8_SA(0, 0), a2, voffA);
            PG8_BAR; PG8_WAIT_L(0); PG8_MMA(1, 0, At, B0); PG8_BAR; PG8_SCHED;
            PG8_STAGE(PG8_SB(0, 1), b2 + hstep, voffB);
            PG8_WAIT_V(6); PG8_BAR; PG8_MMA(1, 1, At, B1); PG8_BAR;
            PG8_LDB(B0, 1, 0); PG8_SCHED; PG8_LDA(At, 1, 0); PG8_STAGE(PG8_SA(0, 1), a2 + hstep, voffA);
            PG8_WAIT_L(8); PG8_BAR; PG8_WAIT_L(0); PG8_MMA(0, 0, At, B0); PG8_BAR; PG8_SCHED;
            PG8_LDB(B1, 1, 1); PG8_STAGE(PG8_SB(1, 0), b3, voffB);
            PG8_BAR; PG8_WAIT_L(0); PG8_MMA(0, 1, At, B1); PG8_BAR;
            PG8_LDA(At, 1, 1); PG8_STAGE(PG8_SA(1, 0), a3, voffA);
            PG8_BAR; PG8_WAIT_L(0); PG8_MMA(1, 0, At, B0); PG8_BAR; PG8_SCHED;
            PG8_STAGE(PG8_SB(1, 1), b3 + hstep, voffB);
            PG8_WAIT_V(6); PG8_BAR; PG8_MMA(1, 1, At, B1); PG8_BAR;
            }
        }
        if constexpr (ALIGN_EPI) { if (wr == 0) PG8_BAR; }
        if constexpr (!Epi::AFTER_DRAIN) { E(acc, cur, wr, wc, fr, fq); S.done(cur); }
        if (!has_next) break;
#pragma unroll
        for (int a = 0; a < 2; ++a)
#pragma unroll
            for (int b = 0; b < 2; ++b)
#pragma unroll
                for (int m = 0; m < 4; ++m)
#pragma unroll
                    for (int n = 0; n < 2; ++n) acc[a][b][m][n] = (f32x4){0.f, 0.f, 0.f, 0.f};
        cur = nxt; cA = nA; cB = nB; ++ui;
        if constexpr (ALIGN_EPI) { if (wr == 1) PG8_BAR; }
    }
    PG8_WAIT_V(0);
    if constexpr (!ALIGN_EPI) { if (wr == 0) PG8_BAR; }
    PG8_BAR;
    if constexpr (Epi::AFTER_DRAIN) { E.fused(acc, cur, wr, wc, fr, fq, lds, wid, lane); S.done(cur); }
#undef PG8_SA
#undef PG8_SB
#undef PG8_STAGE
#undef PG8_LDA
#undef PG8_LDB
#undef PG8_MMA
#undef PG8_WAIT_V
#undef PG8_WAIT_L
#undef PG8_BAR
#undef PG8_SCHED
}
}
#define GAS __attribute__((address_space(1)))
#define LAS __attribute__((address_space(3)))
typedef unsigned short bf16;
typedef unsigned v4u __attribute__((ext_vector_type(4)));
typedef float f32x4 __attribute__((ext_vector_type(4)));
typedef short bf16x8 __attribute__((ext_vector_type(8)));
typedef GAS unsigned gu32;
typedef GAS unsigned long long gu64;
#define RLX_AGENT __ATOMIC_RELAXED, __HIP_MEMORY_SCOPE_AGENT
#define LDS_WAIT() asm volatile("s_waitcnt lgkmcnt(0)" ::: "memory")
#define VM_WAIT() asm volatile("s_waitcnt vmcnt(0)" ::: "memory")
__device__ __forceinline__ unsigned long long rt() { return __builtin_amdgcn_s_memrealtime(); }
#define XB_TMO      128
#define XB_XCNT(j)  (256  + 64 * (j))
#define XB_XSUB(j)  (1280 + 64 * (j))
#define XB_XGEN(j)  (2304 + 64 * (j))
#define XB_TOP      3328
#define XB_TOPGEN   3392
#define XCD_BAR_WORDS 3456
#define XB_SPIN_CAP (1u << 18)

__device__ __forceinline__ unsigned xb_ld(unsigned* p)              { return __hip_atomic_load(p, __ATOMIC_RELAXED, __HIP_MEMORY_SCOPE_AGENT); }
__device__ __forceinline__ unsigned xb_add(unsigned* p, unsigned v) { return __hip_atomic_fetch_add(p, v, __ATOMIC_RELAXED, __HIP_MEMORY_SCOPE_AGENT); }
__device__ __forceinline__ unsigned xb_xcc_id() { return (unsigned)__builtin_amdgcn_s_getreg((3 << 11) | 20) & 0xFu; }
#define XB_SPIN(cond, bar) do { unsigned _sp = 0; while (cond) { __builtin_amdgcn_s_sleep(1); \
    if ((++_sp & 255u) == 0u) { if (xb_ld(&(bar)[XB_TMO])) break; if (_sp > XB_SPIN_CAP) { atomicAdd(&(bar)[XB_TMO], 1u); break; } } } } while (0)

struct XcdBarrier {
    unsigned* bar; unsigned x;
    volatile LAS unsigned* st;
};

__device__ __forceinline__ XcdBarrier xcd_barrier_post(unsigned* bar, volatile LAS unsigned* st) {
    XcdBarrier b; b.bar = bar; b.x = xb_xcc_id(); b.st = st;
    if (threadIdx.x == 0) (void)xb_add(&bar[XB_XCNT(b.x)], 1u);
    return b;
}
__device__ __forceinline__ void xcd_barrier_complete(unsigned* bar, unsigned x, unsigned& nloc, unsigned& nx) {
    const unsigned G = gridDim.x * gridDim.y * gridDim.z;
    unsigned sum, cnt, mine, sp = 0u;
    for (;;) {
        sum = 0u; cnt = 0u; mine = 0u;
#pragma unroll
        for (unsigned j = 0; j < 16; ++j) { const unsigned c = xb_ld(&bar[XB_XCNT(j)]); sum += c; cnt += (c > 0u) ? 1u : 0u; mine = (j == x) ? c : mine; }
        if (sum == G) break;
        __builtin_amdgcn_s_sleep(1);
        if ((++sp & 255u) == 0u) { if (xb_ld(&bar[XB_TMO])) break; if (sp > XB_SPIN_CAP) { atomicAdd(&bar[XB_TMO], 1u); break; } }
    }
    nloc = mine > 0u ? mine : 1u; nx = cnt > 0u ? cnt : 1u;
}

__device__ __forceinline__ void xcd_barrier(const XcdBarrier& b) {
    asm volatile("s_waitcnt vmcnt(0)" ::: "memory");
    __syncthreads();
    if (threadIdx.x == 0) {
        unsigned* bar = b.bar;
        __builtin_amdgcn_s_waitcnt(0);
        unsigned nloc = b.st[0], nx = b.st[1];
        if (nloc == 0u) { xcd_barrier_complete(bar, b.x, nloc, nx); b.st[0] = nloc; b.st[1] = nx; }
        const unsigned old = xb_add(&bar[XB_XSUB(b.x)], 1u);
        const unsigned gen = old / nloc;
        if (old + 1u == (gen + 1u) * nloc) {
            __builtin_amdgcn_fence(__ATOMIC_RELEASE, "agent");
            asm volatile("s_waitcnt vmcnt(0)" ::: "memory");
            const unsigned og = xb_add(&bar[XB_TOP], 1u);
            const unsigned tg = og / nx;
            if (og + 1u == (tg + 1u) * nx) xb_add(&bar[XB_TOPGEN], 1u);
            else XB_SPIN(xb_ld(&bar[XB_TOPGEN]) == tg, bar);
            __builtin_amdgcn_fence(__ATOMIC_ACQUIRE, "agent");
            xb_add(&bar[XB_XGEN(b.x)], 1u);
            asm volatile("s_waitcnt vmcnt(0)" ::: "memory");
        } else {
            XB_SPIN(xb_ld(&bar[XB_XGEN(b.x)]) == gen, bar);
            __builtin_amdgcn_fence(__ATOMIC_ACQUIRE, "agent");
            asm volatile("s_waitcnt vmcnt(0)" ::: "memory");
        }
    }
    __syncthreads();
}
namespace att {
using bf16x8 = __attribute__((ext_vector_type(8))) short;
using s16x4  = __attribute__((ext_vector_type(4))) short;
using f32x16 = __attribute__((ext_vector_type(16))) float;
using f32x4v = __attribute__((ext_vector_type(4))) float;
using u32x4  = __attribute__((ext_vector_type(4))) unsigned;
constexpr int NW = 8, QBLK = 32, KVBLK = 64;
constexpr float THRL = 6.f;
#define ASBAR() __builtin_amdgcn_sched_barrier(0)
__device__ __forceinline__ int crow(int r, int hi) { return (r & 3) + 8 * (r >> 2) + 4 * hi; }
__device__ __forceinline__ unsigned cvtpk(float lo, float hi) { unsigned r; asm volatile("v_cvt_pk_bf16_f32 %0, %1, %2" : "=v"(r) : "v"(lo), "v"(hi)); return r; }
template <int DQK> struct Cfg {
    static constexpr int KROW = DQK * 2 + 16;
    static constexpr int SHM_V = 8192, SHM_K = 64 * KROW;
    static constexpr int OFF_V = 0, OFF_K = 2 * SHM_V, OFF_WS = OFF_K + 2 * SHM_K, OFF_OST = OFF_WS + NW * 256, OSTW = 32 * 68 * 4, END = OFF_OST + NW * OSTW;
    static constexpr int KCH = DQK / 8;
};
__device__ __forceinline__ void partialSM(f32x16& p0, f32x16& p1, float& m_reg, float& mn, float& alpha) {
    float pmax = p0[0];
#pragma unroll
    for (int r = 1; r < 16; ++r) pmax = fmaxf(pmax, p0[r]);
#pragma unroll
    for (int r = 0; r < 16; ++r) pmax = fmaxf(pmax, p1[r]);
    { auto rr = __builtin_amdgcn_permlane32_swap(__float_as_uint(pmax), __float_as_uint(pmax), false, false); pmax = fmaxf(__uint_as_float(rr[0]), __uint_as_float(rr[1])); }
    if (__builtin_expect(__all(pmax - m_reg <= THRL), 1)) { mn = m_reg; alpha = 1.f; }
    else { mn = fmaxf(m_reg, pmax); alpha = __builtin_amdgcn_exp2f(m_reg - mn); m_reg = mn; }
#pragma unroll
    for (int r = 0; r < 16; ++r) p0[r] -= mn;
#pragma unroll
    for (int r = 0; r < 16; ++r) p1[r] -= mn;
#pragma unroll
    for (int r = 0; r < 16; ++r) p0[r] = __builtin_amdgcn_exp2f(p0[r]);
}
__device__ __forceinline__ void finishSM(f32x16& p0, f32x16& p1, float alpha, float& l_reg, bf16x8& pa0, bf16x8& pa1, bf16x8& pa2, bf16x8& pa3) {
#pragma unroll
    for (int r = 0; r < 16; ++r) p1[r] = __builtin_amdgcn_exp2f(p1[r]);
    float ps = 0;
#pragma unroll
    for (int r = 0; r < 16; ++r) ps += p0[r];
#pragma unroll
    for (int r = 0; r < 16; ++r) ps += p1[r];
    { auto rr = __builtin_amdgcn_permlane32_swap(__float_as_uint(ps), __float_as_uint(ps), false, false); ps = __uint_as_float(rr[0]) + __uint_as_float(rr[1]); }
    l_reg = l_reg * alpha + ps;
#define ATT_PK4(P, BASE, OUT) do { unsigned a0 = cvtpk(P[BASE + 0], P[BASE + 1]), a1 = cvtpk(P[BASE + 2], P[BASE + 3]);   \
    unsigned b0 = cvtpk(P[BASE + 4], P[BASE + 5]), b1 = cvtpk(P[BASE + 6], P[BASE + 7]);                              \
    auto r0 = __builtin_amdgcn_permlane32_swap(a0, b0, false, false); auto r1 = __builtin_amdgcn_permlane32_swap(a1, b1, false, false); \
    u32x4 w = {r0[0], r1[0], r0[1], r1[1]}; OUT = *reinterpret_cast<bf16x8*>(&w); } while (0)
    ATT_PK4(p0, 0, pa0); ATT_PK4(p0, 8, pa1); ATT_PK4(p1, 0, pa2); ATT_PK4(p1, 8, pa3);
#undef ATT_PK4
}
template <int DQK> __device__ __forceinline__ void qkt(f32x16& p0, f32x16& p1, const char* Ks, const bf16x8* qr, int r32, int hi) {
    constexpr int KROW = Cfg<DQK>::KROW;
    p0 = f32x16{}; p1 = f32x16{};
#pragma unroll
    for (int d0 = 0; d0 < DQK / 16; ++d0) { const int cb = (d0 * 16 + hi * 8) * 2;
        const bf16x8 b0 = *reinterpret_cast<const bf16x8*>(Ks + r32 * KROW + cb);
        const bf16x8 b1 = *reinterpret_cast<const bf16x8*>(Ks + (32 + r32) * KROW + cb);
        p0 = __builtin_amdgcn_mfma_f32_32x32x16_bf16(b0, qr[d0], p0, 0, 0, 0);
        p1 = __builtin_amdgcn_mfma_f32_32x32x16_bf16(b1, qr[d0], p1, 0, 0, 0); }
}
__device__ __forceinline__ int v_st(int k, int c) { const int kk = (k & ~0xC) | ((k & 4) << 1) | ((k & 8) >> 1); return ((kk >> 3) * 2 + (c >> 5)) * 512 + ((kk & 7) * 32 + (c & 31)) * 2; }
__device__ __forceinline__ int v_rd_base(int lane) { return ((lane & 3) << 3) | (((lane >> 2) & 3) << 6) | (((lane >> 4) & 1) << 5) | (((lane >> 5) & 1) << 8); }
constexpr int v_rd_off(int d0, int ks, int half) { return d0 * 512 + ks * 2048 + half * 1024; }
template <int OFF> __device__ __forceinline__ s16x4 tr_read(int vb) { s16x4 r; asm volatile("ds_read_b64_tr_b16 %0, %1 offset:%2" : "=&v"(r) : "v"(vb), "i"(OFF) : "memory"); return r; }
template <int D0> __device__ __forceinline__ void pv_one(f32x16& od, int vb, bf16x8 pa0, bf16x8 pa1, bf16x8 pa2, bf16x8 pa3) {
    const s16x4 l0 = tr_read<v_rd_off(D0, 0, 0)>(vb), h0 = tr_read<v_rd_off(D0, 0, 1)>(vb), l1 = tr_read<v_rd_off(D0, 1, 0)>(vb), h1 = tr_read<v_rd_off(D0, 1, 1)>(vb);
    const s16x4 l2 = tr_read<v_rd_off(D0, 2, 0)>(vb), h2 = tr_read<v_rd_off(D0, 2, 1)>(vb), l3 = tr_read<v_rd_off(D0, 3, 0)>(vb), h3 = tr_read<v_rd_off(D0, 3, 1)>(vb);
    asm volatile("s_waitcnt lgkmcnt(0)" ::: "memory"); ASBAR();
#define ATT_PK(L, H) (bf16x8){L[0], L[1], L[2], L[3], H[0], H[1], H[2], H[3]}
    od = __builtin_amdgcn_mfma_f32_32x32x16_bf16(pa0, ATT_PK(l0, h0), od, 0, 0, 0);
    od = __builtin_amdgcn_mfma_f32_32x32x16_bf16(pa1, ATT_PK(l1, h1), od, 0, 0, 0);
    od = __builtin_amdgcn_mfma_f32_32x32x16_bf16(pa2, ATT_PK(l2, h2), od, 0, 0, 0);
    od = __builtin_amdgcn_mfma_f32_32x32x16_bf16(pa3, ATT_PK(l3, h3), od, 0, 0, 0);
#undef ATT_PK
}
__device__ __forceinline__ void pv_d0(f32x16* o, int vb, bf16x8 pa0, bf16x8 pa1, bf16x8 pa2, bf16x8 pa3) { pv_one<0>(o[0], vb, pa0, pa1, pa2, pa3); pv_one<1>(o[1], vb, pa0, pa1, pa2, pa3); }

__device__ __forceinline__ float rowmax32(const f32x16& p0, const f32x16& p1) {
#define ATT_MX3(a, b, c) __builtin_fmaxf(__builtin_fmaxf((a), (b)), (c))
    float a = ATT_MX3(p0[0], p0[1], p1[0]), b = ATT_MX3(p0[2], p0[3], p1[1]); a = ATT_MX3(a, p1[2], p1[3]);
#pragma unroll
    for (int r = 4; r < 16; r += 4) { a = ATT_MX3(a, p0[r], p0[r + 1]); b = ATT_MX3(b, p0[r + 2], p0[r + 3]); a = ATT_MX3(a, p1[r], p1[r + 1]); b = ATT_MX3(b, p1[r + 2], p1[r + 3]); }
#undef ATT_MX3
    float m = __builtin_fmaxf(a, b);
    auto rr = __builtin_amdgcn_permlane32_swap(__float_as_uint(m), __float_as_uint(m), false, false);
    return __builtin_fmaxf(__uint_as_float(rr[0]), __uint_as_float(rr[1]));
}
#ifndef ATT_NEGM
#define ATT_NEGM 1
#endif
template <bool FIRST> __device__ __forceinline__ void partialSM2(f32x16& p0, f32x16& p1, float& mhat, f32x16& negm, float& alpha) {
#if !ATT_NEGM
    float pmax = rowmax32(p0, p1) - mhat; alpha = 1.f;
    if (FIRST || __builtin_expect(__any(pmax > THRL), 0)) { const float dl = FIRST ? pmax : __builtin_fmaxf(pmax, 0.f); mhat += dl; if (!FIRST) alpha = __builtin_amdgcn_exp2f(-dl); }
    _Pragma("unroll") for (int r = 0; r < 16; ++r) { p0[r] -= mhat; p1[r] -= mhat; }
    _Pragma("unroll") for (int r = 0; r < 16; ++r) p0[r] = __builtin_amdgcn_exp2f(p0[r]);
    return;
#else
    const float pmax = rowmax32(p0, p1);
    alpha = 1.f;
    if (FIRST || __builtin_expect(__any(pmax > THRL), 0)) { const float dl = FIRST ? pmax : __builtin_fmaxf(pmax, 0.f); mhat += dl;
#pragma unroll
        for (int r = 0; r < 16; ++r) { p0[r] -= dl; p1[r] -= dl; }
#pragma unroll
        for (int r = 0; r < 16; ++r) negm[r] = -mhat;
        if (!FIRST) alpha = __builtin_amdgcn_exp2f(-dl); }
#pragma unroll
    for (int r = 0; r < 16; ++r) p0[r] = __builtin_amdgcn_exp2f(p0[r]);
#endif
}
template <int DQK> __device__ __forceinline__ void qkt2(f32x16& p0, f32x16& p1, const char* Ks, const bf16x8* qr, const f32x16& negm, int r32, int hi) {
    constexpr int KROW = Cfg<DQK>::KROW;
#pragma unroll
    for (int d0 = 0; d0 < DQK / 16; ++d0) { const int cb = (d0 * 16 + hi * 8) * 2;
        const bf16x8 b0 = *reinterpret_cast<const bf16x8*>(Ks + r32 * KROW + cb);
        const bf16x8 b1 = *reinterpret_cast<const bf16x8*>(Ks + (32 + r32) * KROW + cb);
#if ATT_NEGM
        if (d0 == 0) { p0 = __builtin_amdgcn_mfma_f32_32x32x16_bf16(b0, qr[0], negm, 0, 0, 0); p1 = __builtin_amdgcn_mfma_f32_32x32x16_bf16(b1, qr[0], negm, 0, 0, 0); }
#else
        if (d0 == 0) { p0 = __builtin_amdgcn_mfma_f32_32x32x16_bf16(b0, qr[0], f32x16{}, 0, 0, 0); p1 = __builtin_amdgcn_mfma_f32_32x32x16_bf16(b1, qr[0], f32x16{}, 0, 0, 0); }
#endif
        else { p0 = __builtin_amdgcn_mfma_f32_32x32x16_bf16(b0, qr[d0], p0, 0, 0, 0); p1 = __builtin_amdgcn_mfma_f32_32x32x16_bf16(b1, qr[d0], p1, 0, 0, 0); } }
}
template <int DQK> struct Cfg2 {
    static constexpr int KROW = DQK * 2 + 16, SHM_V = 8192, SHM_K = 64 * KROW;
    static constexpr int OFF_V = 0, OFF_K = 3 * SHM_V, OFF_WS = OFF_K + 2 * SHM_K, OFF_OST = OFF_WS + NW * 256, OSTW = 32 * 68 * 4, END = OFF_OST + NW * OSTW;
};
__device__ __forceinline__ float softmax_tile(f32x16& p0, f32x16& p1, float& mhat, f32x16& negm, float& l_reg, bool first, bf16x8& pa0, bf16x8& pa1, bf16x8& pa2, bf16x8& pa3) {
    const float pmax = rowmax32(p0, p1);
    float alpha = 1.f;
    if (__builtin_expect(first || __any(pmax > THRL), 0)) { const float dl = first ? pmax : __builtin_fmaxf(pmax, 0.f); mhat += dl;
#pragma unroll
        for (int r = 0; r < 16; ++r) { p0[r] -= dl; p1[r] -= dl; }
#pragma unroll
        for (int r = 0; r < 16; ++r) negm[r] = -mhat;
        if (!first) alpha = __builtin_amdgcn_exp2f(-dl); }
#pragma unroll
    for (int r = 0; r < 16; ++r) { p0[r] = __builtin_amdgcn_exp2f(p0[r]); p1[r] = __builtin_amdgcn_exp2f(p1[r]); }
    float ps = 0;
#pragma unroll
    for (int r = 0; r < 16; ++r) ps += p0[r];
#pragma unroll
    for (int r = 0; r < 16; ++r) ps += p1[r];
    { auto rr = __builtin_amdgcn_permlane32_swap(__float_as_uint(ps), __float_as_uint(ps), false, false); ps = __uint_as_float(rr[0]) + __uint_as_float(rr[1]); }
    l_reg = l_reg * alpha + ps;
#define ATT_PK4(P, BASE, OUT) do { unsigned a0 = cvtpk(P[BASE + 0], P[BASE + 1]), a1 = cvtpk(P[BASE + 2], P[BASE + 3]);   \
    unsigned b0 = cvtpk(P[BASE + 4], P[BASE + 5]), b1 = cvtpk(P[BASE + 6], P[BASE + 7]);                              \
    auto r0 = __builtin_amdgcn_permlane32_swap(a0, b0, false, false); auto r1 = __builtin_amdgcn_permlane32_swap(a1, b1, false, false); \
    u32x4 w = {r0[0], r1[0], r0[1], r1[1]}; OUT = *reinterpret_cast<bf16x8*>(&w); } while (0)
    ATT_PK4(p0, 0, pa0); ATT_PK4(p0, 8, pa1); ATT_PK4(p1, 0, pa2); ATT_PK4(p1, 8, pa3);
#undef ATT_PK4
    return alpha;
}
template <int DQK>
__device__ __forceinline__ void attn_unit(const bf16_t* __restrict__ Qb, int ldq, const bf16_t* __restrict__ Kh, int ldk, const bf16_t* __restrict__ Vh, int ldv, int seq,
                                          bf16_t* __restrict__ Ob, const bf16_t* __restrict__ Gb, char* lds) {
    using C = Cfg2<DQK>;
    constexpr int KROW = C::KROW, KCH = DQK / 8, SHM_V = C::SHM_V, SHM_K = C::SHM_K;
    const int tid = threadIdx.x, wid = __builtin_amdgcn_readfirstlane(tid >> 6), lane = tid & 63, r32 = lane & 31, hi = lane >> 5; const bool h1 = wid >= 4;
    char* V_lds = lds + C::OFF_V; char* K_lds = lds + C::OFF_K;
    float* ws = (float*)(lds + C::OFF_WS) + wid * 64; float* li_l = ws; float* al_l = ws + 32;
    float mhat = 0.f, l_reg = 0.f; f32x16 o[2] = {}; f32x16 negm = {}; bf16x8 qr[DQK / 16];
    const bf16_t* Qw = Qb + (size_t)(wid * QBLK + r32) * ldq + hi * 8;
#pragma unroll
    for (int d0 = 0; d0 < DQK / 16; ++d0) qr[d0] = *reinterpret_cast<const bf16x8*>(Qw + d0 * 16);
    const int vk = tid >> 3, vc = (tid & 7) * 8, vst = v_st(vk, vc);
    const int kr0 = tid / KCH, kc0 = (tid % KCH) * 8, kr1 = (512 + tid) / KCH, kc1 = ((512 + tid) % KCH) * 8;
    const bool two = (KCH * 64 > 512) && (tid < KCH * 64 - 512);
    const int vb0 = (int)(uintptr_t)V_lds + v_rd_base(lane);
    bf16x8 s_vs, s_k0, s_k1;
#define ATT_SLOAD(k0) do { s_vs = *reinterpret_cast<const bf16x8*>(Vh + (size_t)((k0) + vk) * ldv + vc); \
    s_k0 = *reinterpret_cast<const bf16x8*>(Kh + (size_t)((k0) + kr0) * ldk + kc0); \
    if (two) s_k1 = *reinterpret_cast<const bf16x8*>(Kh + (size_t)((k0) + kr1) * ldk + kc1); } while (0)
#define ATT_SWRITE(kb, vs) do { *(bf16x8*)(V_lds + (vs) + vst) = s_vs; *(bf16x8*)(K_lds + (kb) * SHM_K + kr0 * KROW + kc0 * 2) = s_k0; \
    if (two) *(bf16x8*)(K_lds + (kb) * SHM_K + kr1 * KROW + kc1 * 2) = s_k1; } while (0)
#define ATT_RESC(a) do { if (__any((a) < 1.f)) { if (hi == 0) al_l[r32] = (a); asm volatile("s_waitcnt lgkmcnt(0)" ::: "memory"); \
    _Pragma("unroll") for (int d = 0; d < 2; ++d) _Pragma("unroll") for (int r = 0; r < 16; ++r) o[d][r] *= al_l[crow(r, hi)]; } } while (0)
    f32x16 p0, p1; bf16x8 pa0, pa1, pa2, pa3; const int NT = seq / KVBLK;
    int vsr = 0, vsw = 2 * SHM_V;
#define ATT_ROT() do { vsr = (vsr == 2 * SHM_V) ? 0 : vsr + SHM_V; vsw = (vsw == 2 * SHM_V) ? 0 : vsw + SHM_V; } while (0)
    ATT_SLOAD(0); ATT_SWRITE(0, 0); __syncthreads(); ATT_SLOAD(KVBLK);
    ASBAR(); qkt2<DQK>(p0, p1, K_lds, qr, negm, r32, hi);
    if (!h1) { (void)softmax_tile(p0, p1, mhat, negm, l_reg, true, pa0, pa1, pa2, pa3); }
    ATT_SWRITE(1, SHM_V); __syncthreads(); if (2 < NT) ATT_SLOAD(2 * KVBLK);
    for (int t = 0; t < NT; ++t) {
        if (h1) { const float al = softmax_tile(p0, p1, mhat, negm, l_reg, t == 0, pa0, pa1, pa2, pa3); ATT_RESC(al); }
        ASBAR(); pv_d0(o, vb0 + vsr, pa0, pa1, pa2, pa3);
        if (t + 1 < NT) {
            ASBAR(); qkt2<DQK>(p0, p1, K_lds + ((t + 1) & 1) * SHM_K, qr, negm, r32, hi);
            if (!h1) { const float al = softmax_tile(p0, p1, mhat, negm, l_reg, false, pa0, pa1, pa2, pa3); ATT_RESC(al); }
            if (t + 2 < NT) ATT_SWRITE(t & 1, vsw);
            __syncthreads();
            if (t + 3 < NT) ATT_SLOAD((t + 3) * KVBLK);
            ATT_ROT();
        }
    }
    if (hi == 0) li_l[r32] = l_reg; asm volatile("s_waitcnt lgkmcnt(0)" ::: "memory");
    float* stg = (float*)(lds + C::OFF_OST + wid * C::OSTW);
#pragma unroll
    for (int r = 0; r < 16; ++r) { const int orow = crow(r, hi); const float rli = __builtin_amdgcn_rcpf(li_l[orow]);
        stg[orow * 68 + r32] = o[0][r] * rli; stg[orow * 68 + 32 + r32] = o[1][r] * rli; }
    asm volatile("s_waitcnt lgkmcnt(0)" ::: "memory");
#pragma unroll
    for (int i = 0; i < 4; ++i) { const int row = i * 8 + (lane >> 3), ch = (lane & 7) * 8;
        const f32x4v a = *(const f32x4v*)(stg + row * 68 + ch), b = *(const f32x4v*)(stg + row * 68 + ch + 4);
        const size_t off = (size_t)(wid * QBLK + row) * 1024 + ch; const u32x4 g = *(const u32x4*)(Gb + off); u32x4 w;
        w.x = cvtpk(a[0] * __uint_as_float(g.x << 16), a[1] * __uint_as_float(g.x & 0xffff0000u)); w.y = cvtpk(a[2] * __uint_as_float(g.y << 16), a[3] * __uint_as_float(g.y & 0xffff0000u));
        w.z = cvtpk(b[0] * __uint_as_float(g.z << 16), b[1] * __uint_as_float(g.z & 0xffff0000u)); w.w = cvtpk(b[2] * __uint_as_float(g.w << 16), b[3] * __uint_as_float(g.w & 0xffff0000u));
        *(u32x4*)(Ob + off) = w; }
    __syncthreads();
#undef ATT_SLOAD
#undef ATT_SWRITE
#undef ATT_RESC
#undef ATT_ROT
}
#undef ASBAR
}
namespace fft {
using bf16x8 = __attribute__((ext_vector_type(8))) short;
using s16x4  = __attribute__((ext_vector_type(4))) short;
using f32x16 = __attribute__((ext_vector_type(16))) float;
using f32x4v = __attribute__((ext_vector_type(4))) float;
using u32x4  = __attribute__((ext_vector_type(4))) unsigned;
constexpr int OFF_X = 0, OFF_STG = 65536;
__device__ __forceinline__ int crow(int r, int hi) { return (r & 3) + 8 * (r >> 2) + 4 * hi; }
__device__ __forceinline__ unsigned cvtpk(float lo, float hi) { unsigned r; asm volatile("v_cvt_pk_bf16_f32 %0, %1, %2" : "=v"(r) : "v"(lo), "v"(hi)); return r; }
__device__ __forceinline__ int x_st(int kk, int c) { const int kp = (kk & ~0xC) | ((kk & 4) << 1) | ((kk & 8) >> 1); return ((kp >> 3) * 8 + (c >> 5)) * 512 + ((kp & 7) * 32 + (c & 31)) * 2; }
__device__ __forceinline__ int x_rd_base(int lane) { return ((lane & 3) << 3) | (((lane >> 2) & 3) << 6) | (((lane >> 4) & 1) << 5) | (((lane >> 5) & 1) << 8); }
constexpr int x_rd_off(int nb, int ks, int half) { return ks * 8192 + half * 4096 + nb * 512; }
template <int OFF> __device__ __forceinline__ s16x4 tr_read(int vb) { s16x4 r; asm volatile("ds_read_b64_tr_b16 %0, %1 offset:%2" : "=&v"(r) : "v"(vb), "i"(OFF) : "memory"); return r; }
template <int NB> __device__ __forceinline__ void mm_block(f32x16& acc, const bf16x8 (&afr)[8], int vb) {
#define FFT_PK(L, H) (bf16x8){L[0], L[1], L[2], L[3], H[0], H[1], H[2], H[3]}
    { const s16x4 l0 = tr_read<x_rd_off(NB, 0, 0)>(vb), h0 = tr_read<x_rd_off(NB, 0, 1)>(vb), l1 = tr_read<x_rd_off(NB, 1, 0)>(vb), h1 = tr_read<x_rd_off(NB, 1, 1)>(vb);
      const s16x4 l2 = tr_read<x_rd_off(NB, 2, 0)>(vb), h2 = tr_read<x_rd_off(NB, 2, 1)>(vb), l3 = tr_read<x_rd_off(NB, 3, 0)>(vb), h3 = tr_read<x_rd_off(NB, 3, 1)>(vb);
      asm volatile("s_waitcnt lgkmcnt(0)" ::: "memory"); __builtin_amdgcn_sched_barrier(0);
      acc = __builtin_amdgcn_mfma_f32_32x32x16_bf16(afr[0], FFT_PK(l0, h0), acc, 0, 0, 0); acc = __builtin_amdgcn_mfma_f32_32x32x16_bf16(afr[1], FFT_PK(l1, h1), acc, 0, 0, 0);
      acc = __builtin_amdgcn_mfma_f32_32x32x16_bf16(afr[2], FFT_PK(l2, h2), acc, 0, 0, 0); acc = __builtin_amdgcn_mfma_f32_32x32x16_bf16(afr[3], FFT_PK(l3, h3), acc, 0, 0, 0); }
    { const s16x4 l0 = tr_read<x_rd_off(NB, 4, 0)>(vb), h0 = tr_read<x_rd_off(NB, 4, 1)>(vb), l1 = tr_read<x_rd_off(NB, 5, 0)>(vb), h1 = tr_read<x_rd_off(NB, 5, 1)>(vb);
      const s16x4 l2 = tr_read<x_rd_off(NB, 6, 0)>(vb), h2 = tr_read<x_rd_off(NB, 6, 1)>(vb), l3 = tr_read<x_rd_off(NB, 7, 0)>(vb), h3 = tr_read<x_rd_off(NB, 7, 1)>(vb);
      asm volatile("s_waitcnt lgkmcnt(0)" ::: "memory"); __builtin_amdgcn_sched_barrier(0);
      acc = __builtin_amdgcn_mfma_f32_32x32x16_bf16(afr[4], FFT_PK(l0, h0), acc, 0, 0, 0); acc = __builtin_amdgcn_mfma_f32_32x32x16_bf16(afr[5], FFT_PK(l1, h1), acc, 0, 0, 0);
      acc = __builtin_amdgcn_mfma_f32_32x32x16_bf16(afr[6], FFT_PK(l2, h2), acc, 0, 0, 0); acc = __builtin_amdgcn_mfma_f32_32x32x16_bf16(afr[7], FFT_PK(l3, h3), acc, 0, 0, 0); }
#undef FFT_PK
}
struct TileRegs { bf16x8 v[8]; };
__device__ __forceinline__ void tile_load(TileRegs& t, const bf16_t* src  , size_t rowstride, int tid) {
    const bf16_t* p = src + (size_t)(tid >> 5) * rowstride + (tid & 31) * 8;
#pragma unroll
    for (int i = 0; i < 8; ++i) t.v[i] = *reinterpret_cast<const bf16x8*>(p + (size_t)(16 * i) * rowstride);
}
__device__ __forceinline__ void tile_write(const TileRegs& t, char* xl, int tid) {
    char* p = xl + x_st(tid >> 5, (tid & 31) * 8);
#pragma unroll
    for (int i = 0; i < 8; ++i) *reinterpret_cast<bf16x8*>(p + 8192 * i) = t.v[i];
}

__device__ __forceinline__ void stage_a(const bf16_t* __restrict__ PQ, bf16_t* __restrict__ Y, char* lds, int vcu, int G) {
    const int tid = threadIdx.x, wid = tid >> 6, lane = tid & 63, r32 = lane & 31, hi = lane >> 5, w = wid & 3, nh = wid >> 2;
    char* xl = lds + OFF_X; char* stg = lds + OFF_STG + wid * 8192;
    bf16x8 afr[8];
    { const int reim = r32 >> 4, k1 = 16 * w + (r32 & 15);
#pragma unroll
      for (int ks = 0; ks < 8; ++ks) { float v[8];
#pragma unroll
          for (int j = 0; j < 8; ++j) { const int kk = 16 * ks + 8 * hi + j, s1 = kk >> 1, pq = kk & 1; const float f = (float)((k1 * s1) & 63) * (1.f / 64.f);
              const float c = __builtin_amdgcn_cosf(f) * 0.125f, s = __builtin_amdgcn_sinf(f) * 0.125f; v[j] = reim == 0 ? (pq == 0 ? c : -s) : (pq == 0 ? s : c); }
          u32x4 p = {cvtpk(v[0], v[1]), cvtpk(v[2], v[3]), cvtpk(v[4], v[5]), cvtpk(v[6], v[7])}; afr[ks] = *reinterpret_cast<bf16x8*>(&p); } }
    const int vb = (int)(uintptr_t)xl + x_rd_base(lane) + nh * 4 * 512;
    constexpr int NU = NB * 192;
    TileRegs tr;
    int u = vcu;
    if (u < NU) tile_load(tr, PQ + (size_t)(u / 192) * 128 * 49152 + (u % 192) * 256, 49152, tid);
    for (; u < NU; u += G) {
        const int b = u / 192, j = u % 192;
        tile_write(tr, xl, tid);
        __syncthreads();
        { const int un = u + G; if (un < NU) tile_load(tr, PQ + (size_t)(un / 192) * 128 * 49152 + (un % 192) * 256, 49152, tid); }
        f32x16 acc[4] = {};
        mm_block<0>(acc[0], afr, vb); mm_block<1>(acc[1], afr, vb); mm_block<2>(acc[2], afr, vb); mm_block<3>(acc[3], afr, vb);
        const int s2 = j / 3;
#pragma unroll
        for (int r = 0; r < 8; ++r) { const int kl = crow(r, hi), k1 = 16 * w + kl; const float f = (float)(k1 * s2) * (1.f / 4096.f); const float tr_ = __builtin_amdgcn_cosf(f), ti_ = __builtin_amdgcn_sinf(f);
#pragma unroll
            for (int nb = 0; nb < 4; ++nb) { const float re = acc[nb][r], im = acc[nb][r + 8];
                *(bf16_t*)(stg + kl * 256 + (nb * 32 + r32) * 2) = f2bf(tr_ * re - ti_ * im);
                *(bf16_t*)(stg + (16 + kl) * 256 + (nb * 32 + r32) * 2) = f2bf(ti_ * re + tr_ * im); } }
        asm volatile("s_waitcnt lgkmcnt(0)" ::: "memory");
#pragma unroll
        for (int i = 0; i < 8; ++i) { const int rowl = i * 4 + (lane >> 4), c16 = lane & 15; const u32x4 v = *(const u32x4*)(stg + rowl * 256 + c16 * 16);
            const int reim = rowl >> 4, k1 = 16 * w + (rowl & 15);
            *(u32x4*)(Y + ((size_t)((b * 64 + k1) * 2 + reim)) * 49152 + j * 256 + nh * 128 + c16 * 8) = v; }
        __syncthreads();
    }
}
__device__ __forceinline__ void stage_b(const bf16_t* __restrict__ Y, const bf16_t* __restrict__ SG, bf16_t* __restrict__ BR, char* lds, int vcu, int G) {
    const int tid = threadIdx.x, wid = tid >> 6, lane = tid & 63, r32 = lane & 31, hi = lane >> 5, w = wid & 1, nq = wid >> 1;
    char* xl = lds + OFF_X; float* stg = (float*)(lds + OFF_STG + wid * 8192);
    bf16x8 afr[8];
    { const int k2 = 32 * w + r32;
#pragma unroll
      for (int ks = 0; ks < 8; ++ks) { float v[8];
#pragma unroll
          for (int j = 0; j < 8; ++j) { const int kk = 16 * ks + 8 * hi + j, reim = kk >> 6, s2 = kk & 63; const float f = (float)((k2 * s2) & 63) * (1.f / 64.f);
              v[j] = reim == 0 ? __builtin_amdgcn_cosf(f) * 0.125f : -__builtin_amdgcn_sinf(f) * 0.125f; }
          u32x4 p = {cvtpk(v[0], v[1]), cvtpk(v[2], v[3]), cvtpk(v[4], v[5]), cvtpk(v[6], v[7])}; afr[ks] = *reinterpret_cast<bf16x8*>(&p); } }
    const int vb = (int)(uintptr_t)xl + x_rd_base(lane) + nq * 2 * 512;
    constexpr int NU = NB * 64 * 3;
    TileRegs tr;
    int u = vcu;
    if (u < NU) tile_load(tr, Y + (size_t)(u / 3) * 2 * 49152 + (u % 3) * 256, 768, tid);
    for (; u < NU; u += G) {
        const int bk1 = u / 3, j = u % 3, b = bk1 >> 6, k1 = bk1 & 63;
        tile_write(tr, xl, tid);
        __syncthreads();
        { const int un = u + G; if (un < NU) tile_load(tr, Y + (size_t)(un / 3) * 2 * 49152 + (un % 3) * 256, 768, tid); }
        f32x16 acc[2] = {};
        mm_block<0>(acc[0], afr, vb); mm_block<1>(acc[1], afr, vb);
#pragma unroll
        for (int r = 0; r < 16; ++r) { const int rl = crow(r, hi); stg[rl * 64 + r32] = acc[0][r]; stg[rl * 64 + 32 + r32] = acc[1][r]; }
        asm volatile("s_waitcnt lgkmcnt(0)" ::: "memory");
#pragma unroll
        for (int i = 0; i < 4; ++i) { const int rowl = i * 8 + (lane >> 3), c8 = (lane & 7) * 8;
            const f32x4v a = *(const f32x4v*)(stg + rowl * 64 + c8), c = *(const f32x4v*)(stg + rowl * 64 + c8 + 4);
            const size_t off = ((size_t)b * SEQ + k1 + 64 * (32 * w + rowl)) * 1024 + j * 256 + nq * 64 + c8; const u32x4 g = *(const u32x4*)(SG + off); u32x4 o;
            o.x = cvtpk(a[0] * __uint_as_float(g.x << 16), a[1] * __uint_as_float(g.x & 0xffff0000u)); o.y = cvtpk(a[2] * __uint_as_float(g.y << 16), a[3] * __uint_as_float(g.y & 0xffff0000u));
            o.z = cvtpk(c[0] * __uint_as_float(g.z << 16), c[1] * __uint_as_float(g.z & 0xffff0000u)); o.w = cvtpk(c[2] * __uint_as_float(g.w << 16), c[3] * __uint_as_float(g.w & 0xffff0000u));
            *(u32x4*)(BR + off) = o; }
        __syncthreads();
    }
}
}
constexpr int NWAVES = 8;
constexpr int N_PHASES = 9;
constexpr int CW_BAR = 4096;
constexpr int RING_OFF = 0, RING_BYTES = 131072;
constexpr int LDSCTL_OFF = RING_BYTES, MISC_OFF = LDSCTL_OFF + 320, RS_OFF = LDSCTL_OFF + 1024  ;
constexpr int LDS_BYTES = 147456;
static_assert(RS_OFF + 4096 <= LDS_BYTES, "LDS map");

struct Args { const void* in[19]; float* out; unsigned char* ws; int ph_lo, ph_hi, li, pad; };

__device__ __forceinline__ void prep_w_job(const float* __restrict__ W, int ldw, int K, bf16_t* __restrict__ out, int n0, int nrows, const float* __restrict__ scale, int mode, int off, int gt, int GT) {
    const int total = nrows * (K >> 3);
    for (int idx = gt; idx < total; idx += GT) {
        const int n = idx % nrows, k8 = idx / nrows; const int sc = src_col(mode, n, off);
        float v[8];
#pragma unroll
        for (int i = 0; i < 8; ++i) { const int k = k8 * 8 + i; float w = (sc >= 0) ? W[(size_t)k * ldw + sc] : 0.f; if (scale) w *= scale[k]; v[i] = w; }
        uint4 o; o.x = pk2(v[0], v[1]); o.y = pk2(v[2], v[3]); o.z = pk2(v[4], v[5]); o.w = pk2(v[6], v[7]);
        *(uint4*)(out + (size_t)(n0 + n) * K + k8 * 8) = o;
    }
}
__device__ __forceinline__ void rmsnorm_row(const float* __restrict__ xrow, const float* __restrict__ g, bf16_t* __restrict__ orow, int lane) {
    const float4* xr = (const float4*)xrow + lane; float4 v[4]; float s = 0.f;
#pragma unroll
    for (int j = 0; j < 4; ++j) { v[j] = xr[64 * j]; s += v[j].x * v[j].x + v[j].y * v[j].y + v[j].z * v[j].z + v[j].w * v[j].w; }
    const float rstd = rsqrtf(wave_sum(s) * (1.f / DM) + EPS);
    uint2* o = (uint2*)orow + lane;
#pragma unroll
    for (int j = 0; j < 4; ++j) { const float4 gv = g ? ((const float4*)g)[lane + 64 * j] : make_float4(1.f, 1.f, 1.f, 1.f);
        uint2 w; w.x = pk2(v[j].x * rstd * gv.x, v[j].y * rstd * gv.y); w.y = pk2(v[j].z * rstd * gv.z, v[j].w * rstd * gv.w); o[64 * j] = w; }
}

typedef float f32x4m __attribute__((ext_vector_type(4)));
__device__ __forceinline__ void fold1_tiles(const float* __restrict__ Wf, float* __restrict__ AG, int gw, int NGW, int lane) {
    const int li = lane & 15, lk = lane >> 4;
    for (int tile = gw; tile < 2 * 4 * 12 * 12; tile += NGW) { const int di = tile % 12, ci = (tile / 12) % 12, g = (tile / 144) & 3, pq = tile / 576;
        const int c = ci * 16 + li; int p = (lk * c) % 192; const int step = (4 * c) % 192;
        const float* wp = Wf + ((size_t)g * 192 + lk) * 192 + di * 16 + li;
        f32x4m acc = {0.f, 0.f, 0.f, 0.f};
        for (int m0 = 0; m0 < 192; m0 += 4) { const float f = (float)p * (1.f / 192.f); const float a = pq ? __builtin_amdgcn_sinf(f) : __builtin_amdgcn_cosf(f);
            const float b = wp[(size_t)m0 * 192];
            acc = __builtin_amdgcn_mfma_f32_16x16x4f32(a, b, acc, 0, 0, 0);
            p += step; if (p >= 192) p -= 192; }
        float* op = AG + (((size_t)pq * 4 + g) * 192 + ci * 16 + 4 * lk) * 192 + di * 16 + li;
#pragma unroll
        for (int r = 0; r < 4; ++r) op[(size_t)r * 192] = acc[r] * 0.07216878364870322f; }
}
__device__ __forceinline__ void fold2_strips(const float* __restrict__ Win1, const float* __restrict__ g1, const float* __restrict__ AG, bf16_t* __restrict__ WIN1o, int gw, int NGW, int lane) {
    const int li = lane & 15, lk = lane >> 4;
    for (int s = gw; s < 64 * 8 * 3; s += NGW) { const int ki = s & 63, pg = (s >> 6) & 7, ds = s >> 9;
        const int g = pg & 3; const float* ap = Win1 + (size_t)(ki * 16 + li) * 2048 + 192 * g + lk; const float* bp = AG + ((size_t)pg * 192 + lk) * 192 + ds * 64 + li;
        f32x4m acc[4] = {{0.f, 0.f, 0.f, 0.f}, {0.f, 0.f, 0.f, 0.f}, {0.f, 0.f, 0.f, 0.f}, {0.f, 0.f, 0.f, 0.f}};
#pragma unroll 4
        for (int c0 = 0; c0 < 192; c0 += 4) { const float a = ap[c0]; const float* b = bp + (size_t)c0 * 192;
#pragma unroll
            for (int n = 0; n < 4; ++n) acc[n] = __builtin_amdgcn_mfma_f32_16x16x4f32(a, b[16 * n], acc[n], 0, 0, 0); }
        const int k0 = ki * 16 + 4 * lk; const float4 gv = *(const float4*)(g1 + k0);
#pragma unroll
        for (int n = 0; n < 4; ++n) { uint2 w; w.x = pk2(acc[n][0] * gv.x, acc[n][1] * gv.y); w.y = pk2(acc[n][2] * gv.z, acc[n][3] * gv.w);
            *(uint2*)(WIN1o + (size_t)((pg >> 2) * 768 + g * 192 + ds * 64 + n * 16 + li) * 1024 + k0) = w; } }
}
__device__ __forceinline__ void rmsnorm_rows2(const float* __restrict__ X, const float* __restrict__ g, bf16_t* __restrict__ O, int nrows, int gw, int NGW, int lane) {
    for (int m = 2 * gw; m < nrows; m += 2 * NGW) {
        const float4* x0 = (const float4*)(X + (size_t)m * DM) + lane; const float4* x1 = x0 + DM / 4; float4 v[8]; float s0 = 0.f, s1 = 0.f;
#pragma unroll
        for (int j = 0; j < 4; ++j) { v[j] = x0[64 * j]; v[4 + j] = x1[64 * j]; }
#pragma unroll
        for (int j = 0; j < 4; ++j) { s0 += v[j].x * v[j].x + v[j].y * v[j].y + v[j].z * v[j].z + v[j].w * v[j].w; s1 += v[4 + j].x * v[4 + j].x + v[4 + j].y * v[4 + j].y + v[4 + j].z * v[4 + j].z + v[4 + j].w * v[4 + j].w; }
        const float r0 = rsqrtf(wave_sum(s0) * (1.f / DM) + EPS), r1 = rsqrtf(wave_sum(s1) * (1.f / DM) + EPS);
        uint2* o0 = (uint2*)(O + (size_t)m * DM) + lane; uint2* o1 = o0 + DM / 4;
#pragma unroll
        for (int j = 0; j < 4; ++j) { const float4 gv = g ? ((const float4*)g)[lane + 64 * j] : make_float4(1.f, 1.f, 1.f, 1.f);
            uint2 w; w.x = pk2(v[j].x * r0 * gv.x, v[j].y * r0 * gv.y); w.y = pk2(v[j].z * r0 * gv.z, v[j].w * r0 * gv.w); o0[64 * j] = w;
            uint2 z; z.x = pk2(v[4 + j].x * r1 * gv.x, v[4 + j].y * r1 * gv.y); z.y = pk2(v[4 + j].z * r1 * gv.z, v[4 + j].w * r1 * gv.w); o1[64 * j] = z; } }
}
template <int DQK>
__device__ __forceinline__ void attn_naive_vb(float* Ks, float* Vs, int t256, const bf16_t* __restrict__ Q, int ldq, int qhs, const bf16_t* __restrict__ Kp, int ldk, int khs, const bf16_t* __restrict__ Vp, int ldv, int vhs,
                                              int nkeys, bf16_t* __restrict__ O, const bf16_t* __restrict__ G, int ocol0, int qblk, int h, int b) {
    constexpr int KT = 8;
    const size_t t = (size_t)b * SEQ + qblk * 256 + t256;
    unsigned qp2[DQK / 2]; float o[64], m = -1e30f, l = 0.f;
    { const bf16_t* qp = Q + t * ldq + h * qhs;
#pragma unroll
      for (int d = 0; d < DQK; d += 8) { const uint4 v = *(const uint4*)(qp + d); qp2[d / 2] = v.x; qp2[d / 2 + 1] = v.y; qp2[d / 2 + 2] = v.z; qp2[d / 2 + 3] = v.w; } }
#pragma unroll
    for (int d = 0; d < 64; ++d) o[d] = 0.f;
    const bf16_t* Kb = Kp + (size_t)b * nkeys * ldk + h * khs; const bf16_t* Vb = Vp + (size_t)b * nkeys * ldv + h * vhs;
    for (int k0 = 0; k0 < nkeys; k0 += KT) {
        __syncthreads();
        if (t256 < KT * DQK / 8) { const int j = t256 / (DQK / 8), d = (t256 % (DQK / 8)) * 8; const uint4 v = *(const uint4*)(Kb + (size_t)(k0 + j) * ldk + d);
            float* p = Ks + j * DQK + d; p[0] = __uint_as_float(v.x << 16); p[1] = __uint_as_float(v.x & 0xffff0000u); p[2] = __uint_as_float(v.y << 16); p[3] = __uint_as_float(v.y & 0xffff0000u);
            p[4] = __uint_as_float(v.z << 16); p[5] = __uint_as_float(v.z & 0xffff0000u); p[6] = __uint_as_float(v.w << 16); p[7] = __uint_as_float(v.w & 0xffff0000u); }
        if (t256 >= 128 && t256 < 128 + KT * 8) { const int tt = t256 - 128, j = tt >> 3, d = (tt & 7) * 8; const uint4 v = *(const uint4*)(Vb + (size_t)(k0 + j) * ldv + d);
            float* p = Vs + j * 64 + d; p[0] = __uint_as_float(v.x << 16); p[1] = __uint_as_float(v.x & 0xffff0000u); p[2] = __uint_as_float(v.y << 16); p[3] = __uint_as_float(v.y & 0xffff0000u);
            p[4] = __uint_as_float(v.z << 16); p[5] = __uint_as_float(v.z & 0xffff0000u); p[6] = __uint_as_float(v.w << 16); p[7] = __uint_as_float(v.w & 0xffff0000u); }
        __syncthreads();
#pragma unroll 1
        for (int j = 0; j < KT; ++j) { float s = 0.f; const float4* kr = (const float4*)(Ks + j * DQK);
#pragma unroll
            for (int d = 0; d < DQK / 4; ++d) { const float4 kv = kr[d]; const unsigned a = qp2[2 * d], c = qp2[2 * d + 1];
                s += __uint_as_float(a << 16) * kv.x + __uint_as_float(a & 0xffff0000u) * kv.y + __uint_as_float(c << 16) * kv.z + __uint_as_float(c & 0xffff0000u) * kv.w; }
            if (s > m) { const float alpha = __builtin_amdgcn_exp2f(m - s); m = s; l *= alpha;
#pragma unroll
                for (int d = 0; d < 64; ++d) o[d] *= alpha; }
            const float p = __builtin_amdgcn_exp2f(s - m); l += p; const float4* vr = (const float4*)(Vs + j * 64);
#pragma unroll
            for (int d = 0; d < 16; ++d) { const float4 vv = vr[d]; o[4 * d] += p * vv.x; o[4 * d + 1] += p * vv.y; o[4 * d + 2] += p * vv.z; o[4 * d + 3] += p * vv.w; } }
    }
    const float rl = 1.f / l;
    const bf16_t* gp = G + t * 1024 + ocol0 + h * 64; bf16_t* op = O + t * 1024 + ocol0 + h * 64;
#pragma unroll
    for (int d = 0; d < 64; d += 8) { const uint4 gv = *(const uint4*)(gp + d); uint4 w;
        w.x = pk2(o[d] * rl * __uint_as_float(gv.x << 16), o[d + 1] * rl * __uint_as_float(gv.x & 0xffff0000u));
        w.y = pk2(o[d + 2] * rl * __uint_as_float(gv.y << 16), o[d + 3] * rl * __uint_as_float(gv.y & 0xffff0000u));
        w.z = pk2(o[d + 4] * rl * __uint_as_float(gv.z << 16), o[d + 5] * rl * __uint_as_float(gv.z & 0xffff0000u));
        w.w = pk2(o[d + 6] * rl * __uint_as_float(gv.w << 16), o[d + 7] * rl * __uint_as_float(gv.w & 0xffff0000u));
        *(uint4*)(op + d) = w; }
}
template <int DQK>
__device__ __forceinline__ void attn_naive_phase(unsigned char* lds, int tid, const bf16_t* Q, int ldq, int qhs, const bf16_t* Kp, int ldk, int khs, const bf16_t* Vp, int ldv, int vhs, int nkeys, int nheads,
                                                 bf16_t* O, const bf16_t* G, int ocol0) {
    const int half = tid >> 8, t256 = tid & 255; float* Ks = (float*)(lds + half * 32768); float* Vs = Ks + 8 * DQK;
    const int total = 16 * nheads * NB, stride = (int)gridDim.x * 2;
    for (int vb = (int)blockIdx.x * 2 + half; vb < total; vb += stride) { const int qblk = vb & 15, h = (vb >> 4) % nheads, b = (vb >> 4) / nheads;
        attn_naive_vb<DQK>(Ks, Vs, t256, Q, ldq, qhs, Kp, ldk, khs, Vp, ldv, vhs, nkeys, O, G, ocol0, qblk, h, b); }
}

__global__ void __launch_bounds__(NWAVES * 64, 2) mk_fwd(Args args) {
    extern __shared__ __attribute__((aligned(16))) unsigned char lds[];
    LAS unsigned char* ldsl = (LAS unsigned char*)lds;
    volatile LAS unsigned* MISC = (volatile LAS unsigned*)(ldsl + MISC_OFF);
    const int tid0 = threadIdx.x;
#define PHASE_IDS() int tid = threadIdx.x; asm volatile("" : "+v"(tid)); const int lane = tid & 63, wave = __builtin_amdgcn_readfirstlane(tid >> 6); const int gt = (int)blockIdx.x * (NWAVES * 64) + tid, gw = (int)blockIdx.x * NWAVES + wave; (void)lane; (void)wave; (void)gt; (void)gw;
    const int vcu = (gridDim.x % 8 == 0) ? ((int)blockIdx.x % 8) * ((int)gridDim.x / 8) + (int)blockIdx.x / 8 : (int)blockIdx.x;
    const int G = gridDim.x, GT = G * NWAVES * 64, NGW = G * NWAVES;
    unsigned char* ws = args.ws;
    gu32* ctl = (gu32*)(ws + WS_CTL);
#define in_x ((const float*)args.in[0])
#define in_mem ((const float*)args.in[1])
#define in_pos ((const int*)args.in[2])
#define in_g0 ((const float*)args.in[3])
#define in_w_in0 ((const float*)args.in[4])
#define in_gq ((const float*)args.in[5])
#define in_gkv ((const float*)args.in[6])
#define in_w_uq ((const float*)args.in[7])
#define in_w_ukv ((const float*)args.in[8])
#define in_gm0 ((const float*)args.in[9])
#define in_w_mkv0 ((const float*)args.in[10])
#define in_w_out0 ((const float*)args.in[11])
#define in_g1 ((const float*)args.in[12])
#define in_w_in1 ((const float*)args.in[13])
#define in_w_fnet ((const float*)args.in[14])
#define in_gm1 ((const float*)args.in[15])
#define in_w_mkv1 ((const float*)args.in[16])
#define in_w_out1 ((const float*)args.in[17])
#define in_gf ((const float*)args.in[18])
#define in_out (args.out)
#define WIN0 ((bf16_t*)(ws + WS_WIN0))
#define WUQ ((bf16_t*)(ws + WS_WUQ))
#define WUKV ((bf16_t*)(ws + WS_WUKV))
#define WMEM ((bf16_t*)(ws + WS_WMEM))
#define WOUT0 ((bf16_t*)(ws + WS_WOUT0))
#define WOUT1 ((bf16_t*)(ws + WS_WOUT1))
#define WIN1 ((bf16_t*)(ws + WS_WIN1))
#define AGBG ((float*)(ws + WS_AGBG))
#define ROPE ((float*)(ws + WS_ROPE))
#define MEMN ((bf16_t*)(ws + WS_MEMN))
#define MEMKV ((bf16_t*)(ws + WS_MEMKV))
#define RSTD1 ((float*)(ws + WS_RSTD1))
#define SSQ ((float*)(ws + WS_SSQ))
#define XN0 ((bf16_t*)(ws + WS_XN0))
#define BR ((bf16_t*)(ws + WS_BR))
#define CQ ((bf16_t*)(ws + WS_CQ))
#define CKV ((bf16_t*)(ws + WS_CKV))
#define QMEM0 ((bf16_t*)(ws + WS_QMEM0))
#define SG0 ((bf16_t*)(ws + WS_SG0))
#define Kb ((bf16_t*)(ws + WS_K))
#define Qb ((bf16_t*)(ws + WS_Q))
#define Vb ((bf16_t*)(ws + WS_V))
#define X1B ((bf16_t*)(ws + WS_X1B))
#define PQ ((bf16_t*)(ws + WS_PQ))
#define QMEM1 ((bf16_t*)(ws + WS_QMEM1))
#define SG1 ((bf16_t*)(ws + WS_SG1))
#define Y ((bf16_t*)(ws + WS_Y))
    for (int u = tid0; u < (LDS_BYTES - LDSCTL_OFF) / 4; u += NWAVES * 64) ((LAS unsigned*)(ldsl + LDSCTL_OFF))[u] = 0u;
    __syncthreads();
    const XcdBarrier bar = xcd_barrier_post((unsigned*)(ctl + CW_BAR) + args.li * XCD_BAR_WORDS, MISC + 8);
#define GRID_BAR() xcd_barrier(bar)
    const int lo = args.ph_lo, hi = args.ph_hi;
#ifndef PH_MASK
#define PH_MASK 0x1ff
#endif
#define IN(k) (((PH_MASK >> (k)) & 1) && lo <= (k) && (k) < hi)
#define BOTH(k) (IN(k) && IN((k) + 1))
    LAS float* rs = (LAS float*)(ldsl + RS_OFF);

    if (IN(0)) { PHASE_IDS();
        prep_w_job(in_w_in0, 1952, 1024, WIN0, 0, 2048, nullptr, MODE_WIN0, 0, gt, GT);
        prep_w_job(in_w_uq, 1152, 384, WUQ, 0, 1280, in_gq, MODE_WUQ, 0, gt, GT);
        prep_w_job(in_w_ukv, 1536, 256, WUKV, 0, 1536, in_gkv, MODE_WUKV, 0, gt, GT);
        prep_w_job(in_w_mkv0, 512, 1024, WMEM, 0, 512, in_gm0, MODE_PLAIN, 0, gt, GT);
        prep_w_job(in_w_mkv1, 512, 1024, WMEM, 512, 512, in_gm1, MODE_PLAIN, 0, gt, GT);
        prep_w_job(in_w_out0, 1024, 1024, WOUT0, 0, 1024, nullptr, MODE_PLAIN, 0, gt, GT);
        prep_w_job(in_w_out1, 1024, 1024, WOUT1, 0, 1024, nullptr, MODE_PLAIN, 0, gt, GT);
        prep_w_job(in_w_in1, 2048, 1024, WIN1, 1536, 1280, in_g1, MODE_PLAIN, 768, gt, GT);
        fold1_tiles(in_w_fnet, AGBG, gw, NGW, lane);
        for (int idx = gt; idx < T * 16; idx += GT) { const int t = idx >> 4, i = idx & 15;
            const float inv_freq = __builtin_amdgcn_exp2f((float)i * -0.83048202372184058696f);
            const float ang = (float)in_pos[t] * inv_freq; double fd = (double)ang * 0.31830988618379067154; fd -= 2.0 * floor(fd * 0.5);
            float sn, cs; sincospif((float)fd, &sn, &cs); ROPE[2 * idx] = cs; ROPE[2 * idx + 1] = sn; }
        rmsnorm_rows2(in_mem, nullptr, MEMN, 4096, gw, NGW, lane);
        rmsnorm_rows2(in_x, in_g0, XN0, T, gw, NGW, lane);
        if (BOTH(0)) GRID_BAR();
    }
    if (IN(1)) { PHASE_IDS();
        fold2_strips(in_w_in1, in_g1, AGBG, WIN1, gw, NGW, lane);
        { pg8::Gemm g{XN0, WIN0, T, 2048, 1024}; pg8::StaticOrder S; S.init(T, 2048, G, (int)blockIdx.x);
          pg8::EpiIn0 E{CQ, CKV, QMEM0, SG0, Kb, SSQ, ROPE};
          pg8::gemm_phase<pg8::EpiIn0, pg8::StaticOrder, true, true>(ldsl + RING_OFF, g, S, E); }
        { pg8::Gemm g{MEMN, WMEM, 4096, 1024, 1024}; pg8::StaticOrder S; S.init(4096, 1024, G, (int)blockIdx.x);
          pg8::EpiPlainB E{MEMKV, 1024, 0};
          pg8::gemm_phase<pg8::EpiPlainB, pg8::StaticOrder, true, true>(ldsl + RING_OFF, g, S, E); }
        if (BOTH(1)) GRID_BAR();
    }
    if (IN(2)) { PHASE_IDS();
        { int kq_ = 384; asm volatile("" : "+s"(kq_)); pg8::Gemm g{CQ, WUQ, T, 1280, kq_}; pg8::StaticOrder S; S.init(T, 1280, G, (int)blockIdx.x);
          pg8::EpiQup E{Qb, SSQ, ROPE};
          pg8::gemm_phase<pg8::EpiQup, pg8::StaticOrder, true, true>(ldsl + RING_OFF, g, S, E); }
        { int kk_ = 256; asm volatile("" : "+s"(kk_)); pg8::Gemm g{CKV, WUKV, T, 1536, kk_}; pg8::StaticOrder S; S.init(T, 1536, G, (int)blockIdx.x);
          pg8::EpiKVup E{Kb, Vb, SSQ};
          pg8::gemm_phase<pg8::EpiKVup, pg8::StaticOrder, true, true>(ldsl + RING_OFF, g, S, E); }
        if (BOTH(2)) GRID_BAR();
    }
    if (IN(3)) { PHASE_IDS();
#ifdef ATTN_NAIVE
        attn_naive_phase<96>(lds, tid, Qb, 1152, 96, Kb, 1152, 96, Vb, 768, 64, SEQ, 12, BR, SG0, 0);
        attn_naive_phase<64>(lds, tid, QMEM0, 256, 64, MEMKV, 1024, 64, MEMKV + 256, 1024, 64, 256, 4, BR, SG0, 768);
#else
        for (int u = vcu; u < 16 * 12 * NB; u += G) { const int qblk = u & 15, pair = u >> 4, b = pair / 12, h = pair % 12; const size_t t0 = (size_t)b * SEQ + qblk * 256;
            att::attn_unit<96>(Qb + t0 * 1152 + h * 96, 1152, Kb + (size_t)b * SEQ * 1152 + h * 96, 1152, Vb + (size_t)b * SEQ * 768 + h * 64, 768, SEQ, BR + t0 * 1024 + h * 64, SG0 + t0 * 1024 + h * 64, (char*)lds); }
        for (int u = vcu; u < 16 * 4 * NB; u += G) { const int qblk = u & 15, pair = u >> 4, b = pair >> 2, h = pair & 3; const size_t t0 = (size_t)b * SEQ + qblk * 256;
            att::attn_unit<64>(QMEM0 + t0 * 256 + h * 64, 256, MEMKV + (size_t)b * 256 * 1024 + h * 64, 1024, MEMKV + (size_t)b * 256 * 1024 + 256 + h * 64, 1024, 256, BR + t0 * 1024 + 768 + h * 64, SG0 + t0 * 1024 + 768 + h * 64, (char*)lds); }
#endif
        if (BOTH(3)) GRID_BAR();
    }
    if (IN(4)) { PHASE_IDS();
        for (int i = tid; i < 1024; i += NWAVES * 64) rs[i] = 0.f;
        __syncthreads();
        { pg8::Gemm g{BR, WOUT0, T, 1024, 1024}; pg8::PanelOrder S; S.init(T, G, (int)blockIdx.x);
          pg8::EpiOut E{in_x, in_out, X1B, rs};
          pg8::gemm_phase<pg8::EpiOut, pg8::PanelOrder, true, true>(ldsl + RING_OFF, g, S, E); }
        __syncthreads();
        if (tid < 256) RSTD1[(size_t)blockIdx.x * 256 + tid] = rsqrtf(((rs[tid * 4] + rs[tid * 4 + 1]) + (rs[tid * 4 + 2] + rs[tid * 4 + 3])) * (1.f / DM) + EPS);
        if (BOTH(4)) GRID_BAR();
    }
    if (IN(5)) { PHASE_IDS();
        { pg8::Gemm g{X1B, WIN1, T, 2816, 1024}; pg8::StaticOrder S; S.init(T, 2816, G, (int)blockIdx.x);
          pg8::EpiIn1 E{PQ, QMEM1, SG1, RSTD1};
          pg8::gemm_phase<pg8::EpiIn1, pg8::StaticOrder, true, true>(ldsl + RING_OFF, g, S, E); }
        if (BOTH(5)) GRID_BAR();
    }
    if (IN(6)) { PHASE_IDS();
#ifdef FFT_NAIVE
        LAS float* tab = (LAS float*)(ldsl + RING_OFF + 65536);
        if (tid < 64) { tab[2 * tid] = cospif(2.f * tid / 64.f); tab[2 * tid + 1] = sinpif(2.f * tid / 64.f); }
        __syncthreads();
        for (int idx = gt; idx < NB * 64 * 49152; idx += GT) { const int e = idx % 49152, k1 = (idx / 49152) & 63, b = idx / (49152 * 64);
            float ar = 0.f, ai = 0.f;
            for (int s1 = 0; s1 < 64; ++s1) { const int w = (k1 * s1) & 63; const float wx = tab[2 * w], wy = tab[2 * w + 1];
                const size_t base = (((size_t)b * 64 + s1) * 2) * 49152 + e; const float p = bf2f(PQ[base]), q = bf2f(PQ[base + 49152]);
                ar += wx * p - wy * q; ai += wy * p + wx * q; }
            ar *= 0.125f; ai *= 0.125f;
            const int s2 = e / 768; const float fr = 2.f * (float)(k1 * s2) / 4096.f; const float tr = cospif(fr), ti = sinpif(fr);
            const size_t ob = (((size_t)b * 64 + k1) * 2) * 49152 + e;
            Y[ob] = f2bf(tr * ar - ti * ai); Y[ob + 49152] = f2bf(ti * ar + tr * ai); }
        __syncthreads();
#else
        fft::stage_a(PQ, Y, (char*)lds, vcu, G);
#endif
#ifdef ATTN_NAIVE
        attn_naive_phase<64>(lds, tid, QMEM1, 256, 64, MEMKV + 512, 1024, 64, MEMKV + 768, 1024, 64, 256, 4, BR, SG1, 768);
#else
        for (int u = vcu; u < 16 * 4 * NB; u += G) { const int qblk = u & 15, pair = u >> 4, b = pair >> 2, h = pair & 3; const size_t t0 = (size_t)b * SEQ + qblk * 256;
            att::attn_unit<64>(QMEM1 + t0 * 256 + h * 64, 256, MEMKV + (size_t)b * 256 * 1024 + 512 + h * 64, 1024, MEMKV + (size_t)b * 256 * 1024 + 768 + h * 64, 1024, 256, BR + t0 * 1024 + 768 + h * 64, SG1 + t0 * 1024 + 768 + h * 64, (char*)lds); }
#endif
        if (BOTH(6)) GRID_BAR();
    }
    if (IN(7)) { PHASE_IDS();
#ifdef FFT_NAIVE
        LAS float* tab = (LAS float*)(ldsl + RING_OFF + 65536);
        __syncthreads();
        if (tid < 64) { tab[2 * tid] = cospif(2.f * tid / 64.f); tab[2 * tid + 1] = sinpif(2.f * tid / 64.f); }
        __syncthreads();
        for (int idx = gt; idx < NB * 64 * 64 * 768; idx += GT) { const int d = idx % 768, k2 = (idx / 768) & 63, bk1 = idx / 49152, b = bk1 >> 6, k1 = bk1 & 63;
            float acc = 0.f;
            for (int s2 = 0; s2 < 64; ++s2) { const int w = (k2 * s2) & 63; const size_t base = ((size_t)bk1 * 2) * 49152 + (size_t)s2 * 768 + d;
                acc += tab[2 * w] * bf2f(Y[base]) - tab[2 * w + 1] * bf2f(Y[base + 49152]); }
            const size_t t = (size_t)b * SEQ + k1 + 64 * k2;
            BR[t * 1024 + d] = f2bf(acc * 0.125f * bf2f(SG1[t * 1024 + d])); }
#else
        fft::stage_b(Y, SG1, BR, (char*)lds, vcu, G);
#endif
        if (BOTH(7)) GRID_BAR();
    }
    if (IN(8)) { PHASE_IDS();
        __syncthreads();
        for (int i = tid; i < 1024; i += NWAVES * 64) rs[i] = 0.f;
        __syncthreads();
        { pg8::Gemm g{BR, WOUT1, T, 1024, 1024}; pg8::PanelOrder S; S.init(T, G, (int)blockIdx.x);
          pg8::EpiOut E{in_out, in_out, nullptr, rs};
          pg8::gemm_phase<pg8::EpiOut, pg8::PanelOrder, true, true>(ldsl + RING_OFF, g, S, E); }
        asm volatile("s_waitcnt vmcnt(0)" ::: "memory");
        __syncthreads();
        for (int r = wave; r < 256; r += NWAVES) { const float rstd = rsqrtf(((rs[r * 4] + rs[r * 4 + 1]) + (rs[r * 4 + 2] + rs[r * 4 + 3])) * (1.f / DM) + EPS);
            float4* xr = (float4*)(in_out + ((size_t)blockIdx.x * 256 + r) * DM) + lane;
#pragma unroll
            for (int j = 0; j < 4; ++j) { float4 v = xr[64 * j]; const float4 gv = ((const float4*)in_gf)[lane + 64 * j]; v.x *= rstd * gv.x; v.y *= rstd * gv.y; v.z *= rstd * gv.z; v.w *= rstd * gv.w; xr[64 * j] = v; } }
    }
#undef in_x
#undef in_mem
#undef in_pos
#undef in_g0
#undef in_w_in0
#undef in_gq
#undef in_gkv
#undef in_w_uq
#undef in_w_ukv
#undef in_gm0
#undef in_w_mkv0
#undef in_w_out0
#undef in_g1
#undef in_w_in1
#undef in_w_fnet
#undef in_gm1
#undef in_w_mkv1
#undef in_w_out1
#undef in_gf
#undef in_out
#undef WIN0
#undef WUQ
#undef WUKV
#undef WMEM
#undef WOUT0
#undef WOUT1
#undef WIN1
#undef AGBG
#undef ROPE
#undef MEMN
#undef MEMKV
#undef RSTD1
#undef SSQ
#undef XN0
#undef BR
#undef CQ
#undef CKV
#undef QMEM0
#undef SG0
#undef Kb
#undef Qb
#undef Vb
#undef X1B
#undef PQ
#undef QMEM1
#undef SG1
#undef Y
#undef PHASE_IDS
#undef IN
#undef BOTH
#undef GRID_BAR
}

extern "C" void kernel_launch(void* const* d_in, const int* in_sizes, int n_in, void* d_out, int out_size, void* d_ws, size_t ws_size, hipStream_t stream) {
    static int grid = 0;
    if (grid == 0) {
        if (n_in != 19 || ws_size < WS_END || out_size != T * DM) { fprintf(stderr, "kernel_launch: unexpected n_in %d / ws %zu / out %d\n", n_in, ws_size, out_size); grid = -1; return; }
        int dev = 0, cus = 0;
        if (hipGetDevice(&dev) != hipSuccess || hipDeviceGetAttribute(&cus, hipDeviceAttributeMultiprocessorCount, dev) != hipSuccess) { grid = -1; return; }
        if (hipFuncSetAttribute((const void*)mk_fwd, hipFuncAttributeMaxDynamicSharedMemorySize, LDS_BYTES) != hipSuccess) { fprintf(stderr, "kernel_launch: hipFuncSetAttribute failed\n"); grid = -1; return; }
        int per_cu = 0; (void)hipOccupancyMaxActiveBlocksPerMultiprocessor(&per_cu, (const void*)mk_fwd, NWAVES * 64, LDS_BYTES); (void)hipGetLastError();
        if (cus != 256 || per_cu < 1) fprintf(stderr, "kernel_launch: note: %d CUs, occupancy query %d (built for 256 CUs, one workgroup each)\n", cus, per_cu);
        grid = 256;
    }
    if (grid < 0) return;
    if (hipMemsetAsync((char*)d_ws + WS_CTL, 0, CTL_ZERO_BYTES, stream) != hipSuccess) { fprintf(stderr, "kernel_launch: memset failed\n"); return; }
    Args a{};
    for (int i = 0; i < 19; ++i) a.in[i] = d_in[i];
    a.out = (float*)d_out; a.ws = (unsigned char*)d_ws;
#ifndef PROBE_PHASE
    const int nl = 1; const int rlo[1] = {0}, rhi[1] = {N_PHASES};
#else
    const int nl = 3; const int rlo[3] = {0, PROBE_PHASE, PROBE_PHASE}, rhi[3] = {PROBE_PHASE + 1, PROBE_PHASE + 1, N_PHASES};
#endif
    for (int li = 0; li < nl; ++li) {
        a.ph_lo = rlo[li]; a.ph_hi = rhi[li]; a.li = li; a.pad = 0;
        hipLaunchKernelGGL(mk_fwd, dim3(grid), dim3(NWAVES * 64), LDS_BYTES, stream, a);
        const hipError_t le = hipPeekAtLastError();
        if (le != hipSuccess) { fprintf(stderr, "kernel_launch: launch %d failed: %s\n", li, hipGetErrorName(le)); break; }
    }
}
```

```cpp
#include <hip/hip_runtime.h>
#include <stdint.h>
#include <cstdio>

typedef unsigned short bf16_t;
constexpr int T = 65536, SEQ = 4096, NB = 16, DM = 1024;
constexpr float EPS = 1e-6f;
constexpr float LOG2E = 1.4426950408889634f;
constexpr float QS_MLA = 0.10206207261596575f * LOG2E;
constexpr float QS_MEM = 0.125f * LOG2E;

constexpr size_t MiB = 1u << 20;
constexpr size_t WS_CTL = 0, CTL_ZERO_BYTES = 1 * MiB;
constexpr size_t WS_WIN0 = 1 * MiB;
constexpr size_t WS_WUQ = 5 * MiB;
constexpr size_t WS_WUKV = 6 * MiB;
constexpr size_t WS_WMEM = 7 * MiB;
constexpr size_t WS_WOUT0 = 9 * MiB;
constexpr size_t WS_WOUT1 = 11 * MiB;
constexpr size_t WS_WIN1 = 13 * MiB;
constexpr size_t WS_AGBG = 19 * MiB;
constexpr size_t WS_ROPE = 21 * MiB;
constexpr size_t WS_MEMN = 29 * MiB;
constexpr size_t WS_MEMKV = 37 * MiB;
constexpr size_t WS_RSTD1 = 45 * MiB;
constexpr size_t WS_SSQ = 46 * MiB;
constexpr size_t WS_XN0 = 64 * MiB;
constexpr size_t WS_BR = 64 * MiB;
constexpr size_t WS_CQ = 192 * MiB;
constexpr size_t WS_CKV = 240 * MiB;
constexpr size_t WS_QMEM0 = 272 * MiB;
constexpr size_t WS_SG0 = 304 * MiB;
constexpr size_t WS_K = 432 * MiB;
constexpr size_t WS_Q = 576 * MiB;
constexpr size_t WS_V = 720 * MiB;
constexpr size_t WS_X1B = 192 * MiB;
constexpr size_t WS_PQ = 320 * MiB;
constexpr size_t WS_QMEM1 = 512 * MiB;
constexpr size_t WS_SG1 = 544 * MiB;
constexpr size_t WS_Y = 672 * MiB;
constexpr size_t WS_END = 864 * MiB;

__device__ __forceinline__ float bf2f(bf16_t h) { return __uint_as_float(((unsigned)h) << 16); }
__device__ __forceinline__ bf16_t f2bf(float f) { unsigned u = __float_as_uint(f); return (bf16_t)((u + 0x7fffu + ((u >> 16) & 1u)) >> 16); }
__device__ __forceinline__ unsigned pk2(float lo, float hi) { return (unsigned)f2bf(lo) | ((unsigned)f2bf(hi) << 16); }
__device__ __forceinline__ float silu_f(float v) { return v * __builtin_amdgcn_rcpf(1.f + __expf(-v)); }
__device__ __forceinline__ float wave_sum(float v) {
#pragma unroll
    for (int o = 1; o < 64; o <<= 1) v += __shfl_xor(v, o);
    return v;
}
__host__ __device__ __forceinline__ int ropedim(int p) { return 4 * (p >> 3) + (p & 3) + 16 * ((p >> 2) & 1); }
enum { MODE_WIN0 = 0, MODE_WUQ = 1, MODE_WUKV = 2, MODE_PLAIN = 3 };
__device__ __forceinline__ int src_col(int mode, int n, int off) {
    if (mode == MODE_WIN0) {
        if (n < 640) return n;
        if (n < 896) return 672 + (n - 640);
        if (n < 928) return 640 + ropedim(n - 896);
        if (n < 1024) return -1;
        return 928 + (n - 1024);
    } else if (mode == MODE_WUQ) {
        if (n < 768) return (n >> 6) * 96 + (n & 63);
        if (n < 1152) { const int r = n - 768; return (r >> 5) * 96 + 64 + ropedim(r & 31); }
        return -1;
    } else if (mode == MODE_WUKV) {
        if (n < 768) return (n >> 6) * 128 + (n & 63);
        const int r = n - 768; return (r >> 6) * 128 + 64 + (r & 63);
    }
    return n + off;
}
namespace pg8 {
#define PG8_LAS __attribute__((address_space(3)))
typedef unsigned short bf16_t;
typedef short bf16x8 __attribute__((ext_vector_type(8)));
typedef float f32x4 __attribute__((ext_vector_type(4)));
typedef unsigned u32x4 __attribute__((ext_vector_type(4)));
constexpr int BM = 256, BK = 64, HALF = 128, HTB = HALF * BK * 2  , STAGE_BYTES = 8 * HTB, NXCD = 8, WGM = 8;

__host__ __device__ __forceinline__ int lds_byte(int r, int c) { const int st = (r >> 4) * 2 + (c >> 5), rr = r & 15, cc = c & 31, ob = rr * 64 + cc * 2; return st * 1024 + (ob ^ (((ob >> 9) & 1) << 5)); }
__host__ __device__ __forceinline__ void stage_rc(int b, int& R, int& C) { const int st = b / 1024, sb = b % 1024, swz = sb ^ (((sb >> 9) & 1) << 5); R = (st >> 1) * 16 + swz / 64; C = (st & 1) * 32 + (swz % 64) / 2; }
__host__ __device__ __forceinline__ int perm32(int rho) { const int n = rho >> 4, i = rho & 15; return 8 * (i >> 2) + 4 * n + (i & 3); }

struct Unit { int pm, pn; };
struct Gemm { const bf16_t* A; const bf16_t* Bt; int M, N, K; };

struct StaticOrder {
    int nM, nN, nwg, G, c;
    __host__ __device__ void init(int M, int N, int G_, int c_) { nM = M / BM; nN = N / BM; nwg = nM * nN; G = G_; c = c_; }
    __host__ __device__ bool next(int i, Unit& u) const {
        const long L = (long)i * G + c; if (L >= nwg) return false;
        int wgid = (int)L; { const int q = nwg / NXCD, r = nwg % NXCD, xcd = wgid % NXCD, off = wgid / NXCD; wgid = (xcd < r ? xcd * (q + 1) : r * (q + 1) + (xcd - r) * q) + off; }
        const int nig = WGM * nN, gid = wgid / nig, fm = gid * WGM, gsz = (nM - fm) < WGM ? (nM - fm) : WGM;
        u.pm = fm + ((wgid % nig) % gsz); u.pn = (wgid % nig) / gsz; return true;
    }
    __device__ __forceinline__ void a_ready(const Unit&) const {}
    __device__ __forceinline__ void done(const Unit&) const {}
};

__device__ __forceinline__ unsigned cvt_pk_bf16(float lo, float hi) { unsigned r; asm volatile("v_cvt_pk_bf16_f32 %0, %1, %2" : "=v"(r) : "v"(lo), "v"(hi)); return r; }
typedef float f32x2 __attribute__((ext_vector_type(2)));
__device__ __forceinline__ u32x4 pack8(const f32x4 a, const f32x4 b, float s) { u32x4 w; w.x = cvt_pk_bf16(a[0] * s, a[1] * s); w.y = cvt_pk_bf16(a[2] * s, a[3] * s); w.z = cvt_pk_bf16(b[0] * s, b[1] * s); w.w = cvt_pk_bf16(b[2] * s, b[3] * s); return w; }
__device__ __forceinline__ float ss8(const f32x4 a, const f32x4 b) { return (a[0] * a[0] + a[1] * a[1]) + (a[2] * a[2] + a[3] * a[3]) + (b[0] * b[0] + b[1] * b[1]) + (b[2] * b[2] + b[3] * b[3]); }
__device__ __forceinline__ float quad_sum(float v) { v += __shfl_xor(v, 16); v += __shfl_xor(v, 32); return v; }
__device__ __forceinline__ f32x4 silu4(const f32x4 v) { f32x4 o; o[0] = silu_f(v[0]); o[1] = silu_f(v[1]); o[2] = silu_f(v[2]); o[3] = silu_f(v[3]); return o; }
typedef unsigned u32x2 __attribute__((ext_vector_type(2)));
__device__ __forceinline__ void rope_pair(const f32x4 a, const f32x4 b, const float* cs  , float s, u32x2& o1, u32x2& o2) {
    const f32x4 c01 = *(const f32x4*)cs, c23 = *(const f32x4*)(cs + 4);
    const float r0 = (a[0] * c01[0] - b[0] * c01[1]) * s, r1 = (a[1] * c01[2] - b[1] * c01[3]) * s, r2 = (a[2] * c23[0] - b[2] * c23[1]) * s, r3 = (a[3] * c23[2] - b[3] * c23[3]) * s;
    const float q0 = (b[0] * c01[0] + a[0] * c01[1]) * s, q1 = (b[1] * c01[2] + a[1] * c01[3]) * s, q2 = (b[2] * c23[0] + a[2] * c23[1]) * s, q3 = (b[3] * c23[2] + a[3] * c23[3]) * s;
    o1.x = cvt_pk_bf16(r0, r1); o1.y = cvt_pk_bf16(r2, r3); o2.x = cvt_pk_bf16(q0, q1); o2.y = cvt_pk_bf16(q2, q3);
}
struct EpiIn0 {
    static constexpr bool PERM = true, AFTER_DRAIN = false;
    bf16_t *CQ, *CKV, *QMEM, *SG, *Kb; float* SSQ; const float* rope;
    __device__ __forceinline__ void operator()(const f32x4 (&acc)[2][2][4][2], const Unit& u, int wr, int wc, int fr, int fq) const {
#pragma unroll
        for (int ai = 0; ai < 2; ++ai)
#pragma unroll
            for (int m = 0; m < 4; ++m) { int rowi_ = u.pm * BM + ai * HALF + wr * 64 + m * 16 + fr; asm volatile("" : "+v"(rowi_)); const size_t row = (size_t)rowi_;
#pragma unroll
                for (int bj = 0; bj < 2; ++bj) { const int cb = u.pn * BM + bj * HALF + wc * 32, c = cb + 8 * fq; const f32x4 v0 = acc[ai][bj][m][0], v1 = acc[ai][bj][m][1];
                    if (cb < 640) { const float ss = quad_sum(ss8(v0, v1));
                        if (cb < 384) { *(u32x4*)(CQ + row * 384 + c) = pack8(v0, v1, 1.f); if (fq == 0) SSQ[row * 20 + (cb >> 5)] = ss; }
                        else { *(u32x4*)(CKV + row * 256 + (c - 384)) = pack8(v0, v1, 1.f); if (fq == 0) SSQ[row * 20 + 12 + ((cb - 384) >> 5)] = ss; } }
                    else if (cb < 896) { *(u32x4*)(QMEM + row * 256 + (c - 640)) = pack8(v0, v1, QS_MEM); }
                    else if (cb < 1024) { if (cb == 896) { u32x2 o1, o2; rope_pair(v0, v1, rope + row * 32 + 8 * fq, 1.f, o1, o2);
#pragma unroll
                            for (int h = 0; h < 12; ++h) { *(u32x2*)(Kb + row * 1152 + h * 96 + 64 + 4 * fq) = o1; *(u32x2*)(Kb + row * 1152 + h * 96 + 80 + 4 * fq) = o2; } } }
                    else { *(u32x4*)(SG + row * 1024 + (c - 1024)) = pack8(silu4(v0), silu4(v1), 1.f); } } }
    }
};
struct EpiPlainB {
    static constexpr bool PERM = true, AFTER_DRAIN = false;
    bf16_t* O; int ldo; int pad;
    __device__ __forceinline__ void operator()(const f32x4 (&acc)[2][2][4][2], const Unit& u, int wr, int wc, int fr, int fq) const {
#pragma unroll
        for (int ai = 0; ai < 2; ++ai)
#pragma unroll
            for (int m = 0; m < 4; ++m) { int rowi_ = u.pm * BM + ai * HALF + wr * 64 + m * 16 + fr; asm volatile("" : "+v"(rowi_)); const size_t row = (size_t)rowi_;
#pragma unroll
                for (int bj = 0; bj < 2; ++bj) { const int c = u.pn * BM + bj * HALF + wc * 32 + 8 * fq; *(u32x4*)(O + row * ldo + c) = pack8(acc[ai][bj][m][0], acc[ai][bj][m][1], 1.f); } }
    }
};
struct EpiQup {
    static constexpr bool PERM = true, AFTER_DRAIN = false;
    bf16_t* Qb; const float* SSQ; const float* rope;
    __device__ __forceinline__ void operator()(const f32x4 (&acc)[2][2][4][2], const Unit& u, int wr, int wc, int fr, int fq) const {
#pragma unroll
        for (int ai = 0; ai < 2; ++ai)
#pragma unroll
            for (int m = 0; m < 4; ++m) { int rowi_ = u.pm * BM + ai * HALF + wr * 64 + m * 16 + fr; asm volatile("" : "+v"(rowi_)); const size_t row = (size_t)rowi_;
                const f32x4 s0 = *(const f32x4*)(SSQ + row * 20), s1 = *(const f32x4*)(SSQ + row * 20 + 4), s2 = *(const f32x4*)(SSQ + row * 20 + 8);
                const float ss = ((s0[0] + s0[1]) + (s0[2] + s0[3])) + ((s1[0] + s1[1]) + (s1[2] + s1[3])) + ((s2[0] + s2[1]) + (s2[2] + s2[3]));
                const float s = rsqrtf(ss * (1.f / 384.f) + EPS) * QS_MLA;
#pragma unroll
                for (int bj = 0; bj < 2; ++bj) { const int cb = u.pn * BM + bj * HALF + wc * 32, c = cb + 8 * fq; const f32x4 v0 = acc[ai][bj][m][0], v1 = acc[ai][bj][m][1];
                    if (cb < 768) { *(u32x4*)(Qb + row * 1152 + (c >> 6) * 96 + (c & 63)) = pack8(v0, v1, s); }
                    else if (cb < 1152) { const int h = (cb - 768) >> 5; u32x2 o1, o2; rope_pair(v0, v1, rope + row * 32 + 8 * fq, s, o1, o2);
                        *(u32x2*)(Qb + row * 1152 + h * 96 + 64 + 4 * fq) = o1; *(u32x2*)(Qb + row * 1152 + h * 96 + 80 + 4 * fq) = o2; } }
                asm volatile("" ::: "memory"); }
    }
};
struct EpiKVup {
    static constexpr bool PERM = true, AFTER_DRAIN = false;
    bf16_t *Kb, *Vb; const float* SSQ;
    __device__ __forceinline__ void operator()(const f32x4 (&acc)[2][2][4][2], const Unit& u, int wr, int wc, int fr, int fq) const {
#pragma unroll
        for (int ai = 0; ai < 2; ++ai)
#pragma unroll
            for (int m = 0; m < 4; ++m) { int rowi_ = u.pm * BM + ai * HALF + wr * 64 + m * 16 + fr; asm volatile("" : "+v"(rowi_)); const size_t row = (size_t)rowi_;
                const f32x4 s0 = *(const f32x4*)(SSQ + row * 20 + 12), s1 = *(const f32x4*)(SSQ + row * 20 + 16);
                const float ss = ((s0[0] + s0[1]) + (s0[2] + s0[3])) + ((s1[0] + s1[1]) + (s1[2] + s1[3]));
                const float s = rsqrtf(ss * (1.f / 256.f) + EPS);
#pragma unroll
                for (int bj = 0; bj < 2; ++bj) { const int cb = u.pn * BM + bj * HALF + wc * 32, c = cb + 8 * fq; const f32x4 v0 = acc[ai][bj][m][0], v1 = acc[ai][bj][m][1];
                    if (cb < 768) *(u32x4*)(Kb + row * 1152 + (c >> 6) * 96 + (c & 63)) = pack8(v0, v1, s);
                    else *(u32x4*)(Vb + row * 768 + (c - 768)) = pack8(v0, v1, s); }
                asm volatile("" ::: "memory"); }
    }
};
struct EpiOutA {
    static constexpr bool PERM = true, AFTER_DRAIN = false;
    const float* R; bf16_t* X1B; PG8_LAS float* rs;
    __device__ __forceinline__ void operator()(const f32x4 (&acc)[2][2][4][2], const Unit& u, int wr, int wc, int fr, int fq) const {
#pragma unroll
        for (int ai = 0; ai < 2; ++ai)
#pragma unroll
            for (int m = 0; m < 4; ++m) { int rl = ai * HALF + wr * 64 + m * 16 + fr; asm volatile("" : "+v"(rl)); const size_t row = (size_t)(u.pm * BM + rl); float ssum = 0.f;
#pragma unroll
                for (int bj = 0; bj < 2; ++bj) { const int c = u.pn * BM + bj * HALF + wc * 32 + 8 * fq;
                    const f32x4 x0 = *(const f32x4*)(R + row * 1024 + c) + acc[ai][bj][m][0], x1 = *(const f32x4*)(R + row * 1024 + c + 4) + acc[ai][bj][m][1];
                    *(u32x4*)(X1B + row * 1024 + c) = pack8(x0, x1, 1.f);
                    ssum += ss8(x0, x1); }
                ssum = quad_sum(ssum); if (fq == 0) rs[rl * 4 + wc] += ssum; }
    }
};
struct EpiOutB {
    static constexpr bool PERM = true, AFTER_DRAIN = false;
    bf16_t* X; PG8_LAS float* rs;
    __device__ __forceinline__ void operator()(const f32x4 (&acc)[2][2][4][2], const Unit& u, int wr, int wc, int fr, int fq) const {
#pragma unroll
        for (int ai = 0; ai < 2; ++ai)
#pragma unroll
            for (int m = 0; m < 4; ++m) { int rl = ai * HALF + wr * 64 + m * 16 + fr; asm volatile("" : "+v"(rl)); const size_t row = (size_t)(u.pm * BM + rl); float ssum = 0.f;
#pragma unroll
                for (int bj = 0; bj < 2; ++bj) { const int c = u.pn * BM + bj * HALF + wc * 32 + 8 * fq; const u32x4 r = *(const u32x4*)(X + row * 1024 + c);
                    f32x4 x0, x1; x0[0] = __uint_as_float(r.x << 16); x0[1] = __uint_as_float(r.x & 0xffff0000u); x0[2] = __uint_as_float(r.y << 16); x0[3] = __uint_as_float(r.y & 0xffff0000u);
                    x1[0] = __uint_as_float(r.z << 16); x1[1] = __uint_as_float(r.z & 0xffff0000u); x1[2] = __uint_as_float(r.w << 16); x1[3] = __uint_as_float(r.w & 0xffff0000u);
                    x0 += acc[ai][bj][m][0]; x1 += acc[ai][bj][m][1];
                    *(u32x4*)(X + row * 1024 + c) = pack8(x0, x1, 1.f);
                    ssum += ss8(x0, x1); }
                ssum = quad_sum(ssum); if (fq == 0) rs[rl * 4 + wc] += ssum; }
    }
};
struct EpiIn1 {
    static constexpr bool PERM = true, AFTER_DRAIN = false;
    bf16_t *PQ, *QMEM, *SG; const float* RSTD;
    __device__ __forceinline__ void operator()(const f32x4 (&acc)[2][2][4][2], const Unit& u, int wr, int wc, int fr, int fq) const {
#pragma unroll
        for (int ai = 0; ai < 2; ++ai)
#pragma unroll
            for (int m = 0; m < 4; ++m) { int rowi = u.pm * BM + ai * HALF + wr * 64 + m * 16 + fr; asm volatile("" : "+v"(rowi)); const size_t row = (size_t)rowi; const float r = RSTD[row];
                const int b = rowi >> 12, sq = rowi & 4095, s1 = sq >> 6, s2 = sq & 63; const size_t prow = ((size_t)(b * 64 + s1) * 2) * 64 + s2;
#pragma unroll
                for (int bj = 0; bj < 2; ++bj) { const int cb = u.pn * BM + bj * HALF + wc * 32, c = cb + 8 * fq; const f32x4 v0 = acc[ai][bj][m][0], v1 = acc[ai][bj][m][1];
                    if (cb < 1536) { const int pq = cb >= 768 ? 1 : 0; *(u32x4*)(PQ + (prow + pq * 64) * 768 + (c - pq * 768)) = pack8(v0, v1, r); }
                    else if (cb < 1792) *(u32x4*)(QMEM + row * 256 + (c - 1536)) = pack8(v0, v1, r * QS_MEM);
                    else *(u32x4*)(SG + row * 1024 + (c - 1792)) = pack8(silu4(v0 * r), silu4(v1 * r), 1.f); } }
    }
};
struct PanelOrder {
    int nM, G, c;
    __device__ void init(int M, int G_, int c_) { nM = M / BM; G = G_; c = c_; }
    __device__ bool next(int i, Unit& u) const { u.pm = c + G * (i >> 2); u.pn = i & 3; return u.pm < nM; }
    __device__ __forceinline__ void a_ready(const Unit&) const {}
    __device__ __forceinline__ void done(const Unit&) const {}
};
template <class Epi, class Sched, bool ALIGN_EPI = false, bool SP2 = false>
__device__ __forceinline__ void gemm_phase(PG8_LAS unsigned char* lds, const Gemm g, const Sched& S, const Epi& E) {
    const int tid = threadIdx.x, wid = __builtin_amdgcn_readfirstlane(tid >> 6), lane = tid & 63, wr = wid >> 2, wc = wid & 3, fr = lane & 15, fq = lane >> 4;
    const int K = g.K, nt = K / BK;
    unsigned voffA[2], voffB[2];
#pragma unroll
    for (int i = 0; i < 2; ++i) { int R, C; stage_rc(tid * 16 + i * 8192, R, C); const int Rb = Epi::PERM ? ((R & ~31) + perm32(R & 31)) : R;
        voffA[i] = (unsigned)(R * K + C) * 2u; voffB[i] = (unsigned)(Rb * K + C) * 2u; }
    const size_t kstep = (size_t)(BK * 2);
    const size_t hstep = (size_t)HALF * K * 2;
    const size_t tstep = 2 * hstep;
    const unsigned ldsw = (unsigned)wid * 1024u;
    const int aoff = lds_byte(wr * 64 + fr, fq * 8), boff = lds_byte(wc * 32 + fr, fq * 8);
#define PG8_SA(b, h) (((b) * 2 + (h)) * HTB)
#define PG8_SB(b, h) ((4 + (b) * 2 + (h)) * HTB)
#define PG8_STAGE(bufoff, gbase, voff) do { _Pragma("unroll") for (int _i = 0; _i < 2; ++_i) \
        __builtin_amdgcn_global_load_lds((const unsigned*)((const char*)(gbase) + (voff)[_i]), (PG8_LAS unsigned*)(lds + (bufoff) + ldsw + _i * 8192), 16, 0, 0); } while (0)
#define PG8_LDA(dst, b, h) do { _Pragma("unroll") for (int m = 0; m < 4; ++m) _Pragma("unroll") for (int k = 0; k < 2; ++k) dst[m][k] = *(const PG8_LAS bf16x8*)(lds + PG8_SA(b, h) + aoff + m * 2048 + k * 1024); } while (0)
#define PG8_LDB(dst, b, h) do { _Pragma("unroll") for (int n = 0; n < 2; ++n) _Pragma("unroll") for (int k = 0; k < 2; ++k) dst[n][k] = *(const PG8_LAS bf16x8*)(lds + PG8_SB(b, h) + boff + n * 2048 + k * 1024); } while (0)
#define PG8_MMA(ai, bj, At, Bt) do { __builtin_amdgcn_s_setprio(1); _Pragma("unroll") for (int m = 0; m < 4; ++m) _Pragma("unroll") for (int n = 0; n < 2; ++n) _Pragma("unroll") for (int k = 0; k < 2; ++k) \
        acc[ai][bj][m][n] = __builtin_amdgcn_mfma_f32_16x16x32_bf16(Bt[n][k], At[m][k], acc[ai][bj][m][n], 0, 0, 0); __builtin_amdgcn_s_setprio(0); } while (0)
#define PG8_WAIT_V(n) asm volatile("s_waitcnt vmcnt(" #n ")" ::: "memory")
#define PG8_WAIT_L(n) asm volatile("s_waitcnt lgkmcnt(" #n ")" ::: "memory")
#define PG8_BAR __builtin_amdgcn_s_barrier()
#define PG8_SCHED __builtin_amdgcn_sched_barrier(0)
    Unit cur, nxt; int ui = 0;
    if (!S.next(0, cur)) return;
    f32x4 acc[2][2][4][2];
#pragma unroll
    for (int a = 0; a < 2; ++a)
#pragma unroll
        for (int b = 0; b < 2; ++b)
#pragma unroll
            for (int m = 0; m < 4; ++m)
#pragma unroll
                for (int n = 0; n < 2; ++n) acc[a][b][m][n] = (f32x4){0.f, 0.f, 0.f, 0.f};
    bf16x8 At[4][2], B0[2][2], B1[2][2];
    const char* cA = (const char*)g.A + (size_t)cur.pm * tstep; const char* cB = (const char*)g.Bt + (size_t)cur.pn * tstep;
    S.a_ready(cur);
    if constexpr (SP2) {
        PG8_STAGE(PG8_SB(0, 0), cB, voffB); PG8_STAGE(PG8_SB(0, 1), cB + hstep, voffB); PG8_STAGE(PG8_SA(0, 0), cA, voffA); PG8_STAGE(PG8_SA(0, 1), cA + hstep, voffA);
        if (wr == 1) PG8_BAR;
        PG8_WAIT_V(2); PG8_BAR;
        PG8_STAGE(PG8_SB(1, 0), cB + kstep, voffB); PG8_STAGE(PG8_SA(1, 0), cA + kstep, voffA); PG8_STAGE(PG8_SB(1, 1), cB + hstep + kstep, voffB);
        PG8_WAIT_V(6); PG8_BAR;
    } else {
        PG8_STAGE(PG8_SB(0, 0), cB, voffB); PG8_STAGE(PG8_SA(0, 0), cA, voffA); PG8_STAGE(PG8_SB(0, 1), cB + hstep, voffB); PG8_STAGE(PG8_SA(0, 1), cA + hstep, voffA);
        if (wr == 1) PG8_BAR;
        PG8_WAIT_V(4); PG8_BAR;
        PG8_STAGE(PG8_SB(1, 0), cB + kstep, voffB); PG8_STAGE(PG8_SA(1, 0), cA + kstep, voffA); PG8_STAGE(PG8_SB(1, 1), cB + hstep + kstep, voffB);
        PG8_WAIT_V(6); PG8_BAR;
    }
    for (;;) {
        const bool has_next = S.next(ui + 1, nxt);
        const char* nA = has_next ? (const char*)g.A + (size_t)nxt.pm * tstep : cA; const char* nB = has_next ? (const char*)g.Bt + (size_t)nxt.pn * tstep : cB;
        for (int t = 0; t < nt; t += 2) {
            const bool last = (t == nt - 2);
            const char* a1 = cA + (size_t)(t + 1) * kstep;
            const char* a2 = last ? nA : cA + (size_t)(t + 2) * kstep; const char* b2 = last ? nB : cB + (size_t)(t + 2) * kstep;
            const char* a3 = a2 + kstep; const char* b3 = b2 + kstep;
            if (last && has_next) S.a_ready(nxt);
            if constexpr (SP2) {
            PG8_LDB(B0, 0, 0); PG8_LDB(B1, 0, 1); PG8_SCHED; PG8_LDA(At, 0, 0); PG8_STAGE(PG8_SA(1, 1), a1 + hstep, voffA);
            PG8_WAIT_V(8); PG8_WAIT_L(0); PG8_BAR; PG8_MMA(0, 0, At, B0); PG8_MMA(0, 1, At, B1); PG8_BAR; PG8_SCHED;
            PG8_LDA(At, 0, 1); PG8_STAGE(PG8_SB(0, 0), b2, voffB); PG8_STAGE(PG8_SB(0, 1), b2 + hstep, voffB); PG8_STAGE(PG8_SA(0, 0), a2, voffA);
            PG8_WAIT_V(8); PG8_WAIT_L(0); PG8_BAR; PG8_MMA(1, 0, At, B0); PG8_MMA(1, 1, At, B1); PG8_BAR; PG8_SCHED;
            PG8_LDB(B0, 1, 0); PG8_LDB(B1, 1, 1); PG8_SCHED; PG8_LDA(At, 1, 0); PG8_STAGE(PG8_SA(0, 1), a2 + hstep, voffA);
            PG8_WAIT_V(8); PG8_WAIT_L(0); PG8_BAR; PG8_MMA(0, 0, At, B0); PG8_MMA(0, 1, At, B1); PG8_BAR; PG8_SCHED;
            PG8_LDA(At, 1, 1); PG8_STAGE(PG8_SB(1, 0), b3, voffB); PG8_STAGE(PG8_SB(1, 1), b3 + hstep, voffB); PG8_STAGE(PG8_SA(1, 0), a3, voffA);
            PG8_WAIT_V(8); PG8_WAIT_L(0); PG8_BAR; PG8_MMA(1, 0, At, B0); PG8_MMA(1, 1, At, B1); PG8_BAR; PG8_SCHED;
            } else {
            PG8_LDB(B0, 0, 0); PG8_SCHED; PG8_LDA(At, 0, 0); PG8_STAGE(PG8_SA(1, 1), a1 + hstep, voffA);
            PG8_WAIT_L(8); PG8_BAR; PG8_WAIT_L(0); PG8_MMA(0, 0, At, B0); PG8_BAR; PG8_SCHED;
            PG8_LDB(B1, 0, 1); PG8_STAGE(PG8_SB(0, 0), b2, voffB);
            PG8_BAR; PG8_WAIT_L(0); PG8_MMA(0, 1, At, B1); PG8_BAR;
            PG8_LDA(At, 0, 1); PG8_STAGE(PG8_SA(0, 0), a2, voffA);
            PG8_BAR; PG8_WAIT_L(0); PG8_MMA(1, 0, At, B0); PG8_BAR; PG8_SCHED;
            PG8_STAGE(PG8_SB(0, 1), b2 + hstep, voffB);
            PG8_WAIT_V(6); PG8_BAR; PG8_MMA(1, 1, At, B1); PG8_BAR;
            PG8_LDB(B0, 1, 0); PG8_SCHED; PG8_LDA(At, 1, 0); PG8_STAGE(PG8_SA(0, 1), a2 + hstep, voffA);
            PG8_WAIT_L(8); PG8_BAR; PG8_WAIT_L(0); PG8_MMA(0, 0, At, B0); PG8_BAR; PG8_SCHED;
            PG8_LDB(B1, 1, 1); PG8_STAGE(PG8_SB(1, 0), b3, voffB);
            PG8_BAR; PG8_WAIT_L(0); PG8_MMA(0, 1, At, B1); PG8_BAR;
            PG8_LDA(At, 1, 1); PG8_STAGE(PG8_SA(1, 0), a3, voffA);
            PG8_BAR; PG8_WAIT_L(0); PG8_MMA(1, 0, At, B0); PG8_BAR; PG8_SCHED;
            PG8_STAGE(PG8_SB(1, 1), b3 + hstep, voffB);
            PG8_WAIT_V(6); PG8_BAR; PG8_MMA(1, 1, At, B1); PG8_BAR;
            }
        }
        if constexpr (ALIGN_EPI) { if (wr == 0) PG8_BAR; }
        if constexpr (!Epi::AFTER_DRAIN) { E(acc, cur, wr, wc, fr, fq); S.done(cur); }
        if (!has_next) break;
#pragma unroll
        for (int a = 0; a < 2; ++a)
#pragma unroll
            for (int b = 0; b < 2; ++b)
#pragma unroll
                for (int m = 0; m < 4; ++m)
#pragma unroll
                    for (int n = 0; n < 2; ++n) acc[a][b][m][n] = (f32x4){0.f, 0.f, 0.f, 0.f};
        cur = nxt; cA = nA; cB = nB; ++ui;
        if constexpr (ALIGN_EPI) { if (wr == 1) PG8_BAR; }
    }
    PG8_WAIT_V(0);
    if constexpr (!ALIGN_EPI) { if (wr == 0) PG8_BAR; }
    PG8_BAR;
    if constexpr (Epi::AFTER_DRAIN) { E.fused(acc, cur, wr, wc, fr, fq, lds, wid, lane); S.done(cur); }
#undef PG8_SA
#undef PG8_SB
#undef PG8_STAGE
#undef PG8_LDA
#undef PG8_LDB
#undef PG8_MMA
#undef PG8_WAIT_V
#undef PG8_WAIT_L
#undef PG8_BAR
#undef PG8_SCHED
}
}
#define GAS __attribute__((address_space(1)))
#define LAS __attribute__((address_space(3)))
typedef unsigned short bf16;
typedef unsigned v4u __attribute__((ext_vector_type(4)));
typedef float f32x4 __attribute__((ext_vector_type(4)));
typedef short bf16x8 __attribute__((ext_vector_type(8)));
typedef GAS unsigned gu32;
typedef GAS unsigned long long gu64;
#define RLX_AGENT __ATOMIC_RELAXED, __HIP_MEMORY_SCOPE_AGENT
#define LDS_WAIT() asm volatile("s_waitcnt lgkmcnt(0)" ::: "memory")
#define VM_WAIT() asm volatile("s_waitcnt vmcnt(0)" ::: "memory")
__device__ __forceinline__ unsigned long long rt() { return __builtin_amdgcn_s_memrealtime(); }
#define XB_TMO      128
#define XB_XCNT(j)  (256  + 64 * (j))
#define XB_XSUB(j)  (1280 + 64 * (j))
#define XB_XGEN(j)  (2304 + 64 * (j))
#define XB_TOP      3328
#define XB_TOPGEN   3392
#define XCD_BAR_WORDS 3456
#define XB_SPIN_CAP (1u << 18)

__device__ __forceinline__ unsigned xb_ld(unsigned* p)              { return __hip_atomic_load(p, __ATOMIC_RELAXED, __HIP_MEMORY_SCOPE_AGENT); }
__device__ __forceinline__ unsigned xb_add(unsigned* p, unsigned v) { return __hip_atomic_fetch_add(p, v, __ATOMIC_RELAXED, __HIP_MEMORY_SCOPE_AGENT); }
__device__ __forceinline__ unsigned xb_xcc_id() { return (unsigned)__builtin_amdgcn_s_getreg((3 << 11) | 20) & 0xFu; }
#define XB_SPIN(cond, bar) do { unsigned _sp = 0; while (cond) { __builtin_amdgcn_s_sleep(1); \
    if ((++_sp & 255u) == 0u) { if (xb_ld(&(bar)[XB_TMO])) break; if (_sp > XB_SPIN_CAP) { atomicAdd(&(bar)[XB_TMO], 1u); break; } } } } while (0)

struct XcdBarrier {
    unsigned* bar; unsigned x;
    volatile LAS unsigned* st;
};

__device__ __forceinline__ XcdBarrier xcd_barrier_post(unsigned* bar, volatile LAS unsigned* st) {
    XcdBarrier b; b.bar = bar; b.x = xb_xcc_id(); b.st = st;
    if (threadIdx.x == 0) (void)xb_add(&bar[XB_XCNT(b.x)], 1u);
    return b;
}
__device__ __forceinline__ void xcd_barrier_complete(unsigned* bar, unsigned x, unsigned& nloc, unsigned& nx) {
    const unsigned G = gridDim.x * gridDim.y * gridDim.z;
    unsigned sum, cnt, mine, sp = 0u;
    for (;;) {
        sum = 0u; cnt = 0u; mine = 0u;
#pragma unroll
        for (unsigned j = 0; j < 16; ++j) { const unsigned c = xb_ld(&bar[XB_XCNT(j)]); sum += c; cnt += (c > 0u) ? 1u : 0u; mine = (j == x) ? c : mine; }
        if (sum == G) break;
        __builtin_amdgcn_s_sleep(1);
        if ((++sp & 255u) == 0u) { if (xb_ld(&bar[XB_TMO])) break; if (sp > XB_SPIN_CAP) { atomicAdd(&bar[XB_TMO], 1u); break; } }
    }
    nloc = mine > 0u ? mine : 1u; nx = cnt > 0u ? cnt : 1u;
}

__device__ __forceinline__ void xcd_barrier(const XcdBarrier& b) {
    asm volatile("s_waitcnt vmcnt(0)" ::: "memory");
    __syncthreads();
    if (threadIdx.x == 0) {
        unsigned* bar = b.bar;
        __builtin_amdgcn_s_waitcnt(0);
        unsigned nloc = b.st[0], nx = b.st[1];
        if (nloc == 0u) { xcd_barrier_complete(bar, b.x, nloc, nx); b.st[0] = nloc; b.st[1] = nx; }
        const unsigned old = xb_add(&bar[XB_XSUB(b.x)], 1u);
        const unsigned gen = old / nloc;
        if (old + 1u == (gen + 1u) * nloc) {
            __builtin_amdgcn_fence(__ATOMIC_RELEASE, "agent");
            asm volatile("s_waitcnt vmcnt(0)" ::: "memory");
            const unsigned og = xb_add(&bar[XB_TOP], 1u);
            const unsigned tg = og / nx;
            if (og + 1u == (tg + 1u) * nx) xb_add(&bar[XB_TOPGEN], 1u);
            else XB_SPIN(xb_ld(&bar[XB_TOPGEN]) == tg, bar);
            __builtin_amdgcn_fence(__ATOMIC_ACQUIRE, "agent");
            xb_add(&bar[XB_XGEN(b.x)], 1u);
            asm volatile("s_waitcnt vmcnt(0)" ::: "memory");
        } else {
            XB_SPIN(xb_ld(&bar[XB_XGEN(b.x)]) == gen, bar);
            __builtin_amdgcn_fence(__ATOMIC_ACQUIRE, "agent");
            asm volatile("s_waitcnt vmcnt(0)" ::: "memory");
        }
    }
    __syncthreads();
}
namespace att {
using bf16x8 = __attribute__((ext_vector_type(8))) short;
using s16x4  = __attribute__((ext_vector_type(4))) short;
using f32x16 = __attribute__((ext_vector_type(16))) float;
using f32x4v = __attribute__((ext_vector_type(4))) float;
using u32x4  = __attribute__((ext_vector_type(4))) unsigned;
constexpr int NW = 8, QBLK = 32, KVBLK = 64;
constexpr float THRL = 6.f;
#define ASBAR() __builtin_amdgcn_sched_barrier(0)
__device__ __forceinline__ int crow(int r, int hi) { return (r & 3) + 8 * (r >> 2) + 4 * hi; }
__device__ __forceinline__ unsigned cvtpk(float lo, float hi) { unsigned r; asm volatile("v_cvt_pk_bf16_f32 %0, %1, %2" : "=v"(r) : "v"(lo), "v"(hi)); return r; }
template <int DQK> struct Cfg {
    static constexpr int KROW = DQK * 2 + 16;
    static constexpr int SHM_V = 8192, SHM_K = 64 * KROW;
    static constexpr int OFF_V = 0, OFF_K = 2 * SHM_V, OFF_WS = OFF_K + 2 * SHM_K, OFF_OST = OFF_WS + NW * 256, OSTW = 32 * 68 * 4, END = OFF_OST + NW * OSTW;
    static constexpr int KCH = DQK / 8;
};
__device__ __forceinline__ void partialSM(f32x16& p0, f32x16& p1, float& m_reg, float& mn, float& alpha) {
    float pmax = p0[0];
#pragma unroll
    for (int r = 1; r < 16; ++r) pmax = fmaxf(pmax, p0[r]);
#pragma unroll
    for (int r = 0; r < 16; ++r) pmax = fmaxf(pmax, p1[r]);
    { auto rr = __builtin_amdgcn_permlane32_swap(__float_as_uint(pmax), __float_as_uint(pmax), false, false); pmax = fmaxf(__uint_as_float(rr[0]), __uint_as_float(rr[1])); }
    if (__builtin_expect(__all(pmax - m_reg <= THRL), 1)) { mn = m_reg; alpha = 1.f; }
    else { mn = fmaxf(m_reg, pmax); alpha = __builtin_amdgcn_exp2f(m_reg - mn); m_reg = mn; }
#pragma unroll
    for (int r = 0; r < 16; ++r) p0[r] -= mn;
#pragma unroll
    for (int r = 0; r < 16; ++r) p1[r] -= mn;
#pragma unroll
    for (int r = 0; r < 16; ++r) p0[r] = __builtin_amdgcn_exp2f(p0[r]);
}
__device__ __forceinline__ void finishSM(f32x16& p0, f32x16& p1, float alpha, float& l_reg, bf16x8& pa0, bf16x8& pa1, bf16x8& pa2, bf16x8& pa3) {
#pragma unroll
    for (int r = 0; r < 16; ++r) p1[r] = __builtin_amdgcn_exp2f(p1[r]);
    float ps = 0;
#pragma unroll
    for (int r = 0; r < 16; ++r) ps += p0[r];
#pragma unroll
    for (int r = 0; r < 16; ++r) ps += p1[r];
    { auto rr = __builtin_amdgcn_permlane32_swap(__float_as_uint(ps), __float_as_uint(ps), false, false); ps = __uint_as_float(rr[0]) + __uint_as_float(rr[1]); }
    l_reg = l_reg * alpha + ps;
#define ATT_PK4(P, BASE, OUT) do { unsigned a0 = cvtpk(P[BASE + 0], P[BASE + 1]), a1 = cvtpk(P[BASE + 2], P[BASE + 3]);   \
    unsigned b0 = cvtpk(P[BASE + 4], P[BASE + 5]), b1 = cvtpk(P[BASE + 6], P[BASE + 7]);                              \
    auto r0 = __builtin_amdgcn_permlane32_swap(a0, b0, false, false); auto r1 = __builtin_amdgcn_permlane32_swap(a1, b1, false, false); \
    u32x4 w = {r0[0], r1[0], r0[1], r1[1]}; OUT = *reinterpret_cast<bf16x8*>(&w); } while (0)
    ATT_PK4(p0, 0, pa0); ATT_PK4(p0, 8, pa1); ATT_PK4(p1, 0, pa2); ATT_PK4(p1, 8, pa3);
#undef ATT_PK4
}
template <int DQK> __device__ __forceinline__ void qkt(f32x16& p0, f32x16& p1, const char* Ks, const bf16x8* qr, int r32, int hi) {
    constexpr int KROW = Cfg<DQK>::KROW;
    p0 = f32x16{}; p1 = f32x16{};
#pragma unroll
    for (int d0 = 0; d0 < DQK / 16; ++d0) { const int cb = (d0 * 16 + hi * 8) * 2;
        const bf16x8 b0 = *reinterpret_cast<const bf16x8*>(Ks + r32 * KROW + cb);
        const bf16x8 b1 = *reinterpret_cast<const bf16x8*>(Ks + (32 + r32) * KROW + cb);
        p0 = __builtin_amdgcn_mfma_f32_32x32x16_bf16(b0, qr[d0], p0, 0, 0, 0);
        p1 = __builtin_amdgcn_mfma_f32_32x32x16_bf16(b1, qr[d0], p1, 0, 0, 0); }
}
__device__ __forceinline__ int v_st(int k, int c) { const int kk = (k & ~0xC) | ((k & 4) << 1) | ((k & 8) >> 1); return ((kk >> 3) * 2 + (c >> 5)) * 512 + ((kk & 7) * 32 + (c & 31)) * 2; }
__device__ __forceinline__ int v_rd_base(int lane) { return ((lane & 3) << 3) | (((lane >> 2) & 3) << 6) | (((lane >> 4) & 1) << 5) | (((lane >> 5) & 1) << 8); }
constexpr int v_rd_off(int d0, int ks, int half) { return d0 * 512 + ks * 2048 + half * 1024; }
template <int OFF> __device__ __forceinline__ s16x4 tr_read(int vb) { s16x4 r; asm volatile("ds_read_b64_tr_b16 %0, %1 offset:%2" : "=&v"(r) : "v"(vb), "i"(OFF) : "memory"); return r; }
template <int D0> __device__ __forceinline__ void pv_one(f32x16& od, int vb, bf16x8 pa0, bf16x8 pa1, bf16x8 pa2, bf16x8 pa3) {
    const s16x4 l0 = tr_read<v_rd_off(D0, 0, 0)>(vb), h0 = tr_read<v_rd_off(D0, 0, 1)>(vb), l1 = tr_read<v_rd_off(D0, 1, 0)>(vb), h1 = tr_read<v_rd_off(D0, 1, 1)>(vb);
    const s16x4 l2 = tr_read<v_rd_off(D0, 2, 0)>(vb), h2 = tr_read<v_rd_off(D0, 2, 1)>(vb), l3 = tr_read<v_rd_off(D0, 3, 0)>(vb), h3 = tr_read<v_rd_off(D0, 3, 1)>(vb);
    asm volatile("s_waitcnt lgkmcnt(0)" ::: "memory"); ASBAR();
#define ATT_PK(L, H) (bf16x8){L[0], L[1], L[2], L[3], H[0], H[1], H[2], H[3]}
    od = __builtin_amdgcn_mfma_f32_32x32x16_bf16(pa0, ATT_PK(l0, h0), od, 0, 0, 0);
    od = __builtin_amdgcn_mfma_f32_32x32x16_bf16(pa1, ATT_PK(l1, h1), od, 0, 0, 0);
    od = __builtin_amdgcn_mfma_f32_32x32x16_bf16(pa2, ATT_PK(l2, h2), od, 0, 0, 0);
    od = __builtin_amdgcn_mfma_f32_32x32x16_bf16(pa3, ATT_PK(l3, h3), od, 0, 0, 0);
#undef ATT_PK
}
__device__ __forceinline__ void pv_d0(f32x16* o, int vb, bf16x8 pa0, bf16x8 pa1, bf16x8 pa2, bf16x8 pa3) { pv_one<0>(o[0], vb, pa0, pa1, pa2, pa3); pv_one<1>(o[1], vb, pa0, pa1, pa2, pa3); }

__device__ __forceinline__ float rowmax32(const f32x16& p0, const f32x16& p1) {
#define ATT_MX3(a, b, c) __builtin_fmaxf(__builtin_fmaxf((a), (b)), (c))
    float a = ATT_MX3(p0[0], p0[1], p1[0]), b = ATT_MX3(p0[2], p0[3], p1[1]); a = ATT_MX3(a, p1[2], p1[3]);
#pragma unroll
    for (int r = 4; r < 16; r += 4) { a = ATT_MX3(a, p0[r], p0[r + 1]); b = ATT_MX3(b, p0[r + 2], p0[r + 3]); a = ATT_MX3(a, p1[r], p1[r + 1]); b = ATT_MX3(b, p1[r + 2], p1[r + 3]); }
#undef ATT_MX3
    float m = __builtin_fmaxf(a, b);
    auto rr = __builtin_amdgcn_permlane32_swap(__float_as_uint(m), __float_as_uint(m), false, false);
    return __builtin_fmaxf(__uint_as_float(rr[0]), __uint_as_float(rr[1]));
}
#ifndef ATT_NEGM
#define ATT_NEGM 1
#endif
template <bool FIRST> __device__ __forceinline__ void partialSM2(f32x16& p0, f32x16& p1, float& mhat, f32x16& negm, float& alpha) {
#if !ATT_NEGM
    float pmax = rowmax32(p0, p1) - mhat; alpha = 1.f;
    if (FIRST || __builtin_expect(__any(pmax > THRL), 0)) { const float dl = FIRST ? pmax : __builtin_fmaxf(pmax, 0.f); mhat += dl; if (!FIRST) alpha = __builtin_amdgcn_exp2f(-dl); }
    _Pragma("unroll") for (int r = 0; r < 16; ++r) { p0[r] -= mhat; p1[r] -= mhat; }
    _Pragma("unroll") for (int r = 0; r < 16; ++r) p0[r] = __builtin_amdgcn_exp2f(p0[r]);
    return;
#else
    const float pmax = rowmax32(p0, p1);
    alpha = 1.f;
    if (FIRST || __builtin_expect(__any(pmax > THRL), 0)) { const float dl = FIRST ? pmax : __builtin_fmaxf(pmax, 0.f); mhat += dl;
#pragma unroll
        for (int r = 0; r < 16; ++r) { p0[r] -= dl; p1[r] -= dl; }
#pragma unroll
        for (int r = 0; r < 16; ++r) negm[r] = -mhat;
        if (!FIRST) alpha = __builtin_amdgcn_exp2f(-dl); }
#pragma unroll
    for (int r = 0; r < 16; ++r) p0[r] = __builtin_amdgcn_exp2f(p0[r]);
#endif
}
template <int DQK> __device__ __forceinline__ void qkt2(f32x16& p0, f32x16& p1, const char* Ks, const bf16x8* qr, const f32x16& negm, int r32, int hi) {
    constexpr int KROW = Cfg<DQK>::KROW;
#pragma unroll
    for (int d0 = 0; d0 < DQK / 16; ++d0) { const int cb = (d0 * 16 + hi * 8) * 2;
        const bf16x8 b0 = *reinterpret_cast<const bf16x8*>(Ks + r32 * KROW + cb);
        const bf16x8 b1 = *reinterpret_cast<const bf16x8*>(Ks + (32 + r32) * KROW + cb);
#if ATT_NEGM
        if (d0 == 0) { p0 = __builtin_amdgcn_mfma_f32_32x32x16_bf16(b0, qr[0], negm, 0, 0, 0); p1 = __builtin_amdgcn_mfma_f32_32x32x16_bf16(b1, qr[0], negm, 0, 0, 0); }
#else
        if (d0 == 0) { p0 = __builtin_amdgcn_mfma_f32_32x32x16_bf16(b0, qr[0], f32x16{}, 0, 0, 0); p1 = __builtin_amdgcn_mfma_f32_32x32x16_bf16(b1, qr[0], f32x16{}, 0, 0, 0); }
#endif
        else { p0 = __builtin_amdgcn_mfma_f32_32x32x16_bf16(b0, qr[d0], p0, 0, 0, 0); p1 = __builtin_amdgcn_mfma_f32_32x32x16_bf16(b1, qr[d0], p1, 0, 0, 0); } }
}
template <int DQK> struct Cfg2 {
    static constexpr int KROW = DQK * 2 + 16, SHM_V = 8192, SHM_K = 64 * KROW;
    static constexpr int OFF_V = 0, OFF_K = 3 * SHM_V, OFF_WS = OFF_K + 2 * SHM_K, OFF_OST = OFF_WS + NW * 256, OSTW = 32 * 68 * 4, END = OFF_OST + NW * OSTW;
};
__device__ __forceinline__ float softmax_tile(f32x16& p0, f32x16& p1, float& mhat, f32x16& negm, float& l_reg, bool first, bf16x8& pa0, bf16x8& pa1, bf16x8& pa2, bf16x8& pa3) {
    const float pmax = rowmax32(p0, p1);
    float alpha = 1.f;
    if (__builtin_expect(first || __any(pmax > THRL), 0)) { const float dl = first ? pmax : __builtin_fmaxf(pmax, 0.f); mhat += dl;
#pragma unroll
        for (int r = 0; r < 16; ++r) { p0[r] -= dl; p1[r] -= dl; }
#pragma unroll
        for (int r = 0; r < 16; ++r) negm[r] = -mhat;
        if (!first) alpha = __builtin_amdgcn_exp2f(-dl); }
#pragma unroll
    for (int r = 0; r < 16; ++r) { p0[r] = __builtin_amdgcn_exp2f(p0[r]); p1[r] = __builtin_amdgcn_exp2f(p1[r]); }
    float ps = 0;
#pragma unroll
    for (int r = 0; r < 16; ++r) ps += p0[r];
#pragma unroll
    for (int r = 0; r < 16; ++r) ps += p1[r];
    { auto rr = __builtin_amdgcn_permlane32_swap(__float_as_uint(ps), __float_as_uint(ps), false, false); ps = __uint_as_float(rr[0]) + __uint_as_float(rr[1]); }
    l_reg = l_reg * alpha + ps;
#define ATT_PK4(P, BASE, OUT) do { unsigned a0 = cvtpk(P[BASE + 0], P[BASE + 1]), a1 = cvtpk(P[BASE + 2], P[BASE + 3]);   \
    unsigned b0 = cvtpk(P[BASE + 4], P[BASE + 5]), b1 = cvtpk(P[BASE + 6], P[BASE + 7]);                              \
    auto r0 = __builtin_amdgcn_permlane32_swap(a0, b0, false, false); auto r1 = __builtin_amdgcn_permlane32_swap(a1, b1, false, false); \
    u32x4 w = {r0[0], r1[0], r0[1], r1[1]}; OUT = *reinterpret_cast<bf16x8*>(&w); } while (0)
    ATT_PK4(p0, 0, pa0); ATT_PK4(p0, 8, pa1); ATT_PK4(p1, 0, pa2); ATT_PK4(p1, 8, pa3);
#undef ATT_PK4
    return alpha;
}
template <int DQK>
__device__ __forceinline__ void attn_unit(const bf16_t* __restrict__ Qb, int ldq, const bf16_t* __restrict__ Kh, int ldk, const bf16_t* __restrict__ Vh, int ldv, int seq,
                                          bf16_t* __restrict__ Ob, const bf16_t* __restrict__ Gb, char* lds) {
    using C = Cfg2<DQK>;
    constexpr int KROW = C::KROW, KCH = DQK / 8, SHM_V = C::SHM_V, SHM_K = C::SHM_K;
    const int tid = threadIdx.x, wid = __builtin_amdgcn_readfirstlane(tid >> 6), lane = tid & 63, r32 = lane & 31, hi = lane >> 5; const bool h1 = wid >= 4;
    char* V_lds = lds + C::OFF_V; char* K_lds = lds + C::OFF_K;
    float* ws = (float*)(lds + C::OFF_WS) + wid * 64; float* li_l = ws; float* al_l = ws + 32;
    float mhat = 0.f, l_reg = 0.f; f32x16 o[2] = {}; f32x16 negm = {}; bf16x8 qr[DQK / 16];
    const bf16_t* Qw = Qb + (size_t)(wid * QBLK + r32) * ldq + hi * 8;
#pragma unroll
    for (int d0 = 0; d0 < DQK / 16; ++d0) qr[d0] = *reinterpret_cast<const bf16x8*>(Qw + d0 * 16);
    const int vk = tid >> 3, vc = (tid & 7) * 8, vst = v_st(vk, vc);
    const int kr0 = tid / KCH, kc0 = (tid % KCH) * 8, kr1 = (512 + tid) / KCH, kc1 = ((512 + tid) % KCH) * 8;
    const bool two = (KCH * 64 > 512) && (tid < KCH * 64 - 512);
    const int vb0 = (int)(uintptr_t)V_lds + v_rd_base(lane);
    bf16x8 s_vs, s_k0, s_k1;
#define ATT_SLOAD(k0) do { s_vs = *reinterpret_cast<const bf16x8*>(Vh + (size_t)((k0) + vk) * ldv + vc); \
    s_k0 = *reinterpret_cast<const bf16x8*>(Kh + (size_t)((k0) + kr0) * ldk + kc0); \
    if (two) s_k1 = *reinterpret_cast<const bf16x8*>(Kh + (size_t)((k0) + kr1) * ldk + kc1); } while (0)
#define ATT_SWRITE(kb, vs) do { *(bf16x8*)(V_lds + (vs) + vst) = s_vs; *(bf16x8*)(K_lds + (kb) * SHM_K + kr0 * KROW + kc0 * 2) = s_k0; \
    if (two) *(bf16x8*)(K_lds + (kb) * SHM_K + kr1 * KROW + kc1 * 2) = s_k1; } while (0)
#define ATT_RESC(a) do { if (__any((a) < 1.f)) { if (hi == 0) al_l[r32] = (a); asm volatile("s_waitcnt lgkmcnt(0)" ::: "memory"); \
    _Pragma("unroll") for (int d = 0; d < 2; ++d) _Pragma("unroll") for (int r = 0; r < 16; ++r) o[d][r] *= al_l[crow(r, hi)]; } } while (0)
    f32x16 p0, p1; bf16x8 pa0, pa1, pa2, pa3; const int NT = seq / KVBLK;
    int vsr = 0, vsw = 2 * SHM_V;
#define ATT_ROT() do { vsr = (vsr == 2 * SHM_V) ? 0 : vsr + SHM_V; vsw = (vsw == 2 * SHM_V) ? 0 : vsw + SHM_V; } while (0)
    ATT_SLOAD(0); ATT_SWRITE(0, 0); __syncthreads(); ATT_SLOAD(KVBLK);
    ASBAR(); qkt2<DQK>(p0, p1, K_lds, qr, negm, r32, hi);
    if (!h1) { (void)softmax_tile(p0, p1, mhat, negm, l_reg, true, pa0, pa1, pa2, pa3); }
    ATT_SWRITE(1, SHM_V); __syncthreads(); if (2 < NT) ATT_SLOAD(2 * KVBLK);
    for (int t = 0; t < NT; ++t) {
        if (h1) { const float al = softmax_tile(p0, p1, mhat, negm, l_reg, t == 0, pa0, pa1, pa2, pa3); ATT_RESC(al); }
        ASBAR(); pv_d0(o, vb0 + vsr, pa0, pa1, pa2, pa3);
        if (t + 1 < NT) {
            ASBAR(); qkt2<DQK>(p0, p1, K_lds + ((t + 1) & 1) * SHM_K, qr, negm, r32, hi);
            if (!h1) { const float al = softmax_tile(p0, p1, mhat, negm, l_reg, false, pa0, pa1, pa2, pa3); ATT_RESC(al); }
            if (t + 2 < NT) ATT_SWRITE(t & 1, vsw);
            __syncthreads();
            if (t + 3 < NT) ATT_SLOAD((t + 3) * KVBLK);
            ATT_ROT();
        }
    }
    if (hi == 0) li_l[r32] = l_reg; asm volatile("s_waitcnt lgkmcnt(0)" ::: "memory");
    float* stg = (float*)(lds + C::OFF_OST + wid * C::OSTW);
#pragma unroll
    for (int r = 0; r < 16; ++r) { const int orow = crow(r, hi); const float rli = __builtin_amdgcn_rcpf(li_l[orow]);
        stg[orow * 68 + r32] = o[0][r] * rli; stg[orow * 68 + 32 + r32] = o[1][r] * rli; }
    asm volatile("s_waitcnt lgkmcnt(0)" ::: "memory");
#pragma unroll
    for (int i = 0; i < 4; ++i) { const int row = i * 8 + (lane >> 3), ch = (lane & 7) * 8;
        const f32x4v a = *(const f32x4v*)(stg + row * 68 + ch), b = *(const f32x4v*)(stg + row * 68 + ch + 4);
        const size_t off = (size_t)(wid * QBLK + row) * 1024 + ch; const u32x4 g = *(const u32x4*)(Gb + off); u32x4 w;
        w.x = cvtpk(a[0] * __uint_as_float(g.x << 16), a[1] * __uint_as_float(g.x & 0xffff0000u)); w.y = cvtpk(a[2] * __uint_as_float(g.y << 16), a[3] * __uint_as_float(g.y & 0xffff0000u));
        w.z = cvtpk(b[0] * __uint_as_float(g.z << 16), b[1] * __uint_as_float(g.z & 0xffff0000u)); w.w = cvtpk(b[2] * __uint_as_float(g.w << 16), b[3] * __uint_as_float(g.w & 0xffff0000u));
        *(u32x4*)(Ob + off) = w; }
    __syncthreads();
#undef ATT_SLOAD
#undef ATT_SWRITE
#undef ATT_RESC
#undef ATT_ROT
}
#undef ASBAR
}
namespace fft {
using bf16x8 = __attribute__((ext_vector_type(8))) short;
using s16x4  = __attribute__((ext_vector_type(4))) short;
using f32x16 = __attribute__((ext_vector_type(16))) float;
using f32x4v = __attribute__((ext_vector_type(4))) float;
using u32x4  = __attribute__((ext_vector_type(4))) unsigned;
constexpr int OFF_X = 0, OFF_STG = 65536;
__device__ __forceinline__ int crow(int r, int hi) { return (r & 3) + 8 * (r >> 2) + 4 * hi; }
__device__ __forceinline__ unsigned cvtpk(float lo, float hi) { unsigned r; asm volatile("v_cvt_pk_bf16_f32 %0, %1, %2" : "=v"(r) : "v"(lo), "v"(hi)); return r; }
__device__ __forceinline__ int x_st(int kk, int c) { const int kp = (kk & ~0xC) | ((kk & 4) << 1) | ((kk & 8) >> 1); return ((kp >> 3) * 8 + (c >> 5)) * 512 + ((kp & 7) * 32 + (c & 31)) * 2; }
__device__ __forceinline__ int x_rd_base(int lane) { return ((lane & 3) << 3) | (((lane >> 2) & 3) << 6) | (((lane >> 4) & 1) << 5) | (((lane >> 5) & 1) << 8); }
constexpr int x_rd_off(int nb, int ks, int half) { return ks * 8192 + half * 4096 + nb * 512; }
template <int OFF> __device__ __forceinline__ s16x4 tr_read(int vb) { s16x4 r; asm volatile("ds_read_b64_tr_b16 %0, %1 offset:%2" : "=&v"(r) : "v"(vb), "i"(OFF) : "memory"); return r; }
template <int NB> __device__ __forceinline__ void mm_block(f32x16& acc, const bf16x8 (&afr)[8], int vb) {
#define FFT_PK(L, H) (bf16x8){L[0], L[1], L[2], L[3], H[0], H[1], H[2], H[3]}
    { const s16x4 l0 = tr_read<x_rd_off(NB, 0, 0)>(vb), h0 = tr_read<x_rd_off(NB, 0, 1)>(vb), l1 = tr_read<x_rd_off(NB, 1, 0)>(vb), h1 = tr_read<x_rd_off(NB, 1, 1)>(vb);
      const s16x4 l2 = tr_read<x_rd_off(NB, 2, 0)>(vb), h2 = tr_read<x_rd_off(NB, 2, 1)>(vb), l3 = tr_read<x_rd_off(NB, 3, 0)>(vb), h3 = tr_read<x_rd_off(NB, 3, 1)>(vb);
      asm volatile("s_waitcnt lgkmcnt(0)" ::: "memory"); __builtin_amdgcn_sched_barrier(0);
      acc = __builtin_amdgcn_mfma_f32_32x32x16_bf16(afr[0], FFT_PK(l0, h0), acc, 0, 0, 0); acc = __builtin_amdgcn_mfma_f32_32x32x16_bf16(afr[1], FFT_PK(l1, h1), acc, 0, 0, 0);
      acc = __builtin_amdgcn_mfma_f32_32x32x16_bf16(afr[2], FFT_PK(l2, h2), acc, 0, 0, 0); acc = __builtin_amdgcn_mfma_f32_32x32x16_bf16(afr[3], FFT_PK(l3, h3), acc, 0, 0, 0); }
    { const s16x4 l0 = tr_read<x_rd_off(NB, 4, 0)>(vb), h0 = tr_read<x_rd_off(NB, 4, 1)>(vb), l1 = tr_read<x_rd_off(NB, 5, 0)>(vb), h1 = tr_read<x_rd_off(NB, 5, 1)>(vb);
      const s16x4 l2 = tr_read<x_rd_off(NB, 6, 0)>(vb), h2 = tr_read<x_rd_off(NB, 6, 1)>(vb), l3 = tr_read<x_rd_off(NB, 7, 0)>(vb), h3 = tr_read<x_rd_off(NB, 7, 1)>(vb);
      asm volatile("s_waitcnt lgkmcnt(0)" ::: "memory"); __builtin_amdgcn_sched_barrier(0);
      acc = __builtin_amdgcn_mfma_f32_32x32x16_bf16(afr[4], FFT_PK(l0, h0), acc, 0, 0, 0); acc = __builtin_amdgcn_mfma_f32_32x32x16_bf16(afr[5], FFT_PK(l1, h1), acc, 0, 0, 0);
      acc = __builtin_amdgcn_mfma_f32_32x32x16_bf16(afr[6], FFT_PK(l2, h2), acc, 0, 0, 0); acc = __builtin_amdgcn_mfma_f32_32x32x16_bf16(afr[7], FFT_PK(l3, h3), acc, 0, 0, 0); }
#undef FFT_PK
}
struct TileRegs { bf16x8 v[8]; };
__device__ __forceinline__ void tile_load(TileRegs& t, const bf16_t* src  , size_t rowstride, int tid) {
    const bf16_t* p = src + (size_t)(tid >> 5) * rowstride + (tid & 31) * 8;
#pragma unroll
    for (int i = 0; i < 8; ++i) t.v[i] = *reinterpret_cast<const bf16x8*>(p + (size_t)(16 * i) * rowstride);
}
__device__ __forceinline__ void tile_write(const TileRegs& t, char* xl, int tid) {
    char* p = xl + x_st(tid >> 5, (tid & 31) * 8);
#pragma unroll
    for (int i = 0; i < 8; ++i) *reinterpret_cast<bf16x8*>(p + 8192 * i) = t.v[i];
}

__device__ __forceinline__ void stage_a(const bf16_t* __restrict__ PQ, bf16_t* __restrict__ Y, char* lds, int vcu, int G) {
    const int tid = threadIdx.x, wid = tid >> 6, lane = tid & 63, r32 = lane & 31, hi = lane >> 5, w = wid & 3, nh = wid >> 2;
    char* xl = lds + OFF_X; char* stg = lds + OFF_STG + wid * 8192;
    bf16x8 afr[8];
    { const int reim = r32 >> 4, k1 = 16 * w + (r32 & 15);
#pragma unroll
      for (int ks = 0; ks < 8; ++ks) { float v[8];
#pragma unroll
          for (int j = 0; j < 8; ++j) { const int kk = 16 * ks + 8 * hi + j, s1 = kk >> 1, pq = kk & 1; const float f = (float)((k1 * s1) & 63) * (1.f / 64.f);
              const float c = __builtin_amdgcn_cosf(f) * 0.125f, s = __builtin_amdgcn_sinf(f) * 0.125f; v[j] = reim == 0 ? (pq == 0 ? c : -s) : (pq == 0 ? s : c); }
          u32x4 p = {cvtpk(v[0], v[1]), cvtpk(v[2], v[3]), cvtpk(v[4], v[5]), cvtpk(v[6], v[7])}; afr[ks] = *reinterpret_cast<bf16x8*>(&p); } }
    const int vb = (int)(uintptr_t)xl + x_rd_base(lane) + nh * 4 * 512;
    constexpr int NU = NB * 192;
    TileRegs tr;
    int u = vcu;
    if (u < NU) tile_load(tr, PQ + (size_t)(u / 192) * 128 * 49152 + (u % 192) * 256, 49152, tid);
    for (; u < NU; u += G) {
        const int b = u / 192, j = u % 192;
        tile_write(tr, xl, tid);
        __syncthreads();
        { const int un = u + G; if (un < NU) tile_load(tr, PQ + (size_t)(un / 192) * 128 * 49152 + (un % 192) * 256, 49152, tid); }
        f32x16 acc[4] = {};
        mm_block<0>(acc[0], afr, vb); mm_block<1>(acc[1], afr, vb); mm_block<2>(acc[2], afr, vb); mm_block<3>(acc[3], afr, vb);
        const int s2 = j / 3;
#pragma unroll
        for (int r = 0; r < 8; ++r) { const int kl = crow(r, hi), k1 = 16 * w + kl; const float f = (float)(k1 * s2) * (1.f / 4096.f); const float tr_ = __builtin_amdgcn_cosf(f), ti_ = __builtin_amdgcn_sinf(f);
#pragma unroll
            for (int nb = 0; nb < 4; ++nb) { const float re = acc[nb][r], im = acc[nb][r + 8];
                *(bf16_t*)(stg + kl * 256 + (nb * 32 + r32) * 2) = f2bf(tr_ * re - ti_ * im);
                *(bf16_t*)(stg + (16 + kl) * 256 + (nb * 32 + r32) * 2) = f2bf(ti_ * re + tr_ * im); } }
        asm volatile("s_waitcnt lgkmcnt(0)" ::: "memory");
#pragma unroll
        for (int i = 0; i < 8; ++i) { const int rowl = i * 4 + (lane >> 4), c16 = lane & 15; const u32x4 v = *(const u32x4*)(stg + rowl * 256 + c16 * 16);
            const int reim = rowl >> 4, k1 = 16 * w + (rowl & 15);
            *(u32x4*)(Y + ((size_t)((b * 64 + k1) * 2 + reim)) * 49152 + j * 256 + nh * 128 + c16 * 8) = v; }
        __syncthreads();
    }
}
__device__ __forceinline__ void stage_b(const bf16_t* __restrict__ Y, const bf16_t* __restrict__ SG, bf16_t* __restrict__ BR, char* lds, int vcu, int G) {
    const int tid = threadIdx.x, wid = tid >> 6, lane = tid & 63, r32 = lane & 31, hi = lane >> 5, w = wid & 1, nq = wid >> 1;
    char* xl = lds + OFF_X; float* stg = (float*)(lds + OFF_STG + wid * 8192);
    bf16x8 afr[8];
    { const int k2 = 32 * w + r32;
#pragma unroll
      for (int ks = 0; ks < 8; ++ks) { float v[8];
#pragma unroll
          for (int j = 0; j < 8; ++j) { const int kk = 16 * ks + 8 * hi + j, reim = kk >> 6, s2 = kk & 63; const float f = (float)((k2 * s2) & 63) * (1.f / 64.f);
              v[j] = reim == 0 ? __builtin_amdgcn_cosf(f) * 0.125f : -__builtin_amdgcn_sinf(f) * 0.125f; }
          u32x4 p = {cvtpk(v[0], v[1]), cvtpk(v[2], v[3]), cvtpk(v[4], v[5]), cvtpk(v[6], v[7])}; afr[ks] = *reinterpret_cast<bf16x8*>(&p); } }
    const int vb = (int)(uintptr_t)xl + x_rd_base(lane) + nq * 2 * 512;
    constexpr int NU = NB * 64 * 3;
    TileRegs tr;
    int u = vcu;
    if (u < NU) tile_load(tr, Y + (size_t)(u / 3) * 2 * 49152 + (u % 3) * 256, 768, tid);
    for (; u < NU; u += G) {
        const int bk1 = u / 3, j = u % 3, b = bk1 >> 6, k1 = bk1 & 63;
        tile_write(tr, xl, tid);
        __syncthreads();
        { const int un = u + G; if (un < NU) tile_load(tr, Y + (size_t)(un / 3) * 2 * 49152 + (un % 3) * 256, 768, tid); }
        f32x16 acc[2] = {};
        mm_block<0>(acc[0], afr, vb); mm_block<1>(acc[1], afr, vb);
#pragma unroll
        for (int r = 0; r < 16; ++r) { const int rl = crow(r, hi); stg[rl * 64 + r32] = acc[0][r]; stg[rl * 64 + 32 + r32] = acc[1][r]; }
        asm volatile("s_waitcnt lgkmcnt(0)" ::: "memory");
#pragma unroll
        for (int i = 0; i < 4; ++i) { const int rowl = i * 8 + (lane >> 3), c8 = (lane & 7) * 8;
            const f32x4v a = *(const f32x4v*)(stg + rowl * 64 + c8), c = *(const f32x4v*)(stg + rowl * 64 + c8 + 4);
            const size_t off = ((size_t)b * SEQ + k1 + 64 * (32 * w + rowl)) * 1024 + j * 256 + nq * 64 + c8; const u32x4 g = *(const u32x4*)(SG + off); u32x4 o;
            o.x = cvtpk(a[0] * __uint_as_float(g.x << 16), a[1] * __uint_as_float(g.x & 0xffff0000u)); o.y = cvtpk(a[2] * __uint_as_float(g.y << 16), a[3] * __uint_as_float(g.y & 0xffff0000u));
            o.z = cvtpk(c[0] * __uint_as_float(g.z << 16), c[1] * __uint_as_float(g.z & 0xffff0000u)); o.w = cvtpk(c[2] * __uint_as_float(g.w << 16), c[3] * __uint_as_float(g.w & 0xffff0000u));
            *(u32x4*)(BR + off) = o; }
        __syncthreads();
    }
}
}
constexpr int NWAVES = 8;
constexpr int N_PHASES = 9;
constexpr int CW_BAR = 4096;
constexpr int RING_OFF = 0, RING_BYTES = 131072;
constexpr int LDSCTL_OFF = RING_BYTES, MISC_OFF = LDSCTL_OFF + 320, RS_OFF = LDSCTL_OFF + 1024  ;
constexpr int LDS_BYTES = 147456;
static_assert(RS_OFF + 4096 <= LDS_BYTES, "LDS map");

struct Args { const void* in[19]; float* out; unsigned char* ws; int ph_lo, ph_hi, li, pad; };

__device__ __forceinline__ void prep_w_job(const float* __restrict__ W, int ldw, int K, bf16_t* __restrict__ out, int n0, int nrows, const float* __restrict__ scale, int mode, int off, int gt, int GT) {
    const int total = nrows * (K >> 3);
    for (int idx = gt; idx < total; idx += GT) {
        const int n = idx % nrows, k8 = idx / nrows; const int sc = src_col(mode, n, off);
        float v[8];
#pragma unroll
        for (int i = 0; i < 8; ++i) { const int k = k8 * 8 + i; float w = (sc >= 0) ? W[(size_t)k * ldw + sc] : 0.f; if (scale) w *= scale[k]; v[i] = w; }
        uint4 o; o.x = pk2(v[0], v[1]); o.y = pk2(v[2], v[3]); o.z = pk2(v[4], v[5]); o.w = pk2(v[6], v[7]);
        *(uint4*)(out + (size_t)(n0 + n) * K + k8 * 8) = o;
    }
}
__device__ __forceinline__ void rmsnorm_row(const float* __restrict__ xrow, const float* __restrict__ g, bf16_t* __restrict__ orow, int lane) {
    const float4* xr = (const float4*)xrow + lane; float4 v[4]; float s = 0.f;
#pragma unroll
    for (int j = 0; j < 4; ++j) { v[j] = xr[64 * j]; s += v[j].x * v[j].x + v[j].y * v[j].y + v[j].z * v[j].z + v[j].w * v[j].w; }
    const float rstd = rsqrtf(wave_sum(s) * (1.f / DM) + EPS);
    uint2* o = (uint2*)orow + lane;
#pragma unroll
    for (int j = 0; j < 4; ++j) { const float4 gv = g ? ((const float4*)g)[lane + 64 * j] : make_float4(1.f, 1.f, 1.f, 1.f);
        uint2 w; w.x = pk2(v[j].x * rstd * gv.x, v[j].y * rstd * gv.y); w.y = pk2(v[j].z * rstd * gv.z, v[j].w * rstd * gv.w); o[64 * j] = w; }
}

typedef float f32x4m __attribute__((ext_vector_type(4)));
__device__ __forceinline__ void fold1_tiles(const float* __restrict__ Wf, float* __restrict__ AG, int gw, int NGW, int lane) {
    const int li = lane & 15, lk = lane >> 4;
    for (int tile = gw; tile < 2 * 4 * 12 * 12; tile += NGW) { const int di = tile % 12, ci = (tile / 12) % 12, g = (tile / 144) & 3, pq = tile / 576;
        const int c = ci * 16 + li; int p = (lk * c) % 192; const int step = (4 * c) % 192;
        const float* wp = Wf + ((size_t)g * 192 + lk) * 192 + di * 16 + li;
        f32x4m acc = {0.f, 0.f, 0.f, 0.f};
        for (int m0 = 0; m0 < 192; m0 += 4) { const float f = (float)p * (1.f / 192.f); const float a = pq ? __builtin_amdgcn_sinf(f) : __builtin_amdgcn_cosf(f);
            const float b = wp[(size_t)m0 * 192];
            acc = __builtin_amdgcn_mfma_f32_16x16x4f32(a, b, acc, 0, 0, 0);
            p += step; if (p >= 192) p -= 192; }
        float* op = AG + (((size_t)pq * 4 + g) * 192 + ci * 16 + 4 * lk) * 192 + di * 16 + li;
#pragma unroll
        for (int r = 0; r < 4; ++r) op[(size_t)r * 192] = acc[r] * 0.07216878364870322f; }
}
__device__ __forceinline__ void fold2_strips(const float* __restrict__ Win1, const float* __restrict__ g1, const float* __restrict__ AG, bf16_t* __restrict__ WIN1o, int gw, int NGW, int lane) {
    const int li = lane & 15, lk = lane >> 4;
    for (int s = gw; s < 64 * 8 * 3; s += NGW) { const int ki = s & 63, pg = (s >> 6) & 7, ds = s >> 9;
        const int g = pg & 3; const float* ap = Win1 + (size_t)(ki * 16 + li) * 2048 + 192 * g + lk; const float* bp = AG + ((size_t)pg * 192 + lk) * 192 + ds * 64 + li;
        f32x4m acc[4] = {{0.f, 0.f, 0.f, 0.f}, {0.f, 0.f, 0.f, 0.f}, {0.f, 0.f, 0.f, 0.f}, {0.f, 0.f, 0.f, 0.f}};
#pragma unroll 4
        for (int c0 = 0; c0 < 192; c0 += 4) { const float a = ap[c0]; const float* b = bp + (size_t)c0 * 192;
#pragma unroll
            for (int n = 0; n < 4; ++n) acc[n] = __builtin_amdgcn_mfma_f32_16x16x4f32(a, b[16 * n], acc[n], 0, 0, 0); }
        const int k0 = ki * 16 + 4 * lk; const float4 gv = *(const float4*)(g1 + k0);
#pragma unroll
        for (int n = 0; n < 4; ++n) { uint2 w; w.x = pk2(acc[n][0] * gv.x, acc[n][1] * gv.y); w.y = pk2(acc[n][2] * gv.z, acc[n][3] * gv.w);
            *(uint2*)(WIN1o + (size_t)((pg >> 2) * 768 + g * 192 + ds * 64 + n * 16 + li) * 1024 + k0) = w; } }
}
__device__ __forceinline__ void rmsnorm_rows2(const float* __restrict__ X, const float* __restrict__ g, bf16_t* __restrict__ O, int nrows, int gw, int NGW, int lane) {
    for (int m = 2 * gw; m < nrows; m += 2 * NGW) {
        const float4* x0 = (const float4*)(X + (size_t)m * DM) + lane; const float4* x1 = x0 + DM / 4; float4 v[8]; float s0 = 0.f, s1 = 0.f;
#pragma unroll
        for (int j = 0; j < 4; ++j) { v[j] = x0[64 * j]; v[4 + j] = x1[64 * j]; }
#pragma unroll
        for (int j = 0; j < 4; ++j) { s0 += v[j].x * v[j].x + v[j].y * v[j].y + v[j].z * v[j].z + v[j].w * v[j].w; s1 += v[4 + j].x * v[4 + j].x + v[4 + j].y * v[4 + j].y + v[4 + j].z * v[4 + j].z + v[4 + j].w * v[4 + j].w; }
        const float r0 = rsqrtf(wave_sum(s0) * (1.f / DM) + EPS), r1 = rsqrtf(wave_sum(s1) * (1.f / DM) + EPS);
        uint2* o0 = (uint2*)(O + (size_t)m * DM) + lane; uint2* o1 = o0 + DM / 4;
#pragma unroll
        for (int j = 0; j < 4; ++j) { const float4 gv = g ? ((const float4*)g)[lane + 64 * j] : make_float4(1.f, 1.f, 1.f, 1.f);
            uint2 w; w.x = pk2(v[j].x * r0 * gv.x, v[j].y * r0 * gv.y); w.y = pk2(v[j].z * r0 * gv.z, v[j].w * r0 * gv.w); o0[64 * j] = w;
            uint2 z; z.x = pk2(v[4 + j].x * r1 * gv.x, v[4 + j].y * r1 * gv.y); z.y = pk2(v[4 + j].z * r1 * gv.z, v[4 + j].w * r1 * gv.w); o1[64 * j] = z; } }
}
template <int DQK>
__device__ __forceinline__ void attn_naive_vb(float* Ks, float* Vs, int t256, const bf16_t* __restrict__ Q, int ldq, int qhs, const bf16_t* __restrict__ Kp, int ldk, int khs, const bf16_t* __restrict__ Vp, int ldv, int vhs,
                                              int nkeys, bf16_t* __restrict__ O, const bf16_t* __restrict__ G, int ocol0, int qblk, int h, int b) {
    constexpr int KT = 8;
    const size_t t = (size_t)b * SEQ + qblk * 256 + t256;
    unsigned qp2[DQK / 2]; float o[64], m = -1e30f, l = 0.f;
    { const bf16_t* qp = Q + t * ldq + h * qhs;
#pragma unroll
      for (int d = 0; d < DQK; d += 8) { const uint4 v = *(const uint4*)(qp + d); qp2[d / 2] = v.x; qp2[d / 2 + 1] = v.y; qp2[d / 2 + 2] = v.z; qp2[d / 2 + 3] = v.w; } }
#pragma unroll
    for (int d = 0; d < 64; ++d) o[d] = 0.f;
    const bf16_t* Kb = Kp + (size_t)b * nkeys * ldk + h * khs; const bf16_t* Vb = Vp + (size_t)b * nkeys * ldv + h * vhs;
    for (int k0 = 0; k0 < nkeys; k0 += KT) {
        __syncthreads();
        if (t256 < KT * DQK / 8) { const int j = t256 / (DQK / 8), d = (t256 % (DQK / 8)) * 8; const uint4 v = *(const uint4*)(Kb + (size_t)(k0 + j) * ldk + d);
            float* p = Ks + j * DQK + d; p[0] = __uint_as_float(v.x << 16); p[1] = __uint_as_float(v.x & 0xffff0000u); p[2] = __uint_as_float(v.y << 16); p[3] = __uint_as_float(v.y & 0xffff0000u);
            p[4] = __uint_as_float(v.z << 16); p[5] = __uint_as_float(v.z & 0xffff0000u); p[6] = __uint_as_float(v.w << 16); p[7] = __uint_as_float(v.w & 0xffff0000u); }
        if (t256 >= 128 && t256 < 128 + KT * 8) { const int tt = t256 - 128, j = tt >> 3, d = (tt & 7) * 8; const uint4 v = *(const uint4*)(Vb + (size_t)(k0 + j) * ldv + d);
            float* p = Vs + j * 64 + d; p[0] = __uint_as_float(v.x << 16); p[1] = __uint_as_float(v.x & 0xffff0000u); p[2] = __uint_as_float(v.y << 16); p[3] = __uint_as_float(v.y & 0xffff0000u);
            p[4] = __uint_as_float(v.z << 16); p[5] = __uint_as_float(v.z & 0xffff0000u); p[6] = __uint_as_float(v.w << 16); p[7] = __uint_as_float(v.w & 0xffff0000u); }
        __syncthreads();
#pragma unroll 1
        for (int j = 0; j < KT; ++j) { float s = 0.f; const float4* kr = (const float4*)(Ks + j * DQK);
#pragma unroll
            for (int d = 0; d < DQK / 4; ++d) { const float4 kv = kr[d]; const unsigned a = qp2[2 * d], c = qp2[2 * d + 1];
                s += __uint_as_float(a << 16) * kv.x + __uint_as_float(a & 0xffff0000u) * kv.y + __uint_as_float(c << 16) * kv.z + __uint_as_float(c & 0xffff0000u) * kv.w; }
            if (s > m) { const float alpha = __builtin_amdgcn_exp2f(m - s); m = s; l *= alpha;
#pragma unroll
                for (int d = 0; d < 64; ++d) o[d] *= alpha; }
            const float p = __builtin_amdgcn_exp2f(s - m); l += p; const float4* vr = (const float4*)(Vs + j * 64);
#pragma unroll
            for (int d = 0; d < 16; ++d) { const float4 vv = vr[d]; o[4 * d] += p * vv.x; o[4 * d + 1] += p * vv.y; o[4 * d + 2] += p * vv.z; o[4 * d + 3] += p * vv.w; } }
    }
    const float rl = 1.f / l;
    const bf16_t* gp = G + t * 1024 + ocol0 + h * 64; bf16_t* op = O + t * 1024 + ocol0 + h * 64;
#pragma unroll
    for (int d = 0; d < 64; d += 8) { const uint4 gv = *(const uint4*)(gp + d); uint4 w;
        w.x = pk2(o[d] * rl * __uint_as_float(gv.x << 16), o[d + 1] * rl * __uint_as_float(gv.x & 0xffff0000u));
        w.y = pk2(o[d + 2] * rl * __uint_as_float(gv.y << 16), o[d + 3] * rl * __uint_as_float(gv.y & 0xffff0000u));
        w.z = pk2(o[d + 4] * rl * __uint_as_float(gv.z << 16), o[d + 5] * rl * __uint_as_float(gv.z & 0xffff0000u));
        w.w = pk2(o[d + 6] * rl * __uint_as_float(gv.w << 16), o[d + 7] * rl * __uint_as_float(gv.w & 0xffff0000u));
        *(uint4*)(op + d) = w; }
}
template <int DQK>
__device__ __forceinline__ void attn_naive_phase(unsigned char* lds, int tid, const bf16_t* Q, int ldq, int qhs, const bf16_t* Kp, int ldk, int khs, const bf16_t* Vp, int ldv, int vhs, int nkeys, int nheads,
                                                 bf16_t* O, const bf16_t* G, int ocol0) {
    const int half = tid >> 8, t256 = tid & 255; float* Ks = (float*)(lds + half * 32768); float* Vs = Ks + 8 * DQK;
    const int total = 16 * nheads * NB, stride = (int)gridDim.x * 2;
    for (int vb = (int)blockIdx.x * 2 + half; vb < total; vb += stride) { const int qblk = vb & 15, h = (vb >> 4) % nheads, b = (vb >> 4) / nheads;
        attn_naive_vb<DQK>(Ks, Vs, t256, Q, ldq, qhs, Kp, ldk, khs, Vp, ldv, vhs, nkeys, O, G, ocol0, qblk, h, b); }
}

__global__ void __launch_bounds__(NWAVES * 64, 2) mk_fwd(Args args) {
    extern __shared__ __attribute__((aligned(16))) unsigned char lds[];
    LAS unsigned char* ldsl = (LAS unsigned char*)lds;
    volatile LAS unsigned* MISC = (volatile LAS unsigned*)(ldsl + MISC_OFF);
    const int tid0 = threadIdx.x;
#define PHASE_IDS() int tid = threadIdx.x; asm volatile("" : "+v"(tid)); const int lane = tid & 63, wave = __builtin_amdgcn_readfirstlane(tid >> 6); const int gt = (int)blockIdx.x * (NWAVES * 64) + tid, gw = (int)blockIdx.x * NWAVES + wave; (void)lane; (void)wave; (void)gt; (void)gw;
    const int vcu = (gridDim.x % 8 == 0) ? ((int)blockIdx.x % 8) * ((int)gridDim.x / 8) + (int)blockIdx.x / 8 : (int)blockIdx.x;
    const int G = gridDim.x, GT = G * NWAVES * 64, NGW = G * NWAVES;
    unsigned char* ws = args.ws;
    gu32* ctl = (gu32*)(ws + WS_CTL);
#define in_x ((const float*)args.in[0])
#define in_mem ((const float*)args.in[1])
#define in_pos ((const int*)args.in[2])
#define in_g0 ((const float*)args.in[3])
#define in_w_in0 ((const float*)args.in[4])
#define in_gq ((const float*)args.in[5])
#define in_gkv ((const float*)args.in[6])
#define in_w_uq ((const float*)args.in[7])
#define in_w_ukv ((const float*)args.in[8])
#define in_gm0 ((const float*)args.in[9])
#define in_w_mkv0 ((const float*)args.in[10])
#define in_w_out0 ((const float*)args.in[11])
#define in_g1 ((const float*)args.in[12])
#define in_w_in1 ((const float*)args.in[13])
#define in_w_fnet ((const float*)args.in[14])
#define in_gm1 ((const float*)args.in[15])
#define in_w_mkv1 ((const float*)args.in[16])
#define in_w_out1 ((const float*)args.in[17])
#define in_gf ((const float*)args.in[18])
#define in_out (args.out)
#define WIN0 ((bf16_t*)(ws + WS_WIN0))
#define WUQ ((bf16_t*)(ws + WS_WUQ))
#define WUKV ((bf16_t*)(ws + WS_WUKV))
#define WMEM ((bf16_t*)(ws + WS_WMEM))
#define WOUT0 ((bf16_t*)(ws + WS_WOUT0))
#define WOUT1 ((bf16_t*)(ws + WS_WOUT1))
#define WIN1 ((bf16_t*)(ws + WS_WIN1))
#define AGBG ((float*)(ws + WS_AGBG))
#define ROPE ((float*)(ws + WS_ROPE))
#define MEMN ((bf16_t*)(ws + WS_MEMN))
#define MEMKV ((bf16_t*)(ws + WS_MEMKV))
#define RSTD1 ((float*)(ws + WS_RSTD1))
#define SSQ ((float*)(ws + WS_SSQ))
#define XN0 ((bf16_t*)(ws + WS_XN0))
#define BR ((bf16_t*)(ws + WS_BR))
#define CQ ((bf16_t*)(ws + WS_CQ))
#define CKV ((bf16_t*)(ws + WS_CKV))
#define QMEM0 ((bf16_t*)(ws + WS_QMEM0))
#define SG0 ((bf16_t*)(ws + WS_SG0))
#define Kb ((bf16_t*)(ws + WS_K))
#define Qb ((bf16_t*)(ws + WS_Q))
#define Vb ((bf16_t*)(ws + WS_V))
#define X1B ((bf16_t*)(ws + WS_X1B))
#define PQ ((bf16_t*)(ws + WS_PQ))
#define QMEM1 ((bf16_t*)(ws + WS_QMEM1))
#define SG1 ((bf16_t*)(ws + WS_SG1))
#define Y ((bf16_t*)(ws + WS_Y))
    for (int u = tid0; u < (LDS_BYTES - LDSCTL_OFF) / 4; u += NWAVES * 64) ((LAS unsigned*)(ldsl + LDSCTL_OFF))[u] = 0u;
    __syncthreads();
    const XcdBarrier bar = xcd_barrier_post((unsigned*)(ctl + CW_BAR) + args.li * XCD_BAR_WORDS, MISC + 8);
#define GRID_BAR() xcd_barrier(bar)
    const int lo = args.ph_lo, hi = args.ph_hi;
#ifndef PH_MASK
#define PH_MASK 0x1ff
#endif
#define IN(k) (((PH_MASK >> (k)) & 1) && lo <= (k) && (k) < hi)
#define BOTH(k) (IN(k) && IN((k) + 1))
    LAS float* rs = (LAS float*)(ldsl + RS_OFF);

    if (IN(0)) { PHASE_IDS();
        prep_w_job(in_w_in0, 1952, 1024, WIN0, 0, 2048, nullptr, MODE_WIN0, 0, gt, GT);
        prep_w_job(in_w_uq, 1152, 384, WUQ, 0, 1280, in_gq, MODE_WUQ, 0, gt, GT);
        prep_w_job(in_w_ukv, 1536, 256, WUKV, 0, 1536, in_gkv, MODE_WUKV, 0, gt, GT);
        prep_w_job(in_w_mkv0, 512, 1024, WMEM, 0, 512, in_gm0, MODE_PLAIN, 0, gt, GT);
        prep_w_job(in_w_mkv1, 512, 1024, WMEM, 512, 512, in_gm1, MODE_PLAIN, 0, gt, GT);
        prep_w_job(in_w_out0, 1024, 1024, WOUT0, 0, 1024, nullptr, MODE_PLAIN, 0, gt, GT);
        prep_w_job(in_w_out1, 1024, 1024, WOUT1, 0, 1024, nullptr, MODE_PLAIN, 0, gt, GT);
        prep_w_job(in_w_in1, 2048, 1024, WIN1, 1536, 1280, in_g1, MODE_PLAIN, 768, gt, GT);
        fold1_tiles(in_w_fnet, AGBG, gw, NGW, lane);
        for (int idx = gt; idx < T * 16; idx += GT) { const int t = idx >> 4, i = idx & 15;
            const float inv_freq = __builtin_amdgcn_exp2f((float)i * -0.83048202372184058696f);
            const float ang = (float)in_pos[t] * inv_freq; double fd = (double)ang * 0.31830988618379067154; fd -= 2.0 * floor(fd * 0.5);
            float sn, cs; sincospif((float)fd, &sn, &cs); ROPE[2 * idx] = cs; ROPE[2 * idx + 1] = sn; }
        rmsnorm_rows2(in_mem, nullptr, MEMN, 4096, gw, NGW, lane);
        rmsnorm_rows2(in_x, in_g0, XN0, T, gw, NGW, lane);
        if (BOTH(0)) GRID_BAR();
    }
    if (IN(1)) { PHASE_IDS();
        fold2_strips(in_w_in1, in_g1, AGBG, WIN1, gw, NGW, lane);
        { pg8::Gemm g{XN0, WIN0, T, 2048, 1024}; pg8::StaticOrder S; S.init(T, 2048, G, (int)blockIdx.x);
          pg8::EpiIn0 E{CQ, CKV, QMEM0, SG0, Kb, SSQ, ROPE};
          pg8::gemm_phase<pg8::EpiIn0, pg8::StaticOrder, true, true>(ldsl + RING_OFF, g, S, E); }
        { pg8::Gemm g{MEMN, WMEM, 4096, 1024, 1024}; pg8::StaticOrder S; S.init(4096, 1024, G, (int)blockIdx.x);
          pg8::EpiPlainB E{MEMKV, 1024, 0};
          pg8::gemm_phase<pg8::EpiPlainB, pg8::StaticOrder, true, true>(ldsl + RING_OFF, g, S, E); }
        if (BOTH(1)) GRID_BAR();
    }
    if (IN(2)) { PHASE_IDS();
        { int kq_ = 384; asm volatile("" : "+s"(kq_)); pg8::Gemm g{CQ, WUQ, T, 1280, kq_}; pg8::StaticOrder S; S.init(T, 1280, G, (int)blockIdx.x);
          pg8::EpiQup E{Qb, SSQ, ROPE};
          pg8::gemm_phase<pg8::EpiQup, pg8::StaticOrder, true, true>(ldsl + RING_OFF, g, S, E); }
        { int kk_ = 256; asm volatile("" : "+s"(kk_)); pg8::Gemm g{CKV, WUKV, T, 1536, kk_}; pg8::StaticOrder S; S.init(T, 1536, G, (int)blockIdx.x);
          pg8::EpiKVup E{Kb, Vb, SSQ};
          pg8::gemm_phase<pg8::EpiKVup, pg8::StaticOrder, true, true>(ldsl + RING_OFF, g, S, E); }
        if (BOTH(2)) GRID_BAR();
    }
    if (IN(3)) { PHASE_IDS();
#ifdef ATTN_NAIVE
        attn_naive_phase<96>(lds, tid, Qb, 1152, 96, Kb, 1152, 96, Vb, 768, 64, SEQ, 12, BR, SG0, 0);
        attn_naive_phase<64>(lds, tid, QMEM0, 256, 64, MEMKV, 1024, 64, MEMKV + 256, 1024, 64, 256, 4, BR, SG0, 768);
#else
        for (int u = vcu; u < 16 * 12 * NB; u += G) { const int qblk = u & 15, pair = u >> 4, b = pair / 12, h = pair % 12; const size_t t0 = (size_t)b * SEQ + qblk * 256;
            att::attn_unit<96>(Qb + t0 * 1152 + h * 96, 1152, Kb + (size_t)b * SEQ * 1152 + h * 96, 1152, Vb + (size_t)b * SEQ * 768 + h * 64, 768, SEQ, BR + t0 * 1024 + h * 64, SG0 + t0 * 1024 + h * 64, (char*)lds); }
        for (int u = vcu; u < 16 * 4 * NB; u += G) { const int qblk = u & 15, pair = u >> 4, b = pair >> 2, h = pair & 3; const size_t t0 = (size_t)b * SEQ + qblk * 256;
            att::attn_unit<64>(QMEM0 + t0 * 256 + h * 64, 256, MEMKV + (size_t)b * 256 * 1024 + h * 64, 1024, MEMKV + (size_t)b * 256 * 1024 + 256 + h * 64, 1024, 256, BR + t0 * 1024 + 768 + h * 64, SG0 + t0 * 1024 + 768 + h * 64, (char*)lds); }
#endif
        if (BOTH(3)) GRID_BAR();
    }
    if (IN(4)) { PHASE_IDS();
        for (int i = tid; i < 1024; i += NWAVES * 64) rs[i] = 0.f;
        __syncthreads();
        { pg8::Gemm g{BR, WOUT0, T, 1024, 1024}; pg8::PanelOrder S; S.init(T, G, (int)blockIdx.x);
          pg8::EpiOutA E{in_x, X1B, rs};
          pg8::gemm_phase<pg8::EpiOutA, pg8::PanelOrder, true, true>(ldsl + RING_OFF, g, S, E); }
        __syncthreads();
        if (tid < 256) RSTD1[(size_t)blockIdx.x * 256 + tid] = rsqrtf(((rs[tid * 4] + rs[tid * 4 + 1]) + (rs[tid * 4 + 2] + rs[tid * 4 + 3])) * (1.f / DM) + EPS);
        if (BOTH(4)) GRID_BAR();
    }
    if (IN(5)) { PHASE_IDS();
        { pg8::Gemm g{X1B, WIN1, T, 2816, 1024}; pg8::StaticOrder S; S.init(T, 2816, G, (int)blockIdx.x);
          pg8::EpiIn1 E{PQ, QMEM1, SG1, RSTD1};
          pg8::gemm_phase<pg8::EpiIn1, pg8::StaticOrder, true, true>(ldsl + RING_OFF, g, S, E); }
        if (BOTH(5)) GRID_BAR();
    }
    if (IN(6)) { PHASE_IDS();
#ifdef FFT_NAIVE
        LAS float* tab = (LAS float*)(ldsl + RING_OFF + 65536);
        if (tid < 64) { tab[2 * tid] = cospif(2.f * tid / 64.f); tab[2 * tid + 1] = sinpif(2.f * tid / 64.f); }
        __syncthreads();
        for (int idx = gt; idx < NB * 64 * 49152; idx += GT) { const int e = idx % 49152, k1 = (idx / 49152) & 63, b = idx / (49152 * 64);
            float ar = 0.f, ai = 0.f;
            for (int s1 = 0; s1 < 64; ++s1) { const int w = (k1 * s1) & 63; const float wx = tab[2 * w], wy = tab[2 * w + 1];
                const size_t base = (((size_t)b * 64 + s1) * 2) * 49152 + e; const float p = bf2f(PQ[base]), q = bf2f(PQ[base + 49152]);
                ar += wx * p - wy * q; ai += wy * p + wx * q; }
            ar *= 0.125f; ai *= 0.125f;
            const int s2 = e / 768; const float fr = 2.f * (float)(k1 * s2) / 4096.f; const float tr = cospif(fr), ti = sinpif(fr);
            const size_t ob = (((size_t)b * 64 + k1) * 2) * 49152 + e;
            Y[ob] = f2bf(tr * ar - ti * ai); Y[ob + 49152] = f2bf(ti * ar + tr * ai); }
        __syncthreads();
#else
        fft::stage_a(PQ, Y, (char*)lds, vcu, G);
#endif
#ifdef ATTN_NAIVE
        attn_naive_phase<64>(lds, tid, QMEM1, 256, 64, MEMKV + 512, 1024, 64, MEMKV + 768, 1024, 64, 256, 4, BR, SG1, 768);
#else
        for (int u = vcu; u < 16 * 4 * NB; u += G) { const int qblk = u & 15, pair = u >> 4, b = pair >> 2, h = pair & 3; const size_t t0 = (size_t)b * SEQ + qblk * 256;
            att::attn_unit<64>(QMEM1 + t0 * 256 + h * 64, 256, MEMKV + (size_t)b * 256 * 1024 + 512 + h * 64, 1024, MEMKV + (size_t)b * 256 * 1024 + 768 + h * 64, 1024, 256, BR + t0 * 1024 + 768 + h * 64, SG1 + t0 * 1024 + 768 + h * 64, (char*)lds); }
#endif
        if (BOTH(6)) GRID_BAR();
    }
    if (IN(7)) { PHASE_IDS();
#ifdef FFT_NAIVE
        LAS float* tab = (LAS float*)(ldsl + RING_OFF + 65536);
        __syncthreads();
        if (tid < 64) { tab[2 * tid] = cospif(2.f * tid / 64.f); tab[2 * tid + 1] = sinpif(2.f * tid / 64.f); }
        __syncthreads();
        for (int idx = gt; idx < NB * 64 * 64 * 768; idx += GT) { const int d = idx % 768, k2 = (idx / 768) & 63, bk1 = idx / 49152, b = bk1 >> 6, k1 = bk1 & 63;
            float acc = 0.f;
            for (int s2 = 0; s2 < 64; ++s2) { const int w = (k2 * s2) & 63; const size_t base = ((size_t)bk1 * 2) * 49152 + (size_t)s2 * 768 + d;
                acc += tab[2 * w] * bf2f(Y[base]) - tab[2 * w + 1] * bf2f(Y[base + 49152]); }
            const size_t t = (size_t)b * SEQ + k1 + 64 * k2;
            BR[t * 1024 + d] = f2bf(acc * 0.125f * bf2f(SG1[t * 1024 + d])); }
#else
        fft::stage_b(Y, SG1, BR, (char*)lds, vcu, G);
#endif
        if (BOTH(7)) GRID_BAR();
    }
    if (IN(8)) { PHASE_IDS();
        __syncthreads();
        for (int i = tid; i < 1024; i += NWAVES * 64) rs[i] = 0.f;
        __syncthreads();
        { pg8::Gemm g{BR, WOUT1, T, 1024, 1024}; pg8::PanelOrder S; S.init(T, G, (int)blockIdx.x);
          pg8::EpiOutB E{X1B, rs};
          pg8::gemm_phase<pg8::EpiOutB, pg8::PanelOrder, true, true>(ldsl + RING_OFF, g, S, E); }
        asm volatile("s_waitcnt vmcnt(0)" ::: "memory");
        __syncthreads();
        for (int r = wave; r < 256; r += NWAVES) { const float rstd = rsqrtf(((rs[r * 4] + rs[r * 4 + 1]) + (rs[r * 4 + 2] + rs[r * 4 + 3])) * (1.f / DM) + EPS);
            const size_t row = (size_t)blockIdx.x * 256 + r; const uint4* xb = (const uint4*)(X1B + row * DM) + lane; float4* orow = (float4*)(in_out + row * DM) + 2 * lane;
#pragma unroll
            for (int j = 0; j < 2; ++j) { const uint4 v = xb[64 * j]; const float4 ga = ((const float4*)in_gf)[2 * lane + 128 * j], gb = ((const float4*)in_gf)[2 * lane + 128 * j + 1]; float4 a, b;
                a.x = __uint_as_float(v.x << 16) * rstd * ga.x; a.y = __uint_as_float(v.x & 0xffff0000u) * rstd * ga.y; a.z = __uint_as_float(v.y << 16) * rstd * ga.z; a.w = __uint_as_float(v.y & 0xffff0000u) * rstd * ga.w;
                b.x = __uint_as_float(v.z << 16) * rstd * gb.x; b.y = __uint_as_float(v.z & 0xffff0000u) * rstd * gb.y; b.z = __uint_as_float(v.w << 16) * rstd * gb.z; b.w = __uint_as_float(v.w & 0xffff0000u) * rstd * gb.w;
                orow[128 * j] = a; orow[128 * j + 1] = b; } }
    }
#undef in_x
#undef in_mem
#undef in_pos
#undef in_g0
#undef in_w_in0
#undef in_gq
#undef in_gkv
#undef in_w_uq
#undef in_w_ukv
#undef in_gm0
#undef in_w_mkv0
#undef in_w_out0
#undef in_g1
#undef in_w_in1
#undef in_w_fnet
#undef in_gm1
#undef in_w_mkv1
#undef in_w_out1
#undef in_gf
#undef in_out
#undef WIN0
#undef WUQ
#undef WUKV
#undef WMEM
#undef WOUT0
#undef WOUT1
#undef WIN1
#undef AGBG
#undef ROPE
#undef MEMN
#undef MEMKV
#undef RSTD1
#undef SSQ
#undef XN0
#undef BR
#undef CQ
#undef CKV
#undef QMEM0
#undef SG0
#undef Kb
#undef Qb
#undef Vb
#undef X1B
#undef PQ
#undef QMEM1
#undef SG1
#undef Y
#undef PHASE_IDS
#undef IN
#undef BOTH
#undef GRID_BAR
}

extern "C" void kernel_launch(void* const* d_in, const int* in_sizes, int n_in, void* d_out, int out_size, void* d_ws, size_t ws_size, hipStream_t stream) {
    static int grid = 0;
    if (grid == 0) {
        if (n_in != 19 || ws_size < WS_END || out_size != T * DM) { fprintf(stderr, "kernel_launch: unexpected n_in %d / ws %zu / out %d\n", n_in, ws_size, out_size); grid = -1; return; }
        int dev = 0, cus = 0;
        if (hipGetDevice(&dev) != hipSuccess || hipDeviceGetAttribute(&cus, hipDeviceAttributeMultiprocessorCount, dev) != hipSuccess) { grid = -1; return; }
        if (hipFuncSetAttribute((const void*)mk_fwd, hipFuncAttributeMaxDynamicSharedMemorySize, LDS_BYTES) != hipSuccess) { fprintf(stderr, "kernel_launch: hipFuncSetAttribute failed\n"); grid = -1; return; }
        int per_cu = 0; (void)hipOccupancyMaxActiveBlocksPerMultiprocessor(&per_cu, (const void*)mk_fwd, NWAVES * 64, LDS_BYTES); (void)hipGetLastError();
        if (cus != 256 || per_cu < 1) fprintf(stderr, "kernel_launch: note: %d CUs, occupancy query %d (built for 256 CUs, one workgroup each)\n", cus, per_cu);
        grid = 256;
    }
    if (grid < 0) return;
    if (hipMemsetAsync((char*)d_ws + WS_CTL, 0, CTL_ZERO_BYTES, stream) != hipSuccess) { fprintf(stderr, "kernel_launch: memset failed\n"); return; }
    Args a{};
    for (int i = 0; i < 19; ++i) a.in[i] = d_in[i];
    a.out = (float*)d_out; a.ws = (unsigned char*)d_ws;
#ifndef PROBE_PHASE
    const int nl = 1; const int rlo[1] = {0}, rhi[1] = {N_PHASES};
#else
    const int nl = 3; const int rlo[3] = {0, PROBE_PHASE, PROBE_PHASE}, rhi[3] = {PROBE_PHASE + 1, PROBE_PHASE + 1, N_PHASES};
#endif
    for (int li = 0; li < nl; ++li) {
        a.ph_lo = rlo[li]; a.ph_hi = rhi[li]; a.li = li; a.pad = 0;
        hipLaunchKernelGGL(mk_fwd, dim3(grid), dim3(NWAVES * 64), LDS_BYTES, stream, a);
        const hipError_t le = hipPeekAtLastError();
        if (le != hipSuccess) { fprintf(stderr, "kernel_launch: launch %d failed: %s\n", li, hipGetErrorName(le)); break; }
    }
}
```

```cpp
#include <hip/hip_runtime.h>
#include <stdint.h>
#include <cstdio>

typedef unsigned short bf16_t;
constexpr int T = 65536, SEQ = 4096, NB = 16, DM = 1024;
constexpr float EPS = 1e-6f;
constexpr float LOG2E = 1.4426950408889634f;
constexpr float QS_MLA = 0.10206207261596575f * LOG2E;
constexpr float QS_MEM = 0.125f * LOG2E;

constexpr size_t MiB = 1u << 20;
constexpr size_t WS_CTL = 0, CTL_ZERO_BYTES = 1 * MiB;
constexpr size_t WS_WIN0 = 1 * MiB;
constexpr size_t WS_WUQ = 5 * MiB;
constexpr size_t WS_WUKV = 6 * MiB;
constexpr size_t WS_WMEM = 7 * MiB;
constexpr size_t WS_WOUT0 = 9 * MiB;
constexpr size_t WS_WOUT1 = 11 * MiB;
constexpr size_t WS_WIN1 = 13 * MiB;
constexpr size_t WS_AGBG = 19 * MiB;
constexpr size_t WS_ROPE = 21 * MiB;
constexpr size_t WS_MEMN = 29 * MiB;
constexpr size_t WS_MEMKV = 37 * MiB;
constexpr size_t WS_RSTD1 = 45 * MiB;
constexpr size_t WS_SSQ = 46 * MiB;
constexpr size_t WS_XN0 = 64 * MiB;
constexpr size_t WS_BR = 64 * MiB;
constexpr size_t WS_CQ = 192 * MiB;
constexpr size_t WS_CKV = 240 * MiB;
constexpr size_t WS_QMEM0 = 272 * MiB;
constexpr size_t WS_SG0 = 304 * MiB;
constexpr size_t WS_K = 432 * MiB;
constexpr size_t WS_Q = 576 * MiB;
constexpr size_t WS_V = 720 * MiB;
constexpr size_t WS_X1B = 192 * MiB;
constexpr size_t WS_PQ = 320 * MiB;
constexpr size_t WS_QMEM1 = 512 * MiB;
constexpr size_t WS_SG1 = 544 * MiB;
constexpr size_t WS_Y = 672 * MiB;
constexpr size_t WS_END = 864 * MiB;

__device__ __forceinline__ float bf2f(bf16_t h) { return __uint_as_float(((unsigned)h) << 16); }
__device__ __forceinline__ bf16_t f2bf(float f) { unsigned u = __float_as_uint(f); return (bf16_t)((u + 0x7fffu + ((u >> 16) & 1u)) >> 16); }
__device__ __forceinline__ unsigned pk2(float lo, float hi) { return (unsigned)f2bf(lo) | ((unsigned)f2bf(hi) << 16); }
__device__ __forceinline__ float silu_f(float v) { return v * __builtin_amdgcn_rcpf(1.f + __expf(-v)); }
__device__ __forceinline__ float wave_sum(float v) {
#pragma unroll
    for (int o = 1; o < 64; o <<= 1) v += __shfl_xor(v, o);
    return v;
}
__host__ __device__ __forceinline__ int ropedim(int p) { return 4 * (p >> 3) + (p & 3) + 16 * ((p >> 2) & 1); }
enum { MODE_WIN0 = 0, MODE_WUQ = 1, MODE_WUKV = 2, MODE_PLAIN = 3 };
__device__ __forceinline__ int src_col(int mode, int n, int off) {
    if (mode == MODE_WIN0) {
        if (n < 640) return n;
        if (n < 896) return 672 + (n - 640);
        if (n < 928) return 640 + ropedim(n - 896);
        if (n < 1024) return -1;
        return 928 + (n - 1024);
    } else if (mode == MODE_WUQ) {
        if (n < 768) return (n >> 6) * 96 + (n & 63);
        if (n < 1152) { const int r = n - 768; return (r >> 5) * 96 + 64 + ropedim(r & 31); }
        return -1;
    } else if (mode == MODE_WUKV) {
        if (n < 768) return (n >> 6) * 128 + (n & 63);
        const int r = n - 768; return (r >> 6) * 128 + 64 + (r & 63);
    }
    return n + off;
}
namespace pg8 {
#define PG8_LAS __attribute__((address_space(3)))
typedef unsigned short bf16_t;
typedef short bf16x8 __attribute__((ext_vector_type(8)));
typedef float f32x4 __attribute__((ext_vector_type(4)));
typedef unsigned u32x4 __attribute__((ext_vector_type(4)));
constexpr int BM = 256, BK = 64, HALF = 128, HTB = HALF * BK * 2  , STAGE_BYTES = 8 * HTB, NXCD = 8, WGM = 8;

__host__ __device__ __forceinline__ int lds_byte(int r, int c) { const int st = (r >> 4) * 2 + (c >> 5), rr = r & 15, cc = c & 31, ob = rr * 64 + cc * 2; return st * 1024 + (ob ^ (((ob >> 9) & 1) << 5)); }
__host__ __device__ __forceinline__ void stage_rc(int b, int& R, int& C) { const int st = b / 1024, sb = b % 1024, swz = sb ^ (((sb >> 9) & 1) << 5); R = (st >> 1) * 16 + swz / 64; C = (st & 1) * 32 + (swz % 64) / 2; }
__host__ __device__ __forceinline__ int perm32(int rho) { const int n = rho >> 4, i = rho & 15; return 8 * (i >> 2) + 4 * n + (i & 3); }

struct Unit { int pm, pn; };
struct Gemm { const bf16_t* A; const bf16_t* Bt; int M, N, K; };

struct StaticOrder {
    int nM, nN, nwg, G, c;
    __host__ __device__ void init(int M, int N, int G_, int c_) { nM = M / BM; nN = N / BM; nwg = nM * nN; G = G_; c = c_; }
    __host__ __device__ bool next(int i, Unit& u) const {
        const long L = (long)i * G + c; if (L >= nwg) return false;
        int wgid = (int)L; { const int q = nwg / NXCD, r = nwg % NXCD, xcd = wgid % NXCD, off = wgid / NXCD; wgid = (xcd < r ? xcd * (q + 1) : r * (q + 1) + (xcd - r) * q) + off; }
        const int nig = WGM * nN, gid = wgid / nig, fm = gid * WGM, gsz = (nM - fm) < WGM ? (nM - fm) : WGM;
        u.pm = fm + ((wgid % nig) % gsz); u.pn = (wgid % nig) / gsz; return true;
    }
    __device__ __forceinline__ void a_ready(const Unit&) const {}
    __device__ __forceinline__ void done(const Unit&) const {}
};

__device__ __forceinline__ unsigned cvt_pk_bf16(float lo, float hi) { unsigned r; asm volatile("v_cvt_pk_bf16_f32 %0, %1, %2" : "=v"(r) : "v"(lo), "v"(hi)); return r; }
typedef float f32x2 __attribute__((ext_vector_type(2)));
__device__ __forceinline__ u32x4 pack8(const f32x4 a, const f32x4 b, float s) { u32x4 w; w.x = cvt_pk_bf16(a[0] * s, a[1] * s); w.y = cvt_pk_bf16(a[2] * s, a[3] * s); w.z = cvt_pk_bf16(b[0] * s, b[1] * s); w.w = cvt_pk_bf16(b[2] * s, b[3] * s); return w; }
__device__ __forceinline__ float ss8(const f32x4 a, const f32x4 b) { return (a[0] * a[0] + a[1] * a[1]) + (a[2] * a[2] + a[3] * a[3]) + (b[0] * b[0] + b[1] * b[1]) + (b[2] * b[2] + b[3] * b[3]); }
__device__ __forceinline__ float quad_sum(float v) { v += __shfl_xor(v, 16); v += __shfl_xor(v, 32); return v; }
__device__ __forceinline__ f32x4 silu4(const f32x4 v) { f32x4 o; o[0] = silu_f(v[0]); o[1] = silu_f(v[1]); o[2] = silu_f(v[2]); o[3] = silu_f(v[3]); return o; }
typedef unsigned u32x2 __attribute__((ext_vector_type(2)));
__device__ __forceinline__ void rope_pair(const f32x4 a, const f32x4 b, const float* cs  , float s, u32x2& o1, u32x2& o2) {
    const f32x4 c01 = *(const f32x4*)cs, c23 = *(const f32x4*)(cs + 4);
    const float r0 = (a[0] * c01[0] - b[0] * c01[1]) * s, r1 = (a[1] * c01[2] - b[1] * c01[3]) * s, r2 = (a[2] * c23[0] - b[2] * c23[1]) * s, r3 = (a[3] * c23[2] - b[3] * c23[3]) * s;
    const float q0 = (b[0] * c01[0] + a[0] * c01[1]) * s, q1 = (b[1] * c01[2] + a[1] * c01[3]) * s, q2 = (b[2] * c23[0] + a[2] * c23[1]) * s, q3 = (b[3] * c23[2] + a[3] * c23[3]) * s;
    o1.x = cvt_pk_bf16(r0, r1); o1.y = cvt_pk_bf16(r2, r3); o2.x = cvt_pk_bf16(q0, q1); o2.y = cvt_pk_bf16(q2, q3);
}
__device__ __forceinline__ void rope_pair2(const f32x4 a, const f32x4 b, const f32x4 c01, const f32x4 c23, float s, u32x2& o1, u32x2& o2) {
    o1.x = cvt_pk_bf16((a[0] * c01[0] - b[0] * c01[1]) * s, (a[1] * c01[2] - b[1] * c01[3]) * s); o1.y = cvt_pk_bf16((a[2] * c23[0] - b[2] * c23[1]) * s, (a[3] * c23[2] - b[3] * c23[3]) * s);
    o2.x = cvt_pk_bf16((b[0] * c01[0] + a[0] * c01[1]) * s, (b[1] * c01[2] + a[1] * c01[3]) * s); o2.y = cvt_pk_bf16((b[2] * c23[0] + a[2] * c23[1]) * s, (b[3] * c23[2] + a[3] * c23[3]) * s);
}
struct EpiIn0 {
    static constexpr bool PERM = true, AFTER_DRAIN = false;
    bf16_t *CQ, *CKV, *QMEM, *SG, *Kb; float* SSQ; const float* rope;
    __device__ __forceinline__ void operator()(const f32x4 (&acc)[2][2][4][2], const Unit& u, int wr, int wc, int fr, int fq) const {
        const bool kr = (u.pn == 3) && (wc == 0);
        f32x4 cs[2][4][2];
        if (kr) {
#pragma unroll
            for (int ai = 0; ai < 2; ++ai)
#pragma unroll
                for (int m = 0; m < 4; ++m) { const float* rp = rope + (size_t)(u.pm * BM + ai * HALF + wr * 64 + m * 16 + fr) * 32 + 8 * fq; cs[ai][m][0] = *(const f32x4*)rp; cs[ai][m][1] = *(const f32x4*)(rp + 4); } }
#pragma unroll
        for (int ai = 0; ai < 2; ++ai)
#pragma unroll
            for (int m = 0; m < 4; ++m) { const size_t row = (size_t)(u.pm * BM + ai * HALF + wr * 64 + m * 16 + fr);
#pragma unroll
                for (int bj = 0; bj < 2; ++bj) { const int cb = u.pn * BM + bj * HALF + wc * 32, c = cb + 8 * fq; const f32x4 v0 = acc[ai][bj][m][0], v1 = acc[ai][bj][m][1];
                    if (cb < 640) { const float ss = quad_sum(ss8(v0, v1));
                        if (cb < 384) { *(u32x4*)(CQ + row * 384 + c) = pack8(v0, v1, 1.f); if (fq == 0) SSQ[row * 20 + (cb >> 5)] = ss; }
                        else { *(u32x4*)(CKV + row * 256 + (c - 384)) = pack8(v0, v1, 1.f); if (fq == 0) SSQ[row * 20 + 12 + ((cb - 384) >> 5)] = ss; } }
                    else if (cb < 896) { *(u32x4*)(QMEM + row * 256 + (c - 640)) = pack8(v0, v1, QS_MEM); }
                    else if (cb < 1024) { if (cb == 896) { u32x2 o1, o2; rope_pair2(v0, v1, cs[ai][m][0], cs[ai][m][1], 1.f, o1, o2);
#pragma unroll
                            for (int h = 0; h < 12; ++h) { *(u32x2*)(Kb + row * 1152 + h * 96 + 64 + 4 * fq) = o1; *(u32x2*)(Kb + row * 1152 + h * 96 + 80 + 4 * fq) = o2; } } }
                    else { *(u32x4*)(SG + row * 1024 + (c - 1024)) = pack8(silu4(v0), silu4(v1), 1.f); } } }
    }
};
struct EpiPlainB {
    static constexpr bool PERM = true, AFTER_DRAIN = false;
    bf16_t* O; int ldo; int pad;
    __device__ __forceinline__ void operator()(const f32x4 (&acc)[2][2][4][2], const Unit& u, int wr, int wc, int fr, int fq) const {
#pragma unroll
        for (int ai = 0; ai < 2; ++ai)
#pragma unroll
            for (int m = 0; m < 4; ++m) { int rowi_ = u.pm * BM + ai * HALF + wr * 64 + m * 16 + fr; asm volatile("" : "+v"(rowi_)); const size_t row = (size_t)rowi_;
#pragma unroll
                for (int bj = 0; bj < 2; ++bj) { const int c = u.pn * BM + bj * HALF + wc * 32 + 8 * fq; *(u32x4*)(O + row * ldo + c) = pack8(acc[ai][bj][m][0], acc[ai][bj][m][1], 1.f); } }
    }
};
struct __attribute__((packed, aligned(4))) F3 { float a, b, c; };
typedef float f32x2 __attribute__((ext_vector_type(2)));
struct EpiQup {
    static constexpr bool PERM = true, AFTER_DRAIN = false;
    bf16_t* Qb; const float* SSQ; const float* rope;
    __device__ __forceinline__ void operator()(const f32x4 (&acc)[2][2][4][2], const Unit& u, int wr, int wc, int fr, int fq) const {
        const int row0 = u.pm * BM + wr * 64 + fr;
        F3 part[2][4];
#pragma unroll
        for (int ai = 0; ai < 2; ++ai)
#pragma unroll
            for (int m = 0; m < 4; ++m) part[ai][m] = *(const F3*)(SSQ + (size_t)(row0 + ai * HALF + m * 16) * 20 + 3 * fq);
        const int cb0 = u.pn * BM + wc * 32;
        const bool rope0 = cb0 >= 768, rope1 = (cb0 + HALF >= 768) && (cb0 + HALF < 1152);
        f32x4 csA[4][2], csB[4][2];
        if (rope1 || rope0) {
#pragma unroll
            for (int m = 0; m < 4; ++m) { const float* rp = rope + (size_t)(row0 + m * 16) * 32 + 8 * fq; csA[m][0] = *(const f32x4*)rp; csA[m][1] = *(const f32x4*)(rp + 4); } }
        float sc[2][4];
#pragma unroll
        for (int ai = 0; ai < 2; ++ai)
#pragma unroll
            for (int m = 0; m < 4; ++m) sc[ai][m] = rsqrtf(quad_sum(part[ai][m].a + part[ai][m].b + part[ai][m].c) * (1.f / 384.f) + EPS) * QS_MLA;
        if (!(rope0 || rope1)) {
#pragma unroll
            for (int bj = 0; bj < 2; ++bj) { const int c = cb0 + bj * HALF + 8 * fq;
#pragma unroll
                for (int ai = 0; ai < 2; ++ai)
#pragma unroll
                    for (int m = 0; m < 4; ++m) *(u32x4*)(Qb + (size_t)(row0 + ai * HALF + m * 16) * 1152 + (c >> 6) * 96 + (c & 63)) = pack8(acc[ai][bj][m][0], acc[ai][bj][m][1], sc[ai][m]); }
            return; }
        u32x2 oA[4][2][2];
#pragma unroll
        for (int m = 0; m < 4; ++m) { if (rope0) rope_pair2(acc[0][0][m][0], acc[0][0][m][1], csA[m][0], csA[m][1], sc[0][m], oA[m][0][0], oA[m][0][1]);
            if (rope1) rope_pair2(acc[0][1][m][0], acc[0][1][m][1], csA[m][0], csA[m][1], sc[0][m], oA[m][1][0], oA[m][1][1]); }
#pragma unroll
        for (int m = 0; m < 4; ++m) { const float* rp = rope + (size_t)(row0 + HALF + m * 16) * 32 + 8 * fq; csB[m][0] = *(const f32x4*)rp; csB[m][1] = *(const f32x4*)(rp + 4); }
        asm volatile("" ::: "memory");
#pragma unroll
        for (int ai = 0; ai < 2; ++ai) {
#pragma unroll
            for (int m = 0; m < 4; ++m) { bf16_t* qrow = Qb + (size_t)(row0 + ai * HALF + m * 16) * 1152;
#pragma unroll
                for (int bj = 0; bj < 2; ++bj) { const int cb = cb0 + bj * HALF; const bool rp_ = bj == 0 ? rope0 : rope1;
                    if (rp_) { const int h = (cb - 768) >> 5; u32x2 o1, o2;
                        if (ai == 0) { o1 = oA[m][bj][0]; o2 = oA[m][bj][1]; } else rope_pair2(acc[1][bj][m][0], acc[1][bj][m][1], csB[m][0], csB[m][1], sc[1][m], o1, o2);
                        *(u32x2*)(qrow + h * 96 + 64 + 4 * fq) = o1; *(u32x2*)(qrow + h * 96 + 80 + 4 * fq) = o2; }
                    else if (cb < 768) { const int c = cb + 8 * fq; *(u32x4*)(qrow + (c >> 6) * 96 + (c & 63)) = pack8(acc[ai][bj][m][0], acc[ai][bj][m][1], sc[ai][m]); } } } }
    }
};
struct EpiKVup {
    static constexpr bool PERM = true, AFTER_DRAIN = false;
    bf16_t *Kb, *Vb; const float* SSQ;
    __device__ __forceinline__ void operator()(const f32x4 (&acc)[2][2][4][2], const Unit& u, int wr, int wc, int fr, int fq) const {
        const int row0 = u.pm * BM + wr * 64 + fr;
        f32x2 part[2][4];
#pragma unroll
        for (int ai = 0; ai < 2; ++ai)
#pragma unroll
            for (int m = 0; m < 4; ++m) part[ai][m] = *(const f32x2*)(SSQ + (size_t)(row0 + ai * HALF + m * 16) * 20 + 12 + 2 * fq);
        float sc[2][4];
#pragma unroll
        for (int ai = 0; ai < 2; ++ai)
#pragma unroll
            for (int m = 0; m < 4; ++m) sc[ai][m] = rsqrtf(quad_sum(part[ai][m][0] + part[ai][m][1]) * (1.f / 256.f) + EPS);
#pragma unroll
        for (int bj = 0; bj < 2; ++bj) { const int cb = u.pn * BM + bj * HALF + wc * 32, c = cb + 8 * fq;
#pragma unroll
            for (int ai = 0; ai < 2; ++ai)
#pragma unroll
                for (int m = 0; m < 4; ++m) { const size_t row = (size_t)(row0 + ai * HALF + m * 16); const u32x4 w = pack8(acc[ai][bj][m][0], acc[ai][bj][m][1], sc[ai][m]);
                    if (cb < 768) *(u32x4*)(Kb + row * 1152 + (c >> 6) * 96 + (c & 63)) = w; else *(u32x4*)(Vb + row * 768 + (c - 768)) = w; } }
    }
};
struct EpiOutA {
    static constexpr bool PERM = true, AFTER_DRAIN = false;
    const float* R; bf16_t* X1B; PG8_LAS float* rs;
    __device__ __forceinline__ void operator()(const f32x4 (&acc)[2][2][4][2], const Unit& u, int wr, int wc, int fr, int fq) const {
        const int c0 = u.pn * BM + wc * 32 + 8 * fq;
        u32x4 outw[2][4][2];
#pragma unroll
        for (int ai = 0; ai < 2; ++ai) { f32x4 res[4][2][2];
#pragma unroll
            for (int m = 0; m < 4; ++m) { const float* rp = R + (size_t)(u.pm * BM + ai * HALF + wr * 64 + m * 16 + fr) * 1024 + c0;
#pragma unroll
                for (int bj = 0; bj < 2; ++bj) { res[m][bj][0] = *(const f32x4*)(rp + bj * HALF); res[m][bj][1] = *(const f32x4*)(rp + bj * HALF + 4); } }
#pragma unroll
            for (int m = 0; m < 4; ++m) { const int rl = ai * HALF + wr * 64 + m * 16 + fr; float ssum = 0.f;
#pragma unroll
                for (int bj = 0; bj < 2; ++bj) { const f32x4 x0 = res[m][bj][0] + acc[ai][bj][m][0], x1 = res[m][bj][1] + acc[ai][bj][m][1];
                    outw[ai][m][bj] = pack8(x0, x1, 1.f); ssum += ss8(x0, x1); }
                ssum = quad_sum(ssum); if (fq == 0) rs[rl * 4 + wc] += ssum; }
            asm volatile("" ::: "memory"); }
#pragma unroll
        for (int ai = 0; ai < 2; ++ai)
#pragma unroll
            for (int m = 0; m < 4; ++m) { bf16_t* xp = X1B + (size_t)(u.pm * BM + ai * HALF + wr * 64 + m * 16 + fr) * 1024 + c0;
#pragma unroll
                for (int bj = 0; bj < 2; ++bj) *(u32x4*)(xp + bj * HALF) = outw[ai][m][bj]; }
    }
};
struct EpiOutB {
    static constexpr bool PERM = true, AFTER_DRAIN = false;
    bf16_t* X; PG8_LAS float* rs;
    __device__ __forceinline__ void operator()(const f32x4 (&acc)[2][2][4][2], const Unit& u, int wr, int wc, int fr, int fq) const {
        const int c0 = u.pn * BM + wc * 32 + 8 * fq;
        u32x4 res[2][4][2];
#pragma unroll
        for (int ai = 0; ai < 2; ++ai)
#pragma unroll
            for (int m = 0; m < 4; ++m) { const bf16_t* rp = X + (size_t)(u.pm * BM + ai * HALF + wr * 64 + m * 16 + fr) * 1024 + c0; res[ai][m][0] = *(const u32x4*)rp; res[ai][m][1] = *(const u32x4*)(rp + HALF); }
#pragma unroll
        for (int ai = 0; ai < 2; ++ai)
#pragma unroll
            for (int m = 0; m < 4; ++m) { const int rl = ai * HALF + wr * 64 + m * 16 + fr; bf16_t* xp = X + (size_t)(u.pm * BM + rl) * 1024 + c0; float ssum = 0.f;
#pragma unroll
                for (int bj = 0; bj < 2; ++bj) { const u32x4 r = res[ai][m][bj];
                    f32x4 x0, x1; x0[0] = __uint_as_float(r.x << 16); x0[1] = __uint_as_float(r.x & 0xffff0000u); x0[2] = __uint_as_float(r.y << 16); x0[3] = __uint_as_float(r.y & 0xffff0000u);
                    x1[0] = __uint_as_float(r.z << 16); x1[1] = __uint_as_float(r.z & 0xffff0000u); x1[2] = __uint_as_float(r.w << 16); x1[3] = __uint_as_float(r.w & 0xffff0000u);
                    x0 += acc[ai][bj][m][0]; x1 += acc[ai][bj][m][1];
                    *(u32x4*)(xp + bj * HALF) = pack8(x0, x1, 1.f); ssum += ss8(x0, x1); }
                ssum = quad_sum(ssum); if (fq == 0) rs[rl * 4 + wc] += ssum; }
    }
};
struct EpiIn1 {
    static constexpr bool PERM = true, AFTER_DRAIN = false;
    bf16_t *PQ, *QMEM, *SG; const float* RSTD;
    __device__ __forceinline__ void operator()(const f32x4 (&acc)[2][2][4][2], const Unit& u, int wr, int wc, int fr, int fq) const {
        const int row0 = u.pm * BM + wr * 64 + fr;
        float rr[2][4];
#pragma unroll
        for (int ai = 0; ai < 2; ++ai)
#pragma unroll
            for (int m = 0; m < 4; ++m) rr[ai][m] = RSTD[row0 + ai * HALF + m * 16];
#pragma unroll
        for (int ai = 0; ai < 2; ++ai)
#pragma unroll
            for (int m = 0; m < 4; ++m) { const int rowi = row0 + ai * HALF + m * 16; const size_t row = (size_t)rowi; const float r = rr[ai][m];
                const int b = rowi >> 12, sq = rowi & 4095, s1 = sq >> 6, s2 = sq & 63; const size_t prow = ((size_t)(b * 64 + s1) * 2) * 64 + s2;
#pragma unroll
                for (int bj = 0; bj < 2; ++bj) { const int cb = u.pn * BM + bj * HALF + wc * 32, c = cb + 8 * fq; const f32x4 v0 = acc[ai][bj][m][0], v1 = acc[ai][bj][m][1];
                    if (cb < 1536) { const int pq = cb >= 768 ? 1 : 0; *(u32x4*)(PQ + (prow + pq * 64) * 768 + (c - pq * 768)) = pack8(v0, v1, r); }
                    else if (cb < 1792) *(u32x4*)(QMEM + row * 256 + (c - 1536)) = pack8(v0, v1, r * QS_MEM);
                    else *(u32x4*)(SG + row * 1024 + (c - 1792)) = pack8(silu4(v0 * r), silu4(v1 * r), 1.f); } }
    }
};
struct PanelOrder {
    int nM, G, c;
    __device__ void init(int M, int G_, int c_) { nM = M / BM; G = G_; c = c_; }
    __device__ bool next(int i, Unit& u) const { u.pm = c + G * (i >> 2); u.pn = i & 3; return u.pm < nM; }
    __device__ __forceinline__ void a_ready(const Unit&) const {}
    __device__ __forceinline__ void done(const Unit&) const {}
};
template <class Epi, class Sched, bool ALIGN_EPI = false, bool SP2 = false>
__device__ __forceinline__ void gemm_phase(PG8_LAS unsigned char* lds, const Gemm g, const Sched& S, const Epi& E) {
    const int tid = threadIdx.x, wid = __builtin_amdgcn_readfirstlane(tid >> 6), lane = tid & 63, wr = wid >> 2, wc = wid & 3, fr = lane & 15, fq = lane >> 4;
    const int K = g.K, nt = K / BK;
    unsigned voffA[2], voffB[2];
#pragma unroll
    for (int i = 0; i < 2; ++i) { int R, C; stage_rc(tid * 16 + i * 8192, R, C); const int Rb = Epi::PERM ? ((R & ~31) + perm32(R & 31)) : R;
        voffA[i] = (unsigned)(R * K + C) * 2u; voffB[i] = (unsigned)(Rb * K + C) * 2u; }
    const size_t kstep = (size_t)(BK * 2);
    const size_t hstep = (size_t)HALF * K * 2;
    const size_t tstep = 2 * hstep;
    const unsigned ldsw = (unsigned)wid * 1024u;
    const int aoff = lds_byte(wr * 64 + fr, fq * 8), boff = lds_byte(wc * 32 + fr, fq * 8);
#define PG8_SA(b, h) (((b) * 2 + (h)) * HTB)
#define PG8_SB(b, h) ((4 + (b) * 2 + (h)) * HTB)
#define PG8_STAGE(bufoff, gbase, voff) do { _Pragma("unroll") for (int _i = 0; _i < 2; ++_i) \
        __builtin_amdgcn_global_load_lds((const unsigned*)((const char*)(gbase) + (voff)[_i]), (PG8_LAS unsigned*)(lds + (bufoff) + ldsw + _i * 8192), 16, 0, 0); } while (0)
#define PG8_LDA(dst, b, h) do { _Pragma("unroll") for (int m = 0; m < 4; ++m) _Pragma("unroll") for (int k = 0; k < 2; ++k) dst[m][k] = *(const PG8_LAS bf16x8*)(lds + PG8_SA(b, h) + aoff + m * 2048 + k * 1024); } while (0)
#define PG8_LDB(dst, b, h) do { _Pragma("unroll") for (int n = 0; n < 2; ++n) _Pragma("unroll") for (int k = 0; k < 2; ++k) dst[n][k] = *(const PG8_LAS bf16x8*)(lds + PG8_SB(b, h) + boff + n * 2048 + k * 1024); } while (0)
#define PG8_MMA(ai, bj, At, Bt) do { __builtin_amdgcn_s_setprio(1); _Pragma("unroll") for (int m = 0; m < 4; ++m) _Pragma("unroll") for (int n = 0; n < 2; ++n) _Pragma("unroll") for (int k = 0; k < 2; ++k) \
        acc[ai][bj][m][n] = __builtin_amdgcn_mfma_f32_16x16x32_bf16(Bt[n][k], At[m][k], acc[ai][bj][m][n], 0, 0, 0); __builtin_amdgcn_s_setprio(0); } while (0)
#define PG8_WAIT_V(n) asm volatile("s_waitcnt vmcnt(" #n ")" ::: "memory")
#define PG8_WAIT_L(n) asm volatile("s_waitcnt lgkmcnt(" #n ")" ::: "memory")
#define PG8_BAR __builtin_amdgcn_s_barrier()
#define PG8_SCHED __builtin_amdgcn_sched_barrier(0)
    Unit cur, nxt; int ui = 0;
    if (!S.next(0, cur)) return;
    f32x4 acc[2][2][4][2];
#pragma unroll
    for (int a = 0; a < 2; ++a)
#pragma unroll
        for (int b = 0; b < 2; ++b)
#pragma unroll
            for (int m = 0; m < 4; ++m)
#pragma unroll
                for (int n = 0; n < 2; ++n) acc[a][b][m][n] = (f32x4){0.f, 0.f, 0.f, 0.f};
    bf16x8 At[4][2], B0[2][2], B1[2][2];
    const char* cA = (const char*)g.A + (size_t)cur.pm * tstep; const char* cB = (const char*)g.Bt + (size_t)cur.pn * tstep;
    S.a_ready(cur);
    if constexpr (SP2) {
        PG8_STAGE(PG8_SB(0, 0), cB, voffB); PG8_STAGE(PG8_SB(0, 1), cB + hstep, voffB); PG8_STAGE(PG8_SA(0, 0), cA, voffA); PG8_STAGE(PG8_SA(0, 1), cA + hstep, voffA);
        if (wr == 1) PG8_BAR;
        PG8_WAIT_V(2); PG8_BAR;
        PG8_STAGE(PG8_SB(1, 0), cB + kstep, voffB); PG8_STAGE(PG8_SA(1, 0), cA + kstep, voffA); PG8_STAGE(PG8_SB(1, 1), cB + hstep + kstep, voffB);
        PG8_WAIT_V(6); PG8_BAR;
    } else {
        PG8_STAGE(PG8_SB(0, 0), cB, voffB); PG8_STAGE(PG8_SA(0, 0), cA, voffA); PG8_STAGE(PG8_SB(0, 1), cB + hstep, voffB); PG8_STAGE(PG8_SA(0, 1), cA + hstep, voffA);
        if (wr == 1) PG8_BAR;
        PG8_WAIT_V(4); PG8_BAR;
        PG8_STAGE(PG8_SB(1, 0), cB + kstep, voffB); PG8_STAGE(PG8_SA(1, 0), cA + kstep, voffA); PG8_STAGE(PG8_SB(1, 1), cB + hstep + kstep, voffB);
        PG8_WAIT_V(6); PG8_BAR;
    }
    for (;;) {
        const bool has_next = S.next(ui + 1, nxt);
        const char* nA = has_next ? (const char*)g.A + (size_t)nxt.pm * tstep : cA; const char* nB = has_next ? (const char*)g.Bt + (size_t)nxt.pn * tstep : cB;
        for (int t = 0; t < nt; t += 2) {
            const bool last = (t == nt - 2);
            const char* a1 = cA + (size_t)(t + 1) * kstep;
            const char* a2 = last ? nA : cA + (size_t)(t + 2) * kstep; const char* b2 = last ? nB : cB + (size_t)(t + 2) * kstep;
            const char* a3 = a2 + kstep; const char* b3 = b2 + kstep;
            if (last && has_next) S.a_ready(nxt);
            if constexpr (SP2) {
            PG8_LDB(B0, 0, 0); PG8_LDB(B1, 0, 1); PG8_SCHED; PG8_LDA(At, 0, 0); PG8_STAGE(PG8_SA(1, 1), a1 + hstep, voffA);
            PG8_WAIT_V(8); PG8_WAIT_L(0); PG8_BAR; PG8_MMA(0, 0, At, B0); PG8_MMA(0, 1, At, B1); PG8_BAR; PG8_SCHED;
            PG8_LDA(At, 0, 1); PG8_STAGE(PG8_SB(0, 0), b2, voffB); PG8_STAGE(PG8_SB(0, 1), b2 + hstep, voffB); PG8_STAGE(PG8_SA(0, 0), a2, voffA);
            PG8_WAIT_V(8); PG8_WAIT_L(0); PG8_BAR; PG8_MMA(1, 0, At, B0); PG8_MMA(1, 1, At, B1); PG8_BAR; PG8_SCHED;
            PG8_LDB(B0, 1, 0); PG8_LDB(B1, 1, 1); PG8_SCHED; PG8_LDA(At, 1, 0); PG8_STAGE(PG8_SA(0, 1), a2 + hstep, voffA);
            PG8_WAIT_V(8); PG8_WAIT_L(0); PG8_BAR; PG8_MMA(0, 0, At, B0); PG8_MMA(0, 1, At, B1); PG8_BAR; PG8_SCHED;
            PG8_LDA(At, 1, 1); PG8_STAGE(PG8_SB(1, 0), b3, voffB); PG8_STAGE(PG8_SB(1, 1), b3 + hstep, voffB); PG8_STAGE(PG8_SA(1, 0), a3, voffA);
            PG8_WAIT_V(8); PG8_WAIT_L(0); PG8_BAR; PG8_MMA(1, 0, At, B0); PG8_MMA(1, 1, At, B1); PG8_BAR; PG8_SCHED;
            } else {
            PG8_LDB(B0, 0, 0); PG8_SCHED; PG8_LDA(At, 0, 0); PG8_STAGE(PG8_SA(1, 1), a1 + hstep, voffA);
            PG8_WAIT_L(8); PG8_BAR; PG8_WAIT_L(0); PG8_MMA(0, 0, At, B0); PG8_BAR; PG8_SCHED;
            PG8_LDB(B1, 0, 1); PG8_STAGE(PG8_SB(0, 0), b2, voffB);
            PG8_BAR; PG8_WAIT_L(0); PG8_MMA(0, 1, At, B1); PG8_BAR;
            PG8_LDA(At, 0, 1); PG8_STAGE(PG8_SA(0, 0), a2, voffA);
            PG8_BAR; PG8_WAIT_L(0); PG8_MMA(1, 0, At, B0); PG8_BAR; PG8_SCHED;
            PG8_STAGE(PG8_SB(0, 1), b2 + hstep, voffB);
            PG8_WAIT_V(6); PG8_BAR; PG8_MMA(1, 1, At, B1); PG8_BAR;
            PG8_LDB(B0, 1, 0); PG8_SCHED; PG8_LDA(At, 1, 0); PG8_STAGE(PG8_SA(0, 1), a2 + hstep, voffA);
            PG8_WAIT_L(8); PG8_BAR; PG8_WAIT_L(0); PG8_MMA(0, 0, At, B0); PG8_BAR; PG8_SCHED;
            PG8_LDB(B1, 1, 1); PG8_STAGE(PG8_SB(1, 0), b3, voffB);
            PG8_BAR; PG8_WAIT_L(0); PG8_MMA(0, 1, At, B1); PG8_BAR;
            PG8_LDA(At, 1, 1); PG8_STAGE(PG8_SA(1, 0), a3, voffA);
            PG8_BAR; PG8_WAIT_L(0); PG8_MMA(1, 0, At, B0); PG8_BAR; PG8_SCHED;
            PG8_STAGE(PG8_SB(1, 1), b3 + hstep, voffB);
            PG8_WAIT_V(6); PG8_BAR; PG8_MMA(1, 1, At, B1); PG8_BAR;
            }
        }
        if constexpr (ALIGN_EPI) { if (wr == 0) PG8_BAR; }
        if constexpr (!Epi::AFTER_DRAIN) { E(acc, cur, wr, wc, fr, fq); S.done(cur); }
        if (!has_next) break;
#pragma unroll
        for (int a = 0; a < 2; ++a)
#pragma unroll
            for (int b = 0; b < 2; ++b)
#pragma unroll
                for (int m = 0; m < 4; ++m)
#pragma unroll
                    for (int n = 0; n < 2; ++n) acc[a][b][m][n] = (f32x4){0.f, 0.f, 0.f, 0.f};
        cur = nxt; cA = nA; cB = nB; ++ui;
        if constexpr (ALIGN_EPI) { if (wr == 1) PG8_BAR; }
    }
    PG8_WAIT_V(0);
    if constexpr (!ALIGN_EPI) { if (wr == 0) PG8_BAR; }
    PG8_BAR;
    if constexpr (Epi::AFTER_DRAIN) { E.fused(acc, cur, wr, wc, fr, fq, lds, wid, lane); S.done(cur); }
#undef PG8_SA
#undef PG8_SB
#undef PG8_STAGE
#undef PG8_LDA
#undef PG8_LDB
#undef PG8_MMA
#undef PG8_WAIT_V
#undef PG8_WAIT_L
#undef PG8_BAR
#undef PG8_SCHED
}
}
#define GAS __attribute__((address_space(1)))
#define LAS __attribute__((address_space(3)))
typedef unsigned short bf16;
typedef unsigned v4u __attribute__((ext_vector_type(4)));
typedef float f32x4 __attribute__((ext_vector_type(4)));
typedef short bf16x8 __attribute__((ext_vector_type(8)));
typedef GAS unsigned gu32;
typedef GAS unsigned long long gu64;
#define RLX_AGENT __ATOMIC_RELAXED, __HIP_MEMORY_SCOPE_AGENT
#define LDS_WAIT() asm volatile("s_waitcnt lgkmcnt(0)" ::: "memory")
#define VM_WAIT() asm volatile("s_waitcnt vmcnt(0)" ::: "memory")
__device__ __forceinline__ unsigned long long rt() { return __builtin_amdgcn_s_memrealtime(); }
#define XB_TMO      128
#define XB_XCNT(j)  (256  + 64 * (j))
#define XB_XSUB(j)  (1280 + 64 * (j))
#define XB_XGEN(j)  (2304 + 64 * (j))
#define XB_TOP      3328
#define XB_TOPGEN   3392
#define XCD_BAR_WORDS 3456
#define XB_SPIN_CAP (1u << 18)

__device__ __forceinline__ unsigned xb_ld(unsigned* p)              { return __hip_atomic_load(p, __ATOMIC_RELAXED, __HIP_MEMORY_SCOPE_AGENT); }
__device__ __forceinline__ unsigned xb_add(unsigned* p, unsigned v) { return __hip_atomic_fetch_add(p, v, __ATOMIC_RELAXED, __HIP_MEMORY_SCOPE_AGENT); }
__device__ __forceinline__ unsigned xb_xcc_id() { return (unsigned)__builtin_amdgcn_s_getreg((3 << 11) | 20) & 0xFu; }
#define XB_SPIN(cond, bar) do { unsigned _sp = 0; while (cond) { __builtin_amdgcn_s_sleep(1); \
    if ((++_sp & 255u) == 0u) { if (xb_ld(&(bar)[XB_TMO])) break; if (_sp > XB_SPIN_CAP) { atomicAdd(&(bar)[XB_TMO], 1u); break; } } } } while (0)

struct XcdBarrier {
    unsigned* bar; unsigned x;
    volatile LAS unsigned* st;
};

__device__ __forceinline__ XcdBarrier xcd_barrier_post(unsigned* bar, volatile LAS unsigned* st) {
    XcdBarrier b; b.bar = bar; b.x = xb_xcc_id(); b.st = st;
    if (threadIdx.x == 0) (void)xb_add(&bar[XB_XCNT(b.x)], 1u);
    return b;
}
__device__ __forceinline__ void xcd_barrier_complete(unsigned* bar, unsigned x, unsigned& nloc, unsigned& nx) {
    const unsigned G = gridDim.x * gridDim.y * gridDim.z;
    unsigned sum, cnt, mine, sp = 0u;
    for (;;) {
        sum = 0u; cnt = 0u; mine = 0u;
#pragma unroll
        for (unsigned j = 0; j < 16; ++j) { const unsigned c = xb_ld(&bar[XB_XCNT(j)]); sum += c; cnt += (c > 0u) ? 1u : 0u; mine = (j == x) ? c : mine; }
        if (sum == G) break;
        __builtin_amdgcn_s_sleep(1);
        if ((++sp & 255u) == 0u) { if (xb_ld(&bar[XB_TMO])) break; if (sp > XB_SPIN_CAP) { atomicAdd(&bar[XB_TMO], 1u); break; } }
    }
    nloc = mine > 0u ? mine : 1u; nx = cnt > 0u ? cnt : 1u;
}

__device__ __forceinline__ void xcd_barrier(const XcdBarrier& b) {
    asm volatile("s_waitcnt vmcnt(0)" ::: "memory");
    __syncthreads();
    if (threadIdx.x == 0) {
        unsigned* bar = b.bar;
        __builtin_amdgcn_s_waitcnt(0);
        unsigned nloc = b.st[0], nx = b.st[1];
        if (nloc == 0u) { xcd_barrier_complete(bar, b.x, nloc, nx); b.st[0] = nloc; b.st[1] = nx; }
        const unsigned old = xb_add(&bar[XB_XSUB(b.x)], 1u);
        const unsigned gen = old / nloc;
        if (old + 1u == (gen + 1u) * nloc) {
            __builtin_amdgcn_fence(__ATOMIC_RELEASE, "agent");
            asm volatile("s_waitcnt vmcnt(0)" ::: "memory");
            const unsigned og = xb_add(&bar[XB_TOP], 1u);
            const unsigned tg = og / nx;
            if (og + 1u == (tg + 1u) * nx) xb_add(&bar[XB_TOPGEN], 1u);
            else XB_SPIN(xb_ld(&bar[XB_TOPGEN]) == tg, bar);
            __builtin_amdgcn_fence(__ATOMIC_ACQUIRE, "agent");
            xb_add(&bar[XB_XGEN(b.x)], 1u);
            asm volatile("s_waitcnt vmcnt(0)" ::: "memory");
        } else {
            XB_SPIN(xb_ld(&bar[XB_XGEN(b.x)]) == gen, bar);
            __builtin_amdgcn_fence(__ATOMIC_ACQUIRE, "agent");
            asm volatile("s_waitcnt vmcnt(0)" ::: "memory");
        }
    }
    __syncthreads();
}
namespace att {
using bf16x8 = __attribute__((ext_vector_type(8))) short;
using s16x4  = __attribute__((ext_vector_type(4))) short;
using f32x16 = __attribute__((ext_vector_type(16))) float;
using f32x4v = __attribute__((ext_vector_type(4))) float;
using u32x4  = __attribute__((ext_vector_type(4))) unsigned;
constexpr int NW = 8, QBLK = 32, KVBLK = 64;
constexpr float THRL = 6.f;
#define ASBAR() __builtin_amdgcn_sched_barrier(0)
__device__ __forceinline__ int crow(int r, int hi) { return (r & 3) + 8 * (r >> 2) + 4 * hi; }
__device__ __forceinline__ unsigned cvtpk(float lo, float hi) { unsigned r; asm volatile("v_cvt_pk_bf16_f32 %0, %1, %2" : "=v"(r) : "v"(lo), "v"(hi)); return r; }
template <int DQK> struct Cfg {
    static constexpr int KROW = DQK * 2 + 16;
    static constexpr int SHM_V = 8192, SHM_K = 64 * KROW;
    static constexpr int OFF_V = 0, OFF_K = 2 * SHM_V, OFF_WS = OFF_K + 2 * SHM_K, OFF_OST = OFF_WS + NW * 256, OSTW = 32 * 68 * 4, END = OFF_OST + NW * OSTW;
    static constexpr int KCH = DQK / 8;
};
__device__ __forceinline__ void partialSM(f32x16& p0, f32x16& p1, float& m_reg, float& mn, float& alpha) {
    float pmax = p0[0];
#pragma unroll
    for (int r = 1; r < 16; ++r) pmax = fmaxf(pmax, p0[r]);
#pragma unroll
    for (int r = 0; r < 16; ++r) pmax = fmaxf(pmax, p1[r]);
    { auto rr = __builtin_amdgcn_permlane32_swap(__float_as_uint(pmax), __float_as_uint(pmax), false, false); pmax = fmaxf(__uint_as_float(rr[0]), __uint_as_float(rr[1])); }
    if (__builtin_expect(__all(pmax - m_reg <= THRL), 1)) { mn = m_reg; alpha = 1.f; }
    else { mn = fmaxf(m_reg, pmax); alpha = __builtin_amdgcn_exp2f(m_reg - mn); m_reg = mn; }
#pragma unroll
    for (int r = 0; r < 16; ++r) p0[r] -= mn;
#pragma unroll
    for (int r = 0; r < 16; ++r) p1[r] -= mn;
#pragma unroll
    for (int r = 0; r < 16; ++r) p0[r] = __builtin_amdgcn_exp2f(p0[r]);
}
__device__ __forceinline__ void finishSM(f32x16& p0, f32x16& p1, float alpha, float& l_reg, bf16x8& pa0, bf16x8& pa1, bf16x8& pa2, bf16x8& pa3) {
#pragma unroll
    for (int r = 0; r < 16; ++r) p1[r] = __builtin_amdgcn_exp2f(p1[r]);
    float ps = 0;
#pragma unroll
    for (int r = 0; r < 16; ++r) ps += p0[r];
#pragma unroll
    for (int r = 0; r < 16; ++r) ps += p1[r];
    { auto rr = __builtin_amdgcn_permlane32_swap(__float_as_uint(ps), __float_as_uint(ps), false, false); ps = __uint_as_float(rr[0]) + __uint_as_float(rr[1]); }
    l_reg = l_reg * alpha + ps;
#define ATT_PK4(P, BASE, OUT) do { unsigned a0 = cvtpk(P[BASE + 0], P[BASE + 1]), a1 = cvtpk(P[BASE + 2], P[BASE + 3]);   \
    unsigned b0 = cvtpk(P[BASE + 4], P[BASE + 5]), b1 = cvtpk(P[BASE + 6], P[BASE + 7]);                              \
    auto r0 = __builtin_amdgcn_permlane32_swap(a0, b0, false, false); auto r1 = __builtin_amdgcn_permlane32_swap(a1, b1, false, false); \
    u32x4 w = {r0[0], r1[0], r0[1], r1[1]}; OUT = *reinterpret_cast<bf16x8*>(&w); } while (0)
    ATT_PK4(p0, 0, pa0); ATT_PK4(p0, 8, pa1); ATT_PK4(p1, 0, pa2); ATT_PK4(p1, 8, pa3);
#undef ATT_PK4
}
template <int DQK> __device__ __forceinline__ void qkt(f32x16& p0, f32x16& p1, const char* Ks, const bf16x8* qr, int r32, int hi) {
    constexpr int KROW = Cfg<DQK>::KROW;
    p0 = f32x16{}; p1 = f32x16{};
#pragma unroll
    for (int d0 = 0; d0 < DQK / 16; ++d0) { const int cb = (d0 * 16 + hi * 8) * 2;
        const bf16x8 b0 = *reinterpret_cast<const bf16x8*>(Ks + r32 * KROW + cb);
        const bf16x8 b1 = *reinterpret_cast<const bf16x8*>(Ks + (32 + r32) * KROW + cb);
        p0 = __builtin_amdgcn_mfma_f32_32x32x16_bf16(b0, qr[d0], p0, 0, 0, 0);
        p1 = __builtin_amdgcn_mfma_f32_32x32x16_bf16(b1, qr[d0], p1, 0, 0, 0); }
}
__device__ __forceinline__ int v_st(int k, int c) { const int kk = (k & ~0xC) | ((k & 4) << 1) | ((k & 8) >> 1); return ((kk >> 3) * 2 + (c >> 5)) * 512 + ((kk & 7) * 32 + (c & 31)) * 2; }
__device__ __forceinline__ int v_rd_base(int lane) { return ((lane & 3) << 3) | (((lane >> 2) & 3) << 6) | (((lane >> 4) & 1) << 5) | (((lane >> 5) & 1) << 8); }
constexpr int v_rd_off(int d0, int ks, int half) { return d0 * 512 + ks * 2048 + half * 1024; }
template <int OFF> __device__ __forceinline__ s16x4 tr_read(int vb) { s16x4 r; asm volatile("ds_read_b64_tr_b16 %0, %1 offset:%2" : "=&v"(r) : "v"(vb), "i"(OFF) : "memory"); return r; }
template <int D0> __device__ __forceinline__ void pv_one(f32x16& od, int vb, bf16x8 pa0, bf16x8 pa1, bf16x8 pa2, bf16x8 pa3) {
    const s16x4 l0 = tr_read<v_rd_off(D0, 0, 0)>(vb), h0 = tr_read<v_rd_off(D0, 0, 1)>(vb), l1 = tr_read<v_rd_off(D0, 1, 0)>(vb), h1 = tr_read<v_rd_off(D0, 1, 1)>(vb);
    const s16x4 l2 = tr_read<v_rd_off(D0, 2, 0)>(vb), h2 = tr_read<v_rd_off(D0, 2, 1)>(vb), l3 = tr_read<v_rd_off(D0, 3, 0)>(vb), h3 = tr_read<v_rd_off(D0, 3, 1)>(vb);
    asm volatile("s_waitcnt lgkmcnt(0)" ::: "memory"); ASBAR();
#define ATT_PK(L, H) (bf16x8){L[0], L[1], L[2], L[3], H[0], H[1], H[2], H[3]}
    od = __builtin_amdgcn_mfma_f32_32x32x16_bf16(pa0, ATT_PK(l0, h0), od, 0, 0, 0);
    od = __builtin_amdgcn_mfma_f32_32x32x16_bf16(pa1, ATT_PK(l1, h1), od, 0, 0, 0);
    od = __builtin_amdgcn_mfma_f32_32x32x16_bf16(pa2, ATT_PK(l2, h2), od, 0, 0, 0);
    od = __builtin_amdgcn_mfma_f32_32x32x16_bf16(pa3, ATT_PK(l3, h3), od, 0, 0, 0);
#undef ATT_PK
}
__device__ __forceinline__ void pv_d0(f32x16* o, int vb, bf16x8 pa0, bf16x8 pa1, bf16x8 pa2, bf16x8 pa3) { pv_one<0>(o[0], vb, pa0, pa1, pa2, pa3); pv_one<1>(o[1], vb, pa0, pa1, pa2, pa3); }

__device__ __forceinline__ float rowmax32(const f32x16& p0, const f32x16& p1) {
#define ATT_MX3(a, b, c) __builtin_fmaxf(__builtin_fmaxf((a), (b)), (c))
    float a = ATT_MX3(p0[0], p0[1], p1[0]), b = ATT_MX3(p0[2], p0[3], p1[1]); a = ATT_MX3(a, p1[2], p1[3]);
#pragma unroll
    for (int r = 4; r < 16; r += 4) { a = ATT_MX3(a, p0[r], p0[r + 1]); b = ATT_MX3(b, p0[r + 2], p0[r + 3]); a = ATT_MX3(a, p1[r], p1[r + 1]); b = ATT_MX3(b, p1[r + 2], p1[r + 3]); }
#undef ATT_MX3
    float m = __builtin_fmaxf(a, b);
    auto rr = __builtin_amdgcn_permlane32_swap(__float_as_uint(m), __float_as_uint(m), false, false);
    return __builtin_fmaxf(__uint_as_float(rr[0]), __uint_as_float(rr[1]));
}
#ifndef ATT_NEGM
#define ATT_NEGM 1
#endif
template <bool FIRST> __device__ __forceinline__ void partialSM2(f32x16& p0, f32x16& p1, float& mhat, f32x16& negm, float& alpha) {
#if !ATT_NEGM
    float pmax = rowmax32(p0, p1) - mhat; alpha = 1.f;
    if (FIRST || __builtin_expect(__any(pmax > THRL), 0)) { const float dl = FIRST ? pmax : __builtin_fmaxf(pmax, 0.f); mhat += dl; if (!FIRST) alpha = __builtin_amdgcn_exp2f(-dl); }
    _Pragma("unroll") for (int r = 0; r < 16; ++r) { p0[r] -= mhat; p1[r] -= mhat; }
    _Pragma("unroll") for (int r = 0; r < 16; ++r) p0[r] = __builtin_amdgcn_exp2f(p0[r]);
    return;
#else
    const float pmax = rowmax32(p0, p1);
    alpha = 1.f;
    if (FIRST || __builtin_expect(__any(pmax > THRL), 0)) { const float dl = FIRST ? pmax : __builtin_fmaxf(pmax, 0.f); mhat += dl;
#pragma unroll
        for (int r = 0; r < 16; ++r) { p0[r] -= dl; p1[r] -= dl; }
#pragma unroll
        for (int r = 0; r < 16; ++r) negm[r] = -mhat;
        if (!FIRST) alpha = __builtin_amdgcn_exp2f(-dl); }
#pragma unroll
    for (int r = 0; r < 16; ++r) p0[r] = __builtin_amdgcn_exp2f(p0[r]);
#endif
}
template <int DQK> __device__ __forceinline__ void qkt2(f32x16& p0, f32x16& p1, const char* Ks, const bf16x8* qr, const f32x16& negm, int r32, int hi) {
    constexpr int KROW = Cfg<DQK>::KROW;
#pragma unroll
    for (int d0 = 0; d0 < DQK / 16; ++d0) { const int cb = (d0 * 16 + hi * 8) * 2;
        const bf16x8 b0 = *reinterpret_cast<const bf16x8*>(Ks + r32 * KROW + cb);
        const bf16x8 b1 = *reinterpret_cast<const bf16x8*>(Ks + (32 + r32) * KROW + cb);
#if ATT_NEGM
        if (d0 == 0) { p0 = __builtin_amdgcn_mfma_f32_32x32x16_bf16(b0, qr[0], negm, 0, 0, 0); p1 = __builtin_amdgcn_mfma_f32_32x32x16_bf16(b1, qr[0], negm, 0, 0, 0); }
#else
        if (d0 == 0) { p0 = __builtin_amdgcn_mfma_f32_32x32x16_bf16(b0, qr[0], f32x16{}, 0, 0, 0); p1 = __builtin_amdgcn_mfma_f32_32x32x16_bf16(b1, qr[0], f32x16{}, 0, 0, 0); }
#endif
        else { p0 = __builtin_amdgcn_mfma_f32_32x32x16_bf16(b0, qr[d0], p0, 0, 0, 0); p1 = __builtin_amdgcn_mfma_f32_32x32x16_bf16(b1, qr[d0], p1, 0, 0, 0); } }
}
template <int DQK> struct Cfg2 {
    static constexpr int KROW = DQK * 2 + 16, SHM_V = 8192, SHM_K = 64 * KROW;
    static constexpr int OFF_V = 0, OFF_K = 3 * SHM_V, OFF_WS = OFF_K + 2 * SHM_K, OFF_OST = OFF_WS + NW * 256, OSTW = 32 * 68 * 4, END = OFF_OST + NW * OSTW;
};
__device__ __forceinline__ float softmax_tile(f32x16& p0, f32x16& p1, float& mhat, f32x16& negm, float& l_reg, bool first, bf16x8& pa0, bf16x8& pa1, bf16x8& pa2, bf16x8& pa3) {
    const float pmax = rowmax32(p0, p1);
    float alpha = 1.f;
    if (__builtin_expect(first || __any(pmax > THRL), 0)) { const float dl = first ? pmax : __builtin_fmaxf(pmax, 0.f); mhat += dl;
#pragma unroll
        for (int r = 0; r < 16; ++r) { p0[r] -= dl; p1[r] -= dl; }
#pragma unroll
        for (int r = 0; r < 16; ++r) negm[r] = -mhat;
        if (!first) alpha = __builtin_amdgcn_exp2f(-dl); }
#pragma unroll
    for (int r = 0; r < 16; ++r) { p0[r] = __builtin_amdgcn_exp2f(p0[r]); p1[r] = __builtin_amdgcn_exp2f(p1[r]); }
    float ps = 0;
#pragma unroll
    for (int r = 0; r < 16; ++r) ps += p0[r];
#pragma unroll
    for (int r = 0; r < 16; ++r) ps += p1[r];
    { auto rr = __builtin_amdgcn_permlane32_swap(__float_as_uint(ps), __float_as_uint(ps), false, false); ps = __uint_as_float(rr[0]) + __uint_as_float(rr[1]); }
    l_reg = l_reg * alpha + ps;
#define ATT_PK4(P, BASE, OUT) do { unsigned a0 = cvtpk(P[BASE + 0], P[BASE + 1]), a1 = cvtpk(P[BASE + 2], P[BASE + 3]);   \
    unsigned b0 = cvtpk(P[BASE + 4], P[BASE + 5]), b1 = cvtpk(P[BASE + 6], P[BASE + 7]);                              \
    auto r0 = __builtin_amdgcn_permlane32_swap(a0, b0, false, false); auto r1 = __builtin_amdgcn_permlane32_swap(a1, b1, false, false); \
    u32x4 w = {r0[0], r1[0], r0[1], r1[1]}; OUT = *reinterpret_cast<bf16x8*>(&w); } while (0)
    ATT_PK4(p0, 0, pa0); ATT_PK4(p0, 8, pa1); ATT_PK4(p1, 0, pa2); ATT_PK4(p1, 8, pa3);
#undef ATT_PK4
    return alpha;
}
template <int DQK>
__device__ __forceinline__ void attn_unit(const bf16_t* __restrict__ Qb, int ldq, const bf16_t* __restrict__ Kh, int ldk, const bf16_t* __restrict__ Vh, int ldv, int seq,
                                          bf16_t* __restrict__ Ob, const bf16_t* __restrict__ Gb, char* lds) {
    using C = Cfg2<DQK>;
    constexpr int KROW = C::KROW, KCH = DQK / 8, SHM_V = C::SHM_V, SHM_K = C::SHM_K;
    const int tid = threadIdx.x, wid = __builtin_amdgcn_readfirstlane(tid >> 6), lane = tid & 63, r32 = lane & 31, hi = lane >> 5; const bool h1 = wid >= 4;
    char* V_lds = lds + C::OFF_V; char* K_lds = lds + C::OFF_K;
    float* ws = (float*)(lds + C::OFF_WS) + wid * 64; float* li_l = ws; float* al_l = ws + 32;
    float mhat = 0.f, l_reg = 0.f; f32x16 o[2] = {}; f32x16 negm = {}; bf16x8 qr[DQK / 16];
    const bf16_t* Qw = Qb + (size_t)(wid * QBLK + r32) * ldq + hi * 8;
#pragma unroll
    for (int d0 = 0; d0 < DQK / 16; ++d0) qr[d0] = *reinterpret_cast<const bf16x8*>(Qw + d0 * 16);
    const int vk = tid >> 3, vc = (tid & 7) * 8, vst = v_st(vk, vc);
    const int kr0 = tid / KCH, kc0 = (tid % KCH) * 8, kr1 = (512 + tid) / KCH, kc1 = ((512 + tid) % KCH) * 8;
    const bool two = (KCH * 64 > 512) && (tid < KCH * 64 - 512);
    const int vb0 = (int)(uintptr_t)V_lds + v_rd_base(lane);
    bf16x8 s_vs, s_k0, s_k1;
#define ATT_SLOAD(k0) do { s_vs = *reinterpret_cast<const bf16x8*>(Vh + (size_t)((k0) + vk) * ldv + vc); \
    s_k0 = *reinterpret_cast<const bf16x8*>(Kh + (size_t)((k0) + kr0) * ldk + kc0); \
    if (two) s_k1 = *reinterpret_cast<const bf16x8*>(Kh + (size_t)((k0) + kr1) * ldk + kc1); } while (0)
#define ATT_SWRITE(kb, vs) do { *(bf16x8*)(V_lds + (vs) + vst) = s_vs; *(bf16x8*)(K_lds + (kb) * SHM_K + kr0 * KROW + kc0 * 2) = s_k0; \
    if (two) *(bf16x8*)(K_lds + (kb) * SHM_K + kr1 * KROW + kc1 * 2) = s_k1; } while (0)
#define ATT_RESC(a) do { if (__any((a) < 1.f)) { if (hi == 0) al_l[r32] = (a); asm volatile("s_waitcnt lgkmcnt(0)" ::: "memory"); \
    _Pragma("unroll") for (int d = 0; d < 2; ++d) _Pragma("unroll") for (int r = 0; r < 16; ++r) o[d][r] *= al_l[crow(r, hi)]; } } while (0)
    f32x16 p0, p1; bf16x8 pa0, pa1, pa2, pa3; const int NT = seq / KVBLK;
    int vsr = 0, vsw = 2 * SHM_V;
#define ATT_ROT() do { vsr = (vsr == 2 * SHM_V) ? 0 : vsr + SHM_V; vsw = (vsw == 2 * SHM_V) ? 0 : vsw + SHM_V; } while (0)
    ATT_SLOAD(0); ATT_SWRITE(0, 0); __syncthreads(); ATT_SLOAD(KVBLK);
    ASBAR(); qkt2<DQK>(p0, p1, K_lds, qr, negm, r32, hi);
    if (!h1) { (void)softmax_tile(p0, p1, mhat, negm, l_reg, true, pa0, pa1, pa2, pa3); }
    ATT_SWRITE(1, SHM_V); __syncthreads(); if (2 < NT) ATT_SLOAD(2 * KVBLK);
    for (int t = 0; t < NT; ++t) {
        if (h1) { const float al = softmax_tile(p0, p1, mhat, negm, l_reg, t == 0, pa0, pa1, pa2, pa3); ATT_RESC(al); }
        ASBAR(); pv_d0(o, vb0 + vsr, pa0, pa1, pa2, pa3);
        if (t + 1 < NT) {
            ASBAR(); qkt2<DQK>(p0, p1, K_lds + ((t + 1) & 1) * SHM_K, qr, negm, r32, hi);
            if (!h1) { const float al = softmax_tile(p0, p1, mhat, negm, l_reg, false, pa0, pa1, pa2, pa3); ATT_RESC(al); }
            if (t + 2 < NT) ATT_SWRITE(t & 1, vsw);
            __syncthreads();
            if (t + 3 < NT) ATT_SLOAD((t + 3) * KVBLK);
            ATT_ROT();
        }
    }
    if (hi == 0) li_l[r32] = l_reg; asm volatile("s_waitcnt lgkmcnt(0)" ::: "memory");
    float* stg = (float*)(lds + C::OFF_OST + wid * C::OSTW);
#pragma unroll
    for (int r = 0; r < 16; ++r) { const int orow = crow(r, hi); const float rli = __builtin_amdgcn_rcpf(li_l[orow]);
        stg[orow * 68 + r32] = o[0][r] * rli; stg[orow * 68 + 32 + r32] = o[1][r] * rli; }
    asm volatile("s_waitcnt lgkmcnt(0)" ::: "memory");
#pragma unroll
    for (int i = 0; i < 4; ++i) { const int row = i * 8 + (lane >> 3), ch = (lane & 7) * 8;
        const f32x4v a = *(const f32x4v*)(stg + row * 68 + ch), b = *(const f32x4v*)(stg + row * 68 + ch + 4);
        const size_t off = (size_t)(wid * QBLK + row) * 1024 + ch; const u32x4 g = *(const u32x4*)(Gb + off); u32x4 w;
        w.x = cvtpk(a[0] * __uint_as_float(g.x << 16), a[1] * __uint_as_float(g.x & 0xffff0000u)); w.y = cvtpk(a[2] * __uint_as_float(g.y << 16), a[3] * __uint_as_float(g.y & 0xffff0000u));
        w.z = cvtpk(b[0] * __uint_as_float(g.z << 16), b[1] * __uint_as_float(g.z & 0xffff0000u)); w.w = cvtpk(b[2] * __uint_as_float(g.w << 16), b[3] * __uint_as_float(g.w & 0xffff0000u));
        *(u32x4*)(Ob + off) = w; }
    __syncthreads();
#undef ATT_SLOAD
#undef ATT_SWRITE
#undef ATT_RESC
#undef ATT_ROT
}
#undef ASBAR
}
namespace fft {
using bf16x8 = __attribute__((ext_vector_type(8))) short;
using s16x4  = __attribute__((ext_vector_type(4))) short;
using f32x16 = __attribute__((ext_vector_type(16))) float;
using f32x4v = __attribute__((ext_vector_type(4))) float;
using u32x4  = __attribute__((ext_vector_type(4))) unsigned;
constexpr int OFF_X = 0, OFF_STG = 65536;
__device__ __forceinline__ int crow(int r, int hi) { return (r & 3) + 8 * (r >> 2) + 4 * hi; }
__device__ __forceinline__ unsigned cvtpk(float lo, float hi) { unsigned r; asm volatile("v_cvt_pk_bf16_f32 %0, %1, %2" : "=v"(r) : "v"(lo), "v"(hi)); return r; }
__device__ __forceinline__ int x_st(int kk, int c) { const int kp = (kk & ~0xC) | ((kk & 4) << 1) | ((kk & 8) >> 1); return ((kp >> 3) * 8 + (c >> 5)) * 512 + ((kp & 7) * 32 + (c & 31)) * 2; }
__device__ __forceinline__ int x_rd_base(int lane) { return ((lane & 3) << 3) | (((lane >> 2) & 3) << 6) | (((lane >> 4) & 1) << 5) | (((lane >> 5) & 1) << 8); }
constexpr int x_rd_off(int nb, int ks, int half) { return ks * 8192 + half * 4096 + nb * 512; }
template <int OFF> __device__ __forceinline__ s16x4 tr_read(int vb) { s16x4 r; asm volatile("ds_read_b64_tr_b16 %0, %1 offset:%2" : "=&v"(r) : "v"(vb), "i"(OFF) : "memory"); return r; }
template <int NB> __device__ __forceinline__ void mm_block(f32x16& acc, const bf16x8 (&afr)[8], int vb) {
#define FFT_PK(L, H) (bf16x8){L[0], L[1], L[2], L[3], H[0], H[1], H[2], H[3]}
    { const s16x4 l0 = tr_read<x_rd_off(NB, 0, 0)>(vb), h0 = tr_read<x_rd_off(NB, 0, 1)>(vb), l1 = tr_read<x_rd_off(NB, 1, 0)>(vb), h1 = tr_read<x_rd_off(NB, 1, 1)>(vb);
      const s16x4 l2 = tr_read<x_rd_off(NB, 2, 0)>(vb), h2 = tr_read<x_rd_off(NB, 2, 1)>(vb), l3 = tr_read<x_rd_off(NB, 3, 0)>(vb), h3 = tr_read<x_rd_off(NB, 3, 1)>(vb);
      asm volatile("s_waitcnt lgkmcnt(0)" ::: "memory"); __builtin_amdgcn_sched_barrier(0);
      acc = __builtin_amdgcn_mfma_f32_32x32x16_bf16(afr[0], FFT_PK(l0, h0), acc, 0, 0, 0); acc = __builtin_amdgcn_mfma_f32_32x32x16_bf16(afr[1], FFT_PK(l1, h1), acc, 0, 0, 0);
      acc = __builtin_amdgcn_mfma_f32_32x32x16_bf16(afr[2], FFT_PK(l2, h2), acc, 0, 0, 0); acc = __builtin_amdgcn_mfma_f32_32x32x16_bf16(afr[3], FFT_PK(l3, h3), acc, 0, 0, 0); }
    { const s16x4 l0 = tr_read<x_rd_off(NB, 4, 0)>(vb), h0 = tr_read<x_rd_off(NB, 4, 1)>(vb), l1 = tr_read<x_rd_off(NB, 5, 0)>(vb), h1 = tr_read<x_rd_off(NB, 5, 1)>(vb);
      const s16x4 l2 = tr_read<x_rd_off(NB, 6, 0)>(vb), h2 = tr_read<x_rd_off(NB, 6, 1)>(vb), l3 = tr_read<x_rd_off(NB, 7, 0)>(vb), h3 = tr_read<x_rd_off(NB, 7, 1)>(vb);
      asm volatile("s_waitcnt lgkmcnt(0)" ::: "memory"); __builtin_amdgcn_sched_barrier(0);
      acc = __builtin_amdgcn_mfma_f32_32x32x16_bf16(afr[4], FFT_PK(l0, h0), acc, 0, 0, 0); acc = __builtin_amdgcn_mfma_f32_32x32x16_bf16(afr[5], FFT_PK(l1, h1), acc, 0, 0, 0);
      acc = __builtin_amdgcn_mfma_f32_32x32x16_bf16(afr[6], FFT_PK(l2, h2), acc, 0, 0, 0); acc = __builtin_amdgcn_mfma_f32_32x32x16_bf16(afr[7], FFT_PK(l3, h3), acc, 0, 0, 0); }
#undef FFT_PK
}
struct TileRegs { bf16x8 v[8]; };
__device__ __forceinline__ void tile_load(TileRegs& t, const bf16_t* src  , size_t rowstride, int tid) {
    const bf16_t* p = src + (size_t)(tid >> 5) * rowstride + (tid & 31) * 8;
#pragma unroll
    for (int i = 0; i < 8; ++i) t.v[i] = *reinterpret_cast<const bf16x8*>(p + (size_t)(16 * i) * rowstride);
}
__device__ __forceinline__ void tile_write(const TileRegs& t, char* xl, int tid) {
    char* p = xl + x_st(tid >> 5, (tid & 31) * 8);
#pragma unroll
    for (int i = 0; i < 8; ++i) *reinterpret_cast<bf16x8*>(p + 8192 * i) = t.v[i];
}

__device__ __forceinline__ void stage_a(const bf16_t* __restrict__ PQ, bf16_t* __restrict__ Y, char* lds, int vcu, int G) {
    const int tid = threadIdx.x, wid = tid >> 6, lane = tid & 63, r32 = lane & 31, hi = lane >> 5, w = wid & 3, nh = wid >> 2;
    char* xl = lds + OFF_X; char* stg = lds + OFF_STG + wid * 8192;
    bf16x8 afr[8];
    { const int reim = r32 >> 4, k1 = 16 * w + (r32 & 15);
#pragma unroll
      for (int ks = 0; ks < 8; ++ks) { float v[8];
#pragma unroll
          for (int j = 0; j < 8; ++j) { const int kk = 16 * ks + 8 * hi + j, s1 = kk >> 1, pq = kk & 1; const float f = (float)((k1 * s1) & 63) * (1.f / 64.f);
              const float c = __builtin_amdgcn_cosf(f) * 0.125f, s = __builtin_amdgcn_sinf(f) * 0.125f; v[j] = reim == 0 ? (pq == 0 ? c : -s) : (pq == 0 ? s : c); }
          u32x4 p = {cvtpk(v[0], v[1]), cvtpk(v[2], v[3]), cvtpk(v[4], v[5]), cvtpk(v[6], v[7])}; afr[ks] = *reinterpret_cast<bf16x8*>(&p); } }
    const int vb = (int)(uintptr_t)xl + x_rd_base(lane) + nh * 4 * 512;
    constexpr int NU = NB * 192;
    TileRegs tr;
    int u = vcu;
    if (u < NU) tile_load(tr, PQ + (size_t)(u / 192) * 128 * 49152 + (u % 192) * 256, 49152, tid);
    for (; u < NU; u += G) {
        const int b = u / 192, j = u % 192;
        tile_write(tr, xl, tid);
        __syncthreads();
        { const int un = u + G; if (un < NU) tile_load(tr, PQ + (size_t)(un / 192) * 128 * 49152 + (un % 192) * 256, 49152, tid); }
        f32x16 acc[4] = {};
        mm_block<0>(acc[0], afr, vb); mm_block<1>(acc[1], afr, vb); mm_block<2>(acc[2], afr, vb); mm_block<3>(acc[3], afr, vb);
        const int s2 = j / 3;
#pragma unroll
        for (int r = 0; r < 8; ++r) { const int kl = crow(r, hi), k1 = 16 * w + kl; const float f = (float)(k1 * s2) * (1.f / 4096.f); const float tr_ = __builtin_amdgcn_cosf(f), ti_ = __builtin_amdgcn_sinf(f);
#pragma unroll
            for (int nb = 0; nb < 4; ++nb) { const float re = acc[nb][r], im = acc[nb][r + 8];
                *(bf16_t*)(stg + kl * 256 + (nb * 32 + r32) * 2) = f2bf(tr_ * re - ti_ * im);
                *(bf16_t*)(stg + (16 + kl) * 256 + (nb * 32 + r32) * 2) = f2bf(ti_ * re + tr_ * im); } }
        asm volatile("s_waitcnt lgkmcnt(0)" ::: "memory");
#pragma unroll
        for (int i = 0; i < 8; ++i) { const int rowl = i * 4 + (lane >> 4), c16 = lane & 15; const u32x4 v = *(const u32x4*)(stg + rowl * 256 + c16 * 16);
            const int reim = rowl >> 4, k1 = 16 * w + (rowl & 15);
            *(u32x4*)(Y + ((size_t)((b * 64 + k1) * 2 + reim)) * 49152 + j * 256 + nh * 128 + c16 * 8) = v; }
        __syncthreads();
    }
}
__device__ __forceinline__ void stage_b(const bf16_t* __restrict__ Y, const bf16_t* __restrict__ SG, bf16_t* __restrict__ BR, char* lds, int vcu, int G) {
    const int tid = threadIdx.x, wid = tid >> 6, lane = tid & 63, r32 = lane & 31, hi = lane >> 5, w = wid & 1, nq = wid >> 1;
    char* xl = lds + OFF_X; float* stg = (float*)(lds + OFF_STG + wid * 8192);
    bf16x8 afr[8];
    { const int k2 = 32 * w + r32;
#pragma unroll
      for (int ks = 0; ks < 8; ++ks) { float v[8];
#pragma unroll
          for (int j = 0; j < 8; ++j) { const int kk = 16 * ks + 8 * hi + j, reim = kk >> 6, s2 = kk & 63; const float f = (float)((k2 * s2) & 63) * (1.f / 64.f);
              v[j] = reim == 0 ? __builtin_amdgcn_cosf(f) * 0.125f : -__builtin_amdgcn_sinf(f) * 0.125f; }
          u32x4 p = {cvtpk(v[0], v[1]), cvtpk(v[2], v[3]), cvtpk(v[4], v[5]), cvtpk(v[6], v[7])}; afr[ks] = *reinterpret_cast<bf16x8*>(&p); } }
    const int vb = (int)(uintptr_t)xl + x_rd_base(lane) + nq * 2 * 512;
    constexpr int NU = NB * 64 * 3;
    TileRegs tr;
    int u = vcu;
    if (u < NU) tile_load(tr, Y + (size_t)(u / 3) * 2 * 49152 + (u % 3) * 256, 768, tid);
    for (; u < NU; u += G) {
        const int bk1 = u / 3, j = u % 3, b = bk1 >> 6, k1 = bk1 & 63;
        tile_write(tr, xl, tid);
        __syncthreads();
        { const int un = u + G; if (un < NU) tile_load(tr, Y + (size_t)(un / 3) * 2 * 49152 + (un % 3) * 256, 768, tid); }
        f32x16 acc[2] = {};
        mm_block<0>(acc[0], afr, vb); mm_block<1>(acc[1], afr, vb);
#pragma unroll
        for (int r = 0; r < 16; ++r) { const int rl = crow(r, hi); stg[rl * 64 + r32] = acc[0][r]; stg[rl * 64 + 32 + r32] = acc[1][r]; }
        asm volatile("s_waitcnt lgkmcnt(0)" ::: "memory");
#pragma unroll
        for (int i = 0; i < 4; ++i) { const int rowl = i * 8 + (lane >> 3), c8 = (lane & 7) * 8;
            const f32x4v a = *(const f32x4v*)(stg + rowl * 64 + c8), c = *(const f32x4v*)(stg + rowl * 64 + c8 + 4);
            const size_t off = ((size_t)b * SEQ + k1 + 64 * (32 * w + rowl)) * 1024 + j * 256 + nq * 64 + c8; const u32x4 g = *(const u32x4*)(SG + off); u32x4 o;
            o.x = cvtpk(a[0] * __uint_as_float(g.x << 16), a[1] * __uint_as_float(g.x & 0xffff0000u)); o.y = cvtpk(a[2] * __uint_as_float(g.y << 16), a[3] * __uint_as_float(g.y & 0xffff0000u));
            o.z = cvtpk(c[0] * __uint_as_float(g.z << 16), c[1] * __uint_as_float(g.z & 0xffff0000u)); o.w = cvtpk(c[2] * __uint_as_float(g.w << 16), c[3] * __uint_as_float(g.w & 0xffff0000u));
            *(u32x4*)(BR + off) = o; }
        __syncthreads();
    }
}
}
constexpr int NWAVES = 8;
constexpr int N_PHASES = 9;
constexpr int CW_BAR = 4096;
constexpr int RING_OFF = 0, RING_BYTES = 131072;
constexpr int LDSCTL_OFF = RING_BYTES, MISC_OFF = LDSCTL_OFF + 320, RS_OFF = LDSCTL_OFF + 1024  ;
constexpr int LDS_BYTES = 147456;
static_assert(RS_OFF + 4096 <= LDS_BYTES, "LDS map");

struct Args { const void* in[19]; float* out; unsigned char* ws; int ph_lo, ph_hi, li, pad; };

__device__ __forceinline__ void prep_w_job(const float* __restrict__ W, int ldw, int K, bf16_t* __restrict__ out, int n0, int nrows, const float* __restrict__ scale, int mode, int off, int gt, int GT) {
    const int total = nrows * (K >> 3);
    for (int idx = gt; idx < total; idx += GT) {
        const int n = idx % nrows, k8 = idx / nrows; const int sc = src_col(mode, n, off);
        float v[8];
#pragma unroll
        for (int i = 0; i < 8; ++i) { const int k = k8 * 8 + i; float w = (sc >= 0) ? W[(size_t)k * ldw + sc] : 0.f; if (scale) w *= scale[k]; v[i] = w; }
        uint4 o; o.x = pk2(v[0], v[1]); o.y = pk2(v[2], v[3]); o.z = pk2(v[4], v[5]); o.w = pk2(v[6], v[7]);
        *(uint4*)(out + (size_t)(n0 + n) * K + k8 * 8) = o;
    }
}
__device__ __forceinline__ void rmsnorm_row(const float* __restrict__ xrow, const float* __restrict__ g, bf16_t* __restrict__ orow, int lane) {
    const float4* xr = (const float4*)xrow + lane; float4 v[4]; float s = 0.f;
#pragma unroll
    for (int j = 0; j < 4; ++j) { v[j] = xr[64 * j]; s += v[j].x * v[j].x + v[j].y * v[j].y + v[j].z * v[j].z + v[j].w * v[j].w; }
    const float rstd = rsqrtf(wave_sum(s) * (1.f / DM) + EPS);
    uint2* o = (uint2*)orow + lane;
#pragma unroll
    for (int j = 0; j < 4; ++j) { const float4 gv = g ? ((const float4*)g)[lane + 64 * j] : make_float4(1.f, 1.f, 1.f, 1.f);
        uint2 w; w.x = pk2(v[j].x * rstd * gv.x, v[j].y * rstd * gv.y); w.y = pk2(v[j].z * rstd * gv.z, v[j].w * rstd * gv.w); o[64 * j] = w; }
}

typedef float f32x4m __attribute__((ext_vector_type(4)));
__device__ __forceinline__ void fold1_tiles(const float* __restrict__ Wf, float* __restrict__ AG, int gw, int NGW, int lane) {
    const int li = lane & 15, lk = lane >> 4;
    for (int tile = gw; tile < 2 * 4 * 12 * 12; tile += NGW) { const int di = tile % 12, ci = (tile / 12) % 12, g = (tile / 144) & 3, pq = tile / 576;
        const int c = ci * 16 + li; int p = (lk * c) % 192; const int step = (4 * c) % 192;
        const float* wp = Wf + ((size_t)g * 192 + lk) * 192 + di * 16 + li;
        f32x4m acc = {0.f, 0.f, 0.f, 0.f};
        for (int m0 = 0; m0 < 192; m0 += 4) { const float f = (float)p * (1.f / 192.f); const float a = pq ? __builtin_amdgcn_sinf(f) : __builtin_amdgcn_cosf(f);
            const float b = wp[(size_t)m0 * 192];
            acc = __builtin_amdgcn_mfma_f32_16x16x4f32(a, b, acc, 0, 0, 0);
            p += step; if (p >= 192) p -= 192; }
        float* op = AG + (((size_t)pq * 4 + g) * 192 + ci * 16 + 4 * lk) * 192 + di * 16 + li;
#pragma unroll
        for (int r = 0; r < 4; ++r) op[(size_t)r * 192] = acc[r] * 0.07216878364870322f; }
}
__device__ __forceinline__ void fold2_strips(const float* __restrict__ Win1, const float* __restrict__ g1, const float* __restrict__ AG, bf16_t* __restrict__ WIN1o, int gw, int NGW, int lane) {
    const int li = lane & 15, lk = lane >> 4;
    for (int s = gw; s < 64 * 8 * 3; s += NGW) { const int ki = s & 63, pg = (s >> 6) & 7, ds = s >> 9;
        const int g = pg & 3; const float* ap = Win1 + (size_t)(ki * 16 + li) * 2048 + 192 * g + lk; const float* bp = AG + ((size_t)pg * 192 + lk) * 192 + ds * 64 + li;
        f32x4m acc[4] = {{0.f, 0.f, 0.f, 0.f}, {0.f, 0.f, 0.f, 0.f}, {0.f, 0.f, 0.f, 0.f}, {0.f, 0.f, 0.f, 0.f}};
#pragma unroll 4
        for (int c0 = 0; c0 < 192; c0 += 4) { const float a = ap[c0]; const float* b = bp + (size_t)c0 * 192;
#pragma unroll
            for (int n = 0; n < 4; ++n) acc[n] = __builtin_amdgcn_mfma_f32_16x16x4f32(a, b[16 * n], acc[n], 0, 0, 0); }
        const int k0 = ki * 16 + 4 * lk; const float4 gv = *(const float4*)(g1 + k0);
#pragma unroll
        for (int n = 0; n < 4; ++n) { uint2 w; w.x = pk2(acc[n][0] * gv.x, acc[n][1] * gv.y); w.y = pk2(acc[n][2] * gv.z, acc[n][3] * gv.w);
            *(uint2*)(WIN1o + (size_t)((pg >> 2) * 768 + g * 192 + ds * 64 + n * 16 + li) * 1024 + k0) = w; } }
}
__device__ __forceinline__ void rmsnorm_rows2(const float* __restrict__ X, const float* __restrict__ g, bf16_t* __restrict__ O, int nrows, int gw, int NGW, int lane) {
    for (int m = 2 * gw; m < nrows; m += 2 * NGW) {
        const float4* x0 = (const float4*)(X + (size_t)m * DM) + lane; const float4* x1 = x0 + DM / 4; float4 v[8]; float s0 = 0.f, s1 = 0.f;
#pragma unroll
        for (int j = 0; j < 4; ++j) { v[j] = x0[64 * j]; v[4 + j] = x1[64 * j]; }
#pragma unroll
        for (int j = 0; j < 4; ++j) { s0 += v[j].x * v[j].x + v[j].y * v[j].y + v[j].z * v[j].z + v[j].w * v[j].w; s1 += v[4 + j].x * v[4 + j].x + v[4 + j].y * v[4 + j].y + v[4 + j].z * v[4 + j].z + v[4 + j].w * v[4 + j].w; }
        const float r0 = rsqrtf(wave_sum(s0) * (1.f / DM) + EPS), r1 = rsqrtf(wave_sum(s1) * (1.f / DM) + EPS);
        uint2* o0 = (uint2*)(O + (size_t)m * DM) + lane; uint2* o1 = o0 + DM / 4;
#pragma unroll
        for (int j = 0; j < 4; ++j) { const float4 gv = g ? ((const float4*)g)[lane + 64 * j] : make_float4(1.f, 1.f, 1.f, 1.f);
            uint2 w; w.x = pk2(v[j].x * r0 * gv.x, v[j].y * r0 * gv.y); w.y = pk2(v[j].z * r0 * gv.z, v[j].w * r0 * gv.w); o0[64 * j] = w;
            uint2 z; z.x = pk2(v[4 + j].x * r1 * gv.x, v[4 + j].y * r1 * gv.y); z.y = pk2(v[4 + j].z * r1 * gv.z, v[4 + j].w * r1 * gv.w); o1[64 * j] = z; } }
}
template <int DQK>
__device__ __forceinline__ void attn_naive_vb(float* Ks, float* Vs, int t256, const bf16_t* __restrict__ Q, int ldq, int qhs, const bf16_t* __restrict__ Kp, int ldk, int khs, const bf16_t* __restrict__ Vp, int ldv, int vhs,
                                              int nkeys, bf16_t* __restrict__ O, const bf16_t* __restrict__ G, int ocol0, int qblk, int h, int b) {
    constexpr int KT = 8;
    const size_t t = (size_t)b * SEQ + qblk * 256 + t256;
    unsigned qp2[DQK / 2]; float o[64], m = -1e30f, l = 0.f;
    { const bf16_t* qp = Q + t * ldq + h * qhs;
#pragma unroll
      for (int d = 0; d < DQK; d += 8) { const uint4 v = *(const uint4*)(qp + d); qp2[d / 2] = v.x; qp2[d / 2 + 1] = v.y; qp2[d / 2 + 2] = v.z; qp2[d / 2 + 3] = v.w; } }
#pragma unroll
    for (int d = 0; d < 64; ++d) o[d] = 0.f;
    const bf16_t* Kb = Kp + (size_t)b * nkeys * ldk + h * khs; const bf16_t* Vb = Vp + (size_t)b * nkeys * ldv + h * vhs;
    for (int k0 = 0; k0 < nkeys; k0 += KT) {
        __syncthreads();
        if (t256 < KT * DQK / 8) { const int j = t256 / (DQK / 8), d = (t256 % (DQK / 8)) * 8; const uint4 v = *(const uint4*)(Kb + (size_t)(k0 + j) * ldk + d);
            float* p = Ks + j * DQK + d; p[0] = __uint_as_float(v.x << 16); p[1] = __uint_as_float(v.x & 0xffff0000u); p[2] = __uint_as_float(v.y << 16); p[3] = __uint_as_float(v.y & 0xffff0000u);
            p[4] = __uint_as_float(v.z << 16); p[5] = __uint_as_float(v.z & 0xffff0000u); p[6] = __uint_as_float(v.w << 16); p[7] = __uint_as_float(v.w & 0xffff0000u); }
        if (t256 >= 128 && t256 < 128 + KT * 8) { const int tt = t256 - 128, j = tt >> 3, d = (tt & 7) * 8; const uint4 v = *(const uint4*)(Vb + (size_t)(k0 + j) * ldv + d);
            float* p = Vs + j * 64 + d; p[0] = __uint_as_float(v.x << 16); p[1] = __uint_as_float(v.x & 0xffff0000u); p[2] = __uint_as_float(v.y << 16); p[3] = __uint_as_float(v.y & 0xffff0000u);
            p[4] = __uint_as_float(v.z << 16); p[5] = __uint_as_float(v.z & 0xffff0000u); p[6] = __uint_as_float(v.w << 16); p[7] = __uint_as_float(v.w & 0xffff0000u); }
        __syncthreads();
#pragma unroll 1
        for (int j = 0; j < KT; ++j) { float s = 0.f; const float4* kr = (const float4*)(Ks + j * DQK);
#pragma unroll
            for (int d = 0; d < DQK / 4; ++d) { const float4 kv = kr[d]; const unsigned a = qp2[2 * d], c = qp2[2 * d + 1];
                s += __uint_as_float(a << 16) * kv.x + __uint_as_float(a & 0xffff0000u) * kv.y + __uint_as_float(c << 16) * kv.z + __uint_as_float(c & 0xffff0000u) * kv.w; }
            if (s > m) { const float alpha = __builtin_amdgcn_exp2f(m - s); m = s; l *= alpha;
#pragma unroll
                for (int d = 0; d < 64; ++d) o[d] *= alpha; }
            const float p = __builtin_amdgcn_exp2f(s - m); l += p; const float4* vr = (const float4*)(Vs + j * 64);
#pragma unroll
            for (int d = 0; d < 16; ++d) { const float4 vv = vr[d]; o[4 * d] += p * vv.x; o[4 * d + 1] += p * vv.y; o[4 * d + 2] += p * vv.z; o[4 * d + 3] += p * vv.w; } }
    }
    const float rl = 1.f / l;
    const bf16_t* gp = G + t * 1024 + ocol0 + h * 64; bf16_t* op = O + t * 1024 + ocol0 + h * 64;
#pragma unroll
    for (int d = 0; d < 64; d += 8) { const uint4 gv = *(const uint4*)(gp + d); uint4 w;
        w.x = pk2(o[d] * rl * __uint_as_float(gv.x << 16), o[d + 1] * rl * __uint_as_float(gv.x & 0xffff0000u));
        w.y = pk2(o[d + 2] * rl * __uint_as_float(gv.y << 16), o[d + 3] * rl * __uint_as_float(gv.y & 0xffff0000u));
        w.z = pk2(o[d + 4] * rl * __uint_as_float(gv.z << 16), o[d + 5] * rl * __uint_as_float(gv.z & 0xffff0000u));
        w.w = pk2(o[d + 6] * rl * __uint_as_float(gv.w << 16), o[d + 7] * rl * __uint_as_float(gv.w & 0xffff0000u));
        *(uint4*)(op + d) = w; }
}
template <int DQK>
__device__ __forceinline__ void attn_naive_phase(unsigned char* lds, int tid, const bf16_t* Q, int ldq, int qhs, const bf16_t* Kp, int ldk, int khs, const bf16_t* Vp, int ldv, int vhs, int nkeys, int nheads,
                                                 bf16_t* O, const bf16_t* G, int ocol0) {
    const int half = tid >> 8, t256 = tid & 255; float* Ks = (float*)(lds + half * 32768); float* Vs = Ks + 8 * DQK;
    const int total = 16 * nheads * NB, stride = (int)gridDim.x * 2;
    for (int vb = (int)blockIdx.x * 2 + half; vb < total; vb += stride) { const int qblk = vb & 15, h = (vb >> 4) % nheads, b = (vb >> 4) / nheads;
        attn_naive_vb<DQK>(Ks, Vs, t256, Q, ldq, qhs, Kp, ldk, khs, Vp, ldv, vhs, nkeys, O, G, ocol0, qblk, h, b); }
}

__global__ void __launch_bounds__(NWAVES * 64, 2) mk_fwd(Args args) {
    extern __shared__ __attribute__((aligned(16))) unsigned char lds[];
    LAS unsigned char* ldsl = (LAS unsigned char*)lds;
    volatile LAS unsigned* MISC = (volatile LAS unsigned*)(ldsl + MISC_OFF);
    const int tid0 = threadIdx.x;
#define PHASE_IDS() int tid = threadIdx.x; asm volatile("" : "+v"(tid)); const int lane = tid & 63, wave = __builtin_amdgcn_readfirstlane(tid >> 6); const int gt = (int)blockIdx.x * (NWAVES * 64) + tid, gw = (int)blockIdx.x * NWAVES + wave; (void)lane; (void)wave; (void)gt; (void)gw;
    const int vcu = (gridDim.x % 8 == 0) ? ((int)blockIdx.x % 8) * ((int)gridDim.x / 8) + (int)blockIdx.x / 8 : (int)blockIdx.x;
    const int G = gridDim.x, GT = G * NWAVES * 64, NGW = G * NWAVES;
    unsigned char* ws = args.ws;
    gu32* ctl = (gu32*)(ws + WS_CTL);
#define in_x ((const float*)args.in[0])
#define in_mem ((const float*)args.in[1])
#define in_pos ((const int*)args.in[2])
#define in_g0 ((const float*)args.in[3])
#define in_w_in0 ((const float*)args.in[4])
#define in_gq ((const float*)args.in[5])
#define in_gkv ((const float*)args.in[6])
#define in_w_uq ((const float*)args.in[7])
#define in_w_ukv ((const float*)args.in[8])
#define in_gm0 ((const float*)args.in[9])
#define in_w_mkv0 ((const float*)args.in[10])
#define in_w_out0 ((const float*)args.in[11])
#define in_g1 ((const float*)args.in[12])
#define in_w_in1 ((const float*)args.in[13])
#define in_w_fnet ((const float*)args.in[14])
#define in_gm1 ((const float*)args.in[15])
#define in_w_mkv1 ((const float*)args.in[16])
#define in_w_out1 ((const float*)args.in[17])
#define in_gf ((const float*)args.in[18])
#define in_out (args.out)
#define WIN0 ((bf16_t*)(ws + WS_WIN0))
#define WUQ ((bf16_t*)(ws + WS_WUQ))
#define WUKV ((bf16_t*)(ws + WS_WUKV))
#define WMEM ((bf16_t*)(ws + WS_WMEM))
#define WOUT0 ((bf16_t*)(ws + WS_WOUT0))
#define WOUT1 ((bf16_t*)(ws + WS_WOUT1))
#define WIN1 ((bf16_t*)(ws + WS_WIN1))
#define AGBG ((float*)(ws + WS_AGBG))
#define ROPE ((float*)(ws + WS_ROPE))
#define MEMN ((bf16_t*)(ws + WS_MEMN))
#define MEMKV ((bf16_t*)(ws + WS_MEMKV))
#define RSTD1 ((float*)(ws + WS_RSTD1))
#define SSQ ((float*)(ws + WS_SSQ))
#define XN0 ((bf16_t*)(ws + WS_XN0))
#define BR ((bf16_t*)(ws + WS_BR))
#define CQ ((bf16_t*)(ws + WS_CQ))
#define CKV ((bf16_t*)(ws + WS_CKV))
#define QMEM0 ((bf16_t*)(ws + WS_QMEM0))
#define SG0 ((bf16_t*)(ws + WS_SG0))
#define Kb ((bf16_t*)(ws + WS_K))
#define Qb ((bf16_t*)(ws + WS_Q))
#define Vb ((bf16_t*)(ws + WS_V))
#define X1B ((bf16_t*)(ws + WS_X1B))
#define PQ ((bf16_t*)(ws + WS_PQ))
#define QMEM1 ((bf16_t*)(ws + WS_QMEM1))
#define SG1 ((bf16_t*)(ws + WS_SG1))
#define Y ((bf16_t*)(ws + WS_Y))
    for (int u = tid0; u < (LDS_BYTES - LDSCTL_OFF) / 4; u += NWAVES * 64) ((LAS unsigned*)(ldsl + LDSCTL_OFF))[u] = 0u;
    __syncthreads();
    const XcdBarrier bar = xcd_barrier_post((unsigned*)(ctl + CW_BAR) + args.li * XCD_BAR_WORDS, MISC + 8);
#define GRID_BAR() xcd_barrier(bar)
    const int lo = args.ph_lo, hi = args.ph_hi;
#ifndef PH_MASK
#define PH_MASK 0x1ff
#endif
#define IN(k) (((PH_MASK >> (k)) & 1) && lo <= (k) && (k) < hi)
#define BOTH(k) (IN(k) && IN((k) + 1))
    LAS float* rs = (LAS float*)(ldsl + RS_OFF);

    if (IN(0)) { PHASE_IDS();
        prep_w_job(in_w_in0, 1952, 1024, WIN0, 0, 2048, nullptr, MODE_WIN0, 0, gt, GT);
        prep_w_job(in_w_uq, 1152, 384, WUQ, 0, 1280, in_gq, MODE_WUQ, 0, gt, GT);
        prep_w_job(in_w_ukv, 1536, 256, WUKV, 0, 1536, in_gkv, MODE_WUKV, 0, gt, GT);
        prep_w_job(in_w_mkv0, 512, 1024, WMEM, 0, 512, in_gm0, MODE_PLAIN, 0, gt, GT);
        prep_w_job(in_w_mkv1, 512, 1024, WMEM, 512, 512, in_gm1, MODE_PLAIN, 0, gt, GT);
        prep_w_job(in_w_out0, 1024, 1024, WOUT0, 0, 1024, nullptr, MODE_PLAIN, 0, gt, GT);
        prep_w_job(in_w_out1, 1024, 1024, WOUT1, 0, 1024, nullptr, MODE_PLAIN, 0, gt, GT);
        prep_w_job(in_w_in1, 2048, 1024, WIN1, 1536, 1280, in_g1, MODE_PLAIN, 768, gt, GT);
        fold1_tiles(in_w_fnet, AGBG, gw, NGW, lane);
        for (int idx = gt; idx < T * 16; idx += GT) { const int t = idx >> 4, i = idx & 15;
            const float inv_freq = __builtin_amdgcn_exp2f((float)i * -0.83048202372184058696f);
            const float ang = (float)in_pos[t] * inv_freq; double fd = (double)ang * 0.31830988618379067154; fd -= 2.0 * floor(fd * 0.5);
            float sn, cs; sincospif((float)fd, &sn, &cs); ROPE[2 * idx] = cs; ROPE[2 * idx + 1] = sn; }
        rmsnorm_rows2(in_mem, nullptr, MEMN, 4096, gw, NGW, lane);
        rmsnorm_rows2(in_x, in_g0, XN0, T, gw, NGW, lane);
        if (BOTH(0)) GRID_BAR();
    }
    if (IN(1)) { PHASE_IDS();
        fold2_strips(in_w_in1, in_g1, AGBG, WIN1, gw, NGW, lane);
        { pg8::Gemm g{XN0, WIN0, T, 2048, 1024}; pg8::StaticOrder S; S.init(T, 2048, G, (int)blockIdx.x);
          pg8::EpiIn0 E{CQ, CKV, QMEM0, SG0, Kb, SSQ, ROPE};
          pg8::gemm_phase<pg8::EpiIn0, pg8::StaticOrder, true, true>(ldsl + RING_OFF, g, S, E); }
        { pg8::Gemm g{MEMN, WMEM, 4096, 1024, 1024}; pg8::StaticOrder S; S.init(4096, 1024, G, (int)blockIdx.x);
          pg8::EpiPlainB E{MEMKV, 1024, 0};
          pg8::gemm_phase<pg8::EpiPlainB, pg8::StaticOrder, true, true>(ldsl + RING_OFF, g, S, E); }
        if (BOTH(1)) GRID_BAR();
    }
    if (IN(2)) { PHASE_IDS();
        { int kq_ = 384; asm volatile("" : "+s"(kq_)); pg8::Gemm g{CQ, WUQ, T, 1280, kq_}; pg8::StaticOrder S; S.init(T, 1280, G, (int)blockIdx.x);
          pg8::EpiQup E{Qb, SSQ, ROPE};
          pg8::gemm_phase<pg8::EpiQup, pg8::StaticOrder, true, true>(ldsl + RING_OFF, g, S, E); }
        { int kk_ = 256; asm volatile("" : "+s"(kk_)); pg8::Gemm g{CKV, WUKV, T, 1536, kk_}; pg8::StaticOrder S; S.init(T, 1536, G, (int)blockIdx.x);
          pg8::EpiKVup E{Kb, Vb, SSQ};
          pg8::gemm_phase<pg8::EpiKVup, pg8::StaticOrder, true, true>(ldsl + RING_OFF, g, S, E); }
        if (BOTH(2)) GRID_BAR();
    }
    if (IN(3)) { PHASE_IDS();
#ifdef ATTN_NAIVE
        attn_naive_phase<96>(lds, tid, Qb, 1152, 96, Kb, 1152, 96, Vb, 768, 64, SEQ, 12, BR, SG0, 0);
        attn_naive_phase<64>(lds, tid, QMEM0, 256, 64, MEMKV, 1024, 64, MEMKV + 256, 1024, 64, 256, 4, BR, SG0, 768);
#else
        for (int u = vcu; u < 16 * 12 * NB; u += G) { const int qblk = u & 15, pair = u >> 4, b = pair / 12, h = pair % 12; const size_t t0 = (size_t)b * SEQ + qblk * 256;
            att::attn_unit<96>(Qb + t0 * 1152 + h * 96, 1152, Kb + (size_t)b * SEQ * 1152 + h * 96, 1152, Vb + (size_t)b * SEQ * 768 + h * 64, 768, SEQ, BR + t0 * 1024 + h * 64, SG0 + t0 * 1024 + h * 64, (char*)lds); }
        for (int u = vcu; u < 16 * 4 * NB; u += G) { const int qblk = u & 15, pair = u >> 4, b = pair >> 2, h = pair & 3; const size_t t0 = (size_t)b * SEQ + qblk * 256;
            att::attn_unit<64>(QMEM0 + t0 * 256 + h * 64, 256, MEMKV + (size_t)b * 256 * 1024 + h * 64, 1024, MEMKV + (size_t)b * 256 * 1024 + 256 + h * 64, 1024, 256, BR + t0 * 1024 + 768 + h * 64, SG0 + t0 * 1024 + 768 + h * 64, (char*)lds); }
#endif
        if (BOTH(3)) GRID_BAR();
    }
    if (IN(4)) { PHASE_IDS();
        for (int i = tid; i < 1024; i += NWAVES * 64) rs[i] = 0.f;
        __syncthreads();
        { pg8::Gemm g{BR, WOUT0, T, 1024, 1024}; pg8::PanelOrder S; S.init(T, G, (int)blockIdx.x);
          pg8::EpiOutA E{in_x, X1B, rs};
          pg8::gemm_phase<pg8::EpiOutA, pg8::PanelOrder, true, true>(ldsl + RING_OFF, g, S, E); }
        __syncthreads();
        if (tid < 256) RSTD1[(size_t)blockIdx.x * 256 + tid] = rsqrtf(((rs[tid * 4] + rs[tid * 4 + 1]) + (rs[tid * 4 + 2] + rs[tid * 4 + 3])) * (1.f / DM) + EPS);
        if (BOTH(4)) GRID_BAR();
    }
    if (IN(5)) { PHASE_IDS();
        { pg8::Gemm g{X1B, WIN1, T, 2816, 1024}; pg8::StaticOrder S; S.init(T, 2816, G, (int)blockIdx.x);
          pg8::EpiIn1 E{PQ, QMEM1, SG1, RSTD1};
          pg8::gemm_phase<pg8::EpiIn1, pg8::StaticOrder, true, true>(ldsl + RING_OFF, g, S, E); }
        if (BOTH(5)) GRID_BAR();
    }
    if (IN(6)) { PHASE_IDS();
#ifdef FFT_NAIVE
        LAS float* tab = (LAS float*)(ldsl + RING_OFF + 65536);
        if (tid < 64) { tab[2 * tid] = cospif(2.f * tid / 64.f); tab[2 * tid + 1] = sinpif(2.f * tid / 64.f); }
        __syncthreads();
        for (int idx = gt; idx < NB * 64 * 49152; idx += GT) { const int e = idx % 49152, k1 = (idx / 49152) & 63, b = idx / (49152 * 64);
            float ar = 0.f, ai = 0.f;
            for (int s1 = 0; s1 < 64; ++s1) { const int w = (k1 * s1) & 63; const float wx = tab[2 * w], wy = tab[2 * w + 1];
                const size_t base = (((size_t)b * 64 + s1) * 2) * 49152 + e; const float p = bf2f(PQ[base]), q = bf2f(PQ[base + 49152]);
                ar += wx * p - wy * q; ai += wy * p + wx * q; }
            ar *= 0.125f; ai *= 0.125f;
            const int s2 = e / 768; const float fr = 2.f * (float)(k1 * s2) / 4096.f; const float tr = cospif(fr), ti = sinpif(fr);
            const size_t ob = (((size_t)b * 64 + k1) * 2) * 49152 + e;
            Y[ob] = f2bf(tr * ar - ti * ai); Y[ob + 49152] = f2bf(ti * ar + tr * ai); }
        __syncthreads();
#else
        fft::stage_a(PQ, Y, (char*)lds, vcu, G);
#endif
#ifdef ATTN_NAIVE
        attn_naive_phase<64>(lds, tid, QMEM1, 256, 64, MEMKV + 512, 1024, 64, MEMKV + 768, 1024, 64, 256, 4, BR, SG1, 768);
#else
        for (int u = vcu; u < 16 * 4 * NB; u += G) { const int qblk = u & 15, pair = u >> 4, b = pair >> 2, h = pair & 3; const size_t t0 = (size_t)b * SEQ + qblk * 256;
            att::attn_unit<64>(QMEM1 + t0 * 256 + h * 64, 256, MEMKV + (size_t)b * 256 * 1024 + 512 + h * 64, 1024, MEMKV + (size_t)b * 256 * 1024 + 768 + h * 64, 1024, 256, BR + t0 * 1024 + 768 + h * 64, SG1 + t0 * 1024 + 768 + h * 64, (char*)lds); }
#endif
        if (BOTH(6)) GRID_BAR();
    }
    if (IN(7)) { PHASE_IDS();
#ifdef FFT_NAIVE
        LAS float* tab = (LAS float*)(ldsl + RING_OFF + 65536);
        __syncthreads();
        if (tid < 64) { tab[2 * tid] = cospif(2.f * tid / 64.f); tab[2 * tid + 1] = sinpif(2.f * tid / 64.f); }
        __syncthreads();
        for (int idx = gt; idx < NB * 64 * 64 * 768; idx += GT) { const int d = idx % 768, k2 = (idx / 768) & 63, bk1 = idx / 49152, b = bk1 >> 6, k1 = bk1 & 63;
            float acc = 0.f;
            for (int s2 = 0; s2 < 64; ++s2) { const int w = (k2 * s2) & 63; const size_t base = ((size_t)bk1 * 2) * 49152 + (size_t)s2 * 768 + d;
                acc += tab[2 * w] * bf2f(Y[base]) - tab[2 * w + 1] * bf2f(Y[base + 49152]); }
            const size_t t = (size_t)b * SEQ + k1 + 64 * k2;
            BR[t * 1024 + d] = f2bf(acc * 0.125f * bf2f(SG1[t * 1024 + d])); }
#else
        fft::stage_b(Y, SG1, BR, (char*)lds, vcu, G);
#endif
        if (BOTH(7)) GRID_BAR();
    }
    if (IN(8)) { PHASE_IDS();
        __syncthreads();
        for (int i = tid; i < 1024; i += NWAVES * 64) rs[i] = 0.f;
        __syncthreads();
        { pg8::Gemm g{BR, WOUT1, T, 1024, 1024}; pg8::PanelOrder S; S.init(T, G, (int)blockIdx.x);
          pg8::EpiOutB E{X1B, rs};
          pg8::gemm_phase<pg8::EpiOutB, pg8::PanelOrder, true, true>(ldsl + RING_OFF, g, S, E); }
        asm volatile("s_waitcnt vmcnt(0)" ::: "memory");
        __syncthreads();
        for (int r = wave; r < 256; r += NWAVES) { const float rstd = rsqrtf(((rs[r * 4] + rs[r * 4 + 1]) + (rs[r * 4 + 2] + rs[r * 4 + 3])) * (1.f / DM) + EPS);
            const size_t row = (size_t)blockIdx.x * 256 + r; const uint4* xb = (const uint4*)(X1B + row * DM) + lane; float4* orow = (float4*)(in_out + row * DM) + 2 * lane;
#pragma unroll
            for (int j = 0; j < 2; ++j) { const uint4 v = xb[64 * j]; const float4 ga = ((const float4*)in_gf)[2 * lane + 128 * j], gb = ((const float4*)in_gf)[2 * lane + 128 * j + 1]; float4 a, b;
                a.x = __uint_as_float(v.x << 16) * rstd * ga.x; a.y = __uint_as_float(v.x & 0xffff0000u) * rstd * ga.y; a.z = __uint_as_float(v.y << 16) * rstd * ga.z; a.w = __uint_as_float(v.y & 0xffff0000u) * rstd * ga.w;
                b.x = __uint_as_float(v.z << 16) * rstd * gb.x; b.y = __uint_as_float(v.z & 0xffff0000u) * rstd * gb.y; b.z = __uint_as_float(v.w << 16) * rstd * gb.z; b.w = __uint_as_float(v.w & 0xffff0000u) * rstd * gb.w;
                orow[128 * j] = a; orow[128 * j + 1] = b; } }
    }
#undef in_x
#undef in_mem
#undef in_pos
#undef in_g0
#undef in_w_in0
#undef in_gq
#undef in_gkv
#undef in_w_uq
#undef in_w_ukv
#undef in_gm0
#undef in_w_mkv0
#undef in_w_out0
#undef in_g1
#undef in_w_in1
#undef in_w_fnet
#undef in_gm1
#undef in_w_mkv1
#undef in_w_out1
#undef in_gf
#undef in_out
#undef WIN0
#undef WUQ
#undef WUKV
#undef WMEM
#undef WOUT0
#undef WOUT1
#undef WIN1
#undef AGBG
#undef ROPE
#undef MEMN
#undef MEMKV
#undef RSTD1
#undef SSQ
#undef XN0
#undef BR
#undef CQ
#undef CKV
#undef QMEM0
#undef SG0
#undef Kb
#undef Qb
#undef Vb
#undef X1B
#undef PQ
#undef QMEM1
#undef SG1
#undef Y
#undef PHASE_IDS
#undef IN
#undef BOTH
#undef GRID_BAR
}

extern "C" void kernel_launch(void* const* d_in, const int* in_sizes, int n_in, void* d_out, int out_size, void* d_ws, size_t ws_size, hipStream_t stream) {
    static int grid = 0;
    if (grid == 0) {
        if (n_in != 19 || ws_size < WS_END || out_size != T * DM) { fprintf(stderr, "kernel_launch: unexpected n_in %d / ws %zu / out %d\n", n_in, ws_size, out_size); grid = -1; return; }
        int dev = 0, cus = 0;
        if (hipGetDevice(&dev) != hipSuccess || hipDeviceGetAttribute(&cus, hipDeviceAttributeMultiprocessorCount, dev) != hipSuccess) { grid = -1; return; }
        if (hipFuncSetAttribute((const void*)mk_fwd, hipFuncAttributeMaxDynamicSharedMemorySize, LDS_BYTES) != hipSuccess) { fprintf(stderr, "kernel_launch: hipFuncSetAttribute failed\n"); grid = -1; return; }
        int per_cu = 0; (void)hipOccupancyMaxActiveBlocksPerMultiprocessor(&per_cu, (const void*)mk_fwd, NWAVES * 64, LDS_BYTES); (void)hipGetLastError();
        if (cus != 256 || per_cu < 1) fprintf(stderr, "kernel_launch: note: %d CUs, occupancy query %d (built for 256 CUs, one workgroup each)\n", cus, per_cu);
        grid = 256;
    }
    if (grid < 0) return;
    if (hipMemsetAsync((char*)d_ws + WS_CTL, 0, CTL_ZERO_BYTES, stream) != hipSuccess) { fprintf(stderr, "kernel_launch: memset failed\n"); return; }
    Args a{};
    for (int i = 0; i < 19; ++i) a.in[i] = d_in[i];
    a.out = (float*)d_out; a.ws = (unsigned char*)d_ws;
#ifndef PROBE_PHASE
    const int nl = 1; const int rlo[1] = {0}, rhi[1] = {N_PHASES};
#else
    const int nl = 3; const int rlo[3] = {0, PROBE_PHASE, PROBE_PHASE}, rhi[3] = {PROBE_PHASE + 1, PROBE_PHASE + 1, N_PHASES};
#endif
    for (int li = 0; li < nl; ++li) {
        a.ph_lo = rlo[li]; a.ph_hi = rhi[li]; a.li = li; a.pad = 0;
        hipLaunchKernelGGL(mk_fwd, dim3(grid), dim3(NWAVES * 64), LDS_BYTES, stream, a);
        const hipError_t le = hipPeekAtLastError();
        if (le != hipSuccess) { fprintf(stderr, "kernel_launch: launch %d failed: %s\n", li, hipGetErrorName(le)); break; }
    }
}
```

```cpp
#include <hip/hip_runtime.h>
#include <stdint.h>
#include <cstdio>

typedef unsigned short bf16_t;
constexpr int T = 65536, SEQ = 4096, NB = 16, DM = 1024;
constexpr float EPS = 1e-6f;
constexpr float LOG2E = 1.4426950408889634f;
constexpr float QS_MLA = 0.10206207261596575f * LOG2E;
constexpr float QS_MEM = 0.125f * LOG2E;

constexpr size_t MiB = 1u << 20;
constexpr size_t WS_CTL = 0, CTL_ZERO_BYTES = 65536;
constexpr size_t WS_WIN0 = 1 * MiB;
constexpr size_t WS_WUQ = 5 * MiB;
constexpr size_t WS_WUKV = 6 * MiB;
constexpr size_t WS_WMEM = 7 * MiB;
constexpr size_t WS_WOUT0 = 9 * MiB;
constexpr size_t WS_WOUT1 = 11 * MiB;
constexpr size_t WS_WIN1 = 13 * MiB;
constexpr size_t WS_AGBG = 19 * MiB;
constexpr size_t WS_ROPE = 21 * MiB;
constexpr size_t WS_MEMN = 29 * MiB;
constexpr size_t WS_MEMKV = 37 * MiB;
constexpr size_t WS_RSTD1 = 45 * MiB;
constexpr size_t WS_SSQ = 46 * MiB;
constexpr size_t WS_XN0 = 64 * MiB;
constexpr size_t WS_BR = 64 * MiB;
constexpr size_t WS_CQ = 192 * MiB;
constexpr size_t WS_CKV = 240 * MiB;
constexpr size_t WS_QMEM0 = 272 * MiB;
constexpr size_t WS_SG0 = 304 * MiB;
constexpr size_t WS_K = 432 * MiB;
constexpr size_t WS_Q = 576 * MiB;
constexpr size_t WS_V = 720 * MiB;
constexpr size_t WS_X1B = 192 * MiB;
constexpr size_t WS_PQ = 320 * MiB;
constexpr size_t WS_QMEM1 = 512 * MiB;
constexpr size_t WS_SG1 = 544 * MiB;
constexpr size_t WS_Y = 672 * MiB;
constexpr size_t WS_END = 864 * MiB;

__device__ __forceinline__ float bf2f(bf16_t h) { return __uint_as_float(((unsigned)h) << 16); }
__device__ __forceinline__ bf16_t f2bf(float f) { unsigned u = __float_as_uint(f); return (bf16_t)((u + 0x7fffu + ((u >> 16) & 1u)) >> 16); }
__device__ __forceinline__ unsigned pk2(float lo, float hi) { return (unsigned)f2bf(lo) | ((unsigned)f2bf(hi) << 16); }
__device__ __forceinline__ float silu_f(float v) { return v * __builtin_amdgcn_rcpf(1.f + __expf(-v)); }
__device__ __forceinline__ float wave_sum(float v) {
#pragma unroll
    for (int o = 1; o < 64; o <<= 1) v += __shfl_xor(v, o);
    return v;
}
__host__ __device__ __forceinline__ int ropedim(int p) { return 4 * (p >> 3) + (p & 3) + 16 * ((p >> 2) & 1); }
enum { MODE_WIN0 = 0, MODE_WUQ = 1, MODE_WUKV = 2, MODE_PLAIN = 3 };
__device__ __forceinline__ int src_col(int mode, int n, int off) {
    if (mode == MODE_WIN0) {
        if (n < 640) return n;
        if (n < 896) return 672 + (n - 640);
        if (n < 928) return 640 + ropedim(n - 896);
        if (n < 1024) return -1;
        return 928 + (n - 1024);
    } else if (mode == MODE_WUQ) {
        if (n < 768) return (n >> 6) * 96 + (n & 63);
        if (n < 1152) { const int r = n - 768; return (r >> 5) * 96 + 64 + ropedim(r & 31); }
        return -1;
    } else if (mode == MODE_WUKV) {
        if (n < 768) return (n >> 6) * 128 + (n & 63);
        const int r = n - 768; return (r >> 6) * 128 + 64 + (r & 63);
    }
    return n + off;
}
namespace pg8 {
#define PG8_LAS __attribute__((address_space(3)))
typedef unsigned short bf16_t;
typedef short bf16x8 __attribute__((ext_vector_type(8)));
typedef float f32x4 __attribute__((ext_vector_type(4)));
typedef unsigned u32x4 __attribute__((ext_vector_type(4)));
constexpr int BM = 256, BK = 64, HALF = 128, HTB = HALF * BK * 2  , STAGE_BYTES = 8 * HTB, NXCD = 8, WGM = 8;

__host__ __device__ __forceinline__ int lds_byte(int r, int c) { const int st = (r >> 4) * 2 + (c >> 5), rr = r & 15, cc = c & 31, ob = rr * 64 + cc * 2; return st * 1024 + (ob ^ (((ob >> 9) & 1) << 5)); }
__host__ __device__ __forceinline__ void stage_rc(int b, int& R, int& C) { const int st = b / 1024, sb = b % 1024, swz = sb ^ (((sb >> 9) & 1) << 5); R = (st >> 1) * 16 + swz / 64; C = (st & 1) * 32 + (swz % 64) / 2; }
__host__ __device__ __forceinline__ int perm32(int rho) { const int n = rho >> 4, i = rho & 15; return 8 * (i >> 2) + 4 * n + (i & 3); }

struct Unit { int pm, pn; };
struct Gemm { const bf16_t* A; const bf16_t* Bt; int M, N, K; };

struct StaticOrder {
    int nM, nN, nwg, G, c;
    __host__ __device__ void init(int M, int N, int G_, int c_) { nM = M / BM; nN = N / BM; nwg = nM * nN; G = G_; c = c_; }
    __host__ __device__ bool next(int i, Unit& u) const {
        const long L = (long)i * G + c; if (L >= nwg) return false;
        int wgid = (int)L; { const int q = nwg / NXCD, r = nwg % NXCD, xcd = wgid % NXCD, off = wgid / NXCD; wgid = (xcd < r ? xcd * (q + 1) : r * (q + 1) + (xcd - r) * q) + off; }
        const int nig = WGM * nN, gid = wgid / nig, fm = gid * WGM, gsz = (nM - fm) < WGM ? (nM - fm) : WGM;
        u.pm = fm + ((wgid % nig) % gsz); u.pn = (wgid % nig) / gsz; return true;
    }
    __device__ __forceinline__ void a_ready(const Unit&) const {}
    __device__ __forceinline__ void done(const Unit&) const {}
};

__device__ __forceinline__ unsigned cvt_pk_bf16(float lo, float hi) { unsigned r; asm volatile("v_cvt_pk_bf16_f32 %0, %1, %2" : "=v"(r) : "v"(lo), "v"(hi)); return r; }
typedef float f32x2 __attribute__((ext_vector_type(2)));
__device__ __forceinline__ u32x4 pack8(const f32x4 a, const f32x4 b, float s) { u32x4 w; w.x = cvt_pk_bf16(a[0] * s, a[1] * s); w.y = cvt_pk_bf16(a[2] * s, a[3] * s); w.z = cvt_pk_bf16(b[0] * s, b[1] * s); w.w = cvt_pk_bf16(b[2] * s, b[3] * s); return w; }
__device__ __forceinline__ float ss8(const f32x4 a, const f32x4 b) { return (a[0] * a[0] + a[1] * a[1]) + (a[2] * a[2] + a[3] * a[3]) + (b[0] * b[0] + b[1] * b[1]) + (b[2] * b[2] + b[3] * b[3]); }
__device__ __forceinline__ float quad_sum(float v) { v += __shfl_xor(v, 16); v += __shfl_xor(v, 32); return v; }
__device__ __forceinline__ f32x4 silu4(const f32x4 v) { f32x4 o; o[0] = silu_f(v[0]); o[1] = silu_f(v[1]); o[2] = silu_f(v[2]); o[3] = silu_f(v[3]); return o; }
typedef unsigned u32x2 __attribute__((ext_vector_type(2)));
__device__ __forceinline__ void rope_pair(const f32x4 a, const f32x4 b, const float* cs  , float s, u32x2& o1, u32x2& o2) {
    const f32x4 c01 = *(const f32x4*)cs, c23 = *(const f32x4*)(cs + 4);
    const float r0 = (a[0] * c01[0] - b[0] * c01[1]) * s, r1 = (a[1] * c01[2] - b[1] * c01[3]) * s, r2 = (a[2] * c23[0] - b[2] * c23[1]) * s, r3 = (a[3] * c23[2] - b[3] * c23[3]) * s;
    const float q0 = (b[0] * c01[0] + a[0] * c01[1]) * s, q1 = (b[1] * c01[2] + a[1] * c01[3]) * s, q2 = (b[2] * c23[0] + a[2] * c23[1]) * s, q3 = (b[3] * c23[2] + a[3] * c23[3]) * s;
    o1.x = cvt_pk_bf16(r0, r1); o1.y = cvt_pk_bf16(r2, r3); o2.x = cvt_pk_bf16(q0, q1); o2.y = cvt_pk_bf16(q2, q3);
}
__device__ __forceinline__ void rope_pair2(const f32x4 a, const f32x4 b, const f32x4 c01, const f32x4 c23, float s, u32x2& o1, u32x2& o2) {
    o1.x = cvt_pk_bf16((a[0] * c01[0] - b[0] * c01[1]) * s, (a[1] * c01[2] - b[1] * c01[3]) * s); o1.y = cvt_pk_bf16((a[2] * c23[0] - b[2] * c23[1]) * s, (a[3] * c23[2] - b[3] * c23[3]) * s);
    o2.x = cvt_pk_bf16((b[0] * c01[0] + a[0] * c01[1]) * s, (b[1] * c01[2] + a[1] * c01[3]) * s); o2.y = cvt_pk_bf16((b[2] * c23[0] + a[2] * c23[1]) * s, (b[3] * c23[2] + a[3] * c23[3]) * s);
}
struct EpiIn0 {
    static constexpr bool PERM = true, AFTER_DRAIN = false; static constexpr int NST = 8;
    struct Pre {}; __device__ __forceinline__ void prefetch(Pre&, const Unit&, int, int, int, int) const {}
    bf16_t *CQ, *CKV, *QMEM, *SG, *Kb  ; float* SSQ; const float* rope;
    __device__ __forceinline__ void operator()(const f32x4 (&acc)[2][2][4][2], const Unit& u, int wr, int wc, int fr, int fq, const Pre& pre) const {
        const bool kr = (u.pn == 3) && (wc == 0);
        f32x4 cs[2][4][2];
        if (kr) {
#pragma unroll
            for (int ai = 0; ai < 2; ++ai)
#pragma unroll
                for (int m = 0; m < 4; ++m) { const float* rp = rope + (size_t)(u.pm * BM + ai * HALF + wr * 64 + m * 16 + fr) * 32 + 8 * fq; cs[ai][m][0] = *(const f32x4*)rp; cs[ai][m][1] = *(const f32x4*)(rp + 4); } }
#pragma unroll
        for (int ai = 0; ai < 2; ++ai)
#pragma unroll
            for (int m = 0; m < 4; ++m) { const size_t row = (size_t)(u.pm * BM + ai * HALF + wr * 64 + m * 16 + fr);
#pragma unroll
                for (int bj = 0; bj < 2; ++bj) { const int cb = u.pn * BM + bj * HALF + wc * 32, c = cb + 8 * fq; const f32x4 v0 = acc[ai][bj][m][0], v1 = acc[ai][bj][m][1];
                    if (cb < 640) { const float ss = quad_sum(ss8(v0, v1));
                        if (cb < 384) { *(u32x4*)(CQ + row * 384 + c) = pack8(v0, v1, 1.f); if (fq == 0) SSQ[row * 20 + (cb >> 5)] = ss; }
                        else { *(u32x4*)(CKV + row * 256 + (c - 384)) = pack8(v0, v1, 1.f); if (fq == 0) SSQ[row * 20 + 12 + ((cb - 384) >> 5)] = ss; } }
                    else if (cb < 896) { *(u32x4*)(QMEM + row * 256 + (c - 640)) = pack8(v0, v1, QS_MEM); }
                    else if (cb < 1024) { if (cb == 896) { u32x2 o1, o2; rope_pair2(v0, v1, cs[ai][m][0], cs[ai][m][1], 1.f, o1, o2);
                            *(u32x2*)(Kb + row * 32 + 4 * fq) = o1; *(u32x2*)(Kb + row * 32 + 16 + 4 * fq) = o2; } }
                    else { *(u32x4*)(SG + row * 1024 + (c - 1024)) = pack8(silu4(v0), silu4(v1), 1.f); } } }
    }
};
struct EpiPlainB {
    static constexpr bool PERM = true, AFTER_DRAIN = false; static constexpr int NST = 16;
    struct Pre {}; __device__ __forceinline__ void prefetch(Pre&, const Unit&, int, int, int, int) const {}
    bf16_t* O; int ldo; int pad;
    __device__ __forceinline__ void operator()(const f32x4 (&acc)[2][2][4][2], const Unit& u, int wr, int wc, int fr, int fq, const Pre& pre) const {
#pragma unroll
        for (int ai = 0; ai < 2; ++ai)
#pragma unroll
            for (int m = 0; m < 4; ++m) { int rowi_ = u.pm * BM + ai * HALF + wr * 64 + m * 16 + fr; asm volatile("" : "+v"(rowi_)); const size_t row = (size_t)rowi_;
#pragma unroll
                for (int bj = 0; bj < 2; ++bj) { const int c = u.pn * BM + bj * HALF + wc * 32 + 8 * fq; *(u32x4*)(O + row * ldo + c) = pack8(acc[ai][bj][m][0], acc[ai][bj][m][1], 1.f); } }
    }
};
struct __attribute__((packed, aligned(4))) F3 { float a, b, c; };
typedef float f32x2 __attribute__((ext_vector_type(2)));
struct EpiQup {
    static constexpr bool PERM = true, AFTER_DRAIN = false; static constexpr int NST = 16;
    struct Pre {}; __device__ __forceinline__ void prefetch(Pre&, const Unit&, int, int, int, int) const {}
    bf16_t* Qb; const float* SSQ; const float* rope;
    __device__ __forceinline__ void operator()(const f32x4 (&acc)[2][2][4][2], const Unit& u, int wr, int wc, int fr, int fq, const Pre& pre) const {
        const int row0 = u.pm * BM + wr * 64 + fr;
        F3 part[2][4];
#pragma unroll
        for (int ai = 0; ai < 2; ++ai)
#pragma unroll
            for (int m = 0; m < 4; ++m) part[ai][m] = *(const F3*)(SSQ + (size_t)(row0 + ai * HALF + m * 16) * 20 + 3 * fq);
        const int cb0 = u.pn * BM + wc * 32;
        const bool rope0 = cb0 >= 768, rope1 = (cb0 + HALF >= 768) && (cb0 + HALF < 1152);
        f32x4 csA[4][2], csB[4][2];
        if (rope1 || rope0) {
#pragma unroll
            for (int m = 0; m < 4; ++m) { const float* rp = rope + (size_t)(row0 + m * 16) * 32 + 8 * fq; csA[m][0] = *(const f32x4*)rp; csA[m][1] = *(const f32x4*)(rp + 4); } }
        float sc[2][4];
#pragma unroll
        for (int ai = 0; ai < 2; ++ai)
#pragma unroll
            for (int m = 0; m < 4; ++m) sc[ai][m] = rsqrtf(quad_sum(part[ai][m].a + part[ai][m].b + part[ai][m].c) * (1.f / 384.f) + EPS) * QS_MLA;
        if (!(rope0 || rope1)) {
#pragma unroll
            for (int bj = 0; bj < 2; ++bj) { const int c = cb0 + bj * HALF + 8 * fq;
#pragma unroll
                for (int ai = 0; ai < 2; ++ai)
#pragma unroll
                    for (int m = 0; m < 4; ++m) *(u32x4*)(Qb + (size_t)(row0 + ai * HALF + m * 16) * 1152 + (c >> 6) * 96 + (c & 63)) = pack8(acc[ai][bj][m][0], acc[ai][bj][m][1], sc[ai][m]); }
            return; }
        u32x2 oA[4][2][2];
#pragma unroll
        for (int m = 0; m < 4; ++m) { if (rope0) rope_pair2(acc[0][0][m][0], acc[0][0][m][1], csA[m][0], csA[m][1], sc[0][m], oA[m][0][0], oA[m][0][1]);
            if (rope1) rope_pair2(acc[0][1][m][0], acc[0][1][m][1], csA[m][0], csA[m][1], sc[0][m], oA[m][1][0], oA[m][1][1]); }
#pragma unroll
        for (int m = 0; m < 4; ++m) { const float* rp = rope + (size_t)(row0 + HALF + m * 16) * 32 + 8 * fq; csB[m][0] = *(const f32x4*)rp; csB[m][1] = *(const f32x4*)(rp + 4); }
        asm volatile("" ::: "memory");
#pragma unroll
        for (int ai = 0; ai < 2; ++ai) {
#pragma unroll
            for (int m = 0; m < 4; ++m) { bf16_t* qrow = Qb + (size_t)(row0 + ai * HALF + m * 16) * 1152;
#pragma unroll
                for (int bj = 0; bj < 2; ++bj) { const int cb = cb0 + bj * HALF; const bool rp_ = bj == 0 ? rope0 : rope1;
                    if (rp_) { const int h = (cb - 768) >> 5; u32x2 o1, o2;
                        if (ai == 0) { o1 = oA[m][bj][0]; o2 = oA[m][bj][1]; } else rope_pair2(acc[1][bj][m][0], acc[1][bj][m][1], csB[m][0], csB[m][1], sc[1][m], o1, o2);
                        *(u32x2*)(qrow + h * 96 + 64 + 4 * fq) = o1; *(u32x2*)(qrow + h * 96 + 80 + 4 * fq) = o2; }
                    else if (cb < 768) { const int c = cb + 8 * fq; *(u32x4*)(qrow + (c >> 6) * 96 + (c & 63)) = pack8(acc[ai][bj][m][0], acc[ai][bj][m][1], sc[ai][m]); } } } }
    }
};
struct EpiKVup {
    static constexpr bool PERM = true, AFTER_DRAIN = false; static constexpr int NST = 16;
    struct Pre { f32x2 part[2][4]; };
    __device__ __forceinline__ void prefetch(Pre& p, const Unit& u, int wr, int, int fr, int fq) const { const int row0 = u.pm * BM + wr * 64 + fr;
#pragma unroll
        for (int ai = 0; ai < 2; ++ai)
#pragma unroll
            for (int m = 0; m < 4; ++m) p.part[ai][m] = *(const f32x2*)(SSQ + (size_t)(row0 + ai * HALF + m * 16) * 20 + 12 + 2 * fq); }
    bf16_t *Kb, *Vb; const float* SSQ;
    __device__ __forceinline__ void operator()(const f32x4 (&acc)[2][2][4][2], const Unit& u, int wr, int wc, int fr, int fq, const Pre& pre) const {
        const int row0 = u.pm * BM + wr * 64 + fr;
        const f32x2 (&part)[2][4] = pre.part;
        float sc[2][4];
#pragma unroll
        for (int ai = 0; ai < 2; ++ai)
#pragma unroll
            for (int m = 0; m < 4; ++m) sc[ai][m] = rsqrtf(quad_sum(part[ai][m][0] + part[ai][m][1]) * (1.f / 256.f) + EPS);
#pragma unroll
        for (int bj = 0; bj < 2; ++bj) { const int cb = u.pn * BM + bj * HALF + wc * 32, c = cb + 8 * fq;
#pragma unroll
            for (int ai = 0; ai < 2; ++ai)
#pragma unroll
                for (int m = 0; m < 4; ++m) { const size_t row = (size_t)(row0 + ai * HALF + m * 16); const u32x4 w = pack8(acc[ai][bj][m][0], acc[ai][bj][m][1], sc[ai][m]);
                    if (cb < 768) *(u32x4*)(Kb + row * 768 + c) = w; else *(u32x4*)(Vb + row * 768 + (c - 768)) = w; } }
    }
};
struct EpiOutA {
    static constexpr bool PERM = true, AFTER_DRAIN = false; static constexpr int NST = 16;
    struct Pre {}; __device__ __forceinline__ void prefetch(Pre&, const Unit&, int, int, int, int) const {}
    const float* R; bf16_t* X1B; PG8_LAS float* rs;
    __device__ __forceinline__ void operator()(const f32x4 (&acc)[2][2][4][2], const Unit& u, int wr, int wc, int fr, int fq, const Pre& pre) const {
        const int c0 = u.pn * BM + wc * 32 + 8 * fq;
        u32x4 outw[2][4][2];
#pragma unroll
        for (int ai = 0; ai < 2; ++ai) { f32x4 res[4][2][2];
#pragma unroll
            for (int m = 0; m < 4; ++m) { const float* rp = R + (size_t)(u.pm * BM + ai * HALF + wr * 64 + m * 16 + fr) * 1024 + c0;
#pragma unroll
                for (int bj = 0; bj < 2; ++bj) { res[m][bj][0] = *(const f32x4*)(rp + bj * HALF); res[m][bj][1] = *(const f32x4*)(rp + bj * HALF + 4); } }
#pragma unroll
            for (int m = 0; m < 4; ++m) { const int rl = ai * HALF + wr * 64 + m * 16 + fr; float ssum = 0.f;
#pragma unroll
                for (int bj = 0; bj < 2; ++bj) { const f32x4 x0 = res[m][bj][0] + acc[ai][bj][m][0], x1 = res[m][bj][1] + acc[ai][bj][m][1];
                    outw[ai][m][bj] = pack8(x0, x1, 1.f); ssum += ss8(x0, x1); }
                ssum = quad_sum(ssum); if (fq == 0) rs[rl * 4 + wc] += ssum; }
            asm volatile("" ::: "memory"); }
#pragma unroll
        for (int ai = 0; ai < 2; ++ai)
#pragma unroll
            for (int m = 0; m < 4; ++m) { bf16_t* xp = X1B + (size_t)(u.pm * BM + ai * HALF + wr * 64 + m * 16 + fr) * 1024 + c0;
#pragma unroll
                for (int bj = 0; bj < 2; ++bj) *(u32x4*)(xp + bj * HALF) = outw[ai][m][bj]; }
    }
};
struct EpiOutB {
    static constexpr bool PERM = true, AFTER_DRAIN = false; static constexpr int NST = 16;
    struct Pre { u32x4 res[2][4][2]; };
    __device__ __forceinline__ void prefetch(Pre& p, const Unit& u, int wr, int wc, int fr, int fq) const { const int c0 = u.pn * BM + wc * 32 + 8 * fq;
#pragma unroll
        for (int ai = 0; ai < 2; ++ai)
#pragma unroll
            for (int m = 0; m < 4; ++m) { const bf16_t* rp = X + (size_t)(u.pm * BM + ai * HALF + wr * 64 + m * 16 + fr) * 1024 + c0; p.res[ai][m][0] = *(const u32x4*)rp; p.res[ai][m][1] = *(const u32x4*)(rp + HALF); } }
    bf16_t* X; PG8_LAS float* rs;
    __device__ __forceinline__ void operator()(const f32x4 (&acc)[2][2][4][2], const Unit& u, int wr, int wc, int fr, int fq, const Pre& pre) const {
        const int c0 = u.pn * BM + wc * 32 + 8 * fq;
        const u32x4 (&res)[2][4][2] = pre.res;
#pragma unroll
        for (int ai = 0; ai < 2; ++ai)
#pragma unroll
            for (int m = 0; m < 4; ++m) { const int rl = ai * HALF + wr * 64 + m * 16 + fr; bf16_t* xp = X + (size_t)(u.pm * BM + rl) * 1024 + c0; float ssum = 0.f;
#pragma unroll
                for (int bj = 0; bj < 2; ++bj) { const u32x4 r = res[ai][m][bj];
                    f32x4 x0, x1; x0[0] = __uint_as_float(r.x << 16); x0[1] = __uint_as_float(r.x & 0xffff0000u); x0[2] = __uint_as_float(r.y << 16); x0[3] = __uint_as_float(r.y & 0xffff0000u);
                    x1[0] = __uint_as_float(r.z << 16); x1[1] = __uint_as_float(r.z & 0xffff0000u); x1[2] = __uint_as_float(r.w << 16); x1[3] = __uint_as_float(r.w & 0xffff0000u);
                    x0 += acc[ai][bj][m][0]; x1 += acc[ai][bj][m][1];
                    *(u32x4*)(xp + bj * HALF) = pack8(x0, x1, 1.f); ssum += ss8(x0, x1); }
                ssum = quad_sum(ssum); if (fq == 0) rs[rl * 4 + wc] += ssum; }
    }
};
struct EpiIn1 {
    static constexpr bool PERM = true, AFTER_DRAIN = false; static constexpr int NST = 16;
    struct Pre { float rr[2][4]; };
    __device__ __forceinline__ void prefetch(Pre& p, const Unit& u, int wr, int, int fr, int) const { const int row0 = u.pm * BM + wr * 64 + fr;
#pragma unroll
        for (int ai = 0; ai < 2; ++ai)
#pragma unroll
            for (int m = 0; m < 4; ++m) p.rr[ai][m] = RSTD[row0 + ai * HALF + m * 16]; }
    bf16_t *PQ, *QMEM, *SG; const float* RSTD;
    __device__ __forceinline__ void operator()(const f32x4 (&acc)[2][2][4][2], const Unit& u, int wr, int wc, int fr, int fq, const Pre& pre) const {
        const int row0 = u.pm * BM + wr * 64 + fr;
        const float (&rr)[2][4] = pre.rr;
#pragma unroll
        for (int ai = 0; ai < 2; ++ai)
#pragma unroll
            for (int m = 0; m < 4; ++m) { const int rowi = row0 + ai * HALF + m * 16; const size_t row = (size_t)rowi; const float r = rr[ai][m];
                const int b = rowi >> 12, sq = rowi & 4095, s1 = sq >> 6, s2 = sq & 63; const size_t prow = ((size_t)(b * 64 + s1) * 2) * 64 + s2;
#pragma unroll
                for (int bj = 0; bj < 2; ++bj) { const int cb = u.pn * BM + bj * HALF + wc * 32, c = cb + 8 * fq; const f32x4 v0 = acc[ai][bj][m][0], v1 = acc[ai][bj][m][1];
                    if (cb < 1536) { const int pq = cb >= 768 ? 1 : 0; *(u32x4*)(PQ + (prow + pq * 64) * 768 + (c - pq * 768)) = pack8(v0, v1, r); }
                    else if (cb < 1792) *(u32x4*)(QMEM + row * 256 + (c - 1536)) = pack8(v0, v1, r * QS_MEM);
                    else *(u32x4*)(SG + row * 1024 + (c - 1792)) = pack8(silu4(v0 * r), silu4(v1 * r), 1.f); } }
    }
};
struct PanelOrder {
    int nM, G, c;
    __device__ void init(int M, int G_, int c_) { nM = M / BM; G = G_; c = c_; }
    __device__ bool next(int i, Unit& u) const { u.pm = c + G * (i >> 2); u.pn = i & 3; return u.pm < nM; }
    __device__ __forceinline__ void a_ready(const Unit&) const {}
    __device__ __forceinline__ void done(const Unit&) const {}
};
template <class Epi, class Sched, bool ALIGN_EPI = false, bool SP2 = false>
__device__ __forceinline__ void gemm_phase(PG8_LAS unsigned char* lds, const Gemm g, const Sched& S, const Epi& E) {
    const int tid = threadIdx.x, wid = __builtin_amdgcn_readfirstlane(tid >> 6), lane = tid & 63, wr = wid >> 2, wc = wid & 3, fr = lane & 15, fq = lane >> 4;
    const int K = g.K, nt = K / BK;
    unsigned voffA[2], voffB[2];
#pragma unroll
    for (int i = 0; i < 2; ++i) { int R, C; stage_rc(tid * 16 + i * 8192, R, C); const int Rb = Epi::PERM ? ((R & ~31) + perm32(R & 31)) : R;
        voffA[i] = (unsigned)(R * K + C) * 2u; voffB[i] = (unsigned)(Rb * K + C) * 2u; }
    const size_t kstep = (size_t)(BK * 2);
    const size_t hstep = (size_t)HALF * K * 2;
    const size_t tstep = 2 * hstep;
    const unsigned ldsw = (unsigned)wid * 1024u;
    const int aoff = lds_byte(wr * 64 + fr, fq * 8), boff = lds_byte(wc * 32 + fr, fq * 8);
#define PG8_SA(b, h) (((b) * 2 + (h)) * HTB)
#define PG8_SB(b, h) ((4 + (b) * 2 + (h)) * HTB)
#define PG8_STAGE(bufoff, gbase, voff) do { _Pragma("unroll") for (int _i = 0; _i < 2; ++_i) \
        __builtin_amdgcn_global_load_lds((const unsigned*)((const char*)(gbase) + (voff)[_i]), (PG8_LAS unsigned*)(lds + (bufoff) + ldsw + _i * 8192), 16, 0, 0); } while (0)
#define PG8_LDA(dst, b, h) do { _Pragma("unroll") for (int m = 0; m < 4; ++m) _Pragma("unroll") for (int k = 0; k < 2; ++k) dst[m][k] = *(const PG8_LAS bf16x8*)(lds + PG8_SA(b, h) + aoff + m * 2048 + k * 1024); } while (0)
#define PG8_LDB(dst, b, h) do { _Pragma("unroll") for (int n = 0; n < 2; ++n) _Pragma("unroll") for (int k = 0; k < 2; ++k) dst[n][k] = *(const PG8_LAS bf16x8*)(lds + PG8_SB(b, h) + boff + n * 2048 + k * 1024); } while (0)
#define PG8_MMA(ai, bj, At, Bt) do { __builtin_amdgcn_s_setprio(1); _Pragma("unroll") for (int m = 0; m < 4; ++m) _Pragma("unroll") for (int n = 0; n < 2; ++n) _Pragma("unroll") for (int k = 0; k < 2; ++k) \
        acc[ai][bj][m][n] = __builtin_amdgcn_mfma_f32_16x16x32_bf16(Bt[n][k], At[m][k], acc[ai][bj][m][n], 0, 0, 0); __builtin_amdgcn_s_setprio(0); } while (0)
#define PG8_WAIT_V(n) asm volatile("s_waitcnt vmcnt(" #n ")" ::: "memory")
#define PG8_WAIT_L(n) asm volatile("s_waitcnt lgkmcnt(" #n ")" ::: "memory")
#define PG8_WAIT_VF(fr, n) asm volatile("s_cmp_lg_u32 %0, 0\n\ts_cbranch_scc0 .Lwvs%=\n\ts_waitcnt vmcnt(%1)\n\ts_branch .Lwve%=\n.Lwvs%=:\n\ts_waitcnt vmcnt(8)\n.Lwve%=:" :: "s"(fr), "n"(n) : "memory", "scc")
#define PG8_BAR __builtin_amdgcn_s_barrier()
#define PG8_SCHED __builtin_amdgcn_sched_barrier(0)
    Unit cur, nxt; int ui = 0;
    if (!S.next(0, cur)) return;
    f32x4 acc[2][2][4][2];
#pragma unroll
    for (int a = 0; a < 2; ++a)
#pragma unroll
        for (int b = 0; b < 2; ++b)
#pragma unroll
            for (int m = 0; m < 4; ++m)
#pragma unroll
                for (int n = 0; n < 2; ++n) acc[a][b][m][n] = (f32x4){0.f, 0.f, 0.f, 0.f};
    bf16x8 At[4][2], B0[2][2], B1[2][2];
    const char* cA = (const char*)g.A + (size_t)cur.pm * tstep; const char* cB = (const char*)g.Bt + (size_t)cur.pn * tstep;
    S.a_ready(cur);
    if constexpr (SP2) {
        PG8_STAGE(PG8_SB(0, 0), cB, voffB); PG8_STAGE(PG8_SB(0, 1), cB + hstep, voffB); PG8_STAGE(PG8_SA(0, 0), cA, voffA); PG8_STAGE(PG8_SA(0, 1), cA + hstep, voffA);
        if (wr == 1) PG8_BAR;
        PG8_WAIT_V(2); PG8_BAR;
        PG8_STAGE(PG8_SB(1, 0), cB + kstep, voffB); PG8_STAGE(PG8_SA(1, 0), cA + kstep, voffA); PG8_STAGE(PG8_SB(1, 1), cB + hstep + kstep, voffB);
        PG8_WAIT_V(6); PG8_BAR;
    } else {
        PG8_STAGE(PG8_SB(0, 0), cB, voffB); PG8_STAGE(PG8_SA(0, 0), cA, voffA); PG8_STAGE(PG8_SB(0, 1), cB + hstep, voffB); PG8_STAGE(PG8_SA(0, 1), cA + hstep, voffA);
        if (wr == 1) PG8_BAR;
        PG8_WAIT_V(4); PG8_BAR;
        PG8_STAGE(PG8_SB(1, 0), cB + kstep, voffB); PG8_STAGE(PG8_SA(1, 0), cA + kstep, voffA); PG8_STAGE(PG8_SB(1, 1), cB + hstep + kstep, voffB);
        PG8_WAIT_V(6); PG8_BAR;
    }
    for (;;) {
        const bool has_next = S.next(ui + 1, nxt);
        const char* nA = has_next ? (const char*)g.A + (size_t)nxt.pm * tstep : cA; const char* nB = has_next ? (const char*)g.Bt + (size_t)nxt.pn * tstep : cB;
        for (int t = 0; t < nt; t += 2) {
            const bool last = (t == nt - 2);
            const char* a1 = cA + (size_t)(t + 1) * kstep;
            const char* a2 = last ? nA : cA + (size_t)(t + 2) * kstep; const char* b2 = last ? nB : cB + (size_t)(t + 2) * kstep;
            const char* a3 = a2 + kstep; const char* b3 = b2 + kstep;
            if (last && has_next) S.a_ready(nxt);
            if constexpr (SP2) {
            const int fresh = __builtin_amdgcn_readfirstlane(((t == 0) && (ui > 0)) ? 1 : 0);
            PG8_LDB(B0, 0, 0); PG8_LDB(B1, 0, 1); PG8_SCHED; PG8_LDA(At, 0, 0); PG8_STAGE(PG8_SA(1, 1), a1 + hstep, voffA);
            PG8_WAIT_VF(fresh, 8 + Epi::NST);
            PG8_WAIT_L(0); PG8_BAR; PG8_MMA(0, 0, At, B0); PG8_MMA(0, 1, At, B1); PG8_BAR; PG8_SCHED;
            PG8_LDA(At, 0, 1); PG8_STAGE(PG8_SB(0, 0), b2, voffB); PG8_STAGE(PG8_SB(0, 1), b2 + hstep, voffB); PG8_STAGE(PG8_SA(0, 0), a2, voffA);
            PG8_WAIT_VF(fresh, 8 + Epi::NST);
            PG8_WAIT_L(0); PG8_BAR; PG8_MMA(1, 0, At, B0); PG8_MMA(1, 1, At, B1); PG8_BAR; PG8_SCHED;
            PG8_LDB(B0, 1, 0); PG8_LDB(B1, 1, 1); PG8_SCHED; PG8_LDA(At, 1, 0); PG8_STAGE(PG8_SA(0, 1), a2 + hstep, voffA);
            if constexpr (ALIGN_EPI) PG8_WAIT_VF(fresh, 8 + Epi::NST); else PG8_WAIT_V(8);
            PG8_WAIT_L(0); PG8_BAR; PG8_MMA(0, 0, At, B0); PG8_MMA(0, 1, At, B1); PG8_BAR; PG8_SCHED;
            PG8_LDA(At, 1, 1); PG8_STAGE(PG8_SB(1, 0), b3, voffB); PG8_STAGE(PG8_SB(1, 1), b3 + hstep, voffB); PG8_STAGE(PG8_SA(1, 0), a3, voffA);
            PG8_WAIT_V(8); PG8_WAIT_L(0); PG8_BAR; PG8_MMA(1, 0, At, B0); PG8_MMA(1, 1, At, B1); PG8_BAR; PG8_SCHED;
            } else {
            PG8_LDB(B0, 0, 0); PG8_SCHED; PG8_LDA(At, 0, 0); PG8_STAGE(PG8_SA(1, 1), a1 + hstep, voffA);
            PG8_WAIT_L(8); PG8_BAR; PG8_WAIT_L(0); PG8_MMA(0, 0, At, B0); PG8_BAR; PG8_SCHED;
            PG8_LDB(B1, 0, 1); PG8_STAGE(PG8_SB(0, 0), b2, voffB);
            PG8_BAR; PG8_WAIT_L(0); PG8_MMA(0, 1, At, B1); PG8_BAR;
            PG8_LDA(At, 0, 1); PG8_STAGE(PG8_SA(0, 0), a2, voffA);
            PG8_BAR; PG8_WAIT_L(0); PG8_MMA(1, 0, At, B0); PG8_BAR; PG8_SCHED;
            PG8_STAGE(PG8_SB(0, 1), b2 + hstep, voffB);
            PG8_WAIT_V(6); PG8_BAR; PG8_MMA(1, 1, At, B1); PG8_BAR;
            PG8_LDB(B0, 1, 0); PG8_SCHED; PG8_LDA(At, 1, 0); PG8_STAGE(PG8_SA(0, 1), a2 + hstep, voffA);
            PG8_WAIT_L(8); PG8_BAR; PG8_WAIT_L(0); PG8_MMA(0, 0, At, B0); PG8_BAR; PG8_SCHED;
            PG8_LDB(B1, 1, 1); PG8_STAGE(PG8_SB(1, 0), b3, voffB);
            PG8_BAR; PG8_WAIT_L(0); PG8_MMA(0, 1, At, B1); PG8_BAR;
            PG8_LDA(At, 1, 1); PG8_STAGE(PG8_SA(1, 0), a3, voffA);
            PG8_BAR; PG8_WAIT_L(0); PG8_MMA(1, 0, At, B0); PG8_BAR; PG8_SCHED;
            PG8_STAGE(PG8_SB(1, 1), b3 + hstep, voffB);
            PG8_WAIT_V(6); PG8_BAR; PG8_MMA(1, 1, At, B1); PG8_BAR;
            }
        }
        typename Epi::Pre pre;
        E.prefetch(pre, cur, wr, wc, fr, fq);
        if constexpr (ALIGN_EPI) { if (wr == 0) PG8_BAR; }
        if constexpr (SP2 && ALIGN_EPI) { if (has_next) PG8_STAGE(PG8_SA(1, 1), nA + kstep + hstep, voffA); }
        if constexpr (!Epi::AFTER_DRAIN) { E(acc, cur, wr, wc, fr, fq, pre); S.done(cur); }
        if (!has_next) break;
#pragma unroll
        for (int a = 0; a < 2; ++a)
#pragma unroll
            for (int b = 0; b < 2; ++b)
#pragma unroll
                for (int m = 0; m < 4; ++m)
#pragma unroll
                    for (int n = 0; n < 2; ++n) acc[a][b][m][n] = (f32x4){0.f, 0.f, 0.f, 0.f};
        cur = nxt; cA = nA; cB = nB; ++ui;
        if constexpr (ALIGN_EPI) { if (wr == 1) PG8_BAR; }
    }
    PG8_WAIT_V(0);
    if constexpr (!ALIGN_EPI) { if (wr == 0) PG8_BAR; }
    PG8_BAR;
    if constexpr (Epi::AFTER_DRAIN) { E.fused(acc, cur, wr, wc, fr, fq, lds, wid, lane); S.done(cur); }
#undef PG8_SA
#undef PG8_SB
#undef PG8_STAGE
#undef PG8_LDA
#undef PG8_LDB
#undef PG8_MMA
#undef PG8_WAIT_V
#undef PG8_WAIT_L
#undef PG8_BAR
#undef PG8_SCHED
}
}
#define GAS __attribute__((address_space(1)))
#define LAS __attribute__((address_space(3)))
typedef unsigned short bf16;
typedef unsigned v4u __attribute__((ext_vector_type(4)));
typedef float f32x4 __attribute__((ext_vector_type(4)));
typedef short bf16x8 __attribute__((ext_vector_type(8)));
typedef GAS unsigned gu32;
typedef GAS unsigned long long gu64;
#define RLX_AGENT __ATOMIC_RELAXED, __HIP_MEMORY_SCOPE_AGENT
#define LDS_WAIT() asm volatile("s_waitcnt lgkmcnt(0)" ::: "memory")
#define VM_WAIT() asm volatile("s_waitcnt vmcnt(0)" ::: "memory")
__device__ __forceinline__ unsigned long long rt() { return __builtin_amdgcn_s_memrealtime(); }
#define XB_TMO      128
#define XB_XCNT(j)  (256  + 64 * (j))
#define XB_XSUB(j)  (1280 + 64 * (j))
#define XB_XGEN(j)  (2304 + 64 * (j))
#define XB_TOP      3328
#define XB_TOPGEN   3392
#define XCD_BAR_WORDS 3456
#define XB_SPIN_CAP (1u << 18)

__device__ __forceinline__ unsigned xb_ld(unsigned* p)              { return __hip_atomic_load(p, __ATOMIC_RELAXED, __HIP_MEMORY_SCOPE_AGENT); }
__device__ __forceinline__ unsigned xb_add(unsigned* p, unsigned v) { return __hip_atomic_fetch_add(p, v, __ATOMIC_RELAXED, __HIP_MEMORY_SCOPE_AGENT); }
__device__ __forceinline__ unsigned xb_xcc_id() { return (unsigned)__builtin_amdgcn_s_getreg((3 << 11) | 20) & 0xFu; }
#define XB_SPIN(cond, bar) do { unsigned _sp = 0; while (cond) { __builtin_amdgcn_s_sleep(1); \
    if ((++_sp & 255u) == 0u) { if (xb_ld(&(bar)[XB_TMO])) break; if (_sp > XB_SPIN_CAP) { atomicAdd(&(bar)[XB_TMO], 1u); break; } } } } while (0)

struct XcdBarrier {
    unsigned* bar; unsigned x;
    volatile LAS unsigned* st;
};

__device__ __forceinline__ XcdBarrier xcd_barrier_post(unsigned* bar, volatile LAS unsigned* st) {
    XcdBarrier b; b.bar = bar; b.x = xb_xcc_id(); b.st = st;
    if (threadIdx.x == 0) (void)xb_add(&bar[XB_XCNT(b.x)], 1u);
    return b;
}
__device__ __forceinline__ void xcd_barrier_complete(unsigned* bar, unsigned x, unsigned& nloc, unsigned& nx) {
    const unsigned G = gridDim.x * gridDim.y * gridDim.z;
    unsigned sum, cnt, mine, sp = 0u;
    for (;;) {
        sum = 0u; cnt = 0u; mine = 0u;
#pragma unroll
        for (unsigned j = 0; j < 16; ++j) { const unsigned c = xb_ld(&bar[XB_XCNT(j)]); sum += c; cnt += (c > 0u) ? 1u : 0u; mine = (j == x) ? c : mine; }
        if (sum == G) break;
        __builtin_amdgcn_s_sleep(1);
        if ((++sp & 255u) == 0u) { if (xb_ld(&bar[XB_TMO])) break; if (sp > XB_SPIN_CAP) { atomicAdd(&bar[XB_TMO], 1u); break; } }
    }
    nloc = mine > 0u ? mine : 1u; nx = cnt > 0u ? cnt : 1u;
}

__device__ __forceinline__ void xcd_barrier(const XcdBarrier& b) {
    asm volatile("s_waitcnt vmcnt(0)" ::: "memory");
    __syncthreads();
    if (threadIdx.x == 0) {
        unsigned* bar = b.bar;
        __builtin_amdgcn_s_waitcnt(0);
        unsigned nloc = b.st[0], nx = b.st[1];
        if (nloc == 0u) { xcd_barrier_complete(bar, b.x, nloc, nx); b.st[0] = nloc; b.st[1] = nx; }
        const unsigned old = xb_add(&bar[XB_XSUB(b.x)], 1u);
        const unsigned gen = old / nloc;
        if (old + 1u == (gen + 1u) * nloc) {
            __builtin_amdgcn_fence(__ATOMIC_RELEASE, "agent");
            asm volatile("s_waitcnt vmcnt(0)" ::: "memory");
            const unsigned og = xb_add(&bar[XB_TOP], 1u);
            const unsigned tg = og / nx;
            if (og + 1u == (tg + 1u) * nx) xb_add(&bar[XB_TOPGEN], 1u);
            else XB_SPIN(xb_ld(&bar[XB_TOPGEN]) == tg, bar);
            __builtin_amdgcn_fence(__ATOMIC_ACQUIRE, "agent");
            xb_add(&bar[XB_XGEN(b.x)], 1u);
            asm volatile("s_waitcnt vmcnt(0)" ::: "memory");
        } else {
            XB_SPIN(xb_ld(&bar[XB_XGEN(b.x)]) == gen, bar);
            __builtin_amdgcn_fence(__ATOMIC_ACQUIRE, "agent");
            asm volatile("s_waitcnt vmcnt(0)" ::: "memory");
        }
    }
    __syncthreads();
}
namespace att {
using bf16x8 = __attribute__((ext_vector_type(8))) short;
using s16x4  = __attribute__((ext_vector_type(4))) short;
using f32x16 = __attribute__((ext_vector_type(16))) float;
using f32x4v = __attribute__((ext_vector_type(4))) float;
using u32x4  = __attribute__((ext_vector_type(4))) unsigned;
constexpr int NW = 8, QBLK = 32, KVBLK = 64;
constexpr float THRL = 6.f;
#define ASBAR() __builtin_amdgcn_sched_barrier(0)
__device__ __forceinline__ int crow(int r, int hi) { return (r & 3) + 8 * (r >> 2) + 4 * hi; }
__device__ __forceinline__ unsigned cvtpk(float lo, float hi) { unsigned r; asm volatile("v_cvt_pk_bf16_f32 %0, %1, %2" : "=v"(r) : "v"(lo), "v"(hi)); return r; }
template <int DQK> struct Cfg {
    static constexpr int KROW = DQK * 2 + 16;
    static constexpr int SHM_V = 8192, SHM_K = 64 * KROW;
    static constexpr int OFF_V = 0, OFF_K = 2 * SHM_V, OFF_WS = OFF_K + 2 * SHM_K, OFF_OST = OFF_WS + NW * 256, OSTW = 32 * 68 * 4, END = OFF_OST + NW * OSTW;
    static constexpr int KCH = DQK / 8;
};
__device__ __forceinline__ int v_st(int k, int c) { const int kk = k; return ((kk >> 3) * 2 + (c >> 5)) * 512 + ((kk & 7) * 32 + (c & 31)) * 2; }
__device__ __forceinline__ int v_rd_base(int lane) { return ((lane & 3) << 3) | (((lane >> 2) & 3) << 6) | (((lane >> 4) & 1) << 5) | (((lane >> 5) & 1) << 8); }
constexpr int v_rd_off(int d0, int ks, int half) { return d0 * 512 + ks * 2048 + half * 1024; }
template <int OFF> __device__ __forceinline__ s16x4 tr_read(int vb) { s16x4 r; asm volatile("ds_read_b64_tr_b16 %0, %1 offset:%2" : "=&v"(r) : "v"(vb), "i"(OFF) : "memory"); return r; }
struct VFr { s16x4 l0, h0, l1, h1, l2, h2, l3, h3, m0, n0, m1, n1, m2, n2, m3, n3; };
__device__ __forceinline__ void pv_issue(VFr& v, int vb) {
    v.l0 = tr_read<v_rd_off(0, 0, 0)>(vb); v.h0 = tr_read<v_rd_off(0, 0, 1)>(vb); v.l1 = tr_read<v_rd_off(0, 1, 0)>(vb); v.h1 = tr_read<v_rd_off(0, 1, 1)>(vb);
    v.l2 = tr_read<v_rd_off(0, 2, 0)>(vb); v.h2 = tr_read<v_rd_off(0, 2, 1)>(vb); v.l3 = tr_read<v_rd_off(0, 3, 0)>(vb); v.h3 = tr_read<v_rd_off(0, 3, 1)>(vb);
    v.m0 = tr_read<v_rd_off(1, 0, 0)>(vb); v.n0 = tr_read<v_rd_off(1, 0, 1)>(vb); v.m1 = tr_read<v_rd_off(1, 1, 0)>(vb); v.n1 = tr_read<v_rd_off(1, 1, 1)>(vb);
    v.m2 = tr_read<v_rd_off(1, 2, 0)>(vb); v.n2 = tr_read<v_rd_off(1, 2, 1)>(vb); v.m3 = tr_read<v_rd_off(1, 3, 0)>(vb); v.n3 = tr_read<v_rd_off(1, 3, 1)>(vb);
}
__device__ __forceinline__ void pv_mma(f32x16* o, const VFr& v, bf16x8 pa0, bf16x8 pa1, bf16x8 pa2, bf16x8 pa3) {
#define ATT_PK(L, H) (bf16x8){L[0], L[1], L[2], L[3], H[0], H[1], H[2], H[3]}
    asm volatile("s_waitcnt lgkmcnt(0)" ::: "memory"); ASBAR();
    o[0] = __builtin_amdgcn_mfma_f32_32x32x16_bf16(pa0, ATT_PK(v.l0, v.h0), o[0], 0, 0, 0);
    o[1] = __builtin_amdgcn_mfma_f32_32x32x16_bf16(pa0, ATT_PK(v.m0, v.n0), o[1], 0, 0, 0);
    o[0] = __builtin_amdgcn_mfma_f32_32x32x16_bf16(pa1, ATT_PK(v.l1, v.h1), o[0], 0, 0, 0);
    o[1] = __builtin_amdgcn_mfma_f32_32x32x16_bf16(pa1, ATT_PK(v.m1, v.n1), o[1], 0, 0, 0);
    o[0] = __builtin_amdgcn_mfma_f32_32x32x16_bf16(pa2, ATT_PK(v.l2, v.h2), o[0], 0, 0, 0);
    o[1] = __builtin_amdgcn_mfma_f32_32x32x16_bf16(pa2, ATT_PK(v.m2, v.n2), o[1], 0, 0, 0);
    o[0] = __builtin_amdgcn_mfma_f32_32x32x16_bf16(pa3, ATT_PK(v.l3, v.h3), o[0], 0, 0, 0);
    o[1] = __builtin_amdgcn_mfma_f32_32x32x16_bf16(pa3, ATT_PK(v.m3, v.n3), o[1], 0, 0, 0);
#undef ATT_PK
}

__device__ __forceinline__ float rowmax32(const f32x16& p0, const f32x16& p1) {
#define ATT_MX3(a, b, c) __builtin_fmaxf(__builtin_fmaxf((a), (b)), (c))
    float a = ATT_MX3(p0[0], p0[1], p1[0]), b = ATT_MX3(p0[2], p0[3], p1[1]); a = ATT_MX3(a, p1[2], p1[3]);
#pragma unroll
    for (int r = 4; r < 16; r += 4) { a = ATT_MX3(a, p0[r], p0[r + 1]); b = ATT_MX3(b, p0[r + 2], p0[r + 3]); a = ATT_MX3(a, p1[r], p1[r + 1]); b = ATT_MX3(b, p1[r + 2], p1[r + 3]); }
#undef ATT_MX3
    float m = __builtin_fmaxf(a, b);
    auto rr = __builtin_amdgcn_permlane32_swap(__float_as_uint(m), __float_as_uint(m), false, false);
    return __builtin_fmaxf(__uint_as_float(rr[0]), __uint_as_float(rr[1]));
}
template <int DQK> __device__ __forceinline__ void qkt2(f32x16& p0, f32x16& p1, const char* Ks, const bf16x8* qr, const f32x16& negm, int r32, int hi) {
    constexpr int KROW = Cfg<DQK>::KROW;
#pragma unroll
    for (int d0 = 0; d0 < DQK / 16; ++d0) { const int cb = (d0 * 16 + hi * 8) * 2;
        const bf16x8 b0 = *reinterpret_cast<const bf16x8*>(Ks + r32 * KROW + cb);
        const bf16x8 b1 = *reinterpret_cast<const bf16x8*>(Ks + (32 + r32) * KROW + cb);
        if (d0 == 0) { p0 = __builtin_amdgcn_mfma_f32_32x32x16_bf16(b0, qr[0], negm, 0, 0, 0); p1 = __builtin_amdgcn_mfma_f32_32x32x16_bf16(b1, qr[0], negm, 0, 0, 0); }
        else { p0 = __builtin_amdgcn_mfma_f32_32x32x16_bf16(b0, qr[d0], p0, 0, 0, 0); p1 = __builtin_amdgcn_mfma_f32_32x32x16_bf16(b1, qr[d0], p1, 0, 0, 0); } }
}
template <int DQK> struct Cfg2 {
    static constexpr int KROW = DQK * 2 + 16, SHM_V = 8192, SHM_K = 64 * KROW;
    static constexpr int OFF_V = 0, OFF_K = 3 * SHM_V, OFF_WS = OFF_K + 2 * SHM_K, OFF_OST = OFF_WS + NW * 256, OSTW = 32 * 68 * 4, END = OFF_OST + NW * OSTW;
};
__device__ __forceinline__ float softmax_tile(f32x16& p0, f32x16& p1, float& mhat, f32x16& negm, float& l_reg, bool first, bf16x8& pa0, bf16x8& pa1, bf16x8& pa2, bf16x8& pa3) {
    const float pmax = rowmax32(p0, p1);
    float alpha = 1.f;
    if (__builtin_expect(first || __any(pmax > THRL), 0)) { const float dl = first ? pmax : __builtin_fmaxf(pmax, 0.f); mhat += dl;
#pragma unroll
        for (int r = 0; r < 16; ++r) { p0[r] -= dl; p1[r] -= dl; }
#pragma unroll
        for (int r = 0; r < 16; ++r) negm[r] = -mhat;
        if (!first) alpha = __builtin_amdgcn_exp2f(-dl); }
#pragma unroll
    for (int r = 0; r < 16; ++r) { p0[r] = __builtin_amdgcn_exp2f(p0[r]); p1[r] = __builtin_amdgcn_exp2f(p1[r]); }
    float ps = 0;
#pragma unroll
    for (int r = 0; r < 16; ++r) ps += p0[r];
#pragma unroll
    for (int r = 0; r < 16; ++r) ps += p1[r];
    { auto rr = __builtin_amdgcn_permlane32_swap(__float_as_uint(ps), __float_as_uint(ps), false, false); ps = __uint_as_float(rr[0]) + __uint_as_float(rr[1]); }
    l_reg = l_reg * alpha + ps;
#define ATT_PK4(P, BASE, OUT) do { u32x4 w = {cvtpk(P[BASE + 0], P[BASE + 1]), cvtpk(P[BASE + 2], P[BASE + 3]), cvtpk(P[BASE + 4], P[BASE + 5]), cvtpk(P[BASE + 6], P[BASE + 7])}; \
    OUT = *reinterpret_cast<bf16x8*>(&w); } while (0)
    ATT_PK4(p0, 0, pa0); ATT_PK4(p0, 8, pa1); ATT_PK4(p1, 0, pa2); ATT_PK4(p1, 8, pa3);
#undef ATT_PK4
    return alpha;
}
__device__ __forceinline__ void softmax_fast(f32x16& p0, f32x16& p1, float& l_reg  , float& bad, bf16x8& pa0, bf16x8& pa1, bf16x8& pa2, bf16x8& pa3) {
#pragma unroll
    for (int r = 0; r < 16; ++r) { p0[r] = __builtin_amdgcn_exp2f(p0[r]); p1[r] = __builtin_amdgcn_exp2f(p1[r]); }
    float ps = 0;
#pragma unroll
    for (int r = 0; r < 16; ++r) ps += p0[r];
#pragma unroll
    for (int r = 0; r < 16; ++r) ps += p1[r];
    bad = (ps < 1.152921504606846976e18f) ? bad : 1.f;
    l_reg += ps;
#define ATT_PK4(P, BASE, OUT) do { u32x4 w = {cvtpk(P[BASE + 0], P[BASE + 1]), cvtpk(P[BASE + 2], P[BASE + 3]), cvtpk(P[BASE + 4], P[BASE + 5]), cvtpk(P[BASE + 6], P[BASE + 7])}; \
    OUT = *reinterpret_cast<bf16x8*>(&w); } while (0)
    ATT_PK4(p0, 0, pa0); ATT_PK4(p0, 8, pa1); ATT_PK4(p1, 0, pa2); ATT_PK4(p1, 8, pa3);
#undef ATT_PK4
}
template <int DQK, bool FAST = false>
__device__ __forceinline__ bool attn_unit(const bf16_t* __restrict__ Qb, int ldq, const bf16_t* __restrict__ Kh, int ldk, const bf16_t* __restrict__ Kr  ,
                                          const bf16_t* __restrict__ Vh, int ldv, int seq, bf16_t* __restrict__ Ob, const bf16_t* __restrict__ Gb, char* lds, int tid, int par = 0  ) {
    using C = Cfg2<DQK>;
    constexpr int KROW = C::KROW, KCH = DQK / 8, SHM_V = C::SHM_V, SHM_K = C::SHM_K;
    const int wid = __builtin_amdgcn_readfirstlane(tid >> 6), lane = tid & 63, r32 = lane & 31, hi = lane >> 5; const bool h1 = wid >= 4;
    char* V_lds = lds + C::OFF_V; char* K_lds = lds + C::OFF_K;
    float* ws = (float*)(lds + C::OFF_WS) + wid * 64; float* li_l = ws; float* al_l = ws + 32;
    float mhat = 0.f, l_reg = 0.f; f32x16 o[2] = {}; f32x16 negm = {}; bf16x8 qr[DQK / 16];
    const bf16_t* Qw = Qb + (size_t)(wid * QBLK + r32) * ldq + hi * 8;
#pragma unroll
    for (int d0 = 0; d0 < DQK / 16; ++d0) qr[d0] = *reinterpret_cast<const bf16x8*>(Qw + d0 * 16);
    const int vk = tid >> 3, vc = (tid & 7) * 8, vst = v_st(vk, vc);
    const int kr0 = tid / KCH, kc0 = (tid % KCH) * 8, kr1 = (512 + tid) / KCH, kc1 = ((512 + tid) % KCH) * 8;
    const bool two = (KCH * 64 > 512) && (tid < KCH * 64 - 512);
    const int vb0 = (int)(uintptr_t)V_lds + v_rd_base(lane);
    bf16x8 s_vs, s_k0, s_k1;
    const bf16_t* ksrc0 = (kc0 < 64) ? Kh + (size_t)kr0 * ldk + kc0 : Kr + (size_t)kr0 * 32 + (kc0 - 64); const int kst0 = (kc0 < 64) ? ldk : 32;
    const bf16_t* ksrc1 = (kc1 < 64) ? Kh + (size_t)kr1 * ldk + kc1 : Kr + (size_t)kr1 * 32 + (kc1 - 64); const int kst1 = (kc1 < 64) ? ldk : 32;
#define ATT_SLOAD(k0) do { s_vs = *reinterpret_cast<const bf16x8*>(Vh + (size_t)((k0) + vk) * ldv + vc); \
    s_k0 = *reinterpret_cast<const bf16x8*>(ksrc0 + (size_t)(k0) * kst0); \
    if (two) s_k1 = *reinterpret_cast<const bf16x8*>(ksrc1 + (size_t)(k0) * kst1); } while (0)
#define ATT_SWRITE(kb, vs) do { *(bf16x8*)(V_lds + (vs) + vst) = s_vs; *(bf16x8*)(K_lds + (kb) * SHM_K + kr0 * KROW + kc0 * 2) = s_k0; \
    if (two) *(bf16x8*)(K_lds + (kb) * SHM_K + kr1 * KROW + kc1 * 2) = s_k1; } while (0)
#define ATT_RESC(a) do { if (__any((a) < 1.f)) { if (hi == 0) al_l[r32] = (a); asm volatile("s_waitcnt lgkmcnt(0)" ::: "memory"); \
    _Pragma("unroll") for (int d = 0; d < 2; ++d) _Pragma("unroll") for (int r = 0; r < 16; ++r) o[d][r] *= al_l[crow(r, hi)]; } } while (0)
    f32x16 p0, p1; bf16x8 pa0, pa1, pa2, pa3; const int NT = seq / KVBLK; float bad = 0.f, l_part = 0.f;
    int vsr = 0, vsw = 2 * SHM_V;
#define ATT_ROT() do { vsr = (vsr == 2 * SHM_V) ? 0 : vsr + SHM_V; vsw = (vsw == 2 * SHM_V) ? 0 : vsw + SHM_V; } while (0)
    ATT_SLOAD(0); ATT_SWRITE(0, 0); __syncthreads(); ATT_SLOAD(KVBLK);
    unsigned* latch = (unsigned*)(lds + C::END);
    if (FAST && tid == 0) latch[par ^ 1] = 0u;
    ASBAR(); qkt2<DQK>(p0, p1, K_lds, qr, negm, r32, hi);
    if (!h1) { (void)softmax_tile(p0, p1, mhat, negm, l_reg, true, pa0, pa1, pa2, pa3); }
    VFr vf;
    if (!h1) pv_issue(vf, vb0);
    ATT_SWRITE(1, SHM_V); __syncthreads(); if (2 < NT) ATT_SLOAD(2 * KVBLK);
#define ATT_STAGE() do { if (t + 2 < NT) { ATT_SWRITE(t & 1, vsw); if (t + 3 < NT) ATT_SLOAD((t + 3) * KVBLK); } } while (0)
    for (int t = 0; t < NT; ++t) {
        if (h1) { pv_issue(vf, vb0 + vsr);
            if (FAST && t > 0) softmax_fast(p0, p1, l_part, bad, pa0, pa1, pa2, pa3);
            else { const float al = softmax_tile(p0, p1, mhat, negm, l_reg, t == 0, pa0, pa1, pa2, pa3); ATT_RESC(al); }
            ATT_STAGE(); }
        ASBAR(); pv_mma(o, vf, pa0, pa1, pa2, pa3);
        if (!h1) ATT_STAGE();
        if (t + 1 < NT) {
            ASBAR(); qkt2<DQK>(p0, p1, K_lds + ((t + 1) & 1) * SHM_K, qr, negm, r32, hi);
            if (!h1) { const int vnx = vb0 + ((vsr == 2 * SHM_V) ? 0 : vsr + SHM_V);
                       if (FAST) { pv_issue(vf, vnx); softmax_fast(p0, p1, l_part, bad, pa0, pa1, pa2, pa3); }
                       else { const float al = softmax_tile(p0, p1, mhat, negm, l_reg, false, pa0, pa1, pa2, pa3); ATT_RESC(al); pv_issue(vf, vnx); } }
            __syncthreads();
            ATT_ROT();
        }
    }
#undef ATT_STAGE
    u32x4 gt_[4];
#pragma unroll
    for (int i = 0; i < 4; ++i) gt_[i] = *(const u32x4*)(Gb + (size_t)(wid * QBLK + i * 8 + (lane >> 3)) * 1024 + (lane & 7) * 8);
    if (FAST) { auto rr = __builtin_amdgcn_permlane32_swap(__float_as_uint(l_part), __float_as_uint(l_part), false, false); l_reg += __uint_as_float(rr[0]) + __uint_as_float(rr[1]); }
    if (hi == 0) li_l[r32] = l_reg; asm volatile("s_waitcnt lgkmcnt(0)" ::: "memory");
    float* stg = (float*)(lds + C::OFF_OST + wid * C::OSTW);
#pragma unroll
    for (int r = 0; r < 16; ++r) { const int orow = crow(r, hi); const float rli = __builtin_amdgcn_rcpf(li_l[orow]);
        stg[orow * 68 + r32] = o[0][r] * rli; stg[orow * 68 + 32 + r32] = o[1][r] * rli; }
    asm volatile("s_waitcnt lgkmcnt(0)" ::: "memory");
#pragma unroll
    for (int i = 0; i < 4; ++i) { const int row = i * 8 + (lane >> 3), ch = (lane & 7) * 8;
        const f32x4v a = *(const f32x4v*)(stg + row * 68 + ch), b = *(const f32x4v*)(stg + row * 68 + ch + 4);
        const size_t off = (size_t)(wid * QBLK + row) * 1024 + ch; const u32x4 g = gt_[i]; u32x4 w;
        w.x = cvtpk(a[0] * __uint_as_float(g.x << 16), a[1] * __uint_as_float(g.x & 0xffff0000u)); w.y = cvtpk(a[2] * __uint_as_float(g.y << 16), a[3] * __uint_as_float(g.y & 0xffff0000u));
        w.z = cvtpk(b[0] * __uint_as_float(g.z << 16), b[1] * __uint_as_float(g.z & 0xffff0000u)); w.w = cvtpk(b[2] * __uint_as_float(g.w << 16), b[3] * __uint_as_float(g.w & 0xffff0000u));
        *(u32x4*)(Ob + off) = w; }
    bool redo = false;
    if (FAST) { if (__any(bad != 0.f) && lane == 0) latch[par] = 1u; __syncthreads(); redo = (latch[par] != 0u); } else __syncthreads();
#undef ATT_SLOAD
#undef ATT_SWRITE
#undef ATT_RESC
#undef ATT_ROT
    return redo;
}
#undef ASBAR
}
namespace fft {
using bf16x8 = __attribute__((ext_vector_type(8))) short;
using s16x4  = __attribute__((ext_vector_type(4))) short;
using f32x16 = __attribute__((ext_vector_type(16))) float;
using f32x4v = __attribute__((ext_vector_type(4))) float;
using u32x4  = __attribute__((ext_vector_type(4))) unsigned;
constexpr int OFF_X = 0, OFF_STG = 65536;
__device__ __forceinline__ int crow(int r, int hi) { return (r & 3) + 8 * (r >> 2) + 4 * hi; }
__device__ __forceinline__ unsigned cvtpk(float lo, float hi) { unsigned r; asm volatile("v_cvt_pk_bf16_f32 %0, %1, %2" : "=v"(r) : "v"(lo), "v"(hi)); return r; }
__device__ __forceinline__ int x_st(int kk, int c) { const int kp = (kk & ~0xC) | ((kk & 4) << 1) | ((kk & 8) >> 1); return ((kp >> 3) * 8 + (c >> 5)) * 512 + ((kp & 7) * 32 + (c & 31)) * 2; }
__device__ __forceinline__ int x_rd_base(int lane) { return ((lane & 3) << 3) | (((lane >> 2) & 3) << 6) | (((lane >> 4) & 1) << 5) | (((lane >> 5) & 1) << 8); }
constexpr int x_rd_off(int nb, int ks, int half) { return ks * 8192 + half * 4096 + nb * 512; }
template <int OFF> __device__ __forceinline__ s16x4 tr_read(int vb) { s16x4 r; asm volatile("ds_read_b64_tr_b16 %0, %1 offset:%2" : "=&v"(r) : "v"(vb), "i"(OFF) : "memory"); return r; }
template <int NB> __device__ __forceinline__ void mm_block(f32x16& acc, const bf16x8 (&afr)[8], int vb) {
#define FFT_PK(L, H) (bf16x8){L[0], L[1], L[2], L[3], H[0], H[1], H[2], H[3]}
    { const s16x4 l0 = tr_read<x_rd_off(NB, 0, 0)>(vb), h0 = tr_read<x_rd_off(NB, 0, 1)>(vb), l1 = tr_read<x_rd_off(NB, 1, 0)>(vb), h1 = tr_read<x_rd_off(NB, 1, 1)>(vb);
      const s16x4 l2 = tr_read<x_rd_off(NB, 2, 0)>(vb), h2 = tr_read<x_rd_off(NB, 2, 1)>(vb), l3 = tr_read<x_rd_off(NB, 3, 0)>(vb), h3 = tr_read<x_rd_off(NB, 3, 1)>(vb);
      asm volatile("s_waitcnt lgkmcnt(0)" ::: "memory"); __builtin_amdgcn_sched_barrier(0);
      acc = __builtin_amdgcn_mfma_f32_32x32x16_bf16(afr[0], FFT_PK(l0, h0), acc, 0, 0, 0); acc = __builtin_amdgcn_mfma_f32_32x32x16_bf16(afr[1], FFT_PK(l1, h1), acc, 0, 0, 0);
      acc = __builtin_amdgcn_mfma_f32_32x32x16_bf16(afr[2], FFT_PK(l2, h2), acc, 0, 0, 0); acc = __builtin_amdgcn_mfma_f32_32x32x16_bf16(afr[3], FFT_PK(l3, h3), acc, 0, 0, 0); }
    { const s16x4 l0 = tr_read<x_rd_off(NB, 4, 0)>(vb), h0 = tr_read<x_rd_off(NB, 4, 1)>(vb), l1 = tr_read<x_rd_off(NB, 5, 0)>(vb), h1 = tr_read<x_rd_off(NB, 5, 1)>(vb);
      const s16x4 l2 = tr_read<x_rd_off(NB, 6, 0)>(vb), h2 = tr_read<x_rd_off(NB, 6, 1)>(vb), l3 = tr_read<x_rd_off(NB, 7, 0)>(vb), h3 = tr_read<x_rd_off(NB, 7, 1)>(vb);
      asm volatile("s_waitcnt lgkmcnt(0)" ::: "memory"); __builtin_amdgcn_sched_barrier(0);
      acc = __builtin_amdgcn_mfma_f32_32x32x16_bf16(afr[4], FFT_PK(l0, h0), acc, 0, 0, 0); acc = __builtin_amdgcn_mfma_f32_32x32x16_bf16(afr[5], FFT_PK(l1, h1), acc, 0, 0, 0);
      acc = __builtin_amdgcn_mfma_f32_32x32x16_bf16(afr[6], FFT_PK(l2, h2), acc, 0, 0, 0); acc = __builtin_amdgcn_mfma_f32_32x32x16_bf16(afr[7], FFT_PK(l3, h3), acc, 0, 0, 0); }
#undef FFT_PK
}
struct TileRegs { bf16x8 v[8]; };
__device__ __forceinline__ void tile_load(TileRegs& t, const bf16_t* src  , size_t rowstride, int tid) {
    const bf16_t* p = src + (size_t)(tid >> 5) * rowstride + (tid & 31) * 8;
#pragma unroll
    for (int i = 0; i < 8; ++i) t.v[i] = *reinterpret_cast<const bf16x8*>(p + (size_t)(16 * i) * rowstride);
}
__device__ __forceinline__ void tile_write(const TileRegs& t, char* xl, int tid) {
    char* p = xl + x_st(tid >> 5, (tid & 31) * 8);
#pragma unroll
    for (int i = 0; i < 8; ++i) *reinterpret_cast<bf16x8*>(p + 8192 * i) = t.v[i];
}

__device__ __forceinline__ void stage_a(const bf16_t* __restrict__ PQ, bf16_t* __restrict__ Y, char* lds, int vcu, int G) {
    const int tid = threadIdx.x, wid = tid >> 6, lane = tid & 63, r32 = lane & 31, hi = lane >> 5, w = wid & 3, nh = wid >> 2;
    char* xl = lds + OFF_X; char* stg = lds + OFF_STG + wid * 8192;
    bf16x8 afr[8];
    { const int reim = r32 >> 4, k1 = 16 * w + (r32 & 15);
#pragma unroll
      for (int ks = 0; ks < 8; ++ks) { float v[8];
#pragma unroll
          for (int j = 0; j < 8; ++j) { const int kk = 16 * ks + 8 * hi + j, s1 = kk >> 1, pq = kk & 1; const float f = (float)((k1 * s1) & 63) * (1.f / 64.f);
              const float c = __builtin_amdgcn_cosf(f) * 0.125f, s = __builtin_amdgcn_sinf(f) * 0.125f; v[j] = reim == 0 ? (pq == 0 ? c : -s) : (pq == 0 ? s : c); }
          u32x4 p = {cvtpk(v[0], v[1]), cvtpk(v[2], v[3]), cvtpk(v[4], v[5]), cvtpk(v[6], v[7])}; afr[ks] = *reinterpret_cast<bf16x8*>(&p); } }
    const int vb = (int)(uintptr_t)xl + x_rd_base(lane) + nh * 4 * 512;
    constexpr int NU = NB * 192;
    TileRegs tr;
    int u = vcu;
    if (u < NU) tile_load(tr, PQ + (size_t)(u / 192) * 128 * 49152 + (u % 192) * 256, 49152, tid);
    for (; u < NU; u += G) {
        const int b = u / 192, j = u % 192;
        tile_write(tr, xl, tid);
        __syncthreads();
        { const int un = u + G; if (un < NU) tile_load(tr, PQ + (size_t)(un / 192) * 128 * 49152 + (un % 192) * 256, 49152, tid); }
        f32x16 acc[4] = {};
        mm_block<0>(acc[0], afr, vb); mm_block<1>(acc[1], afr, vb); mm_block<2>(acc[2], afr, vb); mm_block<3>(acc[3], afr, vb);
        const int s2 = j / 3;
#pragma unroll
        for (int r = 0; r < 8; ++r) { const int kl = crow(r, hi), k1 = 16 * w + kl; const float f = (float)(k1 * s2) * (1.f / 4096.f); const float tr_ = __builtin_amdgcn_cosf(f), ti_ = __builtin_amdgcn_sinf(f);
#pragma unroll
            for (int nb = 0; nb < 4; ++nb) { const float re = acc[nb][r], im = acc[nb][r + 8];
                *(bf16_t*)(stg + kl * 256 + (nb * 32 + r32) * 2) = f2bf(tr_ * re - ti_ * im);
                *(bf16_t*)(stg + (16 + kl) * 256 + (nb * 32 + r32) * 2) = f2bf(ti_ * re + tr_ * im); } }
        asm volatile("s_waitcnt lgkmcnt(0)" ::: "memory");
#pragma unroll
        for (int i = 0; i < 8; ++i) { const int rowl = i * 4 + (lane >> 4), c16 = lane & 15; const u32x4 v = *(const u32x4*)(stg + rowl * 256 + c16 * 16);
            const int reim = rowl >> 4, k1 = 16 * w + (rowl & 15);
            *(u32x4*)(Y + ((size_t)((b * 64 + k1) * 2 + reim)) * 49152 + j * 256 + nh * 128 + c16 * 8) = v; }
        __syncthreads();
    }
}
__device__ __forceinline__ void stage_b(const bf16_t* __restrict__ Y, const bf16_t* __restrict__ SG, bf16_t* __restrict__ BR, char* lds, int vcu, int G) {
    const int tid = threadIdx.x, wid = tid >> 6, lane = tid & 63, r32 = lane & 31, hi = lane >> 5, w = wid & 1, nq = wid >> 1;
    char* xl = lds + OFF_X; float* stg = (float*)(lds + OFF_STG + wid * 8192);
    bf16x8 afr[8];
    { const int k2 = 32 * w + r32;
#pragma unroll
      for (int ks = 0; ks < 8; ++ks) { float v[8];
#pragma unroll
          for (int j = 0; j < 8; ++j) { const int kk = 16 * ks + 8 * hi + j, reim = kk >> 6, s2 = kk & 63; const float f = (float)((k2 * s2) & 63) * (1.f / 64.f);
              v[j] = reim == 0 ? __builtin_amdgcn_cosf(f) * 0.125f : -__builtin_amdgcn_sinf(f) * 0.125f; }
          u32x4 p = {cvtpk(v[0], v[1]), cvtpk(v[2], v[3]), cvtpk(v[4], v[5]), cvtpk(v[6], v[7])}; afr[ks] = *reinterpret_cast<bf16x8*>(&p); } }
    const int vb = (int)(uintptr_t)xl + x_rd_base(lane) + nq * 2 * 512;
    constexpr int NU = NB * 64 * 3;
    TileRegs tr;
    int u = vcu;
    if (u < NU) tile_load(tr, Y + (size_t)(u / 3) * 2 * 49152 + (u % 3) * 256, 768, tid);
    for (; u < NU; u += G) {
        const int bk1 = u / 3, j = u % 3, b = bk1 >> 6, k1 = bk1 & 63;
        tile_write(tr, xl, tid);
        __syncthreads();
        { const int un = u + G; if (un < NU) tile_load(tr, Y + (size_t)(un / 3) * 2 * 49152 + (un % 3) * 256, 768, tid); }
        f32x16 acc[2] = {};
        mm_block<0>(acc[0], afr, vb); mm_block<1>(acc[1], afr, vb);
#pragma unroll
        for (int r = 0; r < 16; ++r) { const int rl = crow(r, hi); stg[rl * 64 + r32] = acc[0][r]; stg[rl * 64 + 32 + r32] = acc[1][r]; }
        asm volatile("s_waitcnt lgkmcnt(0)" ::: "memory");
#pragma unroll
        for (int i = 0; i < 4; ++i) { const int rowl = i * 8 + (lane >> 3), c8 = (lane & 7) * 8;
            const f32x4v a = *(const f32x4v*)(stg + rowl * 64 + c8), c = *(const f32x4v*)(stg + rowl * 64 + c8 + 4);
            const size_t off = ((size_t)b * SEQ + k1 + 64 * (32 * w + rowl)) * 1024 + j * 256 + nq * 64 + c8; const u32x4 g = *(const u32x4*)(SG + off); u32x4 o;
            o.x = cvtpk(a[0] * __uint_as_float(g.x << 16), a[1] * __uint_as_float(g.x & 0xffff0000u)); o.y = cvtpk(a[2] * __uint_as_float(g.y << 16), a[3] * __uint_as_float(g.y & 0xffff0000u));
            o.z = cvtpk(c[0] * __uint_as_float(g.z << 16), c[1] * __uint_as_float(g.z & 0xffff0000u)); o.w = cvtpk(c[2] * __uint_as_float(g.w << 16), c[3] * __uint_as_float(g.w & 0xffff0000u));
            *(u32x4*)(BR + off) = o; }
        __syncthreads();
    }
}
}
constexpr int NWAVES = 8;
constexpr int N_PHASES = 9;
constexpr int CW_BAR = 4096;
constexpr int RING_OFF = 0, RING_BYTES = 131072;
constexpr int LDSCTL_OFF = RING_BYTES, MISC_OFF = LDSCTL_OFF + 320, RS_OFF = LDSCTL_OFF + 1024  ;
constexpr int LDS_BYTES = 147456;
static_assert(RS_OFF + 4096 <= LDS_BYTES, "LDS map");

struct Args { const void* in[19]; float* out; unsigned char* ws; int ph_lo, ph_hi, li, pad; };

__device__ __forceinline__ void prep_w_job(const float* __restrict__ W, int ldw, int K, bf16_t* __restrict__ out, int n0, int nrows, const float* __restrict__ scale, int mode, int off, int gt, int GT) {
    const int total = nrows * (K >> 3);
    for (int idx = gt; idx < total; idx += GT) {
        const int n = idx % nrows, k8 = idx / nrows; const int sc = src_col(mode, n, off);
        float v[8];
#pragma unroll
        for (int i = 0; i < 8; ++i) { const int k = k8 * 8 + i; float w = (sc >= 0) ? W[(size_t)k * ldw + sc] : 0.f; if (scale) w *= scale[k]; v[i] = w; }
        uint4 o; o.x = pk2(v[0], v[1]); o.y = pk2(v[2], v[3]); o.z = pk2(v[4], v[5]); o.w = pk2(v[6], v[7]);
        *(uint4*)(out + (size_t)(n0 + n) * K + k8 * 8) = o;
    }
}
__device__ __forceinline__ void rmsnorm_row(const float* __restrict__ xrow, const float* __restrict__ g, bf16_t* __restrict__ orow, int lane) {
    const float4* xr = (const float4*)xrow + lane; float4 v[4]; float s = 0.f;
#pragma unroll
    for (int j = 0; j < 4; ++j) { v[j] = xr[64 * j]; s += v[j].x * v[j].x + v[j].y * v[j].y + v[j].z * v[j].z + v[j].w * v[j].w; }
    const float rstd = rsqrtf(wave_sum(s) * (1.f / DM) + EPS);
    uint2* o = (uint2*)orow + lane;
#pragma unroll
    for (int j = 0; j < 4; ++j) { const float4 gv = g ? ((const float4*)g)[lane + 64 * j] : make_float4(1.f, 1.f, 1.f, 1.f);
        uint2 w; w.x = pk2(v[j].x * rstd * gv.x, v[j].y * rstd * gv.y); w.y = pk2(v[j].z * rstd * gv.z, v[j].w * rstd * gv.w); o[64 * j] = w; }
}

typedef float f32x4m __attribute__((ext_vector_type(4)));
__device__ __forceinline__ void fold1_tiles(const float* __restrict__ Wf, float* __restrict__ AG, int gw, int NGW, int lane) {
    const int li = lane & 15, lk = lane >> 4;
    for (int tile = gw; tile < 2 * 4 * 12 * 12; tile += NGW) { const int di = tile % 12, ci = (tile / 12) % 12, g = (tile / 144) & 3, pq = tile / 576;
        const int c = ci * 16 + li; int p = (lk * c) % 192; const int step = (4 * c) % 192;
        const float* wp = Wf + ((size_t)g * 192 + lk) * 192 + di * 16 + li;
        f32x4m acc = {0.f, 0.f, 0.f, 0.f};
#pragma unroll 8
        for (int m0 = 0; m0 < 192; m0 += 4) { const float f = (float)p * (1.f / 192.f); const float a = pq ? __builtin_amdgcn_sinf(f) : __builtin_amdgcn_cosf(f);
            const float b = wp[(size_t)m0 * 192];
            acc = __builtin_amdgcn_mfma_f32_16x16x4f32(a, b, acc, 0, 0, 0);
            p += step; if (p >= 192) p -= 192; }
        float* op = AG + (((size_t)pq * 4 + g) * 192 + ci * 16 + 4 * lk) * 192 + di * 16 + li;
#pragma unroll
        for (int r = 0; r < 4; ++r) op[(size_t)r * 192] = acc[r] * 0.07216878364870322f; }
}
__device__ __forceinline__ void fold2_strips(const float* __restrict__ Win1, const float* __restrict__ g1, const float* __restrict__ AG, bf16_t* __restrict__ WIN1o, int gw, int NGW, int lane) {
    const int li = lane & 15, lk = lane >> 4;
    for (int s = gw; s < 64 * 8 * 3; s += NGW) { const int ki = s & 63, pg = (s >> 6) & 7, ds = s >> 9;
        const int g = pg & 3; const float* ap = Win1 + (size_t)(ki * 16 + li) * 2048 + 192 * g + lk; const float* bp = AG + ((size_t)pg * 192 + lk) * 192 + ds * 64 + li;
        f32x4m acc[4] = {{0.f, 0.f, 0.f, 0.f}, {0.f, 0.f, 0.f, 0.f}, {0.f, 0.f, 0.f, 0.f}, {0.f, 0.f, 0.f, 0.f}};
#pragma unroll 4
        for (int c0 = 0; c0 < 192; c0 += 4) { const float a = ap[c0]; const float* b = bp + (size_t)c0 * 192;
#pragma unroll
            for (int n = 0; n < 4; ++n) acc[n] = __builtin_amdgcn_mfma_f32_16x16x4f32(a, b[16 * n], acc[n], 0, 0, 0); }
        const int k0 = ki * 16 + 4 * lk; const float4 gv = *(const float4*)(g1 + k0);
#pragma unroll
        for (int n = 0; n < 4; ++n) { uint2 w; w.x = pk2(acc[n][0] * gv.x, acc[n][1] * gv.y); w.y = pk2(acc[n][2] * gv.z, acc[n][3] * gv.w);
            *(uint2*)(WIN1o + (size_t)((pg >> 2) * 768 + g * 192 + ds * 64 + n * 16 + li) * 1024 + k0) = w; } }
}
__device__ __forceinline__ void rmsnorm_rows2(const float* __restrict__ X, const float* __restrict__ g, bf16_t* __restrict__ O, int nrows, int gw, int NGW, int lane) {
    for (int m = 2 * gw; m < nrows; m += 2 * NGW) {
        const float4* x0 = (const float4*)(X + (size_t)m * DM) + lane; const float4* x1 = x0 + DM / 4; float4 v[8]; float s0 = 0.f, s1 = 0.f;
#pragma unroll
        for (int j = 0; j < 4; ++j) { v[j] = x0[64 * j]; v[4 + j] = x1[64 * j]; }
#pragma unroll
        for (int j = 0; j < 4; ++j) { s0 += v[j].x * v[j].x + v[j].y * v[j].y + v[j].z * v[j].z + v[j].w * v[j].w; s1 += v[4 + j].x * v[4 + j].x + v[4 + j].y * v[4 + j].y + v[4 + j].z * v[4 + j].z + v[4 + j].w * v[4 + j].w; }
        const float r0 = rsqrtf(wave_sum(s0) * (1.f / DM) + EPS), r1 = rsqrtf(wave_sum(s1) * (1.f / DM) + EPS);
        uint2* o0 = (uint2*)(O + (size_t)m * DM) + lane; uint2* o1 = o0 + DM / 4;
#pragma unroll
        for (int j = 0; j < 4; ++j) { const float4 gv = g ? ((const float4*)g)[lane + 64 * j] : make_float4(1.f, 1.f, 1.f, 1.f);
            uint2 w; w.x = pk2(v[j].x * r0 * gv.x, v[j].y * r0 * gv.y); w.y = pk2(v[j].z * r0 * gv.z, v[j].w * r0 * gv.w); o0[64 * j] = w;
            uint2 z; z.x = pk2(v[4 + j].x * r1 * gv.x, v[4 + j].y * r1 * gv.y); z.y = pk2(v[4 + j].z * r1 * gv.z, v[4 + j].w * r1 * gv.w); o1[64 * j] = z; } }
}
__global__ void __launch_bounds__(NWAVES * 64, 2) mk_fwd(Args args) {
    extern __shared__ __attribute__((aligned(16))) unsigned char lds[];
    LAS unsigned char* ldsl = (LAS unsigned char*)lds;
    volatile LAS unsigned* MISC = (volatile LAS unsigned*)(ldsl + MISC_OFF);
    const int tid0 = threadIdx.x;
#define PHASE_IDS() int tid = threadIdx.x; asm volatile("" : "+v"(tid)); const int lane = tid & 63, wave = __builtin_amdgcn_readfirstlane(tid >> 6); const int gt = (int)blockIdx.x * (NWAVES * 64) + tid, gw = (int)blockIdx.x * NWAVES + wave; (void)lane; (void)wave; (void)gt; (void)gw;
    const int vcu = (gridDim.x % 8 == 0) ? ((int)blockIdx.x % 8) * ((int)gridDim.x / 8) + (int)blockIdx.x / 8 : (int)blockIdx.x;
    const int G = gridDim.x, GT = G * NWAVES * 64, NGW = G * NWAVES;
    unsigned char* ws = args.ws;
    gu32* ctl = (gu32*)(ws + WS_CTL);
#define in_x ((const float*)args.in[0])
#define in_mem ((const float*)args.in[1])
#define in_pos ((const int*)args.in[2])
#define in_g0 ((const float*)args.in[3])
#define in_w_in0 ((const float*)args.in[4])
#define in_gq ((const float*)args.in[5])
#define in_gkv ((const float*)args.in[6])
#define in_w_uq ((const float*)args.in[7])
#define in_w_ukv ((const float*)args.in[8])
#define in_gm0 ((const float*)args.in[9])
#define in_w_mkv0 ((const float*)args.in[10])
#define in_w_out0 ((const float*)args.in[11])
#define in_g1 ((const float*)args.in[12])
#define in_w_in1 ((const float*)args.in[13])
#define in_w_fnet ((const float*)args.in[14])
#define in_gm1 ((const float*)args.in[15])
#define in_w_mkv1 ((const float*)args.in[16])
#define in_w_out1 ((const float*)args.in[17])
#define in_gf ((const float*)args.in[18])
#define in_out (args.out)
#define WIN0 ((bf16_t*)(ws + WS_WIN0))
#define WUQ ((bf16_t*)(ws + WS_WUQ))
#define WUKV ((bf16_t*)(ws + WS_WUKV))
#define WMEM ((bf16_t*)(ws + WS_WMEM))
#define WOUT0 ((bf16_t*)(ws + WS_WOUT0))
#define WOUT1 ((bf16_t*)(ws + WS_WOUT1))
#define WIN1 ((bf16_t*)(ws + WS_WIN1))
#define AGBG ((float*)(ws + WS_AGBG))
#define ROPE ((float*)(ws + WS_ROPE))
#define MEMN ((bf16_t*)(ws + WS_MEMN))
#define MEMKV ((bf16_t*)(ws + WS_MEMKV))
#define RSTD1 ((float*)(ws + WS_RSTD1))
#define SSQ ((float*)(ws + WS_SSQ))
#define XN0 ((bf16_t*)(ws + WS_XN0))
#define BR ((bf16_t*)(ws + WS_BR))
#define CQ ((bf16_t*)(ws + WS_CQ))
#define CKV ((bf16_t*)(ws + WS_CKV))
#define QMEM0 ((bf16_t*)(ws + WS_QMEM0))
#define SG0 ((bf16_t*)(ws + WS_SG0))
#define Kb ((bf16_t*)(ws + WS_K))
#define KR ((bf16_t*)(ws + WS_K + 96 * MiB))
#define Qb ((bf16_t*)(ws + WS_Q))
#define Vb ((bf16_t*)(ws + WS_V))
#define X1B ((bf16_t*)(ws + WS_X1B))
#define PQ ((bf16_t*)(ws + WS_PQ))
#define QMEM1 ((bf16_t*)(ws + WS_QMEM1))
#define SG1 ((bf16_t*)(ws + WS_SG1))
#define Y ((bf16_t*)(ws + WS_Y))
    for (int u = tid0; u < (LDS_BYTES - LDSCTL_OFF) / 4; u += NWAVES * 64) ((LAS unsigned*)(ldsl + LDSCTL_OFF))[u] = 0u;
    __syncthreads();
    const XcdBarrier bar = xcd_barrier_post((unsigned*)(ctl + CW_BAR) + args.li * XCD_BAR_WORDS, MISC + 8);
#define GRID_BAR() xcd_barrier(bar)
    const int lo = args.ph_lo, hi = args.ph_hi;
#ifndef PH_MASK
#define PH_MASK 0x1ff
#endif
#define IN(k) (((PH_MASK >> (k)) & 1) && lo <= (k) && (k) < hi)
#define BOTH(k) (IN(k) && IN((k) + 1))
    LAS float* rs = (LAS float*)(ldsl + RS_OFF);

    if (IN(0)) { PHASE_IDS();
        prep_w_job(in_w_in0, 1952, 1024, WIN0, 0, 2048, nullptr, MODE_WIN0, 0, gt, GT);
        prep_w_job(in_w_mkv0, 512, 1024, WMEM, 0, 512, in_gm0, MODE_PLAIN, 0, gt, GT);
        prep_w_job(in_w_mkv1, 512, 1024, WMEM, 512, 512, in_gm1, MODE_PLAIN, 0, gt, GT);
        fold1_tiles(in_w_fnet, AGBG, gw, NGW, lane);
        for (int idx = gt; idx < T * 16; idx += GT) { const int t = idx >> 4, i = idx & 15;
            const float inv_freq = __builtin_amdgcn_exp2f((float)i * -0.83048202372184058696f);
            const float ang = (float)in_pos[t] * inv_freq; double fd = (double)ang * 0.31830988618379067154; fd -= 2.0 * floor(fd * 0.5);
            float sn, cs; sincospif((float)fd, &sn, &cs); ROPE[2 * idx] = cs; ROPE[2 * idx + 1] = sn; }
        rmsnorm_rows2(in_mem, nullptr, MEMN, 4096, gw, NGW, lane);
        rmsnorm_rows2(in_x, in_g0, XN0, T, gw, NGW, lane);
        if (BOTH(0)) GRID_BAR();
    }
    if (IN(1)) { PHASE_IDS();
        { pg8::Gemm g{XN0, WIN0, T, 2048, 1024}; pg8::StaticOrder S; S.init(T, 2048, G, (int)blockIdx.x);
          pg8::EpiIn0 E{CQ, CKV, QMEM0, SG0, KR, SSQ, ROPE};
          pg8::gemm_phase<pg8::EpiIn0, pg8::StaticOrder, true, true>(ldsl + RING_OFF, g, S, E); }
        { const int nidle = G > 64 ? G - 64 : 0;
          if (nidle == 0 || (int)blockIdx.x >= 64) { const int bi = nidle ? (int)blockIdx.x - 64 : (int)blockIdx.x, nb = nidle ? nidle : G;
              const int gtI = bi * (NWAVES * 64) + tid, GTI = nb * NWAVES * 64;
              fold2_strips(in_w_in1, in_g1, AGBG, WIN1, bi * NWAVES + wave, nb * NWAVES, lane);
              prep_w_job(in_w_uq, 1152, 384, WUQ, 0, 1280, in_gq, MODE_WUQ, 0, gtI, GTI);
              prep_w_job(in_w_ukv, 1536, 256, WUKV, 0, 1536, in_gkv, MODE_WUKV, 0, gtI, GTI);
              prep_w_job(in_w_out0, 1024, 1024, WOUT0, 0, 1024, nullptr, MODE_PLAIN, 0, gtI, GTI);
              prep_w_job(in_w_in1, 2048, 1024, WIN1, 1536, 1280, in_g1, MODE_PLAIN, 768, gtI, GTI);
              prep_w_job(in_w_out1, 1024, 1024, WOUT1, 0, 1024, nullptr, MODE_PLAIN, 0, gtI, GTI); } }
        { pg8::Gemm g{MEMN, WMEM, 4096, 1024, 1024}; pg8::StaticOrder S; S.init(4096, 1024, G, (int)blockIdx.x);
          pg8::EpiPlainB E{MEMKV, 1024, 0};
          pg8::gemm_phase<pg8::EpiPlainB, pg8::StaticOrder, true, true>(ldsl + RING_OFF, g, S, E); }
        if (BOTH(1)) GRID_BAR();
    }
    if (IN(2)) { PHASE_IDS();
        { int kq_ = 384; asm volatile("" : "+s"(kq_)); pg8::Gemm g{CQ, WUQ, T, 1280, kq_}; pg8::StaticOrder S; S.init(T, 1280, G, (int)blockIdx.x);
          pg8::EpiQup E{Qb, SSQ, ROPE};
          pg8::gemm_phase<pg8::EpiQup, pg8::StaticOrder, true, true>(ldsl + RING_OFF, g, S, E); }
        { int kk_ = 256; asm volatile("" : "+s"(kk_)); pg8::Gemm g{CKV, WUKV, T, 1536, kk_}; pg8::StaticOrder S; S.init(T, 1536, G, (int)blockIdx.x);
          pg8::EpiKVup E{Kb, Vb, SSQ};
          pg8::gemm_phase<pg8::EpiKVup, pg8::StaticOrder, true, true>(ldsl + RING_OFF, g, S, E); }
        if (BOTH(2)) GRID_BAR();
    }
    if (IN(3)) { PHASE_IDS();
        unsigned redo_mask = 0u;
        if (tid == 0) { unsigned* l2 = (unsigned*)((char*)lds + att::Cfg2<96>::END); l2[0] = 0u; l2[1] = 0u; }
        __syncthreads();
        { int it = 0;
        for (int u = vcu; u < 16 * 12 * NB; u += G, ++it) { const int qblk = u & 15, pair = u >> 4, b = pair / 12, h = pair % 12; const size_t t0 = (size_t)b * SEQ + qblk * 256;
            if (att::attn_unit<96, true>(Qb + t0 * 1152 + h * 96, 1152, Kb + (size_t)b * SEQ * 768 + h * 64, 768, KR + (size_t)b * SEQ * 32, Vb + (size_t)b * SEQ * 768 + h * 64, 768, SEQ, BR + t0 * 1024 + h * 64, SG0 + t0 * 1024 + h * 64, (char*)lds, tid, it & 1)) redo_mask |= 1u << it; } }
        if (redo_mask) { int tid2 = threadIdx.x; asm volatile("" : "+v"(tid2)); int it = 0;
        for (int u = vcu; u < 16 * 12 * NB; u += G, ++it) { if (!((redo_mask >> it) & 1u)) continue; const int qblk = u & 15, pair = u >> 4, b = pair / 12, h = pair % 12; const size_t t0 = (size_t)b * SEQ + qblk * 256;
            (void)att::attn_unit<96, false>(Qb + t0 * 1152 + h * 96, 1152, Kb + (size_t)b * SEQ * 768 + h * 64, 768, KR + (size_t)b * SEQ * 32, Vb + (size_t)b * SEQ * 768 + h * 64, 768, SEQ, BR + t0 * 1024 + h * 64, SG0 + t0 * 1024 + h * 64, (char*)lds, tid2); } }
        int tid3 = threadIdx.x; asm volatile("" : "+v"(tid3));
        for (int u = vcu; u < 16 * 4 * NB; u += G) { const int qblk = u & 15, pair = u >> 4, b = pair >> 2, h = pair & 3; const size_t t0 = (size_t)b * SEQ + qblk * 256;
            (void)att::attn_unit<64, false>(QMEM0 + t0 * 256 + h * 64, 256, MEMKV + (size_t)b * 256 * 1024 + h * 64, 1024, nullptr, MEMKV + (size_t)b * 256 * 1024 + 256 + h * 64, 1024, 256, BR + t0 * 1024 + 768 + h * 64, SG0 + t0 * 1024 + 768 + h * 64, (char*)lds, tid3); }
        if (BOTH(3)) GRID_BAR();
    }
    if (IN(4)) { PHASE_IDS();
        for (int i = tid; i < 1024; i += NWAVES * 64) rs[i] = 0.f;
        __syncthreads();
        { pg8::Gemm g{BR, WOUT0, T, 1024, 1024}; pg8::PanelOrder S; S.init(T, G, (int)blockIdx.x);
          pg8::EpiOutA E{in_x, X1B, rs};
          pg8::gemm_phase<pg8::EpiOutA, pg8::PanelOrder, true, true>(ldsl + RING_OFF, g, S, E); }
        __syncthreads();
        if (tid < 256) RSTD1[(size_t)blockIdx.x * 256 + tid] = rsqrtf(((rs[tid * 4] + rs[tid * 4 + 1]) + (rs[tid * 4 + 2] + rs[tid * 4 + 3])) * (1.f / DM) + EPS);
        if (BOTH(4)) GRID_BAR();
    }
    if (IN(5)) { PHASE_IDS();
        { pg8::Gemm g{X1B, WIN1, T, 2816, 1024}; pg8::StaticOrder S; S.init(T, 2816, G, (int)blockIdx.x);
          pg8::EpiIn1 E{PQ, QMEM1, SG1, RSTD1};
          pg8::gemm_phase<pg8::EpiIn1, pg8::StaticOrder, true, true>(ldsl + RING_OFF, g, S, E); }
        if (BOTH(5)) GRID_BAR();
    }
    if (IN(6)) { PHASE_IDS();
        fft::stage_a(PQ, Y, (char*)lds, vcu, G);
        for (int u = vcu; u < 16 * 4 * NB; u += G) { const int qblk = u & 15, pair = u >> 4, b = pair >> 2, h = pair & 3; const size_t t0 = (size_t)b * SEQ + qblk * 256;
            (void)att::attn_unit<64, false>(QMEM1 + t0 * 256 + h * 64, 256, MEMKV + (size_t)b * 256 * 1024 + 512 + h * 64, 1024, nullptr, MEMKV + (size_t)b * 256 * 1024 + 768 + h * 64, 1024, 256, BR + t0 * 1024 + 768 + h * 64, SG1 + t0 * 1024 + 768 + h * 64, (char*)lds, tid); }
        if (BOTH(6)) GRID_BAR();
    }
    if (IN(7)) { PHASE_IDS();
        fft::stage_b(Y, SG1, BR, (char*)lds, vcu, G);
        if (BOTH(7)) GRID_BAR();
    }
    if (IN(8)) { PHASE_IDS();
        __syncthreads();
        for (int i = tid; i < 1024; i += NWAVES * 64) rs[i] = 0.f;
        __syncthreads();
        { pg8::Gemm g{BR, WOUT1, T, 1024, 1024}; pg8::PanelOrder S; S.init(T, G, (int)blockIdx.x);
          pg8::EpiOutB E{X1B, rs};
          pg8::gemm_phase<pg8::EpiOutB, pg8::PanelOrder, true, true>(ldsl + RING_OFF, g, S, E); }
        asm volatile("s_waitcnt vmcnt(0)" ::: "memory");
        __syncthreads();
        for (int r0 = wave * 4; r0 < 256; r0 += NWAVES * 4) {
            uint4 v[4][2]; float rstd[4];
#pragma unroll
            for (int q = 0; q < 4; ++q) { const uint4* xb = (const uint4*)(X1B + ((size_t)blockIdx.x * 256 + r0 + q) * DM) + lane; v[q][0] = xb[0]; v[q][1] = xb[64];
                const int r = r0 + q; rstd[q] = rsqrtf(((rs[r * 4] + rs[r * 4 + 1]) + (rs[r * 4 + 2] + rs[r * 4 + 3])) * (1.f / DM) + EPS); }
#pragma unroll
            for (int j = 0; j < 2; ++j) { const float4 ga = ((const float4*)in_gf)[2 * lane + 128 * j], gb = ((const float4*)in_gf)[2 * lane + 128 * j + 1];
#pragma unroll
                for (int q = 0; q < 4; ++q) { const uint4 w = v[q][j]; const float s = rstd[q]; float4 a, b; float4* orow = (float4*)(in_out + ((size_t)blockIdx.x * 256 + r0 + q) * DM) + 2 * lane;
                    a.x = __uint_as_float(w.x << 16) * s * ga.x; a.y = __uint_as_float(w.x & 0xffff0000u) * s * ga.y; a.z = __uint_as_float(w.y << 16) * s * ga.z; a.w = __uint_as_float(w.y & 0xffff0000u) * s * ga.w;
                    b.x = __uint_as_float(w.z << 16) * s * gb.x; b.y = __uint_as_float(w.z & 0xffff0000u) * s * gb.y; b.z = __uint_as_float(w.w << 16) * s * gb.z; b.w = __uint_as_float(w.w & 0xffff0000u) * s * gb.w;
                    orow[128 * j] = a; orow[128 * j + 1] = b; } } }
    }
#undef in_x
#undef in_mem
#undef in_pos
#undef in_g0
#undef in_w_in0
#undef in_gq
#undef in_gkv
#undef in_w_uq
#undef in_w_ukv
#undef in_gm0
#undef in_w_mkv0
#undef in_w_out0
#undef in_g1
#undef in_w_in1
#undef in_w_fnet
#undef in_gm1
#undef in_w_mkv1
#undef in_w_out1
#undef in_gf
#undef in_out
#undef WIN0
#undef WUQ
#undef WUKV
#undef WMEM
#undef WOUT0
#undef WOUT1
#undef WIN1
#undef AGBG
#undef ROPE
#undef MEMN
#undef MEMKV
#undef RSTD1
#undef SSQ
#undef XN0
#undef BR
#undef CQ
#undef CKV
#undef QMEM0
#undef SG0
#undef Kb
#undef KR
#undef Qb
#undef Vb
#undef X1B
#undef PQ
#undef QMEM1
#undef SG1
#undef Y
#undef PHASE_IDS
#undef IN
#undef BOTH
#undef GRID_BAR
}

extern "C" void kernel_launch(void* const* d_in, const int* in_sizes, int n_in, void* d_out, int out_size, void* d_ws, size_t ws_size, hipStream_t stream) {
    static int grid = 0;
    if (grid == 0) {
        if (n_in != 19 || ws_size < WS_END || out_size != T * DM) { fprintf(stderr, "kernel_launch: unexpected n_in %d / ws %zu / out %d\n", n_in, ws_size, out_size); grid = -1; return; }
        int dev = 0, cus = 0;
        if (hipGetDevice(&dev) != hipSuccess || hipDeviceGetAttribute(&cus, hipDeviceAttributeMultiprocessorCount, dev) != hipSuccess) { grid = -1; return; }
        if (hipFuncSetAttribute((const void*)mk_fwd, hipFuncAttributeMaxDynamicSharedMemorySize, LDS_BYTES) != hipSuccess) { fprintf(stderr, "kernel_launch: hipFuncSetAttribute failed\n"); grid = -1; return; }
        int per_cu = 0; (void)hipOccupancyMaxActiveBlocksPerMultiprocessor(&per_cu, (const void*)mk_fwd, NWAVES * 64, LDS_BYTES); (void)hipGetLastError();
        if (cus != 256 || per_cu < 1) fprintf(stderr, "kernel_launch: note: %d CUs, occupancy query %d (built for 256 CUs, one workgroup each)\n", cus, per_cu);
        grid = 256;
    }
    if (grid < 0) return;
    if (hipMemsetAsync((char*)d_ws + WS_CTL, 0, CTL_ZERO_BYTES, stream) != hipSuccess) { fprintf(stderr, "kernel_launch: memset failed\n"); return; }
    Args a{};
    for (int i = 0; i < 19; ++i) a.in[i] = d_in[i];
    a.out = (float*)d_out; a.ws = (unsigned char*)d_ws;
#ifndef PROBE_PHASE
    const int nl = 1; const int rlo[1] = {0}, rhi[1] = {N_PHASES};
#else
    const int nl = 3; const int rlo[3] = {0, PROBE_PHASE, PROBE_PHASE}, rhi[3] = {PROBE_PHASE + 1, PROBE_PHASE + 1, N_PHASES};
#endif
    for (int li = 0; li < nl; ++li) {
        a.ph_lo = rlo[li]; a.ph_hi = rhi[li]; a.li = li; a.pad = 0;
        hipLaunchKernelGGL(mk_fwd, dim3(grid), dim3(NWAVES * 64), LDS_BYTES, stream, a);
        const hipError_t le = hipPeekAtLastError();
        if (le != hipSuccess) { fprintf(stderr, "kernel_launch: launch %d failed: %s\n", li, hipGetErrorName(le)); break; }
    }
}
```

```cpp
#include <hip/hip_runtime.h>
#include <stdint.h>
#include <cstdio>

typedef unsigned short bf16_t;
constexpr int T = 65536, SEQ = 4096, NB = 16, DM = 1024;
constexpr float EPS = 1e-6f;
constexpr float LOG2E = 1.4426950408889634f;
constexpr float QS_MLA = 0.10206207261596575f * LOG2E;
constexpr float QS_MEM = 0.125f * LOG2E;

constexpr size_t MiB = 1u << 20;
constexpr size_t WS_CTL = 0, CTL_ZERO_BYTES = 65536;
constexpr size_t WS_WIN0 = 1 * MiB;
constexpr size_t WS_WUQ = 5 * MiB;
constexpr size_t WS_WUKV = 6 * MiB;
constexpr size_t WS_WMEM = 7 * MiB;
constexpr size_t WS_WOUT0 = 9 * MiB;
constexpr size_t WS_WOUT1 = 11 * MiB;
constexpr size_t WS_WIN1 = 13 * MiB;
constexpr size_t WS_AGBG = 19 * MiB;
constexpr size_t WS_ROPE = 21 * MiB;
constexpr size_t WS_MEMN = 29 * MiB;
constexpr size_t WS_MEMKV = 37 * MiB;
constexpr size_t WS_RSTD1 = 45 * MiB;
constexpr size_t WS_SSQ = 46 * MiB;
constexpr size_t WS_XN0 = 64 * MiB;
constexpr size_t WS_BR = 64 * MiB;
constexpr size_t WS_CQ = 192 * MiB;
constexpr size_t WS_CKV = 240 * MiB;
constexpr size_t WS_QMEM0 = 272 * MiB;
constexpr size_t WS_SG0 = 304 * MiB;
constexpr size_t WS_K = 432 * MiB;
constexpr size_t WS_Q = 576 * MiB;
constexpr size_t WS_V = 720 * MiB;
constexpr size_t WS_X1B = 192 * MiB;
constexpr size_t WS_PQ = 320 * MiB;
constexpr size_t WS_QMEM1 = 512 * MiB;
constexpr size_t WS_SG1 = 544 * MiB;
constexpr size_t WS_Y = 672 * MiB;
constexpr size_t WS_END = 864 * MiB;

__device__ __forceinline__ float bf2f(bf16_t h) { return __uint_as_float(((unsigned)h) << 16); }
__device__ __forceinline__ bf16_t f2bf(float f) { unsigned u = __float_as_uint(f); return (bf16_t)((u + 0x7fffu + ((u >> 16) & 1u)) >> 16); }
__device__ __forceinline__ unsigned pk2(float lo, float hi) { return (unsigned)f2bf(lo) | ((unsigned)f2bf(hi) << 16); }
__device__ __forceinline__ float silu_f(float v) { return v * __builtin_amdgcn_rcpf(1.f + __expf(-v)); }
__device__ __forceinline__ float wave_sum(float v) {
#pragma unroll
    for (int o = 1; o < 64; o <<= 1) v += __shfl_xor(v, o);
    return v;
}
__host__ __device__ __forceinline__ int ropedim(int p) { return 4 * (p >> 3) + (p & 3) + 16 * ((p >> 2) & 1); }
enum { MODE_WIN0 = 0, MODE_WUQ = 1, MODE_WUKV = 2, MODE_PLAIN = 3 };
__device__ __forceinline__ int src_col(int mode, int n, int off) {
    if (mode == MODE_WIN0) {
        if (n < 640) return n;
        if (n < 896) return 672 + (n - 640);
        if (n < 928) return 640 + ropedim(n - 896);
        if (n < 1024) return -1;
        return 928 + (n - 1024);
    } else if (mode == MODE_WUQ) {
        if (n < 768) return (n >> 6) * 96 + (n & 63);
        if (n < 1152) { const int r = n - 768; return (r >> 5) * 96 + 64 + ropedim(r & 31); }
        return -1;
    } else if (mode == MODE_WUKV) {
        if (n < 768) return (n >> 6) * 128 + (n & 63);
        const int r = n - 768; return (r >> 6) * 128 + 64 + (r & 63);
    }
    return n + off;
}
namespace pg8 {
#define PG8_LAS __attribute__((address_space(3)))
typedef unsigned short bf16_t;
typedef short bf16x8 __attribute__((ext_vector_type(8)));
typedef float f32x4 __attribute__((ext_vector_type(4)));
typedef unsigned u32x4 __attribute__((ext_vector_type(4)));
constexpr int BM = 256, BK = 64, HALF = 128, HTB = HALF * BK * 2  , STAGE_BYTES = 8 * HTB, NXCD = 8, WGM = 8;

__host__ __device__ __forceinline__ int lds_byte(int r, int c) { const int st = (r >> 4) * 2 + (c >> 5), rr = r & 15, cc = c & 31, ob = rr * 64 + cc * 2; return st * 1024 + (ob ^ (((ob >> 9) & 1) << 5)); }
__host__ __device__ __forceinline__ void stage_rc(int b, int& R, int& C) { const int st = b / 1024, sb = b % 1024, swz = sb ^ (((sb >> 9) & 1) << 5); R = (st >> 1) * 16 + swz / 64; C = (st & 1) * 32 + (swz % 64) / 2; }
__host__ __device__ __forceinline__ int perm32(int rho) { const int n = rho >> 4, i = rho & 15; return 8 * (i >> 2) + 4 * n + (i & 3); }

struct Unit { int pm, pn; };
struct Gemm { const bf16_t* A; const bf16_t* Bt; int M, N, K; };

struct StaticOrder {
    int nM, nN, nwg, G, c;
    __host__ __device__ void init(int M, int N, int G_, int c_) { nM = M / BM; nN = N / BM; nwg = nM * nN; G = G_; c = c_; }
    __host__ __device__ bool next(int i, Unit& u) const {
        const long L = (long)i * G + c; if (L >= nwg) return false;
        int wgid = (int)L; { const int q = nwg / NXCD, r = nwg % NXCD, xcd = wgid % NXCD, off = wgid / NXCD; wgid = (xcd < r ? xcd * (q + 1) : r * (q + 1) + (xcd - r) * q) + off; }
        const int nig = WGM * nN, gid = wgid / nig, fm = gid * WGM, gsz = (nM - fm) < WGM ? (nM - fm) : WGM;
        u.pm = fm + ((wgid % nig) % gsz); u.pn = (wgid % nig) / gsz; return true;
    }
    __device__ __forceinline__ void a_ready(const Unit&) const {}
    __device__ __forceinline__ void done(const Unit&) const {}
};

__device__ __forceinline__ unsigned cvt_pk_bf16(float lo, float hi) { unsigned r; asm volatile("v_cvt_pk_bf16_f32 %0, %1, %2" : "=v"(r) : "v"(lo), "v"(hi)); return r; }
typedef float f32x2 __attribute__((ext_vector_type(2)));
__device__ __forceinline__ u32x4 pack8(const f32x4 a, const f32x4 b, float s) { u32x4 w; w.x = cvt_pk_bf16(a[0] * s, a[1] * s); w.y = cvt_pk_bf16(a[2] * s, a[3] * s); w.z = cvt_pk_bf16(b[0] * s, b[1] * s); w.w = cvt_pk_bf16(b[2] * s, b[3] * s); return w; }
__device__ __forceinline__ float ss8(const f32x4 a, const f32x4 b) { return (a[0] * a[0] + a[1] * a[1]) + (a[2] * a[2] + a[3] * a[3]) + (b[0] * b[0] + b[1] * b[1]) + (b[2] * b[2] + b[3] * b[3]); }
__device__ __forceinline__ float quad_sum(float v) { v += __shfl_xor(v, 16); v += __shfl_xor(v, 32); return v; }
__device__ __forceinline__ f32x4 silu4(const f32x4 v) { f32x4 o; o[0] = silu_f(v[0]); o[1] = silu_f(v[1]); o[2] = silu_f(v[2]); o[3] = silu_f(v[3]); return o; }
typedef unsigned u32x2 __attribute__((ext_vector_type(2)));
__device__ __forceinline__ void rope_pair(const f32x4 a, const f32x4 b, const float* cs  , float s, u32x2& o1, u32x2& o2) {
    const f32x4 c01 = *(const f32x4*)cs, c23 = *(const f32x4*)(cs + 4);
    const float r0 = (a[0] * c01[0] - b[0] * c01[1]) * s, r1 = (a[1] * c01[2] - b[1] * c01[3]) * s, r2 = (a[2] * c23[0] - b[2] * c23[1]) * s, r3 = (a[3] * c23[2] - b[3] * c23[3]) * s;
    const float q0 = (b[0] * c01[0] + a[0] * c01[1]) * s, q1 = (b[1] * c01[2] + a[1] * c01[3]) * s, q2 = (b[2] * c23[0] + a[2] * c23[1]) * s, q3 = (b[3] * c23[2] + a[3] * c23[3]) * s;
    o1.x = cvt_pk_bf16(r0, r1); o1.y = cvt_pk_bf16(r2, r3); o2.x = cvt_pk_bf16(q0, q1); o2.y = cvt_pk_bf16(q2, q3);
}
__device__ __forceinline__ void rope_pair2(const f32x4 a, const f32x4 b, const f32x4 c01, const f32x4 c23, float s, u32x2& o1, u32x2& o2) {
    o1.x = cvt_pk_bf16((a[0] * c01[0] - b[0] * c01[1]) * s, (a[1] * c01[2] - b[1] * c01[3]) * s); o1.y = cvt_pk_bf16((a[2] * c23[0] - b[2] * c23[1]) * s, (a[3] * c23[2] - b[3] * c23[3]) * s);
    o2.x = cvt_pk_bf16((b[0] * c01[0] + a[0] * c01[1]) * s, (b[1] * c01[2] + a[1] * c01[3]) * s); o2.y = cvt_pk_bf16((b[2] * c23[0] + a[2] * c23[1]) * s, (b[3] * c23[2] + a[3] * c23[3]) * s);
}
struct EpiIn0 {
    static constexpr bool PERM = true, AFTER_DRAIN = false; static constexpr int NST = 8;
    struct Pre {}; __device__ __forceinline__ void prefetch(Pre&, const Unit&, int, int, int, int) const {}
    bf16_t *CQ, *CKV, *QMEM, *SG, *Kb  ; float* SSQ; const float* rope;
    __device__ __forceinline__ void operator()(const f32x4 (&acc)[2][2][4][2], const Unit& u, int wr, int wc, int fr, int fq, const Pre& pre) const {
        const bool kr = (u.pn == 3) && (wc == 0);
        f32x4 cs[2][4][2];
        if (kr) {
#pragma unroll
            for (int ai = 0; ai < 2; ++ai)
#pragma unroll
                for (int m = 0; m < 4; ++m) { const float* rp = rope + (size_t)(u.pm * BM + ai * HALF + wr * 64 + m * 16 + fr) * 32 + 8 * fq; cs[ai][m][0] = *(const f32x4*)rp; cs[ai][m][1] = *(const f32x4*)(rp + 4); } }
#pragma unroll
        for (int ai = 0; ai < 2; ++ai)
#pragma unroll
            for (int m = 0; m < 4; ++m) { const size_t row = (size_t)(u.pm * BM + ai * HALF + wr * 64 + m * 16 + fr);
#pragma unroll
                for (int bj = 0; bj < 2; ++bj) { const int cb = u.pn * BM + bj * HALF + wc * 32, c = cb + 8 * fq; const f32x4 v0 = acc[ai][bj][m][0], v1 = acc[ai][bj][m][1];
                    if (cb < 640) { const float ss = quad_sum(ss8(v0, v1));
                        if (cb < 384) { *(u32x4*)(CQ + row * 384 + c) = pack8(v0, v1, 1.f); if (fq == 0) SSQ[row * 20 + (cb >> 5)] = ss; }
                        else { *(u32x4*)(CKV + row * 256 + (c - 384)) = pack8(v0, v1, 1.f); if (fq == 0) SSQ[row * 20 + 12 + ((cb - 384) >> 5)] = ss; } }
                    else if (cb < 896) { *(u32x4*)(QMEM + row * 256 + (c - 640)) = pack8(v0, v1, QS_MEM); }
                    else if (cb < 1024) { if (cb == 896) { u32x2 o1, o2; rope_pair2(v0, v1, cs[ai][m][0], cs[ai][m][1], 1.f, o1, o2);
                            *(u32x2*)(Kb + row * 32 + 4 * fq) = o1; *(u32x2*)(Kb + row * 32 + 16 + 4 * fq) = o2; } }
                    else { *(u32x4*)(SG + row * 1024 + (c - 1024)) = pack8(silu4(v0), silu4(v1), 1.f); } } }
    }
};
struct EpiPlainB {
    static constexpr bool PERM = true, AFTER_DRAIN = false; static constexpr int NST = 16;
    struct Pre {}; __device__ __forceinline__ void prefetch(Pre&, const Unit&, int, int, int, int) const {}
    bf16_t* O; int ldo; int pad;
    __device__ __forceinline__ void operator()(const f32x4 (&acc)[2][2][4][2], const Unit& u, int wr, int wc, int fr, int fq, const Pre& pre) const {
#pragma unroll
        for (int ai = 0; ai < 2; ++ai)
#pragma unroll
            for (int m = 0; m < 4; ++m) { int rowi_ = u.pm * BM + ai * HALF + wr * 64 + m * 16 + fr; asm volatile("" : "+v"(rowi_)); const size_t row = (size_t)rowi_;
#pragma unroll
                for (int bj = 0; bj < 2; ++bj) { const int c = u.pn * BM + bj * HALF + wc * 32 + 8 * fq; *(u32x4*)(O + row * ldo + c) = pack8(acc[ai][bj][m][0], acc[ai][bj][m][1], 1.f); } }
    }
};
struct __attribute__((packed, aligned(4))) F3 { float a, b, c; };
typedef float f32x2 __attribute__((ext_vector_type(2)));
struct EpiQup {
    static constexpr bool PERM = true, AFTER_DRAIN = false; static constexpr int NST = 16;
    struct Pre { F3 part[2][4]; };
    __device__ __forceinline__ void prefetch(Pre& p, const Unit& u, int wr, int, int fr, int fq) const { const int row0 = u.pm * BM + wr * 64 + fr;
#pragma unroll
        for (int ai = 0; ai < 2; ++ai)
#pragma unroll
            for (int m = 0; m < 4; ++m) p.part[ai][m] = *(const F3*)(SSQ + (size_t)(row0 + ai * HALF + m * 16) * 20 + 3 * fq); }
    bf16_t* Qb; const float* SSQ; const float* rope;
    __device__ __forceinline__ void operator()(const f32x4 (&acc)[2][2][4][2], const Unit& u, int wr, int wc, int fr, int fq, const Pre& pre) const {
        const int row0 = u.pm * BM + wr * 64 + fr;
        const F3 (&part)[2][4] = pre.part;
        const int cb0 = u.pn * BM + wc * 32;
        const bool rope0 = cb0 >= 768, rope1 = (cb0 + HALF >= 768) && (cb0 + HALF < 1152);
        f32x4 csA[4][2], csB[4][2];
        if (rope1 || rope0) {
#pragma unroll
            for (int m = 0; m < 4; ++m) { const float* rp = rope + (size_t)(row0 + m * 16) * 32 + 8 * fq; csA[m][0] = *(const f32x4*)rp; csA[m][1] = *(const f32x4*)(rp + 4); } }
        float sc[2][4];
#pragma unroll
        for (int ai = 0; ai < 2; ++ai)
#pragma unroll
            for (int m = 0; m < 4; ++m) sc[ai][m] = rsqrtf(quad_sum(part[ai][m].a + part[ai][m].b + part[ai][m].c) * (1.f / 384.f) + EPS) * QS_MLA;
        if (!(rope0 || rope1)) {
#pragma unroll
            for (int bj = 0; bj < 2; ++bj) { const int c = cb0 + bj * HALF + 8 * fq;
#pragma unroll
                for (int ai = 0; ai < 2; ++ai)
#pragma unroll
                    for (int m = 0; m < 4; ++m) *(u32x4*)(Qb + (size_t)(row0 + ai * HALF + m * 16) * 1152 + (c >> 6) * 96 + (c & 63)) = pack8(acc[ai][bj][m][0], acc[ai][bj][m][1], sc[ai][m]); }
            return; }
        u32x2 oA[4][2][2];
#pragma unroll
        for (int m = 0; m < 4; ++m) { if (rope0) rope_pair2(acc[0][0][m][0], acc[0][0][m][1], csA[m][0], csA[m][1], sc[0][m], oA[m][0][0], oA[m][0][1]);
            if (rope1) rope_pair2(acc[0][1][m][0], acc[0][1][m][1], csA[m][0], csA[m][1], sc[0][m], oA[m][1][0], oA[m][1][1]); }
#pragma unroll
        for (int m = 0; m < 4; ++m) { const float* rp = rope + (size_t)(row0 + HALF + m * 16) * 32 + 8 * fq; csB[m][0] = *(const f32x4*)rp; csB[m][1] = *(const f32x4*)(rp + 4); }
        asm volatile("" ::: "memory");
#pragma unroll
        for (int ai = 0; ai < 2; ++ai) {
#pragma unroll
            for (int m = 0; m < 4; ++m) { bf16_t* qrow = Qb + (size_t)(row0 + ai * HALF + m * 16) * 1152;
#pragma unroll
                for (int bj = 0; bj < 2; ++bj) { const int cb = cb0 + bj * HALF; const bool rp_ = bj == 0 ? rope0 : rope1;
                    if (rp_) { const int h = (cb - 768) >> 5; u32x2 o1, o2;
                        if (ai == 0) { o1 = oA[m][bj][0]; o2 = oA[m][bj][1]; } else rope_pair2(acc[1][bj][m][0], acc[1][bj][m][1], csB[m][0], csB[m][1], sc[1][m], o1, o2);
                        *(u32x2*)(qrow + h * 96 + 64 + 4 * fq) = o1; *(u32x2*)(qrow + h * 96 + 80 + 4 * fq) = o2; }
                    else if (cb < 768) { const int c = cb + 8 * fq; *(u32x4*)(qrow + (c >> 6) * 96 + (c & 63)) = pack8(acc[ai][bj][m][0], acc[ai][bj][m][1], sc[ai][m]); } } } }
    }
};
struct EpiKVup {
    static constexpr bool PERM = true, AFTER_DRAIN = false; static constexpr int NST = 16;
    struct Pre { f32x2 part[2][4]; };
    __device__ __forceinline__ void prefetch(Pre& p, const Unit& u, int wr, int, int fr, int fq) const { const int row0 = u.pm * BM + wr * 64 + fr;
#pragma unroll
        for (int ai = 0; ai < 2; ++ai)
#pragma unroll
            for (int m = 0; m < 4; ++m) p.part[ai][m] = *(const f32x2*)(SSQ + (size_t)(row0 + ai * HALF + m * 16) * 20 + 12 + 2 * fq); }
    bf16_t *Kb, *Vb; const float* SSQ;
    __device__ __forceinline__ void operator()(const f32x4 (&acc)[2][2][4][2], const Unit& u, int wr, int wc, int fr, int fq, const Pre& pre) const {
        const int row0 = u.pm * BM + wr * 64 + fr;
        const f32x2 (&part)[2][4] = pre.part;
        float sc[2][4];
#pragma unroll
        for (int ai = 0; ai < 2; ++ai)
#pragma unroll
            for (int m = 0; m < 4; ++m) sc[ai][m] = rsqrtf(quad_sum(part[ai][m][0] + part[ai][m][1]) * (1.f / 256.f) + EPS);
#pragma unroll
        for (int bj = 0; bj < 2; ++bj) { const int cb = u.pn * BM + bj * HALF + wc * 32, c = cb + 8 * fq;
#pragma unroll
            for (int ai = 0; ai < 2; ++ai)
#pragma unroll
                for (int m = 0; m < 4; ++m) { const size_t row = (size_t)(row0 + ai * HALF + m * 16); const u32x4 w = pack8(acc[ai][bj][m][0], acc[ai][bj][m][1], sc[ai][m]);
                    if (cb < 768) *(u32x4*)(Kb + row * 768 + c) = w; else *(u32x4*)(Vb + row * 768 + (c - 768)) = w; } }
    }
};
struct EpiOutA {
    static constexpr bool PERM = true, AFTER_DRAIN = false; static constexpr int NST = 16;
    struct Pre {}; __device__ __forceinline__ void prefetch(Pre&, const Unit&, int, int, int, int) const {}
    const float* R; bf16_t* X1B; PG8_LAS float* rs;
    __device__ __forceinline__ void operator()(const f32x4 (&acc)[2][2][4][2], const Unit& u, int wr, int wc, int fr, int fq, const Pre& pre) const {
        const int c0 = u.pn * BM + wc * 32 + 8 * fq;
        u32x4 outw[2][4][2];
#pragma unroll
        for (int ai = 0; ai < 2; ++ai) { f32x4 res[4][2][2];
#pragma unroll
            for (int m = 0; m < 4; ++m) { const float* rp = R + (size_t)(u.pm * BM + ai * HALF + wr * 64 + m * 16 + fr) * 1024 + c0;
#pragma unroll
                for (int bj = 0; bj < 2; ++bj) { res[m][bj][0] = *(const f32x4*)(rp + bj * HALF); res[m][bj][1] = *(const f32x4*)(rp + bj * HALF + 4); } }
#pragma unroll
            for (int m = 0; m < 4; ++m) { const int rl = ai * HALF + wr * 64 + m * 16 + fr; float ssum = 0.f;
#pragma unroll
                for (int bj = 0; bj < 2; ++bj) { const f32x4 x0 = res[m][bj][0] + acc[ai][bj][m][0], x1 = res[m][bj][1] + acc[ai][bj][m][1];
                    outw[ai][m][bj] = pack8(x0, x1, 1.f); ssum += ss8(x0, x1); }
                ssum = quad_sum(ssum); if (fq == 0) rs[rl * 4 + wc] += ssum; }
            asm volatile("" ::: "memory"); }
#pragma unroll
        for (int ai = 0; ai < 2; ++ai)
#pragma unroll
            for (int m = 0; m < 4; ++m) { bf16_t* xp = X1B + (size_t)(u.pm * BM + ai * HALF + wr * 64 + m * 16 + fr) * 1024 + c0;
#pragma unroll
                for (int bj = 0; bj < 2; ++bj) *(u32x4*)(xp + bj * HALF) = outw[ai][m][bj]; }
    }
};
struct EpiOutB {
    static constexpr bool PERM = true, AFTER_DRAIN = false; static constexpr int NST = 16;
    struct Pre { u32x4 res[2][4][2]; };
    __device__ __forceinline__ void prefetch(Pre& p, const Unit& u, int wr, int wc, int fr, int fq) const { const int c0 = u.pn * BM + wc * 32 + 8 * fq;
#pragma unroll
        for (int ai = 0; ai < 2; ++ai)
#pragma unroll
            for (int m = 0; m < 4; ++m) { const bf16_t* rp = X + (size_t)(u.pm * BM + ai * HALF + wr * 64 + m * 16 + fr) * 1024 + c0; p.res[ai][m][0] = *(const u32x4*)rp; p.res[ai][m][1] = *(const u32x4*)(rp + HALF); } }
    bf16_t* X; PG8_LAS float* rs;
    __device__ __forceinline__ void operator()(const f32x4 (&acc)[2][2][4][2], const Unit& u, int wr, int wc, int fr, int fq, const Pre& pre) const {
        const int c0 = u.pn * BM + wc * 32 + 8 * fq;
        const u32x4 (&res)[2][4][2] = pre.res;
#pragma unroll
        for (int ai = 0; ai < 2; ++ai)
#pragma unroll
            for (int m = 0; m < 4; ++m) { const int rl = ai * HALF + wr * 64 + m * 16 + fr; bf16_t* xp = X + (size_t)(u.pm * BM + rl) * 1024 + c0; float ssum = 0.f;
#pragma unroll
                for (int bj = 0; bj < 2; ++bj) { const u32x4 r = res[ai][m][bj];
                    f32x4 x0, x1; x0[0] = __uint_as_float(r.x << 16); x0[1] = __uint_as_float(r.x & 0xffff0000u); x0[2] = __uint_as_float(r.y << 16); x0[3] = __uint_as_float(r.y & 0xffff0000u);
                    x1[0] = __uint_as_float(r.z << 16); x1[1] = __uint_as_float(r.z & 0xffff0000u); x1[2] = __uint_as_float(r.w << 16); x1[3] = __uint_as_float(r.w & 0xffff0000u);
                    x0 += acc[ai][bj][m][0]; x1 += acc[ai][bj][m][1];
                    *(u32x4*)(xp + bj * HALF) = pack8(x0, x1, 1.f); ssum += ss8(x0, x1); }
                ssum = quad_sum(ssum); if (fq == 0) rs[rl * 4 + wc] += ssum; }
    }
};
struct EpiIn1 {
    static constexpr bool PERM = true, AFTER_DRAIN = false; static constexpr int NST = 16;
    struct Pre { float rr[2][4]; };
    __device__ __forceinline__ void prefetch(Pre& p, const Unit& u, int wr, int, int fr, int) const { const int row0 = u.pm * BM + wr * 64 + fr;
#pragma unroll
        for (int ai = 0; ai < 2; ++ai)
#pragma unroll
            for (int m = 0; m < 4; ++m) p.rr[ai][m] = RSTD[row0 + ai * HALF + m * 16]; }
    bf16_t *PQ, *QMEM, *SG; const float* RSTD;
    __device__ __forceinline__ void operator()(const f32x4 (&acc)[2][2][4][2], const Unit& u, int wr, int wc, int fr, int fq, const Pre& pre) const {
        const int row0 = u.pm * BM + wr * 64 + fr;
        const float (&rr)[2][4] = pre.rr;
#pragma unroll
        for (int ai = 0; ai < 2; ++ai)
#pragma unroll
            for (int m = 0; m < 4; ++m) { const int rowi = row0 + ai * HALF + m * 16; const size_t row = (size_t)rowi; const float r = rr[ai][m];
                const int b = rowi >> 12, sq = rowi & 4095, s1 = sq >> 6, s2 = sq & 63; const size_t prow = ((size_t)(b * 64 + s1) * 2) * 64 + s2;
#pragma unroll
                for (int bj = 0; bj < 2; ++bj) { const int cb = u.pn * BM + bj * HALF + wc * 32, c = cb + 8 * fq; const f32x4 v0 = acc[ai][bj][m][0], v1 = acc[ai][bj][m][1];
                    if (cb < 1536) { const int pq = cb >= 768 ? 1 : 0; *(u32x4*)(PQ + (prow + pq * 64) * 768 + (c - pq * 768)) = pack8(v0, v1, r); }
                    else if (cb < 1792) *(u32x4*)(QMEM + row * 256 + (c - 1536)) = pack8(v0, v1, r * QS_MEM);
                    else *(u32x4*)(SG + row * 1024 + (c - 1792)) = pack8(silu4(v0 * r), silu4(v1 * r), 1.f); } }
    }
};
struct PanelOrder {
    int nM, G, c;
    __device__ void init(int M, int G_, int c_) { nM = M / BM; G = G_; c = c_; }
    __device__ bool next(int i, Unit& u) const { u.pm = c + G * (i >> 2); u.pn = i & 3; return u.pm < nM; }
    __device__ __forceinline__ void a_ready(const Unit&) const {}
    __device__ __forceinline__ void done(const Unit&) const {}
};
template <class Epi, class Sched, bool ALIGN_EPI = false, bool SP2 = false>
__device__ __forceinline__ void gemm_phase(PG8_LAS unsigned char* lds, const Gemm g, const Sched& S, const Epi& E) {
    const int tid = threadIdx.x, wid = __builtin_amdgcn_readfirstlane(tid >> 6), lane = tid & 63, wr = wid >> 2, wc = wid & 3, fr = lane & 15, fq = lane >> 4;
    const int K = g.K, nt = K / BK;
    unsigned voffA[2], voffB[2];
#pragma unroll
    for (int i = 0; i < 2; ++i) { int R, C; stage_rc(tid * 16 + i * 8192, R, C); const int Rb = Epi::PERM ? ((R & ~31) + perm32(R & 31)) : R;
        voffA[i] = (unsigned)(R * K + C) * 2u; voffB[i] = (unsigned)(Rb * K + C) * 2u; }
    const size_t kstep = (size_t)(BK * 2);
    const size_t hstep = (size_t)HALF * K * 2;
    const size_t tstep = 2 * hstep;
    const unsigned ldsw = (unsigned)wid * 1024u;
    const int aoff = lds_byte(wr * 64 + fr, fq * 8), boff = lds_byte(wc * 32 + fr, fq * 8);
#define PG8_SA(b, h) (((b) * 2 + (h)) * HTB)
#define PG8_SB(b, h) ((4 + (b) * 2 + (h)) * HTB)
#define PG8_STAGE(bufoff, gbase, voff) do { _Pragma("unroll") for (int _i = 0; _i < 2; ++_i) \
        __builtin_amdgcn_global_load_lds((const unsigned*)((const char*)(gbase) + (voff)[_i]), (PG8_LAS unsigned*)(lds + (bufoff) + ldsw + _i * 8192), 16, 0, 0); } while (0)
#define PG8_LDA(dst, b, h) do { _Pragma("unroll") for (int m = 0; m < 4; ++m) _Pragma("unroll") for (int k = 0; k < 2; ++k) dst[m][k] = *(const PG8_LAS bf16x8*)(lds + PG8_SA(b, h) + aoff + m * 2048 + k * 1024); } while (0)
#define PG8_LDB(dst, b, h) do { _Pragma("unroll") for (int n = 0; n < 2; ++n) _Pragma("unroll") for (int k = 0; k < 2; ++k) dst[n][k] = *(const PG8_LAS bf16x8*)(lds + PG8_SB(b, h) + boff + n * 2048 + k * 1024); } while (0)
#define PG8_MMA(ai, bj, At, Bt) do { __builtin_amdgcn_s_setprio(1); _Pragma("unroll") for (int m = 0; m < 4; ++m) _Pragma("unroll") for (int n = 0; n < 2; ++n) _Pragma("unroll") for (int k = 0; k < 2; ++k) \
        acc[ai][bj][m][n] = __builtin_amdgcn_mfma_f32_16x16x32_bf16(Bt[n][k], At[m][k], acc[ai][bj][m][n], 0, 0, 0); __builtin_amdgcn_s_setprio(0); } while (0)
#define PG8_WAIT_V(n) asm volatile("s_waitcnt vmcnt(" #n ")" ::: "memory")
#define PG8_WAIT_L(n) asm volatile("s_waitcnt lgkmcnt(" #n ")" ::: "memory")
#define PG8_WAIT_VF(fr, n) asm volatile("s_cmp_lg_u32 %0, 0\n\ts_cbranch_scc0 .Lwvs%=\n\ts_waitcnt vmcnt(%1)\n\ts_branch .Lwve%=\n.Lwvs%=:\n\ts_waitcnt vmcnt(8)\n.Lwve%=:" :: "s"(fr), "n"(n) : "memory", "scc")
#define PG8_BAR __builtin_amdgcn_s_barrier()
#define PG8_SCHED __builtin_amdgcn_sched_barrier(0)
    Unit cur, nxt; int ui = 0;
    if (!S.next(0, cur)) return;
    f32x4 acc[2][2][4][2];
#pragma unroll
    for (int a = 0; a < 2; ++a)
#pragma unroll
        for (int b = 0; b < 2; ++b)
#pragma unroll
            for (int m = 0; m < 4; ++m)
#pragma unroll
                for (int n = 0; n < 2; ++n) acc[a][b][m][n] = (f32x4){0.f, 0.f, 0.f, 0.f};
    bf16x8 At[4][2], B0[2][2], B1[2][2];
    const char* cA = (const char*)g.A + (size_t)cur.pm * tstep; const char* cB = (const char*)g.Bt + (size_t)cur.pn * tstep;
    S.a_ready(cur);
    if constexpr (SP2) {
        PG8_STAGE(PG8_SB(0, 0), cB, voffB); PG8_STAGE(PG8_SB(0, 1), cB + hstep, voffB); PG8_STAGE(PG8_SA(0, 0), cA, voffA); PG8_STAGE(PG8_SA(0, 1), cA + hstep, voffA);
        if (wr == 1) PG8_BAR;
        PG8_WAIT_V(2); PG8_BAR;
        PG8_STAGE(PG8_SB(1, 0), cB + kstep, voffB); PG8_STAGE(PG8_SA(1, 0), cA + kstep, voffA); PG8_STAGE(PG8_SB(1, 1), cB + hstep + kstep, voffB);
        PG8_WAIT_V(6); PG8_BAR;
    } else {
        PG8_STAGE(PG8_SB(0, 0), cB, voffB); PG8_STAGE(PG8_SA(0, 0), cA, voffA); PG8_STAGE(PG8_SB(0, 1), cB + hstep, voffB); PG8_STAGE(PG8_SA(0, 1), cA + hstep, voffA);
        if (wr == 1) PG8_BAR;
        PG8_WAIT_V(4); PG8_BAR;
        PG8_STAGE(PG8_SB(1, 0), cB + kstep, voffB); PG8_STAGE(PG8_SA(1, 0), cA + kstep, voffA); PG8_STAGE(PG8_SB(1, 1), cB + hstep + kstep, voffB);
        PG8_WAIT_V(6); PG8_BAR;
    }
    for (;;) {
        const bool has_next = S.next(ui + 1, nxt);
        const char* nA = has_next ? (const char*)g.A + (size_t)nxt.pm * tstep : cA; const char* nB = has_next ? (const char*)g.Bt + (size_t)nxt.pn * tstep : cB;
        for (int t = 0; t < nt; t += 2) {
            const bool last = (t == nt - 2);
            const char* a1 = cA + (size_t)(t + 1) * kstep;
            const char* a2 = last ? nA : cA + (size_t)(t + 2) * kstep; const char* b2 = last ? nB : cB + (size_t)(t + 2) * kstep;
            const char* a3 = a2 + kstep; const char* b3 = b2 + kstep;
            if (last && has_next) S.a_ready(nxt);
            if constexpr (SP2) {
            const int fresh = __builtin_amdgcn_readfirstlane(((t == 0) && (ui > 0)) ? 1 : 0);
            PG8_LDB(B0, 0, 0); PG8_LDB(B1, 0, 1); PG8_SCHED; PG8_LDA(At, 0, 0); PG8_STAGE(PG8_SA(1, 1), a1 + hstep, voffA);
            PG8_WAIT_VF(fresh, 8 + Epi::NST);
            PG8_WAIT_L(0); PG8_BAR; PG8_MMA(0, 0, At, B0); PG8_MMA(0, 1, At, B1); PG8_BAR; PG8_SCHED;
            PG8_LDA(At, 0, 1); PG8_STAGE(PG8_SB(0, 0), b2, voffB); PG8_STAGE(PG8_SB(0, 1), b2 + hstep, voffB); PG8_STAGE(PG8_SA(0, 0), a2, voffA);
            PG8_WAIT_VF(fresh, 8 + Epi::NST);
            PG8_WAIT_L(0); PG8_BAR; PG8_MMA(1, 0, At, B0); PG8_MMA(1, 1, At, B1); PG8_BAR; PG8_SCHED;
            PG8_LDB(B0, 1, 0); PG8_LDB(B1, 1, 1); PG8_SCHED; PG8_LDA(At, 1, 0); PG8_STAGE(PG8_SA(0, 1), a2 + hstep, voffA);
            PG8_WAIT_V(8); PG8_WAIT_L(0); PG8_BAR; PG8_MMA(0, 0, At, B0); PG8_MMA(0, 1, At, B1); PG8_BAR; PG8_SCHED;
            PG8_LDA(At, 1, 1); PG8_STAGE(PG8_SB(1, 0), b3, voffB); PG8_STAGE(PG8_SB(1, 1), b3 + hstep, voffB); PG8_STAGE(PG8_SA(1, 0), a3, voffA);
            PG8_WAIT_V(8); PG8_WAIT_L(0); PG8_BAR; PG8_MMA(1, 0, At, B0); PG8_MMA(1, 1, At, B1); PG8_BAR; PG8_SCHED;
            } else {
            PG8_LDB(B0, 0, 0); PG8_SCHED; PG8_LDA(At, 0, 0); PG8_STAGE(PG8_SA(1, 1), a1 + hstep, voffA);
            PG8_WAIT_L(8); PG8_BAR; PG8_WAIT_L(0); PG8_MMA(0, 0, At, B0); PG8_BAR; PG8_SCHED;
            PG8_LDB(B1, 0, 1); PG8_STAGE(PG8_SB(0, 0), b2, voffB);
            PG8_BAR; PG8_WAIT_L(0); PG8_MMA(0, 1, At, B1); PG8_BAR;
            PG8_LDA(At, 0, 1); PG8_STAGE(PG8_SA(0, 0), a2, voffA);
            PG8_BAR; PG8_WAIT_L(0); PG8_MMA(1, 0, At, B0); PG8_BAR; PG8_SCHED;
            PG8_STAGE(PG8_SB(0, 1), b2 + hstep, voffB);
            PG8_WAIT_V(6); PG8_BAR; PG8_MMA(1, 1, At, B1); PG8_BAR;
            PG8_LDB(B0, 1, 0); PG8_SCHED; PG8_LDA(At, 1, 0); PG8_STAGE(PG8_SA(0, 1), a2 + hstep, voffA);
            PG8_WAIT_L(8); PG8_BAR; PG8_WAIT_L(0); PG8_MMA(0, 0, At, B0); PG8_BAR; PG8_SCHED;
            PG8_LDB(B1, 1, 1); PG8_STAGE(PG8_SB(1, 0), b3, voffB);
            PG8_BAR; PG8_WAIT_L(0); PG8_MMA(0, 1, At, B1); PG8_BAR;
            PG8_LDA(At, 1, 1); PG8_STAGE(PG8_SA(1, 0), a3, voffA);
            PG8_BAR; PG8_WAIT_L(0); PG8_MMA(1, 0, At, B0); PG8_BAR; PG8_SCHED;
            PG8_STAGE(PG8_SB(1, 1), b3 + hstep, voffB);
            PG8_WAIT_V(6); PG8_BAR; PG8_MMA(1, 1, At, B1); PG8_BAR;
            }
        }
        typename Epi::Pre pre;
        E.prefetch(pre, cur, wr, wc, fr, fq);
        if constexpr (ALIGN_EPI) { if (wr == 0) PG8_BAR; }
        if constexpr (!Epi::AFTER_DRAIN) { E(acc, cur, wr, wc, fr, fq, pre); S.done(cur); }
        if (!has_next) break;
#pragma unroll
        for (int a = 0; a < 2; ++a)
#pragma unroll
            for (int b = 0; b < 2; ++b)
#pragma unroll
                for (int m = 0; m < 4; ++m)
#pragma unroll
                    for (int n = 0; n < 2; ++n) acc[a][b][m][n] = (f32x4){0.f, 0.f, 0.f, 0.f};
        cur = nxt; cA = nA; cB = nB; ++ui;
        if constexpr (ALIGN_EPI) { if (wr == 1) PG8_BAR; }
    }
    PG8_WAIT_V(0);
    if constexpr (!ALIGN_EPI) { if (wr == 0) PG8_BAR; }
    PG8_BAR;
    if constexpr (Epi::AFTER_DRAIN) { E.fused(acc, cur, wr, wc, fr, fq, lds, wid, lane); S.done(cur); }
#undef PG8_SA
#undef PG8_SB
#undef PG8_STAGE
#undef PG8_LDA
#undef PG8_LDB
#undef PG8_MMA
#undef PG8_WAIT_V
#undef PG8_WAIT_L
#undef PG8_BAR
#undef PG8_SCHED
}
}
#define GAS __attribute__((address_space(1)))
#define LAS __attribute__((address_space(3)))
typedef unsigned short bf16;
typedef unsigned v4u __attribute__((ext_vector_type(4)));
typedef float f32x4 __attribute__((ext_vector_type(4)));
typedef short bf16x8 __attribute__((ext_vector_type(8)));
typedef GAS unsigned gu32;
typedef GAS unsigned long long gu64;
#define RLX_AGENT __ATOMIC_RELAXED, __HIP_MEMORY_SCOPE_AGENT
#define LDS_WAIT() asm volatile("s_waitcnt lgkmcnt(0)" ::: "memory")
#define VM_WAIT() asm volatile("s_waitcnt vmcnt(0)" ::: "memory")
__device__ __forceinline__ unsigned long long rt() { return __builtin_amdgcn_s_memrealtime(); }
#define XB_TMO      128
#define XB_XCNT(j)  (256  + 64 * (j))
#define XB_XSUB(j)  (1280 + 64 * (j))
#define XB_XGEN(j)  (2304 + 64 * (j))
#define XB_TOP      3328
#define XB_TOPGEN   3392
#define XCD_BAR_WORDS 3456
#define XB_SPIN_CAP (1u << 18)

__device__ __forceinline__ unsigned xb_ld(unsigned* p)              { return __hip_atomic_load(p, __ATOMIC_RELAXED, __HIP_MEMORY_SCOPE_AGENT); }
__device__ __forceinline__ unsigned xb_add(unsigned* p, unsigned v) { return __hip_atomic_fetch_add(p, v, __ATOMIC_RELAXED, __HIP_MEMORY_SCOPE_AGENT); }
__device__ __forceinline__ unsigned xb_xcc_id() { return (unsigned)__builtin_amdgcn_s_getreg((3 << 11) | 20) & 0xFu; }
#define XB_SPIN(cond, bar) do { unsigned _sp = 0; while (cond) { __builtin_amdgcn_s_sleep(1); \
    if ((++_sp & 255u) == 0u) { if (xb_ld(&(bar)[XB_TMO])) break; if (_sp > XB_SPIN_CAP) { atomicAdd(&(bar)[XB_TMO], 1u); break; } } } } while (0)

struct XcdBarrier {
    unsigned* bar; unsigned x;
    volatile LAS unsigned* st;
};

__device__ __forceinline__ XcdBarrier xcd_barrier_post(unsigned* bar, volatile LAS unsigned* st) {
    XcdBarrier b; b.bar = bar; b.x = xb_xcc_id(); b.st = st;
    if (threadIdx.x == 0) (void)xb_add(&bar[XB_XCNT(b.x)], 1u);
    return b;
}
__device__ __forceinline__ void xcd_barrier_complete(unsigned* bar, unsigned x, unsigned& nloc, unsigned& nx) {
    const unsigned G = gridDim.x * gridDim.y * gridDim.z;
    unsigned sum, cnt, mine, sp = 0u;
    for (;;) {
        sum = 0u; cnt = 0u; mine = 0u;
#pragma unroll
        for (unsigned j = 0; j < 16; ++j) { const unsigned c = xb_ld(&bar[XB_XCNT(j)]); sum += c; cnt += (c > 0u) ? 1u : 0u; mine = (j == x) ? c : mine; }
        if (sum == G) break;
        __builtin_amdgcn_s_sleep(1);
        if ((++sp & 255u) == 0u) { if (xb_ld(&bar[XB_TMO])) break; if (sp > XB_SPIN_CAP) { atomicAdd(&bar[XB_TMO], 1u); break; } }
    }
    nloc = mine > 0u ? mine : 1u; nx = cnt > 0u ? cnt : 1u;
}

__device__ __forceinline__ void xcd_barrier(const XcdBarrier& b) {
    asm volatile("s_waitcnt vmcnt(0)" ::: "memory");
    __syncthreads();
    if (threadIdx.x == 0) {
        unsigned* bar = b.bar;
        __builtin_amdgcn_s_waitcnt(0);
        unsigned nloc = b.st[0], nx = b.st[1];
        if (nloc == 0u) { xcd_barrier_complete(bar, b.x, nloc, nx); b.st[0] = nloc; b.st[1] = nx; }
        const unsigned old = xb_add(&bar[XB_XSUB(b.x)], 1u);
        const unsigned gen = old / nloc;
        if (old + 1u == (gen + 1u) * nloc) {
            __builtin_amdgcn_fence(__ATOMIC_RELEASE, "agent");
            asm volatile("s_waitcnt vmcnt(0)" ::: "memory");
            const unsigned og = xb_add(&bar[XB_TOP], 1u);
            const unsigned tg = og / nx;
            if (og + 1u == (tg + 1u) * nx) xb_add(&bar[XB_TOPGEN], 1u);
            else XB_SPIN(xb_ld(&bar[XB_TOPGEN]) == tg, bar);
            __builtin_amdgcn_fence(__ATOMIC_ACQUIRE, "agent");
            xb_add(&bar[XB_XGEN(b.x)], 1u);
            asm volatile("s_waitcnt vmcnt(0)" ::: "memory");
        } else {
            XB_SPIN(xb_ld(&bar[XB_XGEN(b.x)]) == gen, bar);
            __builtin_amdgcn_fence(__ATOMIC_ACQUIRE, "agent");
            asm volatile("s_waitcnt vmcnt(0)" ::: "memory");
        }
    }
    __syncthreads();
}
namespace att {
using bf16x8 = __attribute__((ext_vector_type(8))) short;
using s16x4  = __attribute__((ext_vector_type(4))) short;
using f32x16 = __attribute__((ext_vector_type(16))) float;
using f32x4v = __attribute__((ext_vector_type(4))) float;
using u32x4  = __attribute__((ext_vector_type(4))) unsigned;
constexpr int NW = 8, QBLK = 32, KVBLK = 64;
constexpr float THRL = 6.f;
#define ASBAR() __builtin_amdgcn_sched_barrier(0)
__device__ __forceinline__ int crow(int r, int hi) { return (r & 3) + 8 * (r >> 2) + 4 * hi; }
__device__ __forceinline__ unsigned cvtpk(float lo, float hi) { unsigned r; asm volatile("v_cvt_pk_bf16_f32 %0, %1, %2" : "=v"(r) : "v"(lo), "v"(hi)); return r; }
template <int DQK> struct Cfg {
    static constexpr int KROW = DQK * 2 + 16;
    static constexpr int SHM_V = 8192, SHM_K = 64 * KROW;
    static constexpr int OFF_V = 0, OFF_K = 2 * SHM_V, OFF_WS = OFF_K + 2 * SHM_K, OFF_OST = OFF_WS + NW * 256, OSTW = 32 * 68 * 4, END = OFF_OST + NW * OSTW;
    static constexpr int KCH = DQK / 8;
};
__device__ __forceinline__ int v_st(int k, int c) { const int kk = k; return ((kk >> 3) * 2 + (c >> 5)) * 512 + ((kk & 7) * 32 + (c & 31)) * 2; }
__device__ __forceinline__ int v_rd_base(int lane) { return ((lane & 3) << 3) | (((lane >> 2) & 3) << 6) | (((lane >> 4) & 1) << 5) | (((lane >> 5) & 1) << 8); }
constexpr int v_rd_off(int d0, int ks, int half) { return d0 * 512 + ks * 2048 + half * 1024; }
template <int OFF> __device__ __forceinline__ s16x4 tr_read(int vb) { s16x4 r; asm volatile("ds_read_b64_tr_b16 %0, %1 offset:%2" : "=&v"(r) : "v"(vb), "i"(OFF) : "memory"); return r; }
struct VFr { s16x4 l0, h0, l1, h1, l2, h2, l3, h3, m0, n0, m1, n1, m2, n2, m3, n3; };
__device__ __forceinline__ void pv_issue(VFr& v, int vb) {
    v.l0 = tr_read<v_rd_off(0, 0, 0)>(vb); v.h0 = tr_read<v_rd_off(0, 0, 1)>(vb); v.l1 = tr_read<v_rd_off(0, 1, 0)>(vb); v.h1 = tr_read<v_rd_off(0, 1, 1)>(vb);
    v.l2 = tr_read<v_rd_off(0, 2, 0)>(vb); v.h2 = tr_read<v_rd_off(0, 2, 1)>(vb); v.l3 = tr_read<v_rd_off(0, 3, 0)>(vb); v.h3 = tr_read<v_rd_off(0, 3, 1)>(vb);
    v.m0 = tr_read<v_rd_off(1, 0, 0)>(vb); v.n0 = tr_read<v_rd_off(1, 0, 1)>(vb); v.m1 = tr_read<v_rd_off(1, 1, 0)>(vb); v.n1 = tr_read<v_rd_off(1, 1, 1)>(vb);
    v.m2 = tr_read<v_rd_off(1, 2, 0)>(vb); v.n2 = tr_read<v_rd_off(1, 2, 1)>(vb); v.m3 = tr_read<v_rd_off(1, 3, 0)>(vb); v.n3 = tr_read<v_rd_off(1, 3, 1)>(vb);
}
__device__ __forceinline__ void pv_mma(f32x16* o, const VFr& v, bf16x8 pa0, bf16x8 pa1, bf16x8 pa2, bf16x8 pa3) {
#define ATT_PK(L, H) (bf16x8){L[0], L[1], L[2], L[3], H[0], H[1], H[2], H[3]}
    asm volatile("s_waitcnt lgkmcnt(0)" ::: "memory"); ASBAR();
    o[0] = __builtin_amdgcn_mfma_f32_32x32x16_bf16(pa0, ATT_PK(v.l0, v.h0), o[0], 0, 0, 0);
    o[1] = __builtin_amdgcn_mfma_f32_32x32x16_bf16(pa0, ATT_PK(v.m0, v.n0), o[1], 0, 0, 0);
    o[0] = __builtin_amdgcn_mfma_f32_32x32x16_bf16(pa1, ATT_PK(v.l1, v.h1), o[0], 0, 0, 0);
    o[1] = __builtin_amdgcn_mfma_f32_32x32x16_bf16(pa1, ATT_PK(v.m1, v.n1), o[1], 0, 0, 0);
    o[0] = __builtin_amdgcn_mfma_f32_32x32x16_bf16(pa2, ATT_PK(v.l2, v.h2), o[0], 0, 0, 0);
    o[1] = __builtin_amdgcn_mfma_f32_32x32x16_bf16(pa2, ATT_PK(v.m2, v.n2), o[1], 0, 0, 0);
    o[0] = __builtin_amdgcn_mfma_f32_32x32x16_bf16(pa3, ATT_PK(v.l3, v.h3), o[0], 0, 0, 0);
    o[1] = __builtin_amdgcn_mfma_f32_32x32x16_bf16(pa3, ATT_PK(v.m3, v.n3), o[1], 0, 0, 0);
#undef ATT_PK
}

__device__ __forceinline__ float rowmax32(const f32x16& p0, const f32x16& p1) {
#define ATT_MX3(a, b, c) __builtin_fmaxf(__builtin_fmaxf((a), (b)), (c))
    float a = ATT_MX3(p0[0], p0[1], p1[0]), b = ATT_MX3(p0[2], p0[3], p1[1]); a = ATT_MX3(a, p1[2], p1[3]);
#pragma unroll
    for (int r = 4; r < 16; r += 4) { a = ATT_MX3(a, p0[r], p0[r + 1]); b = ATT_MX3(b, p0[r + 2], p0[r + 3]); a = ATT_MX3(a, p1[r], p1[r + 1]); b = ATT_MX3(b, p1[r + 2], p1[r + 3]); }
#undef ATT_MX3
    float m = __builtin_fmaxf(a, b);
    auto rr = __builtin_amdgcn_permlane32_swap(__float_as_uint(m), __float_as_uint(m), false, false);
    return __builtin_fmaxf(__uint_as_float(rr[0]), __uint_as_float(rr[1]));
}
template <int DQK> __device__ __forceinline__ void qkt2(f32x16& p0, f32x16& p1, const char* Ks, const bf16x8* qr, const f32x16& negm, int r32, int hi) {
    constexpr int KROW = Cfg<DQK>::KROW;
#pragma unroll
    for (int d0 = 0; d0 < DQK / 16; ++d0) { const int cb = (d0 * 16 + hi * 8) * 2;
        const bf16x8 b0 = *reinterpret_cast<const bf16x8*>(Ks + r32 * KROW + cb);
        const bf16x8 b1 = *reinterpret_cast<const bf16x8*>(Ks + (32 + r32) * KROW + cb);
        if (d0 == 0) { p0 = __builtin_amdgcn_mfma_f32_32x32x16_bf16(b0, qr[0], negm, 0, 0, 0); p1 = __builtin_amdgcn_mfma_f32_32x32x16_bf16(b1, qr[0], negm, 0, 0, 0); }
        else { p0 = __builtin_amdgcn_mfma_f32_32x32x16_bf16(b0, qr[d0], p0, 0, 0, 0); p1 = __builtin_amdgcn_mfma_f32_32x32x16_bf16(b1, qr[d0], p1, 0, 0, 0); } }
}
template <int DQK> struct Cfg2 {
    static constexpr int KROW = DQK * 2 + 16, SHM_V = 8192, SHM_K = 64 * KROW;
    static constexpr int OFF_V = 0, OFF_K = 3 * SHM_V, OFF_WS = OFF_K + 2 * SHM_K, OFF_OST = OFF_WS + NW * 256, OSTW = 32 * 68 * 4, END = OFF_OST + NW * OSTW;
};
__device__ __forceinline__ float softmax_tile(f32x16& p0, f32x16& p1, float& mhat, f32x16& negm, float& l_reg, bool first, bf16x8& pa0, bf16x8& pa1, bf16x8& pa2, bf16x8& pa3) {
    const float pmax = rowmax32(p0, p1);
    float alpha = 1.f;
    if (__builtin_expect(first || __any(pmax > THRL), 0)) { const float dl = first ? pmax : __builtin_fmaxf(pmax, 0.f); mhat += dl;
#pragma unroll
        for (int r = 0; r < 16; ++r) { p0[r] -= dl; p1[r] -= dl; }
#pragma unroll
        for (int r = 0; r < 16; ++r) negm[r] = -mhat;
        if (!first) alpha = __builtin_amdgcn_exp2f(-dl); }
#pragma unroll
    for (int r = 0; r < 16; ++r) { p0[r] = __builtin_amdgcn_exp2f(p0[r]); p1[r] = __builtin_amdgcn_exp2f(p1[r]); }
    float ps = 0;
#pragma unroll
    for (int r = 0; r < 16; ++r) ps += p0[r];
#pragma unroll
    for (int r = 0; r < 16; ++r) ps += p1[r];
    { auto rr = __builtin_amdgcn_permlane32_swap(__float_as_uint(ps), __float_as_uint(ps), false, false); ps = __uint_as_float(rr[0]) + __uint_as_float(rr[1]); }
    l_reg = l_reg * alpha + ps;
#define ATT_PK4(P, BASE, OUT) do { u32x4 w = {cvtpk(P[BASE + 0], P[BASE + 1]), cvtpk(P[BASE + 2], P[BASE + 3]), cvtpk(P[BASE + 4], P[BASE + 5]), cvtpk(P[BASE + 6], P[BASE + 7])}; \
    OUT = *reinterpret_cast<bf16x8*>(&w); } while (0)
    ATT_PK4(p0, 0, pa0); ATT_PK4(p0, 8, pa1); ATT_PK4(p1, 0, pa2); ATT_PK4(p1, 8, pa3);
#undef ATT_PK4
    return alpha;
}
__device__ __forceinline__ void softmax_fast(f32x16& p0, f32x16& p1, float& l_reg  , float& bad, bf16x8& pa0, bf16x8& pa1, bf16x8& pa2, bf16x8& pa3) {
#pragma unroll
    for (int r = 0; r < 16; ++r) { p0[r] = __builtin_amdgcn_exp2f(p0[r]); p1[r] = __builtin_amdgcn_exp2f(p1[r]); }
    float ps = 0;
#pragma unroll
    for (int r = 0; r < 16; ++r) ps += p0[r];
#pragma unroll
    for (int r = 0; r < 16; ++r) ps += p1[r];
    bad = (ps < 1.152921504606846976e18f) ? bad : 1.f;
    l_reg += ps;
#define ATT_PK4(P, BASE, OUT) do { u32x4 w = {cvtpk(P[BASE + 0], P[BASE + 1]), cvtpk(P[BASE + 2], P[BASE + 3]), cvtpk(P[BASE + 4], P[BASE + 5]), cvtpk(P[BASE + 6], P[BASE + 7])}; \
    OUT = *reinterpret_cast<bf16x8*>(&w); } while (0)
    ATT_PK4(p0, 0, pa0); ATT_PK4(p0, 8, pa1); ATT_PK4(p1, 0, pa2); ATT_PK4(p1, 8, pa3);
#undef ATT_PK4
}
template <int DQK, bool FAST = false>
__device__ __forceinline__ bool attn_unit(const bf16_t* __restrict__ Qb, int ldq, const bf16_t* __restrict__ Kh, int ldk, const bf16_t* __restrict__ Kr  ,
                                          const bf16_t* __restrict__ Vh, int ldv, int seq, bf16_t* __restrict__ Ob, const bf16_t* __restrict__ Gb, char* lds, int tid, int par = 0  ) {
    using C = Cfg2<DQK>;
    constexpr int KROW = C::KROW, KCH = DQK / 8, SHM_V = C::SHM_V, SHM_K = C::SHM_K;
    const int wid = __builtin_amdgcn_readfirstlane(tid >> 6), lane = tid & 63, r32 = lane & 31, hi = lane >> 5; const bool h1 = wid >= 4;
    char* V_lds = lds + C::OFF_V; char* K_lds = lds + C::OFF_K;
    float* ws = (float*)(lds + C::OFF_WS) + wid * 64; float* li_l = ws; float* al_l = ws + 32;
    float mhat = 0.f, l_reg = 0.f; f32x16 o[2] = {}; f32x16 negm = {}; bf16x8 qr[DQK / 16];
    const bf16_t* Qw = Qb + (size_t)(wid * QBLK + r32) * ldq + hi * 8;
#pragma unroll
    for (int d0 = 0; d0 < DQK / 16; ++d0) qr[d0] = *reinterpret_cast<const bf16x8*>(Qw + d0 * 16);
    const int vk = tid >> 3, vc = (tid & 7) * 8, vst = v_st(vk, vc);
    const int kr0 = tid / KCH, kc0 = (tid % KCH) * 8, kr1 = (512 + tid) / KCH, kc1 = ((512 + tid) % KCH) * 8;
    const bool two = (KCH * 64 > 512) && (tid < KCH * 64 - 512);
    const int vb0 = (int)(uintptr_t)V_lds + v_rd_base(lane);
    bf16x8 s_vs, s_k0, s_k1;
    const bf16_t* ksrc0 = (kc0 < 64) ? Kh + (size_t)kr0 * ldk + kc0 : Kr + (size_t)kr0 * 32 + (kc0 - 64); const int kst0 = (kc0 < 64) ? ldk : 32;
    const bf16_t* ksrc1 = (kc1 < 64) ? Kh + (size_t)kr1 * ldk + kc1 : Kr + (size_t)kr1 * 32 + (kc1 - 64); const int kst1 = (kc1 < 64) ? ldk : 32;
#define ATT_SLOAD(k0) do { s_vs = *reinterpret_cast<const bf16x8*>(Vh + (size_t)((k0) + vk) * ldv + vc); \
    s_k0 = *reinterpret_cast<const bf16x8*>(ksrc0 + (size_t)(k0) * kst0); \
    if (two) s_k1 = *reinterpret_cast<const bf16x8*>(ksrc1 + (size_t)(k0) * kst1); } while (0)
#define ATT_SWRITE(kb, vs) do { *(bf16x8*)(V_lds + (vs) + vst) = s_vs; *(bf16x8*)(K_lds + (kb) * SHM_K + kr0 * KROW + kc0 * 2) = s_k0; \
    if (two) *(bf16x8*)(K_lds + (kb) * SHM_K + kr1 * KROW + kc1 * 2) = s_k1; } while (0)
#define ATT_RESC(a) do { if (__any((a) < 1.f)) { if (hi == 0) al_l[r32] = (a); asm volatile("s_waitcnt lgkmcnt(0)" ::: "memory"); \
    _Pragma("unroll") for (int d = 0; d < 2; ++d) _Pragma("unroll") for (int r = 0; r < 16; ++r) o[d][r] *= al_l[crow(r, hi)]; } } while (0)
    f32x16 p0, p1; bf16x8 pa0, pa1, pa2, pa3; const int NT = seq / KVBLK; float bad = 0.f, l_part = 0.f;
    int vsr = 0, vsw = 2 * SHM_V;
#define ATT_ROT() do { vsr = (vsr == 2 * SHM_V) ? 0 : vsr + SHM_V; vsw = (vsw == 2 * SHM_V) ? 0 : vsw + SHM_V; } while (0)
    ATT_SLOAD(0); ATT_SWRITE(0, 0); __syncthreads(); ATT_SLOAD(KVBLK);
    unsigned* latch = (unsigned*)(lds + C::END);
    if (FAST && tid == 0) latch[par ^ 1] = 0u;
    ASBAR(); qkt2<DQK>(p0, p1, K_lds, qr, negm, r32, hi);
    if (!h1) { (void)softmax_tile(p0, p1, mhat, negm, l_reg, true, pa0, pa1, pa2, pa3); }
    VFr vf;
    if (!h1) pv_issue(vf, vb0);
    ATT_SWRITE(1, SHM_V); __syncthreads(); if (2 < NT) ATT_SLOAD(2 * KVBLK);
#define ATT_STAGE() do { if (t + 2 < NT) { ATT_SWRITE(t & 1, vsw); if (t + 3 < NT) ATT_SLOAD((t + 3) * KVBLK); } } while (0)
    for (int t = 0; t < NT; ++t) {
        if (h1) { pv_issue(vf, vb0 + vsr);
            if (FAST && t > 0) softmax_fast(p0, p1, l_part, bad, pa0, pa1, pa2, pa3);
            else { const float al = softmax_tile(p0, p1, mhat, negm, l_reg, t == 0, pa0, pa1, pa2, pa3); ATT_RESC(al); }
            ATT_STAGE(); }
        ASBAR(); pv_mma(o, vf, pa0, pa1, pa2, pa3);
        if (!h1) ATT_STAGE();
        if (t + 1 < NT) {
            ASBAR(); qkt2<DQK>(p0, p1, K_lds + ((t + 1) & 1) * SHM_K, qr, negm, r32, hi);
            if (!h1) { const int vnx = vb0 + ((vsr == 2 * SHM_V) ? 0 : vsr + SHM_V);
                       if (FAST) { pv_issue(vf, vnx); softmax_fast(p0, p1, l_part, bad, pa0, pa1, pa2, pa3); }
                       else { const float al = softmax_tile(p0, p1, mhat, negm, l_reg, false, pa0, pa1, pa2, pa3); ATT_RESC(al); pv_issue(vf, vnx); } }
            __syncthreads();
            ATT_ROT();
        }
    }
#undef ATT_STAGE
    u32x4 gt_[4];
#pragma unroll
    for (int i = 0; i < 4; ++i) gt_[i] = *(const u32x4*)(Gb + (size_t)(wid * QBLK + i * 8 + (lane >> 3)) * 1024 + (lane & 7) * 8);
    if (FAST) { auto rr = __builtin_amdgcn_permlane32_swap(__float_as_uint(l_part), __float_as_uint(l_part), false, false); l_reg += __uint_as_float(rr[0]) + __uint_as_float(rr[1]); }
    if (hi == 0) li_l[r32] = l_reg; asm volatile("s_waitcnt lgkmcnt(0)" ::: "memory");
    float* stg = (float*)(lds + C::OFF_OST + wid * C::OSTW);
#pragma unroll
    for (int r = 0; r < 16; ++r) { const int orow = crow(r, hi); const float rli = __builtin_amdgcn_rcpf(li_l[orow]);
        stg[orow * 68 + r32] = o[0][r] * rli; stg[orow * 68 + 32 + r32] = o[1][r] * rli; }
    asm volatile("s_waitcnt lgkmcnt(0)" ::: "memory");
#pragma unroll
    for (int i = 0; i < 4; ++i) { const int row = i * 8 + (lane >> 3), ch = (lane & 7) * 8;
        const f32x4v a = *(const f32x4v*)(stg + row * 68 + ch), b = *(const f32x4v*)(stg + row * 68 + ch + 4);
        const size_t off = (size_t)(wid * QBLK + row) * 1024 + ch; const u32x4 g = gt_[i]; u32x4 w;
        w.x = cvtpk(a[0] * __uint_as_float(g.x << 16), a[1] * __uint_as_float(g.x & 0xffff0000u)); w.y = cvtpk(a[2] * __uint_as_float(g.y << 16), a[3] * __uint_as_float(g.y & 0xffff0000u));
        w.z = cvtpk(b[0] * __uint_as_float(g.z << 16), b[1] * __uint_as_float(g.z & 0xffff0000u)); w.w = cvtpk(b[2] * __uint_as_float(g.w << 16), b[3] * __uint_as_float(g.w & 0xffff0000u));
        *(u32x4*)(Ob + off) = w; }
    bool redo = false;
    if (FAST) { if (__any(bad != 0.f) && lane == 0) latch[par] = 1u; __syncthreads(); redo = (latch[par] != 0u); } else __syncthreads();
#undef ATT_SLOAD
#undef ATT_SWRITE
#undef ATT_RESC
#undef ATT_ROT
    return redo;
}
#undef ASBAR
}
namespace fft {
using bf16x8 = __attribute__((ext_vector_type(8))) short;
using s16x4  = __attribute__((ext_vector_type(4))) short;
using f32x16 = __attribute__((ext_vector_type(16))) float;
using f32x4v = __attribute__((ext_vector_type(4))) float;
using u32x4  = __attribute__((ext_vector_type(4))) unsigned;
constexpr int OFF_X = 0, OFF_STG = 65536;
__device__ __forceinline__ int crow(int r, int hi) { return (r & 3) + 8 * (r >> 2) + 4 * hi; }
__device__ __forceinline__ unsigned cvtpk(float lo, float hi) { unsigned r; asm volatile("v_cvt_pk_bf16_f32 %0, %1, %2" : "=v"(r) : "v"(lo), "v"(hi)); return r; }
__device__ __forceinline__ int x_st(int kk, int c) { const int kp = (kk & ~0xC) | ((kk & 4) << 1) | ((kk & 8) >> 1); return ((kp >> 3) * 8 + (c >> 5)) * 512 + ((kp & 7) * 32 + (c & 31)) * 2; }
__device__ __forceinline__ int x_rd_base(int lane) { return ((lane & 3) << 3) | (((lane >> 2) & 3) << 6) | (((lane >> 4) & 1) << 5) | (((lane >> 5) & 1) << 8); }
constexpr int x_rd_off(int nb, int ks, int half) { return ks * 8192 + half * 4096 + nb * 512; }
template <int OFF> __device__ __forceinline__ s16x4 tr_read(int vb) { s16x4 r; asm volatile("ds_read_b64_tr_b16 %0, %1 offset:%2" : "=&v"(r) : "v"(vb), "i"(OFF) : "memory"); return r; }
template <int NB> __device__ __forceinline__ void mm_block(f32x16& acc, const bf16x8 (&afr)[8], int vb) {
#define FFT_PK(L, H) (bf16x8){L[0], L[1], L[2], L[3], H[0], H[1], H[2], H[3]}
    { const s16x4 l0 = tr_read<x_rd_off(NB, 0, 0)>(vb), h0 = tr_read<x_rd_off(NB, 0, 1)>(vb), l1 = tr_read<x_rd_off(NB, 1, 0)>(vb), h1 = tr_read<x_rd_off(NB, 1, 1)>(vb);
      const s16x4 l2 = tr_read<x_rd_off(NB, 2, 0)>(vb), h2 = tr_read<x_rd_off(NB, 2, 1)>(vb), l3 = tr_read<x_rd_off(NB, 3, 0)>(vb), h3 = tr_read<x_rd_off(NB, 3, 1)>(vb);
      asm volatile("s_waitcnt lgkmcnt(0)" ::: "memory"); __builtin_amdgcn_sched_barrier(0);
      acc = __builtin_amdgcn_mfma_f32_32x32x16_bf16(afr[0], FFT_PK(l0, h0), acc, 0, 0, 0); acc = __builtin_amdgcn_mfma_f32_32x32x16_bf16(afr[1], FFT_PK(l1, h1), acc, 0, 0, 0);
      acc = __builtin_amdgcn_mfma_f32_32x32x16_bf16(afr[2], FFT_PK(l2, h2), acc, 0, 0, 0); acc = __builtin_amdgcn_mfma_f32_32x32x16_bf16(afr[3], FFT_PK(l3, h3), acc, 0, 0, 0); }
    { const s16x4 l0 = tr_read<x_rd_off(NB, 4, 0)>(vb), h0 = tr_read<x_rd_off(NB, 4, 1)>(vb), l1 = tr_read<x_rd_off(NB, 5, 0)>(vb), h1 = tr_read<x_rd_off(NB, 5, 1)>(vb);
      const s16x4 l2 = tr_read<x_rd_off(NB, 6, 0)>(vb), h2 = tr_read<x_rd_off(NB, 6, 1)>(vb), l3 = tr_read<x_rd_off(NB, 7, 0)>(vb), h3 = tr_read<x_rd_off(NB, 7, 1)>(vb);
      asm volatile("s_waitcnt lgkmcnt(0)" ::: "memory"); __builtin_amdgcn_sched_barrier(0);
      acc = __builtin_amdgcn_mfma_f32_32x32x16_bf16(afr[4], FFT_PK(l0, h0), acc, 0, 0, 0); acc = __builtin_amdgcn_mfma_f32_32x32x16_bf16(afr[5], FFT_PK(l1, h1), acc, 0, 0, 0);
      acc = __builtin_amdgcn_mfma_f32_32x32x16_bf16(afr[6], FFT_PK(l2, h2), acc, 0, 0, 0); acc = __builtin_amdgcn_mfma_f32_32x32x16_bf16(afr[7], FFT_PK(l3, h3), acc, 0, 0, 0); }
#undef FFT_PK
}
struct TileRegs { bf16x8 v[8]; };
__device__ __forceinline__ void tile_load(TileRegs& t, const bf16_t* src  , size_t rowstride, int tid) {
    const bf16_t* p = src + (size_t)(tid >> 5) * rowstride + (tid & 31) * 8;
#pragma unroll
    for (int i = 0; i < 8; ++i) t.v[i] = *reinterpret_cast<const bf16x8*>(p + (size_t)(16 * i) * rowstride);
}
__device__ __forceinline__ void tile_write(const TileRegs& t, char* xl, int tid) {
    char* p = xl + x_st(tid >> 5, (tid & 31) * 8);
#pragma unroll
    for (int i = 0; i < 8; ++i) *reinterpret_cast<bf16x8*>(p + 8192 * i) = t.v[i];
}

__device__ __forceinline__ void stage_a(const bf16_t* __restrict__ PQ, bf16_t* __restrict__ Y, char* lds, int vcu, int G) {
    const int tid = threadIdx.x, wid = tid >> 6, lane = tid & 63, r32 = lane & 31, hi = lane >> 5, w = wid & 3, nh = wid >> 2;
    char* xl = lds + OFF_X; char* stg = lds + OFF_STG + wid * 8192;
    bf16x8 afr[8];
    { const int reim = r32 >> 4, k1 = 16 * w + (r32 & 15);
#pragma unroll
      for (int ks = 0; ks < 8; ++ks) { float v[8];
#pragma unroll
          for (int j = 0; j < 8; ++j) { const int kk = 16 * ks + 8 * hi + j, s1 = kk >> 1, pq = kk & 1; const float f = (float)((k1 * s1) & 63) * (1.f / 64.f);
              const float c = __builtin_amdgcn_cosf(f) * 0.125f, s = __builtin_amdgcn_sinf(f) * 0.125f; v[j] = reim == 0 ? (pq == 0 ? c : -s) : (pq == 0 ? s : c); }
          u32x4 p = {cvtpk(v[0], v[1]), cvtpk(v[2], v[3]), cvtpk(v[4], v[5]), cvtpk(v[6], v[7])}; afr[ks] = *reinterpret_cast<bf16x8*>(&p); } }
    const int vb = (int)(uintptr_t)xl + x_rd_base(lane) + nh * 4 * 512;
    constexpr int NU = NB * 192;
    TileRegs tr;
    int u = vcu;
    if (u < NU) tile_load(tr, PQ + (size_t)(u / 192) * 128 * 49152 + (u % 192) * 256, 49152, tid);
    for (; u < NU; u += G) {
        const int b = u / 192, j = u % 192;
        tile_write(tr, xl, tid);
        __syncthreads();
        { const int un = u + G; if (un < NU) tile_load(tr, PQ + (size_t)(un / 192) * 128 * 49152 + (un % 192) * 256, 49152, tid); }
        f32x16 acc[4] = {};
        mm_block<0>(acc[0], afr, vb); mm_block<1>(acc[1], afr, vb); mm_block<2>(acc[2], afr, vb); mm_block<3>(acc[3], afr, vb);
        const int s2 = j / 3;
#pragma unroll
        for (int r = 0; r < 8; ++r) { const int kl = crow(r, hi), k1 = 16 * w + kl; const float f = (float)(k1 * s2) * (1.f / 4096.f); const float tr_ = __builtin_amdgcn_cosf(f), ti_ = __builtin_amdgcn_sinf(f);
#pragma unroll
            for (int nb = 0; nb < 4; ++nb) { const float re = acc[nb][r], im = acc[nb][r + 8];
                *(bf16_t*)(stg + kl * 256 + (nb * 32 + r32) * 2) = f2bf(tr_ * re - ti_ * im);
                *(bf16_t*)(stg + (16 + kl) * 256 + (nb * 32 + r32) * 2) = f2bf(ti_ * re + tr_ * im); } }
        asm volatile("s_waitcnt lgkmcnt(0)" ::: "memory");
#pragma unroll
        for (int i = 0; i < 8; ++i) { const int rowl = i * 4 + (lane >> 4), c16 = lane & 15; const u32x4 v = *(const u32x4*)(stg + rowl * 256 + c16 * 16);
            const int reim = rowl >> 4, k1 = 16 * w + (rowl & 15);
            *(u32x4*)(Y + ((size_t)((b * 64 + k1) * 2 + reim)) * 49152 + j * 256 + nh * 128 + c16 * 8) = v; }
        __syncthreads();
    }
}
__device__ __forceinline__ void stage_b(const bf16_t* __restrict__ Y, const bf16_t* __restrict__ SG, bf16_t* __restrict__ BR, char* lds, int vcu, int G) {
    const int tid = threadIdx.x, wid = tid >> 6, lane = tid & 63, r32 = lane & 31, hi = lane >> 5, w = wid & 1, nq = wid >> 1;
    char* xl = lds + OFF_X; float* stg = (float*)(lds + OFF_STG + wid * 8192);
    bf16x8 afr[8];
    { const int k2 = 32 * w + r32;
#pragma unroll
      for (int ks = 0; ks < 8; ++ks) { float v[8];
#pragma unroll
          for (int j = 0; j < 8; ++j) { const int kk = 16 * ks + 8 * hi + j, reim = kk >> 6, s2 = kk & 63; const float f = (float)((k2 * s2) & 63) * (1.f / 64.f);
              v[j] = reim == 0 ? __builtin_amdgcn_cosf(f) * 0.125f : -__builtin_amdgcn_sinf(f) * 0.125f; }
          u32x4 p = {cvtpk(v[0], v[1]), cvtpk(v[2], v[3]), cvtpk(v[4], v[5]), cvtpk(v[6], v[7])}; afr[ks] = *reinterpret_cast<bf16x8*>(&p); } }
    const int vb = (int)(uintptr_t)xl + x_rd_base(lane) + nq * 2 * 512;
    constexpr int NU = NB * 64 * 3;
    TileRegs tr;
    int u = vcu;
    if (u < NU) tile_load(tr, Y + (size_t)(u / 3) * 2 * 49152 + (u % 3) * 256, 768, tid);
    for (; u < NU; u += G) {
        const int bk1 = u / 3, j = u % 3, b = bk1 >> 6, k1 = bk1 & 63;
        tile_write(tr, xl, tid);
        __syncthreads();
        { const int un = u + G; if (un < NU) tile_load(tr, Y + (size_t)(un / 3) * 2 * 49152 + (un % 3) * 256, 768, tid); }
        f32x16 acc[2] = {};
        mm_block<0>(acc[0], afr, vb); mm_block<1>(acc[1], afr, vb);
#pragma unroll
        for (int r = 0; r < 16; ++r) { const int rl = crow(r, hi); stg[rl * 64 + r32] = acc[0][r]; stg[rl * 64 + 32 + r32] = acc[1][r]; }
        asm volatile("s_waitcnt lgkmcnt(0)" ::: "memory");
#pragma unroll
        for (int i = 0; i < 4; ++i) { const int rowl = i * 8 + (lane >> 3), c8 = (lane & 7) * 8;
            const f32x4v a = *(const f32x4v*)(stg + rowl * 64 + c8), c = *(const f32x4v*)(stg + rowl * 64 + c8 + 4);
            const size_t off = ((size_t)b * SEQ + k1 + 64 * (32 * w + rowl)) * 1024 + j * 256 + nq * 64 + c8; const u32x4 g = *(const u32x4*)(SG + off); u32x4 o;
            o.x = cvtpk(a[0] * __uint_as_float(g.x << 16), a[1] * __uint_as_float(g.x & 0xffff0000u)); o.y = cvtpk(a[2] * __uint_as_float(g.y << 16), a[3] * __uint_as_float(g.y & 0xffff0000u));
            o.z = cvtpk(c[0] * __uint_as_float(g.z << 16), c[1] * __uint_as_float(g.z & 0xffff0000u)); o.w = cvtpk(c[2] * __uint_as_float(g.w << 16), c[3] * __uint_as_float(g.w & 0xffff0000u));
            *(u32x4*)(BR + off) = o; }
        __syncthreads();
    }
}
}
constexpr int NWAVES = 8;
constexpr int N_PHASES = 9;
constexpr int CW_BAR = 4096;
constexpr int RING_OFF = 0, RING_BYTES = 131072;
constexpr int LDSCTL_OFF = RING_BYTES, MISC_OFF = LDSCTL_OFF + 320, RS_OFF = LDSCTL_OFF + 1024  ;
constexpr int LDS_BYTES = 147456;
static_assert(RS_OFF + 4096 <= LDS_BYTES, "LDS map");

struct Args { const void* in[19]; float* out; unsigned char* ws; int ph_lo, ph_hi, li, pad; };

__device__ __forceinline__ void prep_w_job(const float* __restrict__ W, int ldw, int K, bf16_t* __restrict__ out, int n0, int nrows, const float* __restrict__ scale, int mode, int off, int gt, int GT) {
    const int total = nrows * (K >> 3);
    for (int idx = gt; idx < total; idx += GT) {
        const int n = idx % nrows, k8 = idx / nrows; const int sc = src_col(mode, n, off);
        float v[8];
#pragma unroll
        for (int i = 0; i < 8; ++i) { const int k = k8 * 8 + i; float w = (sc >= 0) ? W[(size_t)k * ldw + sc] : 0.f; if (scale) w *= scale[k]; v[i] = w; }
        uint4 o; o.x = pk2(v[0], v[1]); o.y = pk2(v[2], v[3]); o.z = pk2(v[4], v[5]); o.w = pk2(v[6], v[7]);
        *(uint4*)(out + (size_t)(n0 + n) * K + k8 * 8) = o;
    }
}
__device__ __forceinline__ void rmsnorm_row(const float* __restrict__ xrow, const float* __restrict__ g, bf16_t* __restrict__ orow, int lane) {
    const float4* xr = (const float4*)xrow + lane; float4 v[4]; float s = 0.f;
#pragma unroll
    for (int j = 0; j < 4; ++j) { v[j] = xr[64 * j]; s += v[j].x * v[j].x + v[j].y * v[j].y + v[j].z * v[j].z + v[j].w * v[j].w; }
    const float rstd = rsqrtf(wave_sum(s) * (1.f / DM) + EPS);
    uint2* o = (uint2*)orow + lane;
#pragma unroll
    for (int j = 0; j < 4; ++j) { const float4 gv = g ? ((const float4*)g)[lane + 64 * j] : make_float4(1.f, 1.f, 1.f, 1.f);
        uint2 w; w.x = pk2(v[j].x * rstd * gv.x, v[j].y * rstd * gv.y); w.y = pk2(v[j].z * rstd * gv.z, v[j].w * rstd * gv.w); o[64 * j] = w; }
}

typedef float f32x4m __attribute__((ext_vector_type(4)));
__device__ __forceinline__ void fold1_tiles(const float* __restrict__ Wf, float* __restrict__ AG, int gw, int NGW, int lane) {
    const int li = lane & 15, lk = lane >> 4;
    for (int tile = gw; tile < 2 * 4 * 12 * 12; tile += NGW) { const int di = tile % 12, ci = (tile / 12) % 12, g = (tile / 144) & 3, pq = tile / 576;
        const int c = ci * 16 + li; int p = (lk * c) % 192; const int step = (4 * c) % 192;
        const float* wp = Wf + ((size_t)g * 192 + lk) * 192 + di * 16 + li;
        f32x4m acc = {0.f, 0.f, 0.f, 0.f};
#pragma unroll 8
        for (int m0 = 0; m0 < 192; m0 += 4) { const float f = (float)p * (1.f / 192.f); const float a = pq ? __builtin_amdgcn_sinf(f) : __builtin_amdgcn_cosf(f);
            const float b = wp[(size_t)m0 * 192];
            acc = __builtin_amdgcn_mfma_f32_16x16x4f32(a, b, acc, 0, 0, 0);
            p += step; if (p >= 192) p -= 192; }
        float* op = AG + (((size_t)pq * 4 + g) * 192 + ci * 16 + 4 * lk) * 192 + di * 16 + li;
#pragma unroll
        for (int r = 0; r < 4; ++r) op[(size_t)r * 192] = acc[r] * 0.07216878364870322f; }
}
__device__ __forceinline__ void fold2_strips(const float* __restrict__ Win1, const float* __restrict__ g1, const float* __restrict__ AG, bf16_t* __restrict__ WIN1o, int gw, int NGW, int lane) {
    const int li = lane & 15, lk = lane >> 4;
    for (int s = gw; s < 64 * 8 * 3; s += NGW) { const int ki = s & 63, pg = (s >> 6) & 7, ds = s >> 9;
        const int g = pg & 3; const float* ap = Win1 + (size_t)(ki * 16 + li) * 2048 + 192 * g + lk; const float* bp = AG + ((size_t)pg * 192 + lk) * 192 + ds * 64 + li;
        f32x4m acc[4] = {{0.f, 0.f, 0.f, 0.f}, {0.f, 0.f, 0.f, 0.f}, {0.f, 0.f, 0.f, 0.f}, {0.f, 0.f, 0.f, 0.f}};
#pragma unroll 4
        for (int c0 = 0; c0 < 192; c0 += 4) { const float a = ap[c0]; const float* b = bp + (size_t)c0 * 192;
#pragma unroll
            for (int n = 0; n < 4; ++n) acc[n] = __builtin_amdgcn_mfma_f32_16x16x4f32(a, b[16 * n], acc[n], 0, 0, 0); }
        const int k0 = ki * 16 + 4 * lk; const float4 gv = *(const float4*)(g1 + k0);
#pragma unroll
        for (int n = 0; n < 4; ++n) { uint2 w; w.x = pk2(acc[n][0] * gv.x, acc[n][1] * gv.y); w.y = pk2(acc[n][2] * gv.z, acc[n][3] * gv.w);
            *(uint2*)(WIN1o + (size_t)((pg >> 2) * 768 + g * 192 + ds * 64 + n * 16 + li) * 1024 + k0) = w; } }
}
__device__ __forceinline__ void rmsnorm_rows2(const float* __restrict__ X, const float* __restrict__ g, bf16_t* __restrict__ O, int nrows, int gw, int NGW, int lane) {
    for (int m = 2 * gw; m < nrows; m += 2 * NGW) {
        const float4* x0 = (const float4*)(X + (size_t)m * DM) + lane; const float4* x1 = x0 + DM / 4; float4 v[8]; float s0 = 0.f, s1 = 0.f;
#pragma unroll
        for (int j = 0; j < 4; ++j) { v[j] = x0[64 * j]; v[4 + j] = x1[64 * j]; }
#pragma unroll
        for (int j = 0; j < 4; ++j) { s0 += v[j].x * v[j].x + v[j].y * v[j].y + v[j].z * v[j].z + v[j].w * v[j].w; s1 += v[4 + j].x * v[4 + j].x + v[4 + j].y * v[4 + j].y + v[4 + j].z * v[4 + j].z + v[4 + j].w * v[4 + j].w; }
        const float r0 = rsqrtf(wave_sum(s0) * (1.f / DM) + EPS), r1 = rsqrtf(wave_sum(s1) * (1.f / DM) + EPS);
        uint2* o0 = (uint2*)(O + (size_t)m * DM) + lane; uint2* o1 = o0 + DM / 4;
#pragma unroll
        for (int j = 0; j < 4; ++j) { const float4 gv = g ? ((const float4*)g)[lane + 64 * j] : make_float4(1.f, 1.f, 1.f, 1.f);
            uint2 w; w.x = pk2(v[j].x * r0 * gv.x, v[j].y * r0 * gv.y); w.y = pk2(v[j].z * r0 * gv.z, v[j].w * r0 * gv.w); o0[64 * j] = w;
            uint2 z; z.x = pk2(v[4 + j].x * r1 * gv.x, v[4 + j].y * r1 * gv.y); z.y = pk2(v[4 + j].z * r1 * gv.z, v[4 + j].w * r1 * gv.w); o1[64 * j] = z; } }
}
__global__ void __launch_bounds__(NWAVES * 64, 2) mk_fwd(Args args) {
    extern __shared__ __attribute__((aligned(16))) unsigned char lds[];
    LAS unsigned char* ldsl = (LAS unsigned char*)lds;
    volatile LAS unsigned* MISC = (volatile LAS unsigned*)(ldsl + MISC_OFF);
    const int tid0 = threadIdx.x;
#define PHASE_IDS() int tid = threadIdx.x; asm volatile("" : "+v"(tid)); const int lane = tid & 63, wave = __builtin_amdgcn_readfirstlane(tid >> 6); const int gt = (int)blockIdx.x * (NWAVES * 64) + tid, gw = (int)blockIdx.x * NWAVES + wave; (void)lane; (void)wave; (void)gt; (void)gw;
    const int vcu = (gridDim.x % 8 == 0) ? ((int)blockIdx.x % 8) * ((int)gridDim.x / 8) + (int)blockIdx.x / 8 : (int)blockIdx.x;
    const int G = gridDim.x, GT = G * NWAVES * 64, NGW = G * NWAVES;
    unsigned char* ws = args.ws;
    gu32* ctl = (gu32*)(ws + WS_CTL);
#define in_x ((const float*)args.in[0])
#define in_mem ((const float*)args.in[1])
#define in_pos ((const int*)args.in[2])
#define in_g0 ((const float*)args.in[3])
#define in_w_in0 ((const float*)args.in[4])
#define in_gq ((const float*)args.in[5])
#define in_gkv ((const float*)args.in[6])
#define in_w_uq ((const float*)args.in[7])
#define in_w_ukv ((const float*)args.in[8])
#define in_gm0 ((const float*)args.in[9])
#define in_w_mkv0 ((const float*)args.in[10])
#define in_w_out0 ((const float*)args.in[11])
#define in_g1 ((const float*)args.in[12])
#define in_w_in1 ((const float*)args.in[13])
#define in_w_fnet ((const float*)args.in[14])
#define in_gm1 ((const float*)args.in[15])
#define in_w_mkv1 ((const float*)args.in[16])
#define in_w_out1 ((const float*)args.in[17])
#define in_gf ((const float*)args.in[18])
#define in_out (args.out)
#define WIN0 ((bf16_t*)(ws + WS_WIN0))
#define WUQ ((bf16_t*)(ws + WS_WUQ))
#define WUKV ((bf16_t*)(ws + WS_WUKV))
#define WMEM ((bf16_t*)(ws + WS_WMEM))
#define WOUT0 ((bf16_t*)(ws + WS_WOUT0))
#define WOUT1 ((bf16_t*)(ws + WS_WOUT1))
#define WIN1 ((bf16_t*)(ws + WS_WIN1))
#define AGBG ((float*)(ws + WS_AGBG))
#define ROPE ((float*)(ws + WS_ROPE))
#define MEMN ((bf16_t*)(ws + WS_MEMN))
#define MEMKV ((bf16_t*)(ws + WS_MEMKV))
#define RSTD1 ((float*)(ws + WS_RSTD1))
#define SSQ ((float*)(ws + WS_SSQ))
#define XN0 ((bf16_t*)(ws + WS_XN0))
#define BR ((bf16_t*)(ws + WS_BR))
#define CQ ((bf16_t*)(ws + WS_CQ))
#define CKV ((bf16_t*)(ws + WS_CKV))
#define QMEM0 ((bf16_t*)(ws + WS_QMEM0))
#define SG0 ((bf16_t*)(ws + WS_SG0))
#define Kb ((bf16_t*)(ws + WS_K))
#define KR ((bf16_t*)(ws + WS_K + 96 * MiB))
#define Qb ((bf16_t*)(ws + WS_Q))
#define Vb ((bf16_t*)(ws + WS_V))
#define X1B ((bf16_t*)(ws + WS_X1B))
#define PQ ((bf16_t*)(ws + WS_PQ))
#define QMEM1 ((bf16_t*)(ws + WS_QMEM1))
#define SG1 ((bf16_t*)(ws + WS_SG1))
#define Y ((bf16_t*)(ws + WS_Y))
    for (int u = tid0; u < (LDS_BYTES - LDSCTL_OFF) / 4; u += NWAVES * 64) ((LAS unsigned*)(ldsl + LDSCTL_OFF))[u] = 0u;
    __syncthreads();
    const XcdBarrier bar = xcd_barrier_post((unsigned*)(ctl + CW_BAR) + args.li * XCD_BAR_WORDS, MISC + 8);
#define GRID_BAR() xcd_barrier(bar)
    const int lo = args.ph_lo, hi = args.ph_hi;
#ifndef PH_MASK
#define PH_MASK 0x1ff
#endif
#define IN(k) (((PH_MASK >> (k)) & 1) && lo <= (k) && (k) < hi)
#define BOTH(k) (IN(k) && IN((k) + 1))
    LAS float* rs = (LAS float*)(ldsl + RS_OFF);

    if (IN(0)) { PHASE_IDS();
        prep_w_job(in_w_in0, 1952, 1024, WIN0, 0, 2048, nullptr, MODE_WIN0, 0, gt, GT);
        prep_w_job(in_w_mkv0, 512, 1024, WMEM, 0, 512, in_gm0, MODE_PLAIN, 0, gt, GT);
        prep_w_job(in_w_mkv1, 512, 1024, WMEM, 512, 512, in_gm1, MODE_PLAIN, 0, gt, GT);
        fold1_tiles(in_w_fnet, AGBG, gw, NGW, lane);
        for (int idx = gt; idx < T * 16; idx += GT) { const int t = idx >> 4, i = idx & 15;
            const float inv_freq = __builtin_amdgcn_exp2f((float)i * -0.83048202372184058696f);
            const float ang = (float)in_pos[t] * inv_freq; double fd = (double)ang * 0.31830988618379067154; fd -= 2.0 * floor(fd * 0.5);
            float sn, cs; sincospif((float)fd, &sn, &cs); ROPE[2 * idx] = cs; ROPE[2 * idx + 1] = sn; }
        rmsnorm_rows2(in_mem, nullptr, MEMN, 4096, gw, NGW, lane);
        rmsnorm_rows2(in_x, in_g0, XN0, T, gw, NGW, lane);
        if (BOTH(0)) GRID_BAR();
    }
    if (IN(1)) { PHASE_IDS();
        { pg8::Gemm g{XN0, WIN0, T, 2048, 1024}; pg8::StaticOrder S; S.init(T, 2048, G, (int)blockIdx.x);
          pg8::EpiIn0 E{CQ, CKV, QMEM0, SG0, KR, SSQ, ROPE};
          pg8::gemm_phase<pg8::EpiIn0, pg8::StaticOrder, true, true>(ldsl + RING_OFF, g, S, E); }
        { const int nidle = G > 64 ? G - 64 : 0;
          if (nidle == 0 || (int)blockIdx.x >= 64) { const int bi = nidle ? (int)blockIdx.x - 64 : (int)blockIdx.x, nb = nidle ? nidle : G;
              const int gtI = bi * (NWAVES * 64) + tid, GTI = nb * NWAVES * 64;
              fold2_strips(in_w_in1, in_g1, AGBG, WIN1, bi * NWAVES + wave, nb * NWAVES, lane);
              prep_w_job(in_w_uq, 1152, 384, WUQ, 0, 1280, in_gq, MODE_WUQ, 0, gtI, GTI);
              prep_w_job(in_w_ukv, 1536, 256, WUKV, 0, 1536, in_gkv, MODE_WUKV, 0, gtI, GTI);
              prep_w_job(in_w_out0, 1024, 1024, WOUT0, 0, 1024, nullptr, MODE_PLAIN, 0, gtI, GTI);
              prep_w_job(in_w_in1, 2048, 1024, WIN1, 1536, 1280, in_g1, MODE_PLAIN, 768, gtI, GTI);
              prep_w_job(in_w_out1, 1024, 1024, WOUT1, 0, 1024, nullptr, MODE_PLAIN, 0, gtI, GTI); } }
        { pg8::Gemm g{MEMN, WMEM, 4096, 1024, 1024}; pg8::StaticOrder S; S.init(4096, 1024, G, (int)blockIdx.x);
          pg8::EpiPlainB E{MEMKV, 1024, 0};
          pg8::gemm_phase<pg8::EpiPlainB, pg8::StaticOrder, true, true>(ldsl + RING_OFF, g, S, E); }
        if (BOTH(1)) GRID_BAR();
    }
    if (IN(2)) { PHASE_IDS();
        { int kq_ = 384; asm volatile("" : "+s"(kq_)); pg8::Gemm g{CQ, WUQ, T, 1280, kq_}; pg8::StaticOrder S; S.init(T, 1280, G, (int)blockIdx.x);
          pg8::EpiQup E{Qb, SSQ, ROPE};
          pg8::gemm_phase<pg8::EpiQup, pg8::StaticOrder, true, true>(ldsl + RING_OFF, g, S, E); }
        { int kk_ = 256; asm volatile("" : "+s"(kk_)); pg8::Gemm g{CKV, WUKV, T, 1536, kk_}; pg8::StaticOrder S; S.init(T, 1536, G, (int)blockIdx.x);
          pg8::EpiKVup E{Kb, Vb, SSQ};
          pg8::gemm_phase<pg8::EpiKVup, pg8::StaticOrder, true, true>(ldsl + RING_OFF, g, S, E); }
        if (BOTH(2)) GRID_BAR();
    }
    if (IN(3)) { PHASE_IDS();
        unsigned redo_mask = 0u;
        if (tid == 0) { unsigned* l2 = (unsigned*)((char*)lds + att::Cfg2<96>::END); l2[0] = 0u; l2[1] = 0u; }
        __syncthreads();
        { int it = 0;
        for (int u = vcu; u < 16 * 12 * NB; u += G, ++it) { const int qblk = u & 15, pair = u >> 4, b = pair / 12, h = pair % 12; const size_t t0 = (size_t)b * SEQ + qblk * 256;
            if (att::attn_unit<96, true>(Qb + t0 * 1152 + h * 96, 1152, Kb + (size_t)b * SEQ * 768 + h * 64, 768, KR + (size_t)b * SEQ * 32, Vb + (size_t)b * SEQ * 768 + h * 64, 768, SEQ, BR + t0 * 1024 + h * 64, SG0 + t0 * 1024 + h * 64, (char*)lds, tid, it & 1)) redo_mask |= 1u << it; } }
        if (redo_mask) { int tid2 = threadIdx.x; asm volatile("" : "+v"(tid2)); int it = 0;
        for (int u = vcu; u < 16 * 12 * NB; u += G, ++it) { if (!((redo_mask >> it) & 1u)) continue; const int qblk = u & 15, pair = u >> 4, b = pair / 12, h = pair % 12; const size_t t0 = (size_t)b * SEQ + qblk * 256;
            (void)att::attn_unit<96, false>(Qb + t0 * 1152 + h * 96, 1152, Kb + (size_t)b * SEQ * 768 + h * 64, 768, KR + (size_t)b * SEQ * 32, Vb + (size_t)b * SEQ * 768 + h * 64, 768, SEQ, BR + t0 * 1024 + h * 64, SG0 + t0 * 1024 + h * 64, (char*)lds, tid2); } }
        int tid3 = threadIdx.x; asm volatile("" : "+v"(tid3));
        for (int u = vcu; u < 16 * 4 * NB; u += G) { const int qblk = u & 15, pair = u >> 4, b = pair >> 2, h = pair & 3; const size_t t0 = (size_t)b * SEQ + qblk * 256;
            (void)att::attn_unit<64, false>(QMEM0 + t0 * 256 + h * 64, 256, MEMKV + (size_t)b * 256 * 1024 + h * 64, 1024, nullptr, MEMKV + (size_t)b * 256 * 1024 + 256 + h * 64, 1024, 256, BR + t0 * 1024 + 768 + h * 64, SG0 + t0 * 1024 + 768 + h * 64, (char*)lds, tid3); }
        if (BOTH(3)) GRID_BAR();
    }
    if (IN(4)) { PHASE_IDS();
        for (int i = tid; i < 1024; i += NWAVES * 64) rs[i] = 0.f;
        __syncthreads();
        { pg8::Gemm g{BR, WOUT0, T, 1024, 1024}; pg8::PanelOrder S; S.init(T, G, (int)blockIdx.x);
          pg8::EpiOutA E{in_x, X1B, rs};
          pg8::gemm_phase<pg8::EpiOutA, pg8::PanelOrder, true, true>(ldsl + RING_OFF, g, S, E); }
        __syncthreads();
        if (tid < 256) RSTD1[(size_t)blockIdx.x * 256 + tid] = rsqrtf(((rs[tid * 4] + rs[tid * 4 + 1]) + (rs[tid * 4 + 2] + rs[tid * 4 + 3])) * (1.f / DM) + EPS);
        if (BOTH(4)) GRID_BAR();
    }
    if (IN(5)) { PHASE_IDS();
        { pg8::Gemm g{X1B, WIN1, T, 2816, 1024}; pg8::StaticOrder S; S.init(T, 2816, G, (int)blockIdx.x);
          pg8::EpiIn1 E{PQ, QMEM1, SG1, RSTD1};
          pg8::gemm_phase<pg8::EpiIn1, pg8::StaticOrder, true, true>(ldsl + RING_OFF, g, S, E); }
        if (BOTH(5)) GRID_BAR();
    }
    if (IN(6)) { PHASE_IDS();
        fft::stage_a(PQ, Y, (char*)lds, vcu, G);
        for (int u = vcu; u < 16 * 4 * NB; u += G) { const int qblk = u & 15, pair = u >> 4, b = pair >> 2, h = pair & 3; const size_t t0 = (size_t)b * SEQ + qblk * 256;
            (void)att::attn_unit<64, false>(QMEM1 + t0 * 256 + h * 64, 256, MEMKV + (size_t)b * 256 * 1024 + 512 + h * 64, 1024, nullptr, MEMKV + (size_t)b * 256 * 1024 + 768 + h * 64, 1024, 256, BR + t0 * 1024 + 768 + h * 64, SG1 + t0 * 1024 + 768 + h * 64, (char*)lds, tid); }
        if (BOTH(6)) GRID_BAR();
    }
    if (IN(7)) { PHASE_IDS();
        fft::stage_b(Y, SG1, BR, (char*)lds, vcu, G);
        if (BOTH(7)) GRID_BAR();
    }
    if (IN(8)) { PHASE_IDS();
        __syncthreads();
        for (int i = tid; i < 1024; i += NWAVES * 64) rs[i] = 0.f;
        __syncthreads();
        { pg8::Gemm g{BR, WOUT1, T, 1024, 1024}; pg8::PanelOrder S; S.init(T, G, (int)blockIdx.x);
          pg8::EpiOutB E{X1B, rs};
          pg8::gemm_phase<pg8::EpiOutB, pg8::PanelOrder, true, true>(ldsl + RING_OFF, g, S, E); }
        asm volatile("s_waitcnt vmcnt(0)" ::: "memory");
        __syncthreads();
        for (int r0 = wave * 4; r0 < 256; r0 += NWAVES * 4) {
            uint4 v[4][2]; float rstd[4];
#pragma unroll
            for (int q = 0; q < 4; ++q) { const uint4* xb = (const uint4*)(X1B + ((size_t)blockIdx.x * 256 + r0 + q) * DM) + lane; v[q][0] = xb[0]; v[q][1] = xb[64];
                const int r = r0 + q; rstd[q] = rsqrtf(((rs[r * 4] + rs[r * 4 + 1]) + (rs[r * 4 + 2] + rs[r * 4 + 3])) * (1.f / DM) + EPS); }
#pragma unroll
            for (int j = 0; j < 2; ++j) { const float4 ga = ((const float4*)in_gf)[2 * lane + 128 * j], gb = ((const float4*)in_gf)[2 * lane + 128 * j + 1];
#pragma unroll
                for (int q = 0; q < 4; ++q) { const uint4 w = v[q][j]; const float s = rstd[q]; float4 a, b; float4* orow = (float4*)(in_out + ((size_t)blockIdx.x * 256 + r0 + q) * DM) + 2 * lane;
                    a.x = __uint_as_float(w.x << 16) * s * ga.x; a.y = __uint_as_float(w.x & 0xffff0000u) * s * ga.y; a.z = __uint_as_float(w.y << 16) * s * ga.z; a.w = __uint_as_float(w.y & 0xffff0000u) * s * ga.w;
                    b.x = __uint_as_float(w.z << 16) * s * gb.x; b.y = __uint_as_float(w.z & 0xffff0000u) * s * gb.y; b.z = __uint_as_float(w.w << 16) * s * gb.z; b.w = __uint_as_float(w.w & 0xffff0000u) * s * gb.w;
                    orow[128 * j] = a; orow[128 * j + 1] = b; } } }
    }
#undef in_x
#undef in_mem
#undef in_pos
#undef in_g0
#undef in_w_in0
#undef in_gq
#undef in_gkv
#undef in_w_uq
#undef in_w_ukv
#undef in_gm0
#undef in_w_mkv0
#undef in_w_out0
#undef in_g1
#undef in_w_in1
#undef in_w_fnet
#undef in_gm1
#undef in_w_mkv1
#undef in_w_out1
#undef in_gf
#undef in_out
#undef WIN0
#undef WUQ
#undef WUKV
#undef WMEM
#undef WOUT0
#undef WOUT1
#undef WIN1
#undef AGBG
#undef ROPE
#undef MEMN
#undef MEMKV
#undef RSTD1
#undef SSQ
#undef XN0
#undef BR
#undef CQ
#undef CKV
#undef QMEM0
#undef SG0
#undef Kb
#undef KR
#undef Qb
#undef Vb
#undef X1B
#undef PQ
#undef QMEM1
#undef SG1
#undef Y
#undef PHASE_IDS
#undef IN
#undef BOTH
#undef GRID_BAR
}

extern "C" void kernel_launch(void* const* d_in, const int* in_sizes, int n_in, void* d_out, int out_size, void* d_ws, size_t ws_size, hipStream_t stream) {
    static int grid = 0;
    if (grid == 0) {
        if (n_in != 19 || ws_size < WS_END || out_size != T * DM) { fprintf(stderr, "kernel_launch: unexpected n_in %d / ws %zu / out %d\n", n_in, ws_size, out_size); grid = -1; return; }
        int dev = 0, cus = 0;
        if (hipGetDevice(&dev) != hipSuccess || hipDeviceGetAttribute(&cus, hipDeviceAttributeMultiprocessorCount, dev) != hipSuccess) { grid = -1; return; }
        if (hipFuncSetAttribute((const void*)mk_fwd, hipFuncAttributeMaxDynamicSharedMemorySize, LDS_BYTES) != hipSuccess) { fprintf(stderr, "kernel_launch: hipFuncSetAttribute failed\n"); grid = -1; return; }
        int per_cu = 0; (void)hipOccupancyMaxActiveBlocksPerMultiprocessor(&per_cu, (const void*)mk_fwd, NWAVES * 64, LDS_BYTES); (void)hipGetLastError();
        if (cus != 256 || per_cu < 1) fprintf(stderr, "kernel_launch: note: %d CUs, occupancy query %d (built for 256 CUs, one workgroup each)\n", cus, per_cu);
        grid = 256;
    }
    if (grid < 0) return;
    if (hipMemsetAsync((char*)d_ws + WS_CTL, 0, CTL_ZERO_BYTES, stream) != hipSuccess) { fprintf(stderr, "kernel_launch: memset failed\n"); return; }
    Args a{};
    for (int i = 0; i < 19; ++i) a.in[i] = d_in[i];
    a.out = (float*)d_out; a.ws = (unsigned char*)d_ws;
#ifndef PROBE_PHASE
    const int nl = 1; const int rlo[1] = {0}, rhi[1] = {N_PHASES};
#else
    const int nl = 3; const int rlo[3] = {0, PROBE_PHASE, PROBE_PHASE}, rhi[3] = {PROBE_PHASE + 1, PROBE_PHASE + 1, N_PHASES};
#endif
    for (int li = 0; li < nl; ++li) {
        a.ph_lo = rlo[li]; a.ph_hi = rhi[li]; a.li = li; a.pad = 0;
        hipLaunchKernelGGL(mk_fwd, dim3(grid), dim3(NWAVES * 64), LDS_BYTES, stream, a);
        const hipError_t le = hipPeekAtLastError();
        if (le != hipSuccess) { fprintf(stderr, "kernel_launch: launch %d failed: %s\n", li, hipGetErrorName(le)); break; }
    }
}
```

```cpp
#include <hip/hip_runtime.h>
#include <stdint.h>
#include <cstdio>

typedef unsigned short bf16_t;
constexpr int T = 65536, SEQ = 4096, NB = 16, DM = 1024;
constexpr float EPS = 1e-6f;
constexpr float LOG2E = 1.4426950408889634f;
constexpr float QS_MLA = 0.10206207261596575f * LOG2E;
constexpr float QS_MEM = 0.125f * LOG2E;

constexpr size_t MiB = 1u << 20;
constexpr size_t WS_CTL = 0, CTL_ZERO_BYTES = 65536;
constexpr size_t WS_WIN0 = 1 * MiB;
constexpr size_t WS_WUQ = 5 * MiB;
constexpr size_t WS_WUKV = 6 * MiB;
constexpr size_t WS_WMEM = 7 * MiB;
constexpr size_t WS_WOUT0 = 9 * MiB;
constexpr size_t WS_WOUT1 = 11 * MiB;
constexpr size_t WS_WIN1 = 13 * MiB;
constexpr size_t WS_AGBG = 19 * MiB;
constexpr size_t WS_ROPE = 21 * MiB;
constexpr size_t WS_MEMN = 29 * MiB;
constexpr size_t WS_MEMKV = 37 * MiB;
constexpr size_t WS_RSTD1 = 45 * MiB;
constexpr size_t WS_SSQ = 46 * MiB;
constexpr size_t WS_XN0 = 864 * MiB;
constexpr size_t WS_RSTD0 = 45 * MiB + 512 * 1024;
constexpr size_t WS_BR = 64 * MiB;
constexpr size_t WS_CQ = 192 * MiB;
constexpr size_t WS_CKV = 240 * MiB;
constexpr size_t WS_QMEM0 = 272 * MiB;
constexpr size_t WS_SG0 = 304 * MiB;
constexpr size_t WS_K = 432 * MiB;
constexpr size_t WS_Q = 576 * MiB;
constexpr size_t WS_V = 720 * MiB;
constexpr size_t WS_X1B = 192 * MiB;
constexpr size_t WS_PQ = 320 * MiB;
constexpr size_t WS_QMEM1 = 512 * MiB;
constexpr size_t WS_SG1 = 544 * MiB;
constexpr size_t WS_Y = 672 * MiB;
constexpr size_t WS_END = 992 * MiB;

__device__ __forceinline__ float bf2f(bf16_t h) { return __uint_as_float(((unsigned)h) << 16); }
__device__ __forceinline__ bf16_t f2bf(float f) { unsigned u = __float_as_uint(f); return (bf16_t)((u + 0x7fffu + ((u >> 16) & 1u)) >> 16); }
__device__ __forceinline__ unsigned pk2(float lo, float hi) { return (unsigned)f2bf(lo) | ((unsigned)f2bf(hi) << 16); }
__device__ __forceinline__ float silu_f(float v) { return v * __builtin_amdgcn_rcpf(1.f + __expf(-v)); }
__device__ __forceinline__ float wave_sum(float v) {
#pragma unroll
    for (int o = 1; o < 64; o <<= 1) v += __shfl_xor(v, o);
    return v;
}
__host__ __device__ __forceinline__ int ropedim(int p) { return 4 * (p >> 3) + (p & 3) + 16 * ((p >> 2) & 1); }
enum { MODE_WIN0 = 0, MODE_WUQ = 1, MODE_WUKV = 2, MODE_PLAIN = 3 };
__device__ __forceinline__ int src_col(int mode, int n, int off) {
    if (mode == MODE_WIN0) {
        if (n < 640) return n;
        if (n < 896) return 672 + (n - 640);
        if (n < 928) return 640 + ropedim(n - 896);
        if (n < 1024) return -1;
        return 928 + (n - 1024);
    } else if (mode == MODE_WUQ) {
        if (n < 768) return (n >> 6) * 96 + (n & 63);
        if (n < 1152) { const int r = n - 768; return (r >> 5) * 96 + 64 + ropedim(r & 31); }
        return -1;
    } else if (mode == MODE_WUKV) {
        if (n < 768) return (n >> 6) * 128 + (n & 63);
        const int r = n - 768; return (r >> 6) * 128 + 64 + (r & 63);
    }
    return n + off;
}
namespace pg8 {
#define PG8_LAS __attribute__((address_space(3)))
typedef unsigned short bf16_t;
typedef short bf16x8 __attribute__((ext_vector_type(8)));
typedef float f32x4 __attribute__((ext_vector_type(4)));
typedef unsigned u32x4 __attribute__((ext_vector_type(4)));
constexpr int BM = 256, BK = 64, HALF = 128, HTB = HALF * BK * 2  , STAGE_BYTES = 8 * HTB, NXCD = 8, WGM = 8;

__host__ __device__ __forceinline__ int lds_byte(int r, int c) { const int st = (r >> 4) * 2 + (c >> 5), rr = r & 15, cc = c & 31, ob = rr * 64 + cc * 2; return st * 1024 + (ob ^ (((ob >> 9) & 1) << 5)); }
__host__ __device__ __forceinline__ void stage_rc(int b, int& R, int& C) { const int st = b / 1024, sb = b % 1024, swz = sb ^ (((sb >> 9) & 1) << 5); R = (st >> 1) * 16 + swz / 64; C = (st & 1) * 32 + (swz % 64) / 2; }
__host__ __device__ __forceinline__ int perm32(int rho) { const int n = rho >> 4, i = rho & 15; return 8 * (i >> 2) + 4 * n + (i & 3); }

struct Unit { int pm, pn; };
struct Gemm { const bf16_t* A; const bf16_t* Bt; int M, N, K; };

struct StaticOrder {
    int nM, nN, nwg, G, c;
    __host__ __device__ void init(int M, int N, int G_, int c_) { nM = M / BM; nN = N / BM; nwg = nM * nN; G = G_; c = c_; }
    __host__ __device__ bool next(int i, Unit& u) const {
        const long L = (long)i * G + c; if (L >= nwg) return false;
        int wgid = (int)L; { const int q = nwg / NXCD, r = nwg % NXCD, xcd = wgid % NXCD, off = wgid / NXCD; wgid = (xcd < r ? xcd * (q + 1) : r * (q + 1) + (xcd - r) * q) + off; }
        const int nig = WGM * nN, gid = wgid / nig, fm = gid * WGM, gsz = (nM - fm) < WGM ? (nM - fm) : WGM;
        u.pm = fm + ((wgid % nig) % gsz); u.pn = (wgid % nig) / gsz; return true;
    }
    __device__ __forceinline__ void a_ready(const Unit&) const {}
    __device__ __forceinline__ void done(const Unit&) const {}
};

__device__ __forceinline__ unsigned cvt_pk_bf16(float lo, float hi) { unsigned r; asm volatile("v_cvt_pk_bf16_f32 %0, %1, %2" : "=v"(r) : "v"(lo), "v"(hi)); return r; }
typedef float f32x2 __attribute__((ext_vector_type(2)));
__device__ __forceinline__ u32x4 pack8(const f32x4 a, const f32x4 b, float s) { u32x4 w; w.x = cvt_pk_bf16(a[0] * s, a[1] * s); w.y = cvt_pk_bf16(a[2] * s, a[3] * s); w.z = cvt_pk_bf16(b[0] * s, b[1] * s); w.w = cvt_pk_bf16(b[2] * s, b[3] * s); return w; }
__device__ __forceinline__ float ss8(const f32x4 a, const f32x4 b) { return (a[0] * a[0] + a[1] * a[1]) + (a[2] * a[2] + a[3] * a[3]) + (b[0] * b[0] + b[1] * b[1]) + (b[2] * b[2] + b[3] * b[3]); }
__device__ __forceinline__ float quad_sum(float v) { v += __shfl_xor(v, 16); v += __shfl_xor(v, 32); return v; }
__device__ __forceinline__ f32x4 silu4(const f32x4 v) { f32x4 o; o[0] = silu_f(v[0]); o[1] = silu_f(v[1]); o[2] = silu_f(v[2]); o[3] = silu_f(v[3]); return o; }
typedef unsigned u32x2 __attribute__((ext_vector_type(2)));
__device__ __forceinline__ void rope_pair(const f32x4 a, const f32x4 b, const float* cs  , float s, u32x2& o1, u32x2& o2) {
    const f32x4 c01 = *(const f32x4*)cs, c23 = *(const f32x4*)(cs + 4);
    const float r0 = (a[0] * c01[0] - b[0] * c01[1]) * s, r1 = (a[1] * c01[2] - b[1] * c01[3]) * s, r2 = (a[2] * c23[0] - b[2] * c23[1]) * s, r3 = (a[3] * c23[2] - b[3] * c23[3]) * s;
    const float q0 = (b[0] * c01[0] + a[0] * c01[1]) * s, q1 = (b[1] * c01[2] + a[1] * c01[3]) * s, q2 = (b[2] * c23[0] + a[2] * c23[1]) * s, q3 = (b[3] * c23[2] + a[3] * c23[3]) * s;
    o1.x = cvt_pk_bf16(r0, r1); o1.y = cvt_pk_bf16(r2, r3); o2.x = cvt_pk_bf16(q0, q1); o2.y = cvt_pk_bf16(q2, q3);
}
__device__ __forceinline__ void rope_pair2(const f32x4 a, const f32x4 b, const f32x4 c01, const f32x4 c23, float s, u32x2& o1, u32x2& o2) {
    o1.x = cvt_pk_bf16((a[0] * c01[0] - b[0] * c01[1]) * s, (a[1] * c01[2] - b[1] * c01[3]) * s); o1.y = cvt_pk_bf16((a[2] * c23[0] - b[2] * c23[1]) * s, (a[3] * c23[2] - b[3] * c23[3]) * s);
    o2.x = cvt_pk_bf16((b[0] * c01[0] + a[0] * c01[1]) * s, (b[1] * c01[2] + a[1] * c01[3]) * s); o2.y = cvt_pk_bf16((b[2] * c23[0] + a[2] * c23[1]) * s, (b[3] * c23[2] + a[3] * c23[3]) * s);
}
struct EpiIn0 {
    static constexpr bool PERM = true, AFTER_DRAIN = false; static constexpr int NST = 8;
    struct Pre {}; __device__ __forceinline__ void prefetch(Pre&, const Unit&, int, int, int, int) const {}
    bf16_t *CQ, *CKV, *QMEM, *SG, *Kb  ; float* SSQ; const float* rope; const float* RSTD  ;
    __device__ __forceinline__ void operator()(const f32x4 (&acc)[2][2][4][2], const Unit& u, int wr, int wc, int fr, int fq, const Pre& pre) const {
        const bool kr = (u.pn == 3) && (wc == 0);
        f32x4 cs[2][4][2];
        if (kr) {
#pragma unroll
            for (int ai = 0; ai < 2; ++ai)
#pragma unroll
                for (int m = 0; m < 4; ++m) { const float* rp = rope + (size_t)(u.pm * BM + ai * HALF + wr * 64 + m * 16 + fr) * 32 + 8 * fq; cs[ai][m][0] = *(const f32x4*)rp; cs[ai][m][1] = *(const f32x4*)(rp + 4); } }
#pragma unroll
        for (int ai = 0; ai < 2; ++ai)
#pragma unroll
            for (int m = 0; m < 4; ++m) { const size_t row = (size_t)(u.pm * BM + ai * HALF + wr * 64 + m * 16 + fr); const float rsd = RSTD[row];
#pragma unroll
                for (int bj = 0; bj < 2; ++bj) { const int cb = u.pn * BM + bj * HALF + wc * 32, c = cb + 8 * fq; const f32x4 v0 = acc[ai][bj][m][0] * rsd, v1 = acc[ai][bj][m][1] * rsd;
                    if (cb < 640) { const float ss = quad_sum(ss8(v0, v1));
                        if (cb < 384) { *(u32x4*)(CQ + row * 384 + c) = pack8(v0, v1, 1.f); if (fq == 0) SSQ[row * 20 + (cb >> 5)] = ss; }
                        else { *(u32x4*)(CKV + row * 256 + (c - 384)) = pack8(v0, v1, 1.f); if (fq == 0) SSQ[row * 20 + 12 + ((cb - 384) >> 5)] = ss; } }
                    else if (cb < 896) { *(u32x4*)(QMEM + row * 256 + (c - 640)) = pack8(v0, v1, QS_MEM); }
                    else if (cb < 1024) { if (cb == 896) { u32x2 o1, o2; rope_pair2(v0, v1, cs[ai][m][0], cs[ai][m][1], 1.f, o1, o2);
                            *(u32x2*)(Kb + row * 32 + 4 * fq) = o1; *(u32x2*)(Kb + row * 32 + 16 + 4 * fq) = o2; } }
                    else { *(u32x4*)(SG + row * 1024 + (c - 1024)) = pack8(silu4(v0), silu4(v1), 1.f); } } }
    }
};
struct EpiPlainB {
    static constexpr bool PERM = true, AFTER_DRAIN = false; static constexpr int NST = 16;
    struct Pre {}; __device__ __forceinline__ void prefetch(Pre&, const Unit&, int, int, int, int) const {}
    bf16_t* O; int ldo; int pad;
    __device__ __forceinline__ void operator()(const f32x4 (&acc)[2][2][4][2], const Unit& u, int wr, int wc, int fr, int fq, const Pre& pre) const {
#pragma unroll
        for (int ai = 0; ai < 2; ++ai)
#pragma unroll
            for (int m = 0; m < 4; ++m) { int rowi_ = u.pm * BM + ai * HALF + wr * 64 + m * 16 + fr; asm volatile("" : "+v"(rowi_)); const size_t row = (size_t)rowi_;
#pragma unroll
                for (int bj = 0; bj < 2; ++bj) { const int c = u.pn * BM + bj * HALF + wc * 32 + 8 * fq; *(u32x4*)(O + row * ldo + c) = pack8(acc[ai][bj][m][0], acc[ai][bj][m][1], 1.f); } }
    }
};
struct __attribute__((packed, aligned(4))) F3 { float a, b, c; };
typedef float f32x2 __attribute__((ext_vector_type(2)));
struct EpiQup {
    static constexpr bool PERM = true, AFTER_DRAIN = false; static constexpr int NST = 16;
    struct Pre {}; __device__ __forceinline__ void prefetch(Pre&, const Unit&, int, int, int, int) const {}
    bf16_t* Qb; const float* SSQ; const float* rope;
    __device__ __forceinline__ void operator()(const f32x4 (&acc)[2][2][4][2], const Unit& u, int wr, int wc, int fr, int fq, const Pre& pre) const {
        const int row0 = u.pm * BM + wr * 64 + fr;
        F3 part[2][4];
#pragma unroll
        for (int ai = 0; ai < 2; ++ai)
#pragma unroll
            for (int m = 0; m < 4; ++m) part[ai][m] = *(const F3*)(SSQ + (size_t)(row0 + ai * HALF + m * 16) * 20 + 3 * fq);
        const int cb0 = u.pn * BM + wc * 32;
        const bool rope0 = cb0 >= 768, rope1 = (cb0 + HALF >= 768) && (cb0 + HALF < 1152);
        f32x4 csA[4][2], csB[4][2];
        if (rope1 || rope0) {
#pragma unroll
            for (int m = 0; m < 4; ++m) { const float* rp = rope + (size_t)(row0 + m * 16) * 32 + 8 * fq; csA[m][0] = *(const f32x4*)rp; csA[m][1] = *(const f32x4*)(rp + 4); } }
        float sc[2][4];
#pragma unroll
        for (int ai = 0; ai < 2; ++ai)
#pragma unroll
            for (int m = 0; m < 4; ++m) sc[ai][m] = rsqrtf(quad_sum(part[ai][m].a + part[ai][m].b + part[ai][m].c) * (1.f / 384.f) + EPS) * QS_MLA;
        if (!(rope0 || rope1)) {
#pragma unroll
            for (int bj = 0; bj < 2; ++bj) { const int c = cb0 + bj * HALF + 8 * fq;
#pragma unroll
                for (int ai = 0; ai < 2; ++ai)
#pragma unroll
                    for (int m = 0; m < 4; ++m) *(u32x4*)(Qb + (size_t)(row0 + ai * HALF + m * 16) * 1152 + (c >> 6) * 96 + (c & 63)) = pack8(acc[ai][bj][m][0], acc[ai][bj][m][1], sc[ai][m]); }
            return; }
        u32x2 oA[4][2][2];
#pragma unroll
        for (int m = 0; m < 4; ++m) { if (rope0) rope_pair2(acc[0][0][m][0], acc[0][0][m][1], csA[m][0], csA[m][1], sc[0][m], oA[m][0][0], oA[m][0][1]);
            if (rope1) rope_pair2(acc[0][1][m][0], acc[0][1][m][1], csA[m][0], csA[m][1], sc[0][m], oA[m][1][0], oA[m][1][1]); }
#pragma unroll
        for (int m = 0; m < 4; ++m) { const float* rp = rope + (size_t)(row0 + HALF + m * 16) * 32 + 8 * fq; csB[m][0] = *(const f32x4*)rp; csB[m][1] = *(const f32x4*)(rp + 4); }
        asm volatile("" ::: "memory");
#pragma unroll
        for (int ai = 0; ai < 2; ++ai) {
#pragma unroll
            for (int m = 0; m < 4; ++m) { bf16_t* qrow = Qb + (size_t)(row0 + ai * HALF + m * 16) * 1152;
#pragma unroll
                for (int bj = 0; bj < 2; ++bj) { const int cb = cb0 + bj * HALF; const bool rp_ = bj == 0 ? rope0 : rope1;
                    if (rp_) { const int h = (cb - 768) >> 5; u32x2 o1, o2;
                        if (ai == 0) { o1 = oA[m][bj][0]; o2 = oA[m][bj][1]; } else rope_pair2(acc[1][bj][m][0], acc[1][bj][m][1], csB[m][0], csB[m][1], sc[1][m], o1, o2);
                        *(u32x2*)(qrow + h * 96 + 64 + 4 * fq) = o1; *(u32x2*)(qrow + h * 96 + 80 + 4 * fq) = o2; }
                    else if (cb < 768) { const int c = cb + 8 * fq; *(u32x4*)(qrow + (c >> 6) * 96 + (c & 63)) = pack8(acc[ai][bj][m][0], acc[ai][bj][m][1], sc[ai][m]); } } } }
    }
};
struct EpiKVup {
    static constexpr bool PERM = true, AFTER_DRAIN = false; static constexpr int NST = 16;
    struct Pre { f32x2 part[2][4]; };
    __device__ __forceinline__ void prefetch(Pre& p, const Unit& u, int wr, int, int fr, int fq) const { const int row0 = u.pm * BM + wr * 64 + fr;
#pragma unroll
        for (int ai = 0; ai < 2; ++ai)
#pragma unroll
            for (int m = 0; m < 4; ++m) p.part[ai][m] = *(const f32x2*)(SSQ + (size_t)(row0 + ai * HALF + m * 16) * 20 + 12 + 2 * fq); }
    bf16_t *Kb, *Vb; const float* SSQ;
    __device__ __forceinline__ void operator()(const f32x4 (&acc)[2][2][4][2], const Unit& u, int wr, int wc, int fr, int fq, const Pre& pre) const {
        const int row0 = u.pm * BM + wr * 64 + fr;
        const f32x2 (&part)[2][4] = pre.part;
        float sc[2][4];
#pragma unroll
        for (int ai = 0; ai < 2; ++ai)
#pragma unroll
            for (int m = 0; m < 4; ++m) sc[ai][m] = rsqrtf(quad_sum(part[ai][m][0] + part[ai][m][1]) * (1.f / 256.f) + EPS);
#pragma unroll
        for (int bj = 0; bj < 2; ++bj) { const int cb = u.pn * BM + bj * HALF + wc * 32, c = cb + 8 * fq;
#pragma unroll
            for (int ai = 0; ai < 2; ++ai)
#pragma unroll
                for (int m = 0; m < 4; ++m) { const size_t row = (size_t)(row0 + ai * HALF + m * 16); const u32x4 w = pack8(acc[ai][bj][m][0], acc[ai][bj][m][1], sc[ai][m]);
                    if (cb < 768) *(u32x4*)(Kb + row * 768 + c) = w; else *(u32x4*)(Vb + row * 768 + (c - 768)) = w; } }
    }
};
struct EpiOutA {
    static constexpr bool PERM = true, AFTER_DRAIN = false; static constexpr int NST = 16;
    struct Pre { u32x4 res[2][4][2]; };
    __device__ __forceinline__ void prefetch(Pre& p, const Unit& u, int wr, int wc, int fr, int fq) const { const int c0 = u.pn * BM + wc * 32 + 8 * fq;
#pragma unroll
        for (int ai = 0; ai < 2; ++ai)
#pragma unroll
            for (int m = 0; m < 4; ++m) { const bf16_t* rp = R + (size_t)(u.pm * BM + ai * HALF + wr * 64 + m * 16 + fr) * 1024 + c0; p.res[ai][m][0] = *(const u32x4*)rp; p.res[ai][m][1] = *(const u32x4*)(rp + HALF); } }
    const bf16_t* R  ; bf16_t* X1B; PG8_LAS float* rs;
    __device__ __forceinline__ void operator()(const f32x4 (&acc)[2][2][4][2], const Unit& u, int wr, int wc, int fr, int fq, const Pre& pre) const {
        const int c0 = u.pn * BM + wc * 32 + 8 * fq;
        u32x4 outw[2][4][2];
#pragma unroll
        for (int ai = 0; ai < 2; ++ai) { const u32x4 (&res)[4][2] = pre.res[ai];
#pragma unroll
            for (int m = 0; m < 4; ++m) { const int rl = ai * HALF + wr * 64 + m * 16 + fr; float ssum = 0.f;
#pragma unroll
                for (int bj = 0; bj < 2; ++bj) { const u32x4 rw = res[m][bj];
                    const f32x4 ra = {__uint_as_float(rw.x << 16), __uint_as_float(rw.x & 0xffff0000u), __uint_as_float(rw.y << 16), __uint_as_float(rw.y & 0xffff0000u)};
                    const f32x4 rb = {__uint_as_float(rw.z << 16), __uint_as_float(rw.z & 0xffff0000u), __uint_as_float(rw.w << 16), __uint_as_float(rw.w & 0xffff0000u)};
                    const f32x4 x0 = ra + acc[ai][bj][m][0], x1 = rb + acc[ai][bj][m][1];
                    outw[ai][m][bj] = pack8(x0, x1, 1.f); ssum += ss8(x0, x1); }
                ssum = quad_sum(ssum); if (fq == 0) rs[rl * 4 + wc] += ssum; }
            asm volatile("" ::: "memory"); }
#pragma unroll
        for (int ai = 0; ai < 2; ++ai)
#pragma unroll
            for (int m = 0; m < 4; ++m) { bf16_t* xp = X1B + (size_t)(u.pm * BM + ai * HALF + wr * 64 + m * 16 + fr) * 1024 + c0;
#pragma unroll
                for (int bj = 0; bj < 2; ++bj) *(u32x4*)(xp + bj * HALF) = outw[ai][m][bj]; }
    }
};
struct EpiOutB {
    static constexpr bool PERM = true, AFTER_DRAIN = false; static constexpr int NST = 16;
    struct Pre { u32x4 res[2][4][2]; };
    __device__ __forceinline__ void prefetch(Pre& p, const Unit& u, int wr, int wc, int fr, int fq) const { const int c0 = u.pn * BM + wc * 32 + 8 * fq;
#pragma unroll
        for (int ai = 0; ai < 2; ++ai)
#pragma unroll
            for (int m = 0; m < 4; ++m) { const bf16_t* rp = X + (size_t)(u.pm * BM + ai * HALF + wr * 64 + m * 16 + fr) * 1024 + c0; p.res[ai][m][0] = *(const u32x4*)rp; p.res[ai][m][1] = *(const u32x4*)(rp + HALF); } }
    bf16_t* X; PG8_LAS float* rs;
    __device__ __forceinline__ void operator()(const f32x4 (&acc)[2][2][4][2], const Unit& u, int wr, int wc, int fr, int fq, const Pre& pre) const {
        const int c0 = u.pn * BM + wc * 32 + 8 * fq;
        const u32x4 (&res)[2][4][2] = pre.res;
#pragma unroll
        for (int ai = 0; ai < 2; ++ai)
#pragma unroll
            for (int m = 0; m < 4; ++m) { const int rl = ai * HALF + wr * 64 + m * 16 + fr; bf16_t* xp = X + (size_t)(u.pm * BM + rl) * 1024 + c0; float ssum = 0.f;
#pragma unroll
                for (int bj = 0; bj < 2; ++bj) { const u32x4 r = res[ai][m][bj];
                    f32x4 x0, x1; x0[0] = __uint_as_float(r.x << 16); x0[1] = __uint_as_float(r.x & 0xffff0000u); x0[2] = __uint_as_float(r.y << 16); x0[3] = __uint_as_float(r.y & 0xffff0000u);
                    x1[0] = __uint_as_float(r.z << 16); x1[1] = __uint_as_float(r.z & 0xffff0000u); x1[2] = __uint_as_float(r.w << 16); x1[3] = __uint_as_float(r.w & 0xffff0000u);
                    x0 += acc[ai][bj][m][0]; x1 += acc[ai][bj][m][1];
                    *(u32x4*)(xp + bj * HALF) = pack8(x0, x1, 1.f); ssum += ss8(x0, x1); }
                ssum = quad_sum(ssum); if (fq == 0) rs[rl * 4 + wc] += ssum; }
    }
};
struct EpiIn1 {
    static constexpr bool PERM = true, AFTER_DRAIN = false; static constexpr int NST = 16;
    struct Pre { float rr[2][4]; };
    __device__ __forceinline__ void prefetch(Pre& p, const Unit& u, int wr, int, int fr, int) const { const int row0 = u.pm * BM + wr * 64 + fr;
#pragma unroll
        for (int ai = 0; ai < 2; ++ai)
#pragma unroll
            for (int m = 0; m < 4; ++m) p.rr[ai][m] = RSTD[row0 + ai * HALF + m * 16]; }
    bf16_t *PQ, *QMEM, *SG; const float* RSTD;
    __device__ __forceinline__ void operator()(const f32x4 (&acc)[2][2][4][2], const Unit& u, int wr, int wc, int fr, int fq, const Pre& pre) const {
        const int row0 = u.pm * BM + wr * 64 + fr;
        const float (&rr)[2][4] = pre.rr;
#pragma unroll
        for (int ai = 0; ai < 2; ++ai)
#pragma unroll
            for (int m = 0; m < 4; ++m) { const int rowi = row0 + ai * HALF + m * 16; const size_t row = (size_t)rowi; const float r = rr[ai][m];
                const int b = rowi >> 12, sq = rowi & 4095, s1 = sq >> 6, s2 = sq & 63; const size_t prow = ((size_t)(b * 64 + s1) * 2) * 64 + s2;
#pragma unroll
                for (int bj = 0; bj < 2; ++bj) { const int cb = u.pn * BM + bj * HALF + wc * 32, c = cb + 8 * fq; const f32x4 v0 = acc[ai][bj][m][0], v1 = acc[ai][bj][m][1];
                    if (cb < 1536) { const int pq = cb >= 768 ? 1 : 0; *(u32x4*)(PQ + (prow + pq * 64) * 768 + (c - pq * 768)) = pack8(v0, v1, r); }
                    else if (cb < 1792) *(u32x4*)(QMEM + row * 256 + (c - 1536)) = pack8(v0, v1, r * QS_MEM);
                    else *(u32x4*)(SG + row * 1024 + (c - 1792)) = pack8(silu4(v0 * r), silu4(v1 * r), 1.f); } }
    }
};
struct PanelOrder {
    int nM, G, c;
    __device__ void init(int M, int G_, int c_) { nM = M / BM; G = G_; c = c_; }
    __device__ bool next(int i, Unit& u) const { u.pm = c + G * (i >> 2); u.pn = i & 3; return u.pm < nM; }
    __device__ __forceinline__ void a_ready(const Unit&) const {}
    __device__ __forceinline__ void done(const Unit&) const {}
};
template <class Epi, class Sched, bool ALIGN_EPI = false, bool SP2 = false>
__device__ __forceinline__ void gemm_phase(PG8_LAS unsigned char* lds, const Gemm g, const Sched& S, const Epi& E) {
    const int tid = threadIdx.x, wid = __builtin_amdgcn_readfirstlane(tid >> 6), lane = tid & 63, wr = wid >> 2, wc = wid & 3, fr = lane & 15, fq = lane >> 4;
    const int K = g.K, nt = K / BK;
    unsigned voffA[2], voffB[2];
#pragma unroll
    for (int i = 0; i < 2; ++i) { int R, C; stage_rc(tid * 16 + i * 8192, R, C); const int Rb = Epi::PERM ? ((R & ~31) + perm32(R & 31)) : R;
        voffA[i] = (unsigned)(R * K + C) * 2u; voffB[i] = (unsigned)(Rb * K + C) * 2u; }
    const size_t kstep = (size_t)(BK * 2);
    const size_t hstep = (size_t)HALF * K * 2;
    const size_t tstep = 2 * hstep;
    const unsigned ldsw = (unsigned)wid * 1024u;
    const int aoff = lds_byte(wr * 64 + fr, fq * 8), boff = lds_byte(wc * 32 + fr, fq * 8);
#define PG8_SA(b, h) (((b) * 2 + (h)) * HTB)
#define PG8_SB(b, h) ((4 + (b) * 2 + (h)) * HTB)
#define PG8_STAGE(bufoff, gbase, voff) do { _Pragma("unroll") for (int _i = 0; _i < 2; ++_i) \
        __builtin_amdgcn_global_load_lds((const unsigned*)((const char*)(gbase) + (voff)[_i]), (PG8_LAS unsigned*)(lds + (bufoff) + ldsw + _i * 8192), 16, 0, 0); } while (0)
#define PG8_LDA(dst, b, h) do { _Pragma("unroll") for (int m = 0; m < 4; ++m) _Pragma("unroll") for (int k = 0; k < 2; ++k) dst[m][k] = *(const PG8_LAS bf16x8*)(lds + PG8_SA(b, h) + aoff + m * 2048 + k * 1024); } while (0)
#define PG8_LDB(dst, b, h) do { _Pragma("unroll") for (int n = 0; n < 2; ++n) _Pragma("unroll") for (int k = 0; k < 2; ++k) dst[n][k] = *(const PG8_LAS bf16x8*)(lds + PG8_SB(b, h) + boff + n * 2048 + k * 1024); } while (0)
#define PG8_MMA(ai, bj, At, Bt) do { __builtin_amdgcn_s_setprio(1); _Pragma("unroll") for (int m = 0; m < 4; ++m) _Pragma("unroll") for (int n = 0; n < 2; ++n) _Pragma("unroll") for (int k = 0; k < 2; ++k) \
        acc[ai][bj][m][n] = __builtin_amdgcn_mfma_f32_16x16x32_bf16(Bt[n][k], At[m][k], acc[ai][bj][m][n], 0, 0, 0); __builtin_amdgcn_s_setprio(0); } while (0)
#define PG8_WAIT_V(n) asm volatile("s_waitcnt vmcnt(" #n ")" ::: "memory")
#define PG8_WAIT_L(n) asm volatile("s_waitcnt lgkmcnt(" #n ")" ::: "memory")
#define PG8_WAIT_VF(fr, n) asm volatile("s_cmp_lg_u32 %0, 0\n\ts_cbranch_scc0 .Lwvs%=\n\ts_waitcnt vmcnt(%1)\n\ts_branch .Lwve%=\n.Lwvs%=:\n\ts_waitcnt vmcnt(8)\n.Lwve%=:" :: "s"(fr), "n"(n) : "memory", "scc")
#define PG8_BAR __builtin_amdgcn_s_barrier()
#define PG8_SCHED __builtin_amdgcn_sched_barrier(0)
    Unit cur, nxt; int ui = 0;
    if (!S.next(0, cur)) return;
    f32x4 acc[2][2][4][2];
#pragma unroll
    for (int a = 0; a < 2; ++a)
#pragma unroll
        for (int b = 0; b < 2; ++b)
#pragma unroll
            for (int m = 0; m < 4; ++m)
#pragma unroll
                for (int n = 0; n < 2; ++n) acc[a][b][m][n] = (f32x4){0.f, 0.f, 0.f, 0.f};
    bf16x8 At[4][2], B0[2][2], B1[2][2];
    const char* cA = (const char*)g.A + (size_t)cur.pm * tstep; const char* cB = (const char*)g.Bt + (size_t)cur.pn * tstep;
    S.a_ready(cur);
    if constexpr (SP2) {
        PG8_STAGE(PG8_SB(0, 0), cB, voffB); PG8_STAGE(PG8_SB(0, 1), cB + hstep, voffB); PG8_STAGE(PG8_SA(0, 0), cA, voffA); PG8_STAGE(PG8_SA(0, 1), cA + hstep, voffA);
        if (wr == 1) PG8_BAR;
        PG8_WAIT_V(2); PG8_BAR;
        PG8_STAGE(PG8_SB(1, 0), cB + kstep, voffB); PG8_STAGE(PG8_SA(1, 0), cA + kstep, voffA); PG8_STAGE(PG8_SB(1, 1), cB + hstep + kstep, voffB);
        PG8_WAIT_V(6); PG8_BAR;
    } else {
        PG8_STAGE(PG8_SB(0, 0), cB, voffB); PG8_STAGE(PG8_SA(0, 0), cA, voffA); PG8_STAGE(PG8_SB(0, 1), cB + hstep, voffB); PG8_STAGE(PG8_SA(0, 1), cA + hstep, voffA);
        if (wr == 1) PG8_BAR;
        PG8_WAIT_V(4); PG8_BAR;
        PG8_STAGE(PG8_SB(1, 0), cB + kstep, voffB); PG8_STAGE(PG8_SA(1, 0), cA + kstep, voffA); PG8_STAGE(PG8_SB(1, 1), cB + hstep + kstep, voffB);
        PG8_WAIT_V(6); PG8_BAR;
    }
    for (;;) {
        const bool has_next = S.next(ui + 1, nxt);
        const char* nA = has_next ? (const char*)g.A + (size_t)nxt.pm * tstep : cA; const char* nB = has_next ? (const char*)g.Bt + (size_t)nxt.pn * tstep : cB;
        for (int t = 0; t < nt; t += 2) {
            const bool last = (t == nt - 2);
            const char* a1 = cA + (size_t)(t + 1) * kstep;
            const char* a2 = last ? nA : cA + (size_t)(t + 2) * kstep; const char* b2 = last ? nB : cB + (size_t)(t + 2) * kstep;
            const char* a3 = a2 + kstep; const char* b3 = b2 + kstep;
            if (last && has_next) S.a_ready(nxt);
            if constexpr (SP2) {
            const int fresh = __builtin_amdgcn_readfirstlane(((t == 0) && (ui > 0)) ? 1 : 0);
            PG8_LDB(B0, 0, 0); PG8_LDB(B1, 0, 1); PG8_SCHED; PG8_LDA(At, 0, 0); PG8_STAGE(PG8_SA(1, 1), a1 + hstep, voffA);
            PG8_WAIT_VF(fresh, 8 + Epi::NST);
            PG8_WAIT_L(0); PG8_BAR; PG8_MMA(0, 0, At, B0); PG8_MMA(0, 1, At, B1); PG8_BAR; PG8_SCHED;
            PG8_LDA(At, 0, 1); PG8_STAGE(PG8_SB(0, 0), b2, voffB); PG8_STAGE(PG8_SB(0, 1), b2 + hstep, voffB); PG8_STAGE(PG8_SA(0, 0), a2, voffA);
            PG8_WAIT_VF(fresh, 8 + Epi::NST);
            PG8_WAIT_L(0); PG8_BAR; PG8_MMA(1, 0, At, B0); PG8_MMA(1, 1, At, B1); PG8_BAR; PG8_SCHED;
            PG8_LDB(B0, 1, 0); PG8_LDB(B1, 1, 1); PG8_SCHED; PG8_LDA(At, 1, 0); PG8_STAGE(PG8_SA(0, 1), a2 + hstep, voffA);
            PG8_WAIT_V(8); PG8_WAIT_L(0); PG8_BAR; PG8_MMA(0, 0, At, B0); PG8_MMA(0, 1, At, B1); PG8_BAR; PG8_SCHED;
            PG8_LDA(At, 1, 1); PG8_STAGE(PG8_SB(1, 0), b3, voffB); PG8_STAGE(PG8_SB(1, 1), b3 + hstep, voffB); PG8_STAGE(PG8_SA(1, 0), a3, voffA);
            PG8_WAIT_V(8); PG8_WAIT_L(0); PG8_BAR; PG8_MMA(1, 0, At, B0); PG8_MMA(1, 1, At, B1); PG8_BAR; PG8_SCHED;
            } else {
            PG8_LDB(B0, 0, 0); PG8_SCHED; PG8_LDA(At, 0, 0); PG8_STAGE(PG8_SA(1, 1), a1 + hstep, voffA);
            PG8_WAIT_L(8); PG8_BAR; PG8_WAIT_L(0); PG8_MMA(0, 0, At, B0); PG8_BAR; PG8_SCHED;
            PG8_LDB(B1, 0, 1); PG8_STAGE(PG8_SB(0, 0), b2, voffB);
            PG8_BAR; PG8_WAIT_L(0); PG8_MMA(0, 1, At, B1); PG8_BAR;
            PG8_LDA(At, 0, 1); PG8_STAGE(PG8_SA(0, 0), a2, voffA);
            PG8_BAR; PG8_WAIT_L(0); PG8_MMA(1, 0, At, B0); PG8_BAR; PG8_SCHED;
            PG8_STAGE(PG8_SB(0, 1), b2 + hstep, voffB);
            PG8_WAIT_V(6); PG8_BAR; PG8_MMA(1, 1, At, B1); PG8_BAR;
            PG8_LDB(B0, 1, 0); PG8_SCHED; PG8_LDA(At, 1, 0); PG8_STAGE(PG8_SA(0, 1), a2 + hstep, voffA);
            PG8_WAIT_L(8); PG8_BAR; PG8_WAIT_L(0); PG8_MMA(0, 0, At, B0); PG8_BAR; PG8_SCHED;
            PG8_LDB(B1, 1, 1); PG8_STAGE(PG8_SB(1, 0), b3, voffB);
            PG8_BAR; PG8_WAIT_L(0); PG8_MMA(0, 1, At, B1); PG8_BAR;
            PG8_LDA(At, 1, 1); PG8_STAGE(PG8_SA(1, 0), a3, voffA);
            PG8_BAR; PG8_WAIT_L(0); PG8_MMA(1, 0, At, B0); PG8_BAR; PG8_SCHED;
            PG8_STAGE(PG8_SB(1, 1), b3 + hstep, voffB);
            PG8_WAIT_V(6); PG8_BAR; PG8_MMA(1, 1, At, B1); PG8_BAR;
            }
        }
        typename Epi::Pre pre;
        E.prefetch(pre, cur, wr, wc, fr, fq);
        if constexpr (ALIGN_EPI) { if (wr == 0) PG8_BAR; }
        if constexpr (!Epi::AFTER_DRAIN) { E(acc, cur, wr, wc, fr, fq, pre); S.done(cur); }
        if (!has_next) break;
#pragma unroll
        for (int a = 0; a < 2; ++a)
#pragma unroll
            for (int b = 0; b < 2; ++b)
#pragma unroll
                for (int m = 0; m < 4; ++m)
#pragma unroll
                    for (int n = 0; n < 2; ++n) acc[a][b][m][n] = (f32x4){0.f, 0.f, 0.f, 0.f};
        cur = nxt; cA = nA; cB = nB; ++ui;
        if constexpr (ALIGN_EPI) { if (wr == 1) PG8_BAR; }
    }
    PG8_WAIT_V(0);
    if constexpr (!ALIGN_EPI) { if (wr == 0) PG8_BAR; }
    PG8_BAR;
    if constexpr (Epi::AFTER_DRAIN) { E.fused(acc, cur, wr, wc, fr, fq, lds, wid, lane); S.done(cur); }
#undef PG8_SA
#undef PG8_SB
#undef PG8_STAGE
#undef PG8_LDA
#undef PG8_LDB
#undef PG8_MMA
#undef PG8_WAIT_V
#undef PG8_WAIT_L
#undef PG8_BAR
#undef PG8_SCHED
}
}
#define GAS __attribute__((address_space(1)))
#define LAS __attribute__((address_space(3)))
typedef unsigned short bf16;
typedef unsigned v4u __attribute__((ext_vector_type(4)));
typedef float f32x4 __attribute__((ext_vector_type(4)));
typedef short bf16x8 __attribute__((ext_vector_type(8)));
typedef GAS unsigned gu32;
typedef GAS unsigned long long gu64;
#define RLX_AGENT __ATOMIC_RELAXED, __HIP_MEMORY_SCOPE_AGENT
#define LDS_WAIT() asm volatile("s_waitcnt lgkmcnt(0)" ::: "memory")
#define VM_WAIT() asm volatile("s_waitcnt vmcnt(0)" ::: "memory")
__device__ __forceinline__ unsigned long long rt() { return __builtin_amdgcn_s_memrealtime(); }
#define XB_TMO      128
#define XB_XCNT(j)  (256  + 64 * (j))
#define XB_XSUB(j)  (1280 + 64 * (j))
#define XB_XGEN(j)  (2304 + 64 * (j))
#define XB_TOP      3328
#define XB_TOPGEN   3392
#define XCD_BAR_WORDS 3456
#define XB_SPIN_CAP (1u << 18)

__device__ __forceinline__ unsigned xb_ld(unsigned* p)              { return __hip_atomic_load(p, __ATOMIC_RELAXED, __HIP_MEMORY_SCOPE_AGENT); }
__device__ __forceinline__ unsigned xb_add(unsigned* p, unsigned v) { return __hip_atomic_fetch_add(p, v, __ATOMIC_RELAXED, __HIP_MEMORY_SCOPE_AGENT); }
__device__ __forceinline__ unsigned xb_xcc_id() { return (unsigned)__builtin_amdgcn_s_getreg((3 << 11) | 20) & 0xFu; }
#define XB_SPIN(cond, bar) do { unsigned _sp = 0; while (cond) { __builtin_amdgcn_s_sleep(1); \
    if ((++_sp & 255u) == 0u) { if (xb_ld(&(bar)[XB_TMO])) break; if (_sp > XB_SPIN_CAP) { atomicAdd(&(bar)[XB_TMO], 1u); break; } } } } while (0)

struct XcdBarrier {
    unsigned* bar; unsigned x;
    volatile LAS unsigned* st;
};

__device__ __forceinline__ XcdBarrier xcd_barrier_post(unsigned* bar, volatile LAS unsigned* st) {
    XcdBarrier b; b.bar = bar; b.x = xb_xcc_id(); b.st = st;
    if (threadIdx.x == 0) (void)xb_add(&bar[XB_XCNT(b.x)], 1u);
    return b;
}
__device__ __forceinline__ void xcd_barrier_complete(unsigned* bar, unsigned x, unsigned& nloc, unsigned& nx) {
    const unsigned G = gridDim.x * gridDim.y * gridDim.z;
    unsigned sum, cnt, mine, sp = 0u;
    for (;;) {
        sum = 0u; cnt = 0u; mine = 0u;
#pragma unroll
        for (unsigned j = 0; j < 16; ++j) { const unsigned c = xb_ld(&bar[XB_XCNT(j)]); sum += c; cnt += (c > 0u) ? 1u : 0u; mine = (j == x) ? c : mine; }
        if (sum == G) break;
        __builtin_amdgcn_s_sleep(1);
        if ((++sp & 255u) == 0u) { if (xb_ld(&bar[XB_TMO])) break; if (sp > XB_SPIN_CAP) { atomicAdd(&bar[XB_TMO], 1u); break; } }
    }
    nloc = mine > 0u ? mine : 1u; nx = cnt > 0u ? cnt : 1u;
}

__device__ __forceinline__ void xcd_barrier(const XcdBarrier& b) {
    asm volatile("s_waitcnt vmcnt(0)" ::: "memory");
    __syncthreads();
    if (threadIdx.x == 0) {
        unsigned* bar = b.bar;
        __builtin_amdgcn_s_waitcnt(0);
        unsigned nloc = b.st[0], nx = b.st[1];
        if (nloc == 0u) { xcd_barrier_complete(bar, b.x, nloc, nx); b.st[0] = nloc; b.st[1] = nx; }
        const unsigned old = xb_add(&bar[XB_XSUB(b.x)], 1u);
        const unsigned gen = old / nloc;
        if (old + 1u == (gen + 1u) * nloc) {
            __builtin_amdgcn_fence(__ATOMIC_RELEASE, "agent");
            asm volatile("s_waitcnt vmcnt(0)" ::: "memory");
            const unsigned og = xb_add(&bar[XB_TOP], 1u);
            const unsigned tg = og / nx;
            if (og + 1u == (tg + 1u) * nx) xb_add(&bar[XB_TOPGEN], 1u);
            else XB_SPIN(xb_ld(&bar[XB_TOPGEN]) == tg, bar);
            __builtin_amdgcn_fence(__ATOMIC_ACQUIRE, "agent");
            xb_add(&bar[XB_XGEN(b.x)], 1u);
            asm volatile("s_waitcnt vmcnt(0)" ::: "memory");
        } else {
            XB_SPIN(xb_ld(&bar[XB_XGEN(b.x)]) == gen, bar);
            __builtin_amdgcn_fence(__ATOMIC_ACQUIRE, "agent");
            asm volatile("s_waitcnt vmcnt(0)" ::: "memory");
        }
    }
    __syncthreads();
}
namespace att {
using bf16x8 = __attribute__((ext_vector_type(8))) short;
using s16x4  = __attribute__((ext_vector_type(4))) short;
using f32x16 = __attribute__((ext_vector_type(16))) float;
using f32x4v = __attribute__((ext_vector_type(4))) float;
using u32x4  = __attribute__((ext_vector_type(4))) unsigned;
constexpr int NW = 8, QBLK = 32, KVBLK = 64;
constexpr float THRL = 6.f;
#define ASBAR() __builtin_amdgcn_sched_barrier(0)
__device__ __forceinline__ int crow(int r, int hi) { return (r & 3) + 8 * (r >> 2) + 4 * hi; }
__device__ __forceinline__ unsigned cvtpk(float lo, float hi) { unsigned r; asm volatile("v_cvt_pk_bf16_f32 %0, %1, %2" : "=v"(r) : "v"(lo), "v"(hi)); return r; }
template <int DQK> struct Cfg {
    static constexpr int KROW = DQK * 2 + 16;
    static constexpr int SHM_V = 8192, SHM_K = 64 * KROW;
    static constexpr int OFF_V = 0, OFF_K = 2 * SHM_V, OFF_WS = OFF_K + 2 * SHM_K, OFF_OST = OFF_WS + NW * 256, OSTW = 32 * 68 * 4, END = OFF_OST + NW * OSTW;
    static constexpr int KCH = DQK / 8;
};
__device__ __forceinline__ int v_st(int k, int c) { const int kk = k; return ((kk >> 3) * 2 + (c >> 5)) * 512 + ((kk & 7) * 32 + (c & 31)) * 2; }
__device__ __forceinline__ int v_rd_base(int lane) { return ((lane & 3) << 3) | (((lane >> 2) & 3) << 6) | (((lane >> 4) & 1) << 5) | (((lane >> 5) & 1) << 8); }
constexpr int v_rd_off(int d0, int ks, int half) { return d0 * 512 + ks * 2048 + half * 1024; }
template <int OFF> __device__ __forceinline__ s16x4 tr_read(int vb) { s16x4 r; asm volatile("ds_read_b64_tr_b16 %0, %1 offset:%2" : "=&v"(r) : "v"(vb), "i"(OFF) : "memory"); return r; }
struct VFr { s16x4 l0, h0, l1, h1, l2, h2, l3, h3, m0, n0, m1, n1, m2, n2, m3, n3; };
__device__ __forceinline__ void pv_issue(VFr& v, int vb) {
    v.l0 = tr_read<v_rd_off(0, 0, 0)>(vb); v.h0 = tr_read<v_rd_off(0, 0, 1)>(vb); v.l1 = tr_read<v_rd_off(0, 1, 0)>(vb); v.h1 = tr_read<v_rd_off(0, 1, 1)>(vb);
    v.l2 = tr_read<v_rd_off(0, 2, 0)>(vb); v.h2 = tr_read<v_rd_off(0, 2, 1)>(vb); v.l3 = tr_read<v_rd_off(0, 3, 0)>(vb); v.h3 = tr_read<v_rd_off(0, 3, 1)>(vb);
    v.m0 = tr_read<v_rd_off(1, 0, 0)>(vb); v.n0 = tr_read<v_rd_off(1, 0, 1)>(vb); v.m1 = tr_read<v_rd_off(1, 1, 0)>(vb); v.n1 = tr_read<v_rd_off(1, 1, 1)>(vb);
    v.m2 = tr_read<v_rd_off(1, 2, 0)>(vb); v.n2 = tr_read<v_rd_off(1, 2, 1)>(vb); v.m3 = tr_read<v_rd_off(1, 3, 0)>(vb); v.n3 = tr_read<v_rd_off(1, 3, 1)>(vb);
}
__device__ __forceinline__ void pv_mma(f32x16* o, const VFr& v, bf16x8 pa0, bf16x8 pa1, bf16x8 pa2, bf16x8 pa3) {
#define ATT_PK(L, H) (bf16x8){L[0], L[1], L[2], L[3], H[0], H[1], H[2], H[3]}
    asm volatile("s_waitcnt lgkmcnt(0)" ::: "memory"); ASBAR();
    o[0] = __builtin_amdgcn_mfma_f32_32x32x16_bf16(pa0, ATT_PK(v.l0, v.h0), o[0], 0, 0, 0);
    o[1] = __builtin_amdgcn_mfma_f32_32x32x16_bf16(pa0, ATT_PK(v.m0, v.n0), o[1], 0, 0, 0);
    o[0] = __builtin_amdgcn_mfma_f32_32x32x16_bf16(pa1, ATT_PK(v.l1, v.h1), o[0], 0, 0, 0);
    o[1] = __builtin_amdgcn_mfma_f32_32x32x16_bf16(pa1, ATT_PK(v.m1, v.n1), o[1], 0, 0, 0);
    o[0] = __builtin_amdgcn_mfma_f32_32x32x16_bf16(pa2, ATT_PK(v.l2, v.h2), o[0], 0, 0, 0);
    o[1] = __builtin_amdgcn_mfma_f32_32x32x16_bf16(pa2, ATT_PK(v.m2, v.n2), o[1], 0, 0, 0);
    o[0] = __builtin_amdgcn_mfma_f32_32x32x16_bf16(pa3, ATT_PK(v.l3, v.h3), o[0], 0, 0, 0);
    o[1] = __builtin_amdgcn_mfma_f32_32x32x16_bf16(pa3, ATT_PK(v.m3, v.n3), o[1], 0, 0, 0);
#undef ATT_PK
}

__device__ __forceinline__ float rowmax32(const f32x16& p0, const f32x16& p1) {
#define ATT_MX3(a, b, c) __builtin_fmaxf(__builtin_fmaxf((a), (b)), (c))
    float a = ATT_MX3(p0[0], p0[1], p1[0]), b = ATT_MX3(p0[2], p0[3], p1[1]); a = ATT_MX3(a, p1[2], p1[3]);
#pragma unroll
    for (int r = 4; r < 16; r += 4) { a = ATT_MX3(a, p0[r], p0[r + 1]); b = ATT_MX3(b, p0[r + 2], p0[r + 3]); a = ATT_MX3(a, p1[r], p1[r + 1]); b = ATT_MX3(b, p1[r + 2], p1[r + 3]); }
#undef ATT_MX3
    float m = __builtin_fmaxf(a, b);
    auto rr = __builtin_amdgcn_permlane32_swap(__float_as_uint(m), __float_as_uint(m), false, false);
    return __builtin_fmaxf(__uint_as_float(rr[0]), __uint_as_float(rr[1]));
}
template <int DQK> __device__ __forceinline__ void qkt2(f32x16& p0, f32x16& p1, const char* Ks, const bf16x8* qr, const f32x16& negm, int r32, int hi) {
    constexpr int KROW = Cfg<DQK>::KROW;
#pragma unroll
    for (int d0 = 0; d0 < DQK / 16; ++d0) { const int cb = (d0 * 16 + hi * 8) * 2;
        const bf16x8 b0 = *reinterpret_cast<const bf16x8*>(Ks + r32 * KROW + cb);
        const bf16x8 b1 = *reinterpret_cast<const bf16x8*>(Ks + (32 + r32) * KROW + cb);
        if (d0 == 0) { p0 = __builtin_amdgcn_mfma_f32_32x32x16_bf16(b0, qr[0], negm, 0, 0, 0); p1 = __builtin_amdgcn_mfma_f32_32x32x16_bf16(b1, qr[0], negm, 0, 0, 0); }
        else { p0 = __builtin_amdgcn_mfma_f32_32x32x16_bf16(b0, qr[d0], p0, 0, 0, 0); p1 = __builtin_amdgcn_mfma_f32_32x32x16_bf16(b1, qr[d0], p1, 0, 0, 0); } }
}
template <int DQK> struct Cfg2 {
    static constexpr int KROW = DQK * 2 + 16, SHM_V = 8192, SHM_K = 64 * KROW;
    static constexpr int OFF_V = 0, OFF_K = 3 * SHM_V, OFF_WS = OFF_K + 2 * SHM_K, OFF_OST = OFF_WS + NW * 256, OSTW = 32 * 68 * 4, END = OFF_OST + NW * OSTW;
};
__device__ __forceinline__ float softmax_tile(f32x16& p0, f32x16& p1, float& mhat, f32x16& negm, float& l_reg, bool first, bf16x8& pa0, bf16x8& pa1, bf16x8& pa2, bf16x8& pa3) {
    const float pmax = rowmax32(p0, p1);
    float alpha = 1.f;
    if (__builtin_expect(first || __any(pmax > THRL), 0)) { const float dl = first ? pmax : __builtin_fmaxf(pmax, 0.f); mhat += dl;
#pragma unroll
        for (int r = 0; r < 16; ++r) { p0[r] -= dl; p1[r] -= dl; }
#pragma unroll
        for (int r = 0; r < 16; ++r) negm[r] = -mhat;
        if (!first) alpha = __builtin_amdgcn_exp2f(-dl); }
#pragma unroll
    for (int r = 0; r < 16; ++r) { p0[r] = __builtin_amdgcn_exp2f(p0[r]); p1[r] = __builtin_amdgcn_exp2f(p1[r]); }
    float ps = 0;
#pragma unroll
    for (int r = 0; r < 16; ++r) ps += p0[r];
#pragma unroll
    for (int r = 0; r < 16; ++r) ps += p1[r];
    { auto rr = __builtin_amdgcn_permlane32_swap(__float_as_uint(ps), __float_as_uint(ps), false, false); ps = __uint_as_float(rr[0]) + __uint_as_float(rr[1]); }
    l_reg = l_reg * alpha + ps;
#define ATT_PK4(P, BASE, OUT) do { u32x4 w = {cvtpk(P[BASE + 0], P[BASE + 1]), cvtpk(P[BASE + 2], P[BASE + 3]), cvtpk(P[BASE + 4], P[BASE + 5]), cvtpk(P[BASE + 6], P[BASE + 7])}; \
    OUT = *reinterpret_cast<bf16x8*>(&w); } while (0)
    ATT_PK4(p0, 0, pa0); ATT_PK4(p0, 8, pa1); ATT_PK4(p1, 0, pa2); ATT_PK4(p1, 8, pa3);
#undef ATT_PK4
    return alpha;
}
__device__ __forceinline__ void softmax_fast(f32x16& p0, f32x16& p1, float& l_reg  , float& bad, bf16x8& pa0, bf16x8& pa1, bf16x8& pa2, bf16x8& pa3) {
#pragma unroll
    for (int r = 0; r < 16; ++r) { p0[r] = __builtin_amdgcn_exp2f(p0[r]); p1[r] = __builtin_amdgcn_exp2f(p1[r]); }
    float ps = 0;
#pragma unroll
    for (int r = 0; r < 16; ++r) ps += p0[r];
#pragma unroll
    for (int r = 0; r < 16; ++r) ps += p1[r];
    bad = (ps < 1.152921504606846976e18f) ? bad : 1.f;
    l_reg += ps;
#define ATT_PK4(P, BASE, OUT) do { u32x4 w = {cvtpk(P[BASE + 0], P[BASE + 1]), cvtpk(P[BASE + 2], P[BASE + 3]), cvtpk(P[BASE + 4], P[BASE + 5]), cvtpk(P[BASE + 6], P[BASE + 7])}; \
    OUT = *reinterpret_cast<bf16x8*>(&w); } while (0)
    ATT_PK4(p0, 0, pa0); ATT_PK4(p0, 8, pa1); ATT_PK4(p1, 0, pa2); ATT_PK4(p1, 8, pa3);
#undef ATT_PK4
}
template <int DQK, bool FAST = false>
__device__ __forceinline__ bool attn_unit(const bf16_t* __restrict__ Qb, int ldq, const bf16_t* __restrict__ Kh, int ldk, const bf16_t* __restrict__ Kr  ,
                                          const bf16_t* __restrict__ Vh, int ldv, int seq, bf16_t* __restrict__ Ob, const bf16_t* __restrict__ Gb, char* lds, int tid, int par = 0  ) {
    using C = Cfg2<DQK>;
    constexpr int KROW = C::KROW, KCH = DQK / 8, SHM_V = C::SHM_V, SHM_K = C::SHM_K;
    const int wid = __builtin_amdgcn_readfirstlane(tid >> 6), lane = tid & 63, r32 = lane & 31, hi = lane >> 5; const bool h1 = wid >= 4;
    char* V_lds = lds + C::OFF_V; char* K_lds = lds + C::OFF_K;
    float* ws = (float*)(lds + C::OFF_WS) + wid * 64; float* li_l = ws; float* al_l = ws + 32;
    float mhat = 0.f, l_reg = 0.f; f32x16 o[2] = {}; f32x16 negm = {}; bf16x8 qr[DQK / 16];
    const bf16_t* Qw = Qb + (size_t)(wid * QBLK + r32) * ldq + hi * 8;
#pragma unroll
    for (int d0 = 0; d0 < DQK / 16; ++d0) qr[d0] = *reinterpret_cast<const bf16x8*>(Qw + d0 * 16);
    const int vk = tid >> 3, vc = (tid & 7) * 8, vst = v_st(vk, vc);
    const int kr0 = tid / KCH, kc0 = (tid % KCH) * 8, kr1 = (512 + tid) / KCH, kc1 = ((512 + tid) % KCH) * 8;
    const bool two = (KCH * 64 > 512) && (tid < KCH * 64 - 512);
    const int vb0 = (int)(uintptr_t)V_lds + v_rd_base(lane);
    bf16x8 s_vs, s_k0, s_k1;
    const bf16_t* ksrc0 = (kc0 < 64) ? Kh + (size_t)kr0 * ldk + kc0 : Kr + (size_t)kr0 * 32 + (kc0 - 64); const int kst0 = (kc0 < 64) ? ldk : 32;
    const bf16_t* ksrc1 = (kc1 < 64) ? Kh + (size_t)kr1 * ldk + kc1 : Kr + (size_t)kr1 * 32 + (kc1 - 64); const int kst1 = (kc1 < 64) ? ldk : 32;
#define ATT_SLOAD(k0) do { s_vs = *reinterpret_cast<const bf16x8*>(Vh + (size_t)((k0) + vk) * ldv + vc); \
    s_k0 = *reinterpret_cast<const bf16x8*>(ksrc0 + (size_t)(k0) * kst0); \
    if (two) s_k1 = *reinterpret_cast<const bf16x8*>(ksrc1 + (size_t)(k0) * kst1); } while (0)
#define ATT_SWRITE(kb, vs) do { *(bf16x8*)(V_lds + (vs) + vst) = s_vs; *(bf16x8*)(K_lds + (kb) * SHM_K + kr0 * KROW + kc0 * 2) = s_k0; \
    if (two) *(bf16x8*)(K_lds + (kb) * SHM_K + kr1 * KROW + kc1 * 2) = s_k1; } while (0)
#define ATT_RESC(a) do { if (__any((a) < 1.f)) { if (hi == 0) al_l[r32] = (a); asm volatile("s_waitcnt lgkmcnt(0)" ::: "memory"); \
    _Pragma("unroll") for (int d = 0; d < 2; ++d) _Pragma("unroll") for (int r = 0; r < 16; ++r) o[d][r] *= al_l[crow(r, hi)]; } } while (0)
    f32x16 p0, p1; bf16x8 pa0, pa1, pa2, pa3; const int NT = seq / KVBLK; float bad = 0.f, l_part = 0.f;
    int vsr = 0, vsw = 2 * SHM_V;
#define ATT_ROT() do { vsr = (vsr == 2 * SHM_V) ? 0 : vsr + SHM_V; vsw = (vsw == 2 * SHM_V) ? 0 : vsw + SHM_V; } while (0)
    ATT_SLOAD(0); ATT_SWRITE(0, 0); __syncthreads(); ATT_SLOAD(KVBLK);
    unsigned* latch = (unsigned*)(lds + C::END);
    if (FAST && tid == 0) latch[par ^ 1] = 0u;
    ASBAR(); qkt2<DQK>(p0, p1, K_lds, qr, negm, r32, hi);
    if (!h1) { (void)softmax_tile(p0, p1, mhat, negm, l_reg, true, pa0, pa1, pa2, pa3); }
    VFr vf;
    if (!h1) pv_issue(vf, vb0);
    ATT_SWRITE(1, SHM_V); __syncthreads(); if (2 < NT) ATT_SLOAD(2 * KVBLK);
#define ATT_STAGE() do { if (t + 2 < NT) { ATT_SWRITE(t & 1, vsw); if (t + 3 < NT) ATT_SLOAD((t + 3) * KVBLK); } } while (0)
    for (int t = 0; t < NT; ++t) {
        if (h1) { pv_issue(vf, vb0 + vsr);
            if (FAST && t > 0) softmax_fast(p0, p1, l_part, bad, pa0, pa1, pa2, pa3);
            else { const float al = softmax_tile(p0, p1, mhat, negm, l_reg, t == 0, pa0, pa1, pa2, pa3); ATT_RESC(al); }
            ATT_STAGE(); }
        ASBAR(); pv_mma(o, vf, pa0, pa1, pa2, pa3);
        if (!h1) ATT_STAGE();
        if (t + 1 < NT) {
            ASBAR(); qkt2<DQK>(p0, p1, K_lds + ((t + 1) & 1) * SHM_K, qr, negm, r32, hi);
            if (!h1) { const int vnx = vb0 + ((vsr == 2 * SHM_V) ? 0 : vsr + SHM_V);
                       if (FAST) { pv_issue(vf, vnx); softmax_fast(p0, p1, l_part, bad, pa0, pa1, pa2, pa3); }
                       else { const float al = softmax_tile(p0, p1, mhat, negm, l_reg, false, pa0, pa1, pa2, pa3); ATT_RESC(al); pv_issue(vf, vnx); } }
            __syncthreads();
            ATT_ROT();
        }
    }
#undef ATT_STAGE
    u32x4 gt_[4];
#pragma unroll
    for (int i = 0; i < 4; ++i) gt_[i] = *(const u32x4*)(Gb + (size_t)(wid * QBLK + i * 8 + (lane >> 3)) * 1024 + (lane & 7) * 8);
    if (FAST) { auto rr = __builtin_amdgcn_permlane32_swap(__float_as_uint(l_part), __float_as_uint(l_part), false, false); l_reg += __uint_as_float(rr[0]) + __uint_as_float(rr[1]); }
    if (hi == 0) li_l[r32] = l_reg; asm volatile("s_waitcnt lgkmcnt(0)" ::: "memory");
    float* stg = (float*)(lds + C::OFF_OST + wid * C::OSTW);
#pragma unroll
    for (int r = 0; r < 16; ++r) { const int orow = crow(r, hi); const float rli = __builtin_amdgcn_rcpf(li_l[orow]);
        stg[orow * 68 + r32] = o[0][r] * rli; stg[orow * 68 + 32 + r32] = o[1][r] * rli; }
    asm volatile("s_waitcnt lgkmcnt(0)" ::: "memory");
#pragma unroll
    for (int i = 0; i < 4; ++i) { const int row = i * 8 + (lane >> 3), ch = (lane & 7) * 8;
        const f32x4v a = *(const f32x4v*)(stg + row * 68 + ch), b = *(const f32x4v*)(stg + row * 68 + ch + 4);
        const size_t off = (size_t)(wid * QBLK + row) * 1024 + ch; const u32x4 g = gt_[i]; u32x4 w;
        w.x = cvtpk(a[0] * __uint_as_float(g.x << 16), a[1] * __uint_as_float(g.x & 0xffff0000u)); w.y = cvtpk(a[2] * __uint_as_float(g.y << 16), a[3] * __uint_as_float(g.y & 0xffff0000u));
        w.z = cvtpk(b[0] * __uint_as_float(g.z << 16), b[1] * __uint_as_float(g.z & 0xffff0000u)); w.w = cvtpk(b[2] * __uint_as_float(g.w << 16), b[3] * __uint_as_float(g.w & 0xffff0000u));
        *(u32x4*)(Ob + off) = w; }
    bool redo = false;
    if (FAST) { if (__any(bad != 0.f) && lane == 0) latch[par] = 1u; __syncthreads(); redo = (latch[par] != 0u); } else __syncthreads();
#undef ATT_SLOAD
#undef ATT_SWRITE
#undef ATT_RESC
#undef ATT_ROT
    return redo;
}
#undef ASBAR
}
namespace fft {
using bf16x8 = __attribute__((ext_vector_type(8))) short;
using s16x4  = __attribute__((ext_vector_type(4))) short;
using f32x16 = __attribute__((ext_vector_type(16))) float;
using f32x4v = __attribute__((ext_vector_type(4))) float;
using u32x4  = __attribute__((ext_vector_type(4))) unsigned;
constexpr int OFF_X = 0, OFF_STG = 65536;
__device__ __forceinline__ int crow(int r, int hi) { return (r & 3) + 8 * (r >> 2) + 4 * hi; }
__device__ __forceinline__ unsigned cvtpk(float lo, float hi) { unsigned r; asm volatile("v_cvt_pk_bf16_f32 %0, %1, %2" : "=v"(r) : "v"(lo), "v"(hi)); return r; }
__device__ __forceinline__ int x_st(int kk, int c) { const int kp = (kk & ~0xC) | ((kk & 4) << 1) | ((kk & 8) >> 1); return ((kp >> 3) * 8 + (c >> 5)) * 512 + ((kp & 7) * 32 + (c & 31)) * 2; }
__device__ __forceinline__ int x_rd_base(int lane) { return ((lane & 3) << 3) | (((lane >> 2) & 3) << 6) | (((lane >> 4) & 1) << 5) | (((lane >> 5) & 1) << 8); }
constexpr int x_rd_off(int nb, int ks, int half) { return ks * 8192 + half * 4096 + nb * 512; }
template <int OFF> __device__ __forceinline__ s16x4 tr_read(int vb) { s16x4 r; asm volatile("ds_read_b64_tr_b16 %0, %1 offset:%2" : "=&v"(r) : "v"(vb), "i"(OFF) : "memory"); return r; }
template <int NB> __device__ __forceinline__ void mm_block(f32x16& acc, const bf16x8 (&afr)[8], int vb) {
#define FFT_PK(L, H) (bf16x8){L[0], L[1], L[2], L[3], H[0], H[1], H[2], H[3]}
    { const s16x4 l0 = tr_read<x_rd_off(NB, 0, 0)>(vb), h0 = tr_read<x_rd_off(NB, 0, 1)>(vb), l1 = tr_read<x_rd_off(NB, 1, 0)>(vb), h1 = tr_read<x_rd_off(NB, 1, 1)>(vb);
      const s16x4 l2 = tr_read<x_rd_off(NB, 2, 0)>(vb), h2 = tr_read<x_rd_off(NB, 2, 1)>(vb), l3 = tr_read<x_rd_off(NB, 3, 0)>(vb), h3 = tr_read<x_rd_off(NB, 3, 1)>(vb);
      asm volatile("s_waitcnt lgkmcnt(0)" ::: "memory"); __builtin_amdgcn_sched_barrier(0);
      acc = __builtin_amdgcn_mfma_f32_32x32x16_bf16(afr[0], FFT_PK(l0, h0), acc, 0, 0, 0); acc = __builtin_amdgcn_mfma_f32_32x32x16_bf16(afr[1], FFT_PK(l1, h1), acc, 0, 0, 0);
      acc = __builtin_amdgcn_mfma_f32_32x32x16_bf16(afr[2], FFT_PK(l2, h2), acc, 0, 0, 0); acc = __builtin_amdgcn_mfma_f32_32x32x16_bf16(afr[3], FFT_PK(l3, h3), acc, 0, 0, 0); }
    { const s16x4 l0 = tr_read<x_rd_off(NB, 4, 0)>(vb), h0 = tr_read<x_rd_off(NB, 4, 1)>(vb), l1 = tr_read<x_rd_off(NB, 5, 0)>(vb), h1 = tr_read<x_rd_off(NB, 5, 1)>(vb);
      const s16x4 l2 = tr_read<x_rd_off(NB, 6, 0)>(vb), h2 = tr_read<x_rd_off(NB, 6, 1)>(vb), l3 = tr_read<x_rd_off(NB, 7, 0)>(vb), h3 = tr_read<x_rd_off(NB, 7, 1)>(vb);
      asm volatile("s_waitcnt lgkmcnt(0)" ::: "memory"); __builtin_amdgcn_sched_barrier(0);
      acc = __builtin_amdgcn_mfma_f32_32x32x16_bf16(afr[4], FFT_PK(l0, h0), acc, 0, 0, 0); acc = __builtin_amdgcn_mfma_f32_32x32x16_bf16(afr[5], FFT_PK(l1, h1), acc, 0, 0, 0);
      acc = __builtin_amdgcn_mfma_f32_32x32x16_bf16(afr[6], FFT_PK(l2, h2), acc, 0, 0, 0); acc = __builtin_amdgcn_mfma_f32_32x32x16_bf16(afr[7], FFT_PK(l3, h3), acc, 0, 0, 0); }
#undef FFT_PK
}
struct TileRegs { bf16x8 v[8]; };
__device__ __forceinline__ void tile_load(TileRegs& t, const bf16_t* src  , size_t rowstride, int tid) {
    const bf16_t* p = src + (size_t)(tid >> 5) * rowstride + (tid & 31) * 8;
#pragma unroll
    for (int i = 0; i < 8; ++i) t.v[i] = *reinterpret_cast<const bf16x8*>(p + (size_t)(16 * i) * rowstride);
}
__device__ __forceinline__ void tile_write(const TileRegs& t, char* xl, int tid) {
    char* p = xl + x_st(tid >> 5, (tid & 31) * 8);
#pragma unroll
    for (int i = 0; i < 8; ++i) *reinterpret_cast<bf16x8*>(p + 8192 * i) = t.v[i];
}

__device__ __forceinline__ void stage_a(const bf16_t* __restrict__ PQ, bf16_t* __restrict__ Y, char* lds, int vcu, int G) {
    const int tid = threadIdx.x, wid = tid >> 6, lane = tid & 63, r32 = lane & 31, hi = lane >> 5, w = wid & 3, nh = wid >> 2;
    char* xl = lds + OFF_X; char* stg = lds + OFF_STG + wid * 8192;
    bf16x8 afr[8];
    { const int reim = r32 >> 4, k1 = 16 * w + (r32 & 15);
#pragma unroll
      for (int ks = 0; ks < 8; ++ks) { float v[8];
#pragma unroll
          for (int j = 0; j < 8; ++j) { const int kk = 16 * ks + 8 * hi + j, s1 = kk >> 1, pq = kk & 1; const float f = (float)((k1 * s1) & 63) * (1.f / 64.f);
              const float c = __builtin_amdgcn_cosf(f) * 0.125f, s = __builtin_amdgcn_sinf(f) * 0.125f; v[j] = reim == 0 ? (pq == 0 ? c : -s) : (pq == 0 ? s : c); }
          u32x4 p = {cvtpk(v[0], v[1]), cvtpk(v[2], v[3]), cvtpk(v[4], v[5]), cvtpk(v[6], v[7])}; afr[ks] = *reinterpret_cast<bf16x8*>(&p); } }
    const int vb = (int)(uintptr_t)xl + x_rd_base(lane) + nh * 4 * 512;
    constexpr int NU = NB * 192;
    TileRegs tr;
    int u = vcu;
    if (u < NU) tile_load(tr, PQ + (size_t)(u / 192) * 128 * 49152 + (u % 192) * 256, 49152, tid);
    for (; u < NU; u += G) {
        const int b = u / 192, j = u % 192;
        tile_write(tr, xl, tid);
        __syncthreads();
        { const int un = u + G; if (un < NU) tile_load(tr, PQ + (size_t)(un / 192) * 128 * 49152 + (un % 192) * 256, 49152, tid); }
        f32x16 acc[4] = {};
        mm_block<0>(acc[0], afr, vb); mm_block<1>(acc[1], afr, vb); mm_block<2>(acc[2], afr, vb); mm_block<3>(acc[3], afr, vb);
        const int s2 = j / 3;
#pragma unroll
        for (int r = 0; r < 8; ++r) { const int kl = crow(r, hi), k1 = 16 * w + kl; const float f = (float)(k1 * s2) * (1.f / 4096.f); const float tr_ = __builtin_amdgcn_cosf(f), ti_ = __builtin_amdgcn_sinf(f);
#pragma unroll
            for (int nb = 0; nb < 4; ++nb) { const float re = acc[nb][r], im = acc[nb][r + 8];
                *(bf16_t*)(stg + kl * 256 + (nb * 32 + r32) * 2) = f2bf(tr_ * re - ti_ * im);
                *(bf16_t*)(stg + (16 + kl) * 256 + (nb * 32 + r32) * 2) = f2bf(ti_ * re + tr_ * im); } }
        asm volatile("s_waitcnt lgkmcnt(0)" ::: "memory");
#pragma unroll
        for (int i = 0; i < 8; ++i) { const int rowl = i * 4 + (lane >> 4), c16 = lane & 15; const u32x4 v = *(const u32x4*)(stg + rowl * 256 + c16 * 16);
            const int reim = rowl >> 4, k1 = 16 * w + (rowl & 15);
            *(u32x4*)(Y + ((size_t)((b * 64 + k1) * 2 + reim)) * 49152 + j * 256 + nh * 128 + c16 * 8) = v; }
        __syncthreads();
    }
}
__device__ __forceinline__ void stage_b(const bf16_t* __restrict__ Y, const bf16_t* __restrict__ SG, bf16_t* __restrict__ BR, char* lds, int vcu, int G) {
    const int tid = threadIdx.x, wid = tid >> 6, lane = tid & 63, r32 = lane & 31, hi = lane >> 5, w = wid & 1, nq = wid >> 1;
    char* xl = lds + OFF_X; float* stg = (float*)(lds + OFF_STG + wid * 8192);
    bf16x8 afr[8];
    { const int k2 = 32 * w + r32;
#pragma unroll
      for (int ks = 0; ks < 8; ++ks) { float v[8];
#pragma unroll
          for (int j = 0; j < 8; ++j) { const int kk = 16 * ks + 8 * hi + j, reim = kk >> 6, s2 = kk & 63; const float f = (float)((k2 * s2) & 63) * (1.f / 64.f);
              v[j] = reim == 0 ? __builtin_amdgcn_cosf(f) * 0.125f : -__builtin_amdgcn_sinf(f) * 0.125f; }
          u32x4 p = {cvtpk(v[0], v[1]), cvtpk(v[2], v[3]), cvtpk(v[4], v[5]), cvtpk(v[6], v[7])}; afr[ks] = *reinterpret_cast<bf16x8*>(&p); } }
    const int vb = (int)(uintptr_t)xl + x_rd_base(lane) + nq * 2 * 512;
    constexpr int NU = NB * 64 * 3;
    TileRegs tr;
    int u = vcu;
    if (u < NU) tile_load(tr, Y + (size_t)(u / 3) * 2 * 49152 + (u % 3) * 256, 768, tid);
    for (; u < NU; u += G) {
        const int bk1 = u / 3, j = u % 3, b = bk1 >> 6, k1 = bk1 & 63;
        tile_write(tr, xl, tid);
        __syncthreads();
        { const int un = u + G; if (un < NU) tile_load(tr, Y + (size_t)(un / 3) * 2 * 49152 + (un % 3) * 256, 768, tid); }
        f32x16 acc[2] = {};
        mm_block<0>(acc[0], afr, vb); mm_block<1>(acc[1], afr, vb);
#pragma unroll
        for (int r = 0; r < 16; ++r) { const int rl = crow(r, hi); stg[rl * 64 + r32] = acc[0][r]; stg[rl * 64 + 32 + r32] = acc[1][r]; }
        asm volatile("s_waitcnt lgkmcnt(0)" ::: "memory");
#pragma unroll
        for (int i = 0; i < 4; ++i) { const int rowl = i * 8 + (lane >> 3), c8 = (lane & 7) * 8;
            const f32x4v a = *(const f32x4v*)(stg + rowl * 64 + c8), c = *(const f32x4v*)(stg + rowl * 64 + c8 + 4);
            const size_t off = ((size_t)b * SEQ + k1 + 64 * (32 * w + rowl)) * 1024 + j * 256 + nq * 64 + c8; const u32x4 g = *(const u32x4*)(SG + off); u32x4 o;
            o.x = cvtpk(a[0] * __uint_as_float(g.x << 16), a[1] * __uint_as_float(g.x & 0xffff0000u)); o.y = cvtpk(a[2] * __uint_as_float(g.y << 16), a[3] * __uint_as_float(g.y & 0xffff0000u));
            o.z = cvtpk(c[0] * __uint_as_float(g.z << 16), c[1] * __uint_as_float(g.z & 0xffff0000u)); o.w = cvtpk(c[2] * __uint_as_float(g.w << 16), c[3] * __uint_as_float(g.w & 0xffff0000u));
            *(u32x4*)(BR + off) = o; }
        __syncthreads();
    }
}
}
constexpr int NWAVES = 8;
constexpr int N_PHASES = 9;
constexpr int CW_BAR = 4096;
constexpr int RING_OFF = 0, RING_BYTES = 131072;
constexpr int LDSCTL_OFF = RING_BYTES, MISC_OFF = LDSCTL_OFF + 320, RS_OFF = LDSCTL_OFF + 1024  ;
constexpr int LDS_BYTES = 147456;
static_assert(RS_OFF + 4096 <= LDS_BYTES, "LDS map");

struct Args { const void* in[19]; float* out; unsigned char* ws; int ph_lo, ph_hi, li, pad; };

__device__ __forceinline__ void prep_w_job(const float* __restrict__ W, int ldw, int K, bf16_t* __restrict__ out, int n0, int nrows, const float* __restrict__ scale, int mode, int off, int gt, int GT) {
    const int total = nrows * (K >> 3);
    for (int idx = gt; idx < total; idx += GT) {
        const int n = idx % nrows, k8 = idx / nrows; const int sc = src_col(mode, n, off);
        float v[8];
#pragma unroll
        for (int i = 0; i < 8; ++i) { const int k = k8 * 8 + i; float w = (sc >= 0) ? W[(size_t)k * ldw + sc] : 0.f; if (scale) w *= scale[k]; v[i] = w; }
        uint4 o; o.x = pk2(v[0], v[1]); o.y = pk2(v[2], v[3]); o.z = pk2(v[4], v[5]); o.w = pk2(v[6], v[7]);
        *(uint4*)(out + (size_t)(n0 + n) * K + k8 * 8) = o;
    }
}
__device__ __forceinline__ void rmsnorm_row(const float* __restrict__ xrow, const float* __restrict__ g, bf16_t* __restrict__ orow, int lane) {
    const float4* xr = (const float4*)xrow + lane; float4 v[4]; float s = 0.f;
#pragma unroll
    for (int j = 0; j < 4; ++j) { v[j] = xr[64 * j]; s += v[j].x * v[j].x + v[j].y * v[j].y + v[j].z * v[j].z + v[j].w * v[j].w; }
    const float rstd = rsqrtf(wave_sum(s) * (1.f / DM) + EPS);
    uint2* o = (uint2*)orow + lane;
#pragma unroll
    for (int j = 0; j < 4; ++j) { const float4 gv = g ? ((const float4*)g)[lane + 64 * j] : make_float4(1.f, 1.f, 1.f, 1.f);
        uint2 w; w.x = pk2(v[j].x * rstd * gv.x, v[j].y * rstd * gv.y); w.y = pk2(v[j].z * rstd * gv.z, v[j].w * rstd * gv.w); o[64 * j] = w; }
}

typedef float f32x4m __attribute__((ext_vector_type(4)));
__device__ __forceinline__ void fold1_tiles(const float* __restrict__ Wf, float* __restrict__ AG, int gw, int NGW, int lane) {
    const int li = lane & 15, lk = lane >> 4;
    for (int tile = gw; tile < 2 * 4 * 12 * 12; tile += NGW) { const int di = tile % 12, ci = (tile / 12) % 12, g = (tile / 144) & 3, pq = tile / 576;
        const int c = ci * 16 + li; int p = (lk * c) % 192; const int step = (4 * c) % 192;
        const float* wp = Wf + ((size_t)g * 192 + lk) * 192 + di * 16 + li;
        f32x4m acc = {0.f, 0.f, 0.f, 0.f};
#pragma unroll 8
        for (int m0 = 0; m0 < 192; m0 += 4) { const float f = (float)p * (1.f / 192.f); const float a = pq ? __builtin_amdgcn_sinf(f) : __builtin_amdgcn_cosf(f);
            const float b = wp[(size_t)m0 * 192];
            acc = __builtin_amdgcn_mfma_f32_16x16x4f32(a, b, acc, 0, 0, 0);
            p += step; if (p >= 192) p -= 192; }
        float* op = AG + (((size_t)pq * 4 + g) * 192 + ci * 16 + 4 * lk) * 192 + di * 16 + li;
#pragma unroll
        for (int r = 0; r < 4; ++r) op[(size_t)r * 192] = acc[r] * 0.07216878364870322f; }
}
__device__ __forceinline__ void fold2_strips(const float* __restrict__ Win1, const float* __restrict__ g1, const float* __restrict__ AG, bf16_t* __restrict__ WIN1o, int gw, int NGW, int lane) {
    const int li = lane & 15, lk = lane >> 4;
    for (int s = gw; s < 64 * 8 * 3; s += NGW) { const int ki = s & 63, pg = (s >> 6) & 7, ds = s >> 9;
        const int g = pg & 3; const float* ap = Win1 + (size_t)(ki * 16 + li) * 2048 + 192 * g + lk; const float* bp = AG + ((size_t)pg * 192 + lk) * 192 + ds * 64 + li;
        f32x4m acc[4] = {{0.f, 0.f, 0.f, 0.f}, {0.f, 0.f, 0.f, 0.f}, {0.f, 0.f, 0.f, 0.f}, {0.f, 0.f, 0.f, 0.f}};
#pragma unroll 4
        for (int c0 = 0; c0 < 192; c0 += 4) { const float a = ap[c0]; const float* b = bp + (size_t)c0 * 192;
#pragma unroll
            for (int n = 0; n < 4; ++n) acc[n] = __builtin_amdgcn_mfma_f32_16x16x4f32(a, b[16 * n], acc[n], 0, 0, 0); }
        const int k0 = ki * 16 + 4 * lk; const float4 gv = *(const float4*)(g1 + k0);
#pragma unroll
        for (int n = 0; n < 4; ++n) { uint2 w; w.x = pk2(acc[n][0] * gv.x, acc[n][1] * gv.y); w.y = pk2(acc[n][2] * gv.z, acc[n][3] * gv.w);
            *(uint2*)(WIN1o + (size_t)((pg >> 2) * 768 + g * 192 + ds * 64 + n * 16 + li) * 1024 + k0) = w; } }
}
__device__ __forceinline__ void rmsnorm_rows2(const float* __restrict__ X, const float* __restrict__ g, bf16_t* __restrict__ O, int nrows, int gw, int NGW, int lane) {
    for (int m = 2 * gw; m < nrows; m += 2 * NGW) {
        const float4* x0 = (const float4*)(X + (size_t)m * DM) + lane; const float4* x1 = x0 + DM / 4; float4 v[8]; float s0 = 0.f, s1 = 0.f;
#pragma unroll
        for (int j = 0; j < 4; ++j) { v[j] = x0[64 * j]; v[4 + j] = x1[64 * j]; }
#pragma unroll
        for (int j = 0; j < 4; ++j) { s0 += v[j].x * v[j].x + v[j].y * v[j].y + v[j].z * v[j].z + v[j].w * v[j].w; s1 += v[4 + j].x * v[4 + j].x + v[4 + j].y * v[4 + j].y + v[4 + j].z * v[4 + j].z + v[4 + j].w * v[4 + j].w; }
        const float r0 = rsqrtf(wave_sum(s0) * (1.f / DM) + EPS), r1 = rsqrtf(wave_sum(s1) * (1.f / DM) + EPS);
        uint2* o0 = (uint2*)(O + (size_t)m * DM) + lane; uint2* o1 = o0 + DM / 4;
#pragma unroll
        for (int j = 0; j < 4; ++j) { const float4 gv = g ? ((const float4*)g)[lane + 64 * j] : make_float4(1.f, 1.f, 1.f, 1.f);
            uint2 w; w.x = pk2(v[j].x * r0 * gv.x, v[j].y * r0 * gv.y); w.y = pk2(v[j].z * r0 * gv.z, v[j].w * r0 * gv.w); o0[64 * j] = w;
            uint2 z; z.x = pk2(v[4 + j].x * r1 * gv.x, v[4 + j].y * r1 * gv.y); z.y = pk2(v[4 + j].z * r1 * gv.z, v[4 + j].w * r1 * gv.w); o1[64 * j] = z; } }
}
__device__ __forceinline__ void bf16_rows2(const float* __restrict__ X, bf16_t* __restrict__ O, float* __restrict__ RS, int nrows, int gw, int NGW, int lane) {
    for (int m = 2 * gw; m < nrows; m += 2 * NGW) {
        const float4* x0 = (const float4*)(X + (size_t)m * DM) + lane; const float4* x1 = x0 + DM / 4; float4 v[8]; float s0 = 0.f, s1 = 0.f;
#pragma unroll
        for (int j = 0; j < 4; ++j) { v[j] = x0[64 * j]; v[4 + j] = x1[64 * j]; }
        uint2* o0 = (uint2*)(O + (size_t)m * DM) + lane; uint2* o1 = o0 + DM / 4;
#pragma unroll
        for (int j = 0; j < 4; ++j) { uint2 w; w.x = pk2(v[j].x, v[j].y); w.y = pk2(v[j].z, v[j].w); o0[64 * j] = w; uint2 z; z.x = pk2(v[4 + j].x, v[4 + j].y); z.y = pk2(v[4 + j].z, v[4 + j].w); o1[64 * j] = z; }
#pragma unroll
        for (int j = 0; j < 4; ++j) { s0 += v[j].x * v[j].x + v[j].y * v[j].y + v[j].z * v[j].z + v[j].w * v[j].w; s1 += v[4 + j].x * v[4 + j].x + v[4 + j].y * v[4 + j].y + v[4 + j].z * v[4 + j].z + v[4 + j].w * v[4 + j].w; }
        const float r0 = rsqrtf(wave_sum(s0) * (1.f / DM) + EPS), r1 = rsqrtf(wave_sum(s1) * (1.f / DM) + EPS);
        if (lane == 0) { RS[m] = r0; RS[m + 1] = r1; } }
}
__global__ void __launch_bounds__(NWAVES * 64, 2) mk_fwd(Args args) {
    extern __shared__ __attribute__((aligned(16))) unsigned char lds[];
    LAS unsigned char* ldsl = (LAS unsigned char*)lds;
    volatile LAS unsigned* MISC = (volatile LAS unsigned*)(ldsl + MISC_OFF);
    const int tid0 = threadIdx.x;
#define PHASE_IDS() int tid = threadIdx.x; asm volatile("" : "+v"(tid)); const int lane = tid & 63, wave = __builtin_amdgcn_readfirstlane(tid >> 6); const int gt = (int)blockIdx.x * (NWAVES * 64) + tid, gw = (int)blockIdx.x * NWAVES + wave; (void)lane; (void)wave; (void)gt; (void)gw;
    const int vcu = (gridDim.x % 8 == 0) ? ((int)blockIdx.x % 8) * ((int)gridDim.x / 8) + (int)blockIdx.x / 8 : (int)blockIdx.x;
    const int G = gridDim.x, GT = G * NWAVES * 64, NGW = G * NWAVES;
    unsigned char* ws = args.ws;
    gu32* ctl = (gu32*)(ws + WS_CTL);
#define in_x ((const float*)args.in[0])
#define in_mem ((const float*)args.in[1])
#define in_pos ((const int*)args.in[2])
#define in_g0 ((const float*)args.in[3])
#define in_w_in0 ((const float*)args.in[4])
#define in_gq ((const float*)args.in[5])
#define in_gkv ((const float*)args.in[6])
#define in_w_uq ((const float*)args.in[7])
#define in_w_ukv ((const float*)args.in[8])
#define in_gm0 ((const float*)args.in[9])
#define in_w_mkv0 ((const float*)args.in[10])
#define in_w_out0 ((const float*)args.in[11])
#define in_g1 ((const float*)args.in[12])
#define in_w_in1 ((const float*)args.in[13])
#define in_w_fnet ((const float*)args.in[14])
#define in_gm1 ((const float*)args.in[15])
#define in_w_mkv1 ((const float*)args.in[16])
#define in_w_out1 ((const float*)args.in[17])
#define in_gf ((const float*)args.in[18])
#define in_out (args.out)
#define WIN0 ((bf16_t*)(ws + WS_WIN0))
#define WUQ ((bf16_t*)(ws + WS_WUQ))
#define WUKV ((bf16_t*)(ws + WS_WUKV))
#define WMEM ((bf16_t*)(ws + WS_WMEM))
#define WOUT0 ((bf16_t*)(ws + WS_WOUT0))
#define WOUT1 ((bf16_t*)(ws + WS_WOUT1))
#define WIN1 ((bf16_t*)(ws + WS_WIN1))
#define AGBG ((float*)(ws + WS_AGBG))
#define ROPE ((float*)(ws + WS_ROPE))
#define MEMN ((bf16_t*)(ws + WS_MEMN))
#define MEMKV ((bf16_t*)(ws + WS_MEMKV))
#define RSTD1 ((float*)(ws + WS_RSTD1))
#define RSTD0 ((float*)(ws + WS_RSTD0))
#define SSQ ((float*)(ws + WS_SSQ))
#define XN0 ((bf16_t*)(ws + WS_XN0))
#define BR ((bf16_t*)(ws + WS_BR))
#define CQ ((bf16_t*)(ws + WS_CQ))
#define CKV ((bf16_t*)(ws + WS_CKV))
#define QMEM0 ((bf16_t*)(ws + WS_QMEM0))
#define SG0 ((bf16_t*)(ws + WS_SG0))
#define Kb ((bf16_t*)(ws + WS_K))
#define KR ((bf16_t*)(ws + WS_K + 96 * MiB))
#define Qb ((bf16_t*)(ws + WS_Q))
#define Vb ((bf16_t*)(ws + WS_V))
#define X1B ((bf16_t*)(ws + WS_X1B))
#define PQ ((bf16_t*)(ws + WS_PQ))
#define QMEM1 ((bf16_t*)(ws + WS_QMEM1))
#define SG1 ((bf16_t*)(ws + WS_SG1))
#define Y ((bf16_t*)(ws + WS_Y))
    for (int u = tid0; u < (LDS_BYTES - LDSCTL_OFF) / 4; u += NWAVES * 64) ((LAS unsigned*)(ldsl + LDSCTL_OFF))[u] = 0u;
    __syncthreads();
    const XcdBarrier bar = xcd_barrier_post((unsigned*)(ctl + CW_BAR) + args.li * XCD_BAR_WORDS, MISC + 8);
#define GRID_BAR() xcd_barrier(bar)
    const int lo = args.ph_lo, hi = args.ph_hi;
#ifndef PH_MASK
#define PH_MASK 0x1ff
#endif
#define IN(k) (((PH_MASK >> (k)) & 1) && lo <= (k) && (k) < hi)
#define BOTH(k) (IN(k) && IN((k) + 1))
    LAS float* rs = (LAS float*)(ldsl + RS_OFF);

    if (IN(0)) { PHASE_IDS();
        prep_w_job(in_w_in0, 1952, 1024, WIN0, 0, 2048, in_g0, MODE_WIN0, 0, gt, GT);
        prep_w_job(in_w_mkv0, 512, 1024, WMEM, 0, 512, in_gm0, MODE_PLAIN, 0, gt, GT);
        prep_w_job(in_w_mkv1, 512, 1024, WMEM, 512, 512, in_gm1, MODE_PLAIN, 0, gt, GT);
        fold1_tiles(in_w_fnet, AGBG, gw, NGW, lane);
        for (int idx = gt; idx < T * 16; idx += GT) { const int t = idx >> 4, i = idx & 15;
            const float inv_freq = __builtin_amdgcn_exp2f((float)i * -0.83048202372184058696f);
            const float ang = (float)in_pos[t] * inv_freq; double fd = (double)ang * 0.31830988618379067154; fd -= 2.0 * floor(fd * 0.5);
            float sn, cs; sincospif((float)fd, &sn, &cs); ROPE[2 * idx] = cs; ROPE[2 * idx + 1] = sn; }
        rmsnorm_rows2(in_mem, nullptr, MEMN, 4096, gw, NGW, lane);
        bf16_rows2(in_x, XN0, RSTD0, T, gw, NGW, lane);
        if (BOTH(0)) GRID_BAR();
    }
    if (IN(1)) { PHASE_IDS();
        { pg8::Gemm g{XN0, WIN0, T, 2048, 1024}; pg8::StaticOrder S; S.init(T, 2048, G, (int)blockIdx.x);
          pg8::EpiIn0 E{CQ, CKV, QMEM0, SG0, KR, SSQ, ROPE, RSTD0};
          pg8::gemm_phase<pg8::EpiIn0, pg8::StaticOrder, true, true>(ldsl + RING_OFF, g, S, E); }
        { const int nidle = G > 64 ? G - 64 : 0;
          if (nidle == 0 || (int)blockIdx.x >= 64) { const int bi = nidle ? (int)blockIdx.x - 64 : (int)blockIdx.x, nb = nidle ? nidle : G;
              const int gtI = bi * (NWAVES * 64) + tid, GTI = nb * NWAVES * 64;
              fold2_strips(in_w_in1, in_g1, AGBG, WIN1, bi * NWAVES + wave, nb * NWAVES, lane);
              prep_w_job(in_w_uq, 1152, 384, WUQ, 0, 1280, in_gq, MODE_WUQ, 0, gtI, GTI);
              prep_w_job(in_w_ukv, 1536, 256, WUKV, 0, 1536, in_gkv, MODE_WUKV, 0, gtI, GTI);
              prep_w_job(in_w_out0, 1024, 1024, WOUT0, 0, 1024, nullptr, MODE_PLAIN, 0, gtI, GTI);
              prep_w_job(in_w_in1, 2048, 1024, WIN1, 1536, 1280, in_g1, MODE_PLAIN, 768, gtI, GTI);
              prep_w_job(in_w_out1, 1024, 1024, WOUT1, 0, 1024, nullptr, MODE_PLAIN, 0, gtI, GTI); } }
        { pg8::Gemm g{MEMN, WMEM, 4096, 1024, 1024}; pg8::StaticOrder S; S.init(4096, 1024, G, (int)blockIdx.x);
          pg8::EpiPlainB E{MEMKV, 1024, 0};
          pg8::gemm_phase<pg8::EpiPlainB, pg8::StaticOrder, true, true>(ldsl + RING_OFF, g, S, E); }
        if (BOTH(1)) GRID_BAR();
    }
    if (IN(2)) { PHASE_IDS();
        { int kq_ = 384; asm volatile("" : "+s"(kq_)); pg8::Gemm g{CQ, WUQ, T, 1280, kq_}; pg8::StaticOrder S; S.init(T, 1280, G, (int)blockIdx.x);
          pg8::EpiQup E{Qb, SSQ, ROPE};
          pg8::gemm_phase<pg8::EpiQup, pg8::StaticOrder, true, true>(ldsl + RING_OFF, g, S, E); }
        { int kk_ = 256; asm volatile("" : "+s"(kk_)); pg8::Gemm g{CKV, WUKV, T, 1536, kk_}; pg8::StaticOrder S; S.init(T, 1536, G, (int)blockIdx.x);
          pg8::EpiKVup E{Kb, Vb, SSQ};
          pg8::gemm_phase<pg8::EpiKVup, pg8::StaticOrder, true, true>(ldsl + RING_OFF, g, S, E); }
        if (BOTH(2)) GRID_BAR();
    }
    if (IN(3)) { PHASE_IDS();
        unsigned redo_mask = 0u;
        if (tid == 0) { unsigned* l2 = (unsigned*)((char*)lds + att::Cfg2<96>::END); l2[0] = 0u; l2[1] = 0u; }
        __syncthreads();
        { int it = 0;
        for (int u = vcu; u < 16 * 12 * NB; u += G, ++it) { const int qblk = u & 15, pair = u >> 4, b = pair / 12, h = pair % 12; const size_t t0 = (size_t)b * SEQ + qblk * 256;
            if (att::attn_unit<96, true>(Qb + t0 * 1152 + h * 96, 1152, Kb + (size_t)b * SEQ * 768 + h * 64, 768, KR + (size_t)b * SEQ * 32, Vb + (size_t)b * SEQ * 768 + h * 64, 768, SEQ, BR + t0 * 1024 + h * 64, SG0 + t0 * 1024 + h * 64, (char*)lds, tid, it & 1)) redo_mask |= 1u << it; } }
        if (redo_mask) { int tid2 = threadIdx.x; asm volatile("" : "+v"(tid2)); int it = 0;
        for (int u = vcu; u < 16 * 12 * NB; u += G, ++it) { if (!((redo_mask >> it) & 1u)) continue; const int qblk = u & 15, pair = u >> 4, b = pair / 12, h = pair % 12; const size_t t0 = (size_t)b * SEQ + qblk * 256;
            (void)att::attn_unit<96, false>(Qb + t0 * 1152 + h * 96, 1152, Kb + (size_t)b * SEQ * 768 + h * 64, 768, KR + (size_t)b * SEQ * 32, Vb + (size_t)b * SEQ * 768 + h * 64, 768, SEQ, BR + t0 * 1024 + h * 64, SG0 + t0 * 1024 + h * 64, (char*)lds, tid2); } }
        int tid3 = threadIdx.x; asm volatile("" : "+v"(tid3));
        for (int u = vcu; u < 16 * 4 * NB; u += G) { const int qblk = u & 15, pair = u >> 4, b = pair >> 2, h = pair & 3; const size_t t0 = (size_t)b * SEQ + qblk * 256;
            (void)att::attn_unit<64, false>(QMEM0 + t0 * 256 + h * 64, 256, MEMKV + (size_t)b * 256 * 1024 + h * 64, 1024, nullptr, MEMKV + (size_t)b * 256 * 1024 + 256 + h * 64, 1024, 256, BR + t0 * 1024 + 768 + h * 64, SG0 + t0 * 1024 + 768 + h * 64, (char*)lds, tid3); }
        if (BOTH(3)) GRID_BAR();
    }
    if (IN(4)) { PHASE_IDS();
        for (int i = tid; i < 1024; i += NWAVES * 64) rs[i] = 0.f;
        __syncthreads();
        { pg8::Gemm g{BR, WOUT0, T, 1024, 1024}; pg8::PanelOrder S; S.init(T, G, (int)blockIdx.x);
          pg8::EpiOutA E{XN0, X1B, rs};
          pg8::gemm_phase<pg8::EpiOutA, pg8::PanelOrder, true, true>(ldsl + RING_OFF, g, S, E); }
        __syncthreads();
        if (tid < 256) RSTD1[(size_t)blockIdx.x * 256 + tid] = rsqrtf(((rs[tid * 4] + rs[tid * 4 + 1]) + (rs[tid * 4 + 2] + rs[tid * 4 + 3])) * (1.f / DM) + EPS);
        if (BOTH(4)) GRID_BAR();
    }
    if (IN(5)) { PHASE_IDS();
        { pg8::Gemm g{X1B, WIN1, T, 2816, 1024}; pg8::StaticOrder S; S.init(T, 2816, G, (int)blockIdx.x);
          pg8::EpiIn1 E{PQ, QMEM1, SG1, RSTD1};
          pg8::gemm_phase<pg8::EpiIn1, pg8::StaticOrder, true, true>(ldsl + RING_OFF, g, S, E); }
        if (BOTH(5)) GRID_BAR();
    }
    if (IN(6)) { PHASE_IDS();
        fft::stage_a(PQ, Y, (char*)lds, vcu, G);
        for (int u = vcu; u < 16 * 4 * NB; u += G) { const int qblk = u & 15, pair = u >> 4, b = pair >> 2, h = pair & 3; const size_t t0 = (size_t)b * SEQ + qblk * 256;
            (void)att::attn_unit<64, false>(QMEM1 + t0 * 256 + h * 64, 256, MEMKV + (size_t)b * 256 * 1024 + 512 + h * 64, 1024, nullptr, MEMKV + (size_t)b * 256 * 1024 + 768 + h * 64, 1024, 256, BR + t0 * 1024 + 768 + h * 64, SG1 + t0 * 1024 + 768 + h * 64, (char*)lds, tid); }
        if (BOTH(6)) GRID_BAR();
    }
    if (IN(7)) { PHASE_IDS();
        fft::stage_b(Y, SG1, BR, (char*)lds, vcu, G);
        if (BOTH(7)) GRID_BAR();
    }
    if (IN(8)) { PHASE_IDS();
        __syncthreads();
        for (int i = tid; i < 1024; i += NWAVES * 64) rs[i] = 0.f;
        __syncthreads();
        { pg8::Gemm g{BR, WOUT1, T, 1024, 1024}; pg8::PanelOrder S; S.init(T, G, (int)blockIdx.x);
          pg8::EpiOutB E{X1B, rs};
          pg8::gemm_phase<pg8::EpiOutB, pg8::PanelOrder, true, true>(ldsl + RING_OFF, g, S, E); }
        asm volatile("s_waitcnt vmcnt(0)" ::: "memory");
        __syncthreads();
        for (int r0 = wave * 4; r0 < 256; r0 += NWAVES * 4) {
            uint4 v[4][2]; float rstd[4];
#pragma unroll
            for (int q = 0; q < 4; ++q) { const uint4* xb = (const uint4*)(X1B + ((size_t)blockIdx.x * 256 + r0 + q) * DM) + lane; v[q][0] = xb[0]; v[q][1] = xb[64];
                const int r = r0 + q; rstd[q] = rsqrtf(((rs[r * 4] + rs[r * 4 + 1]) + (rs[r * 4 + 2] + rs[r * 4 + 3])) * (1.f / DM) + EPS); }
#pragma unroll
            for (int j = 0; j < 2; ++j) { const float4 ga = ((const float4*)in_gf)[2 * lane + 128 * j], gb = ((const float4*)in_gf)[2 * lane + 128 * j + 1];
#pragma unroll
                for (int q = 0; q < 4; ++q) { const uint4 w = v[q][j]; const float s = rstd[q]; float4 a, b; float4* orow = (float4*)(in_out + ((size_t)blockIdx.x * 256 + r0 + q) * DM) + 2 * lane;
                    a.x = __uint_as_float(w.x << 16) * s * ga.x; a.y = __uint_as_float(w.x & 0xffff0000u) * s * ga.y; a.z = __uint_as_float(w.y << 16) * s * ga.z; a.w = __uint_as_float(w.y & 0xffff0000u) * s * ga.w;
                    b.x = __uint_as_float(w.z << 16) * s * gb.x; b.y = __uint_as_float(w.z & 0xffff0000u) * s * gb.y; b.z = __uint_as_float(w.w << 16) * s * gb.z; b.w = __uint_as_float(w.w & 0xffff0000u) * s * gb.w;
                    orow[128 * j] = a; orow[128 * j + 1] = b; } } }
    }
#undef in_x
#undef in_mem
#undef in_pos
#undef in_g0
#undef in_w_in0
#undef in_gq
#undef in_gkv
#undef in_w_uq
#undef in_w_ukv
#undef in_gm0
#undef in_w_mkv0
#undef in_w_out0
#undef in_g1
#undef in_w_in1
#undef in_w_fnet
#undef in_gm1
#undef in_w_mkv1
#undef in_w_out1
#undef in_gf
#undef in_out
#undef WIN0
#undef WUQ
#undef WUKV
#undef WMEM
#undef WOUT0
#undef WOUT1
#undef WIN1
#undef AGBG
#undef ROPE
#undef MEMN
#undef MEMKV
#undef RSTD1
#undef RSTD0
#undef SSQ
#undef XN0
#undef BR
#undef CQ
#undef CKV
#undef QMEM0
#undef SG0
#undef Kb
#undef KR
#undef Qb
#undef Vb
#undef X1B
#undef PQ
#undef QMEM1
#undef SG1
#undef Y
#undef PHASE_IDS
#undef IN
#undef BOTH
#undef GRID_BAR
}

extern "C" void kernel_launch(void* const* d_in, const int* in_sizes, int n_in, void* d_out, int out_size, void* d_ws, size_t ws_size, hipStream_t stream) {
    static int grid = 0;
    if (grid == 0) {
        if (n_in != 19 || ws_size < WS_END || out_size != T * DM) { fprintf(stderr, "kernel_launch: unexpected n_in %d / ws %zu / out %d\n", n_in, ws_size, out_size); grid = -1; return; }
        int dev = 0, cus = 0;
        if (hipGetDevice(&dev) != hipSuccess || hipDeviceGetAttribute(&cus, hipDeviceAttributeMultiprocessorCount, dev) != hipSuccess) { grid = -1; return; }
        if (hipFuncSetAttribute((const void*)mk_fwd, hipFuncAttributeMaxDynamicSharedMemorySize, LDS_BYTES) != hipSuccess) { fprintf(stderr, "kernel_launch: hipFuncSetAttribute failed\n"); grid = -1; return; }
        int per_cu = 0; (void)hipOccupancyMaxActiveBlocksPerMultiprocessor(&per_cu, (const void*)mk_fwd, NWAVES * 64, LDS_BYTES); (void)hipGetLastError();
        if (cus != 256 || per_cu < 1) fprintf(stderr, "kernel_launch: note: %d CUs, occupancy query %d (built for 256 CUs, one workgroup each)\n", cus, per_cu);
        grid = 256;
    }
    if (grid < 0) return;
    if (hipMemsetAsync((char*)d_ws + WS_CTL, 0, CTL_ZERO_BYTES, stream) != hipSuccess) { fprintf(stderr, "kernel_launch: memset failed\n"); return; }
    Args a{};
    for (int i = 0; i < 19; ++i) a.in[i] = d_in[i];
    a.out = (float*)d_out; a.ws = (unsigned char*)d_ws;
#ifndef PROBE_PHASE
    const int nl = 1; const int rlo[1] = {0}, rhi[1] = {N_PHASES};
#else
    const int nl = 3; const int rlo[3] = {0, PROBE_PHASE, PROBE_PHASE}, rhi[3] = {PROBE_PHASE + 1, PROBE_PHASE + 1, N_PHASES};
#endif
    for (int li = 0; li < nl; ++li) {
        a.ph_lo = rlo[li]; a.ph_hi = rhi[li]; a.li = li; a.pad = 0;
        hipLaunchKernelGGL(mk_fwd, dim3(grid), dim3(NWAVES * 64), LDS_BYTES, stream, a);
        const hipError_t le = hipPeekAtLastError();
        if (le != hipSuccess) { fprintf(stderr, "kernel_launch: launch %d failed: %s\n", li, hipGetErrorName(le)); break; }
    }
}
```
